# Optimizing an MI355X kernel written in HIP

```python
import math, functools
import jax, jax.numpy as jnp
from jax import lax
import numpy as np

D_MODEL = 1024
BATCH = 4
SEQ = 4096
DEPTH = 1
DEC_BATCH = 32
DEC_SEQ = 4
PAST_LEN = 8192
PAGE_SIZE = 128

D_CONV = D_MODEL
CONV_W = 3
N_HEADS = 16
HEAD_DIM = 64
N_KV = 4
GROUP = N_HEADS // N_KV
CMP_BLOCK = 32
CMP_STRIDE = 16
SEL_BLOCK = 64
N_SEL = 16
WINDOW = 512
D_PHI = 2 * HEAD_DIM
Q_BLOCK = 128
D_FF = ((8 * D_MODEL // 3 + 255) // 256) * 256
KV_W = N_KV * HEAD_DIM
IN_SIZES = (D_CONV, D_CONV, D_CONV, N_HEADS * HEAD_DIM, KV_W, KV_W, KV_W, KV_W, KV_W, KV_W, 3 * N_HEADS, 2 * D_MODEL)
IN_COLS = 3 * D_CONV + N_HEADS * HEAD_DIM + 6 * KV_W + 3 * N_HEADS + 2 * D_MODEL
EPS = 1e-6
NEG = -1e30
FORCE_BONUS = 1e3

kernel_name = 'hybrid_shortconv_nsa_alibi_adaln_step'


def rmsnorm(x, g):
    xf = x.astype(jnp.float32)
    inv = lax.rsqrt(jnp.mean(xf * xf, axis=-1, keepdims=True) + EPS)
    return (xf * inv).astype(x.dtype) * g


def alibi_slopes():
    s = 2.0 ** (-8.0 * jnp.arange(1, N_HEADS + 1, dtype=jnp.float32) / N_HEADS)
    return s.reshape(N_KV, GROUP)


def split_columns(z):
    parts, start = [], 0
    for size in IN_SIZES:
        parts.append(z[..., start:start + size])
        start += size
    return parts


def short_conv(u, u_prev, w, bias):
    t = u.shape[1]
    up = jnp.concatenate([u_prev, u], axis=1)
    y = bias + sum(w[k] * up[:, k:k + t] for k in range(CONV_W))
    return y, up[:, t:]


def compress(rows, pe, w1, w2):
    b, t, g, d = rows.shape
    nc = t // CMP_STRIDE
    halves = jnp.pad(rows, ((0, 0), (0, CMP_STRIDE), (0, 0), (0, 0))).reshape(b, nc + 1, CMP_STRIDE, g, d)
    blocks = jnp.concatenate([halves[:, :-1], halves[:, 1:]], axis=2) + pe[:, None, :]
    flat = blocks.transpose(0, 1, 3, 2, 4).reshape(b, nc, g, CMP_BLOCK * d)
    return jax.nn.gelu(flat @ w1) @ w2


def compress_kv(rows, pe, w1, w2):
    return (compress(rows[:, :, 0], pe[0], w1[0], w2[0]),
            compress(rows[:, :, 1], pe[1], w1[1], w2[1]))


def attend_block(q, gates, qpos, kc, vc, ks_t, vs_t, kw, vw, kwpos, slopes):
    b, nq = q.shape[:2]
    nc = kc.shape[1]
    ns = ks_t.shape[2]
    tq = qpos.astype(jnp.float32)
    sl = slopes[:, :, None, None]
    ci = jnp.arange(nc, dtype=jnp.int32)
    c_valid = (ci * CMP_STRIDE + CMP_BLOCK - 1)[None, :] <= qpos[:, None]
    c_dist = tq[:, None] - (ci * CMP_STRIDE).astype(jnp.float32)[None, :] - 0.5 * (CMP_BLOCK - 1)
    s_c = jnp.einsum('bqgrd,bcgd->bgrqc', q, kc).astype(jnp.float32) - sl * c_dist
    p_c = jnp.where(c_valid, jax.nn.softmax(jnp.where(c_valid, s_c, NEG), axis=-1), 0.0)
    o_c = jnp.einsum('bgrqc,bcgd->bqgrd', p_c.astype(vc.dtype), vc)
    r4 = p_c.sum(axis=2).reshape(b, N_KV, nq, ns, SEL_BLOCK // CMP_STRIDE)
    imp = r4.sum(-1) + jnp.pad(r4[..., :-1, -1], ((0, 0), (0, 0), (0, 0), (1, 0)))
    si = jnp.arange(ns, dtype=jnp.int32)
    cur = (qpos // SEL_BLOCK)[:, None]
    s_valid = (si * SEL_BLOCK)[None, :] <= qpos[:, None]
    forced = (si[None, :] == 0) | (si[None, :] == cur) | (si[None, :] == cur - 1)
    score = jnp.where(s_valid, imp + jnp.where(forced, FORCE_BONUS, 0.0), NEG)
    _, idx = lax.top_k(score, min(N_SEL, ns))
    bi = jnp.arange(b)[:, None, None, None]
    gi = jnp.arange(N_KV)[None, :, None, None]
    k_sel = ks_t[bi, gi, idx]
    v_sel = vs_t[bi, gi, idx]
    spos = idx[..., None] * SEL_BLOCK + jnp.arange(SEL_BLOCK, dtype=jnp.int32)
    tok_valid = spos <= qpos[None, None, :, None, None]
    s_dist = tq[None, None, :, None, None] - spos.astype(jnp.float32)
    s_s = jnp.einsum('bqgrd,bgqnkd->bgrqnk', q, k_sel).astype(jnp.float32) - slopes[None, :, :, None, None, None] * s_dist[:, :, None]
    p_s = jax.nn.softmax(jnp.where(tok_valid[:, :, None], s_s, NEG), axis=(-2, -1))
    o_s = jnp.einsum('bgrqnk,bgqnkd->bqgrd', p_s.astype(v_sel.dtype), v_sel)
    w_valid = (kwpos[None, :] <= qpos[:, None]) & (qpos[:, None] - kwpos[None, :] < WINDOW) & (kwpos[None, :] >= 0)
    w_dist = tq[:, None] - kwpos.astype(jnp.float32)[None, :]
    s_w = jnp.einsum('bqgrd,bkgd->bgrqk', q, kw).astype(jnp.float32) - sl * w_dist
    p_w = jax.nn.softmax(jnp.where(w_valid, s_w, NEG), axis=-1)
    o_w = jnp.einsum('bgrqk,bkgd->bqgrd', p_w.astype(vw.dtype), vw)
    o = gates[..., 0:1] * o_c + gates[..., 1:2] * o_s + gates[..., 2:3] * o_w
    return o.reshape(b, nq, N_HEADS * HEAD_DIM)


def nsa_prompt(q, gates, kv_cmp, kv_sel, kv_win, pe, w1, w2, slopes):
    b, t = q.shape[:2]
    kc, vc = compress_kv(kv_cmp, pe, w1, w2)
    sel_t = kv_sel.reshape(b, t // SEL_BLOCK, SEL_BLOCK, 2, N_KV, HEAD_DIM).transpose(3, 0, 4, 1, 2, 5)
    kw_pad = jnp.pad(kv_win, ((0, 0), (WINDOW, 0), (0, 0), (0, 0), (0, 0)))

    def one(i):
        q0 = i * Q_BLOCK
        qb = lax.dynamic_slice_in_dim(q, q0, Q_BLOCK, axis=1)
        gb = lax.dynamic_slice_in_dim(gates, q0, Q_BLOCK, axis=1)
        wb = lax.dynamic_slice_in_dim(kw_pad, q0, WINDOW + Q_BLOCK, axis=1)
        qpos = q0 + jnp.arange(Q_BLOCK, dtype=jnp.int32)
        kwpos = q0 - WINDOW + jnp.arange(WINDOW + Q_BLOCK, dtype=jnp.int32)
        return attend_block(qb, gb, qpos, kc, vc, sel_t[0], sel_t[1], wb[:, :, 0], wb[:, :, 1], kwpos, slopes)

    o = lax.map(one, jnp.arange(t // Q_BLOCK, dtype=jnp.int32))
    o = o.transpose(1, 0, 2, 3).reshape(b, t, N_HEADS * HEAD_DIM)
    keep = min(WINDOW, t)
    return o, (kv_cmp, kv_sel, kv_win[:, t - keep:])


def nsa_sample(q, gates, kv_cmp, kv_sel, kv_win, cache_cmp, cache_sel, cache_win, page_table, pe, w1, w2, slopes):
    b, s = q.shape[:2]
    past = page_table.shape[1] * cache_cmp.shape[1]
    t_all = past + s
    t_pad = -(-t_all // SEL_BLOCK) * SEL_BLOCK

    def full_rows(cache, new):
        rows = cache[page_table].reshape(b, past, 2, N_KV, HEAD_DIM)
        rows = jnp.concatenate([rows, new], axis=1)
        return jnp.pad(rows, ((0, 0), (0, t_pad - t_all), (0, 0), (0, 0), (0, 0)))

    kc, vc = compress_kv(full_rows(cache_cmp, kv_cmp), pe, w1, w2)
    sel_t = full_rows(cache_sel, kv_sel).reshape(b, t_pad // SEL_BLOCK, SEL_BLOCK, 2, N_KV, HEAD_DIM).transpose(3, 0, 4, 1, 2, 5)
    wbuf = cache_win.shape[1]
    win = jnp.concatenate([cache_win, kv_win], axis=1)
    qpos = past + jnp.arange(s, dtype=jnp.int32)
    kwpos = past - wbuf + jnp.arange(wbuf + s, dtype=jnp.int32)
    o = attend_block(q, gates, qpos, kc, vc, sel_t[0], sel_t[1], win[:, :, 0], win[:, :, 1], kwpos, slopes)
    return o, (kv_cmp, kv_sel, win[:, s:])


def layer(x, c, conv_prev, attend, w):
    b, t = x.shape[:2]
    mod = jax.nn.silu(c) @ w['w_ada'] + w['b_ada']
    sh1, sc1, g1, sh2, sc2, g2 = jnp.split(mod[:, None, :], 6, axis=-1)
    h = rmsnorm(x, w['norm1']) * (1 + sc1) + sh1
    bg, cg, xin, q, kc, vc, ks, vs, kw, vw, nsa_g, merge_g = split_columns(h @ w['w_in'])
    v, conv_new = short_conv(cg * xin, conv_prev, w['w_conv'], w['b_conv'])
    y_a = (bg * v) @ w['w_out_conv']
    qh = q.reshape(b, t, N_KV, GROUP, HEAD_DIM) * (HEAD_DIM ** -0.5)
    kvh = lambda k_, v_: jnp.stack([k_.reshape(b, t, N_KV, HEAD_DIM), v_.reshape(b, t, N_KV, HEAD_DIM)], axis=2)
    gates = jax.nn.sigmoid(nsa_g.reshape(b, t, N_KV, GROUP, 3))
    o_b, nsa_state = attend(qh, gates, kvh(kc, vc), kvh(ks, vs), kvh(kw, vw))
    y_b = o_b @ w['w_o_nsa']
    ga, gb = jnp.split(jax.nn.sigmoid(merge_g), 2, axis=-1)
    x = x + g1 * ((ga * y_a + gb * y_b) @ w['w_out'])
    h2 = rmsnorm(x, w['norm2']) * (1 + sc2) + sh2
    x = x + g2 * ((jax.nn.silu(h2 @ w['w_gate']) * (h2 @ w['w_up'])) @ w['w_down'])
    return x, nsa_state, conv_new


def setup_inputs(seed: int = 0) -> dict:
    key = jax.random.key(seed)
    k = jax.random.split(key, 28)
    n_pages = PAST_LEN // PAGE_SIZE
    n_used = DEC_BATCH * n_pages
    n_phys = n_used + (n_used + 3) // 4
    win_buf = min(WINDOW, PAST_LEN)
    kv_row = (2, N_KV, HEAD_DIM)

    def nrm(kk, shape, scale=1.0):
        return jax.random.normal(kk, shape, jnp.float32) * scale

    return {
        'x_prompt': nrm(k[0], (BATCH, SEQ, D_MODEL)),
        'x_sample': nrm(k[1], (DEC_BATCH, DEC_SEQ, D_MODEL)),
        'c_prompt': nrm(k[2], (BATCH, D_MODEL)),
        'c_sample': nrm(k[3], (DEC_BATCH, D_MODEL)),
        'cache_cmp': nrm(k[4], (DEPTH, n_phys, PAGE_SIZE) + kv_row),
        'cache_sel': nrm(k[5], (DEPTH, n_phys, PAGE_SIZE) + kv_row),
        'cache_win': nrm(k[6], (DEPTH, DEC_BATCH, win_buf) + kv_row),
        'state_conv': nrm(k[7], (DEPTH, DEC_BATCH, CONV_W - 1, D_CONV)),
        'page_table': jax.random.permutation(k[8], n_phys)[:n_used].reshape(DEC_BATCH, n_pages).astype(jnp.int32),
        'w_ada': nrm(k[9], (DEPTH, D_MODEL, 6 * D_MODEL), 0.5 * D_MODEL ** -0.5),
        'b_ada': nrm(k[10], (DEPTH, 6 * D_MODEL), 0.01),
        'norm1': 1.0 + nrm(k[11], (DEPTH, D_MODEL), 0.02),
        'w_in': nrm(k[12], (DEPTH, D_MODEL, IN_COLS), D_MODEL ** -0.5),
        'w_conv': nrm(k[13], (DEPTH, CONV_W, D_CONV), CONV_W ** -0.5),
        'b_conv': nrm(k[14], (DEPTH, D_CONV), 0.01),
        'w_out_conv': nrm(k[15], (DEPTH, D_CONV, D_MODEL), D_CONV ** -0.5),
        'pe_cmp': nrm(k[16], (DEPTH, 2, CMP_BLOCK, HEAD_DIM), 0.02),
        'w_phi1': nrm(k[17], (DEPTH, 2, CMP_BLOCK * HEAD_DIM, D_PHI), (CMP_BLOCK * HEAD_DIM) ** -0.5),
        'w_phi2': nrm(k[18], (DEPTH, 2, D_PHI, HEAD_DIM), D_PHI ** -0.5),
        'w_o_nsa': nrm(k[19], (DEPTH, N_HEADS * HEAD_DIM, D_MODEL), (N_HEADS * HEAD_DIM) ** -0.5),
        'w_out': nrm(k[20], (DEPTH, D_MODEL, D_MODEL), D_MODEL ** -0.5),
        'norm2': 1.0 + nrm(k[21], (DEPTH, D_MODEL), 0.02),
        'w_gate': nrm(k[22], (DEPTH, D_MODEL, D_FF), D_MODEL ** -0.5),
        'w_up': nrm(k[23], (DEPTH, D_MODEL, D_FF), D_MODEL ** -0.5),
        'w_down': nrm(k[24], (DEPTH, D_FF, D_MODEL), D_FF ** -0.5),
        'norm_f': 1.0 + nrm(k[25], (D_MODEL,), 0.02),
    }


def reference(x_prompt, x_sample, c_prompt, c_sample, cache_cmp, cache_sel, cache_win, state_conv, page_table,
              w_ada, b_ada, norm1, w_in, w_conv, b_conv, w_out_conv, pe_cmp, w_phi1, w_phi2, w_o_nsa, w_out,
              norm2, w_gate, w_up, w_down, norm_f):
    slopes = alibi_slopes()
    xp, xs = x_prompt, x_sample
    conv0 = jnp.zeros((xp.shape[0], CONV_W - 1, D_CONV), xp.dtype)
    st_p, st_s = [], []
    for l in range(DEPTH):
        w = dict(w_ada=w_ada[l], b_ada=b_ada[l], norm1=norm1[l], w_in=w_in[l], w_conv=w_conv[l], b_conv=b_conv[l],
                 w_out_conv=w_out_conv[l], w_o_nsa=w_o_nsa[l], w_out=w_out[l], norm2=norm2[l],
                 w_gate=w_gate[l], w_up=w_up[l], w_down=w_down[l])
        att_p = functools.partial(nsa_prompt, pe=pe_cmp[l], w1=w_phi1[l], w2=w_phi2[l], slopes=slopes)
        xp, nsa_p, conv_p = layer(xp, c_prompt, conv0, att_p, w)
        att_s = functools.partial(nsa_sample, cache_cmp=cache_cmp[l], cache_sel=cache_sel[l], cache_win=cache_win[l],
                                  page_table=page_table, pe=pe_cmp[l], w1=w_phi1[l], w2=w_phi2[l], slopes=slopes)
        xs, nsa_s, conv_s = layer(xs, c_sample, state_conv[l], att_s, w)
        st_p.append(nsa_p + (conv_p,))
        st_s.append(nsa_s + (conv_s,))
    y_prompt = rmsnorm(xp, norm_f)
    y_sample = rmsnorm(xs, norm_f)
    new_cmp_prompt = jnp.stack([s_[0] for s_ in st_p])
    new_sel_prompt = jnp.stack([s_[1] for s_ in st_p])
    new_win_prompt = jnp.stack([s_[2] for s_ in st_p])
    new_conv_prompt = jnp.stack([s_[3] for s_ in st_p])
    new_cmp_sample = jnp.stack([s_[0] for s_ in st_s])
    new_sel_sample = jnp.stack([s_[1] for s_ in st_s])
    new_win_sample = jnp.stack([s_[2] for s_ in st_s])
    new_conv_sample = jnp.stack([s_[3] for s_ in st_s])
    return (y_prompt, y_sample, new_cmp_prompt, new_sel_prompt, new_win_prompt, new_conv_prompt,
            new_cmp_sample, new_sel_sample, new_win_sample, new_conv_sample)
```

```cpp
#include <hip/hip_runtime.h>
#include <cstdio>
#include <cstdint>
namespace pg8 {
#define PG8_LAS __attribute__((address_space(3)))
typedef unsigned short bf16_t;
typedef short bf16x8 __attribute__((ext_vector_type(8)));
typedef float f32x4 __attribute__((ext_vector_type(4)));
typedef unsigned u32x4 __attribute__((ext_vector_type(4)));
constexpr int BM = 256, BK = 64, HALF = 128, HTB = HALF * BK * 2  , STAGE_BYTES = 8 * HTB, NXCD = 8, WGM = 8;

__host__ __device__ __forceinline__ int lds_byte(int r, int c) { const int st = (r >> 4) * 2 + (c >> 5), rr = r & 15, cc = c & 31, ob = rr * 64 + cc * 2; return st * 1024 + (ob ^ (((ob >> 9) & 1) << 5)); }
__host__ __device__ __forceinline__ void stage_rc(int b, int& R, int& C) { const int st = b / 1024, sb = b % 1024, swz = sb ^ (((sb >> 9) & 1) << 5); R = (st >> 1) * 16 + swz / 64; C = (st & 1) * 32 + (swz % 64) / 2; }
__host__ __device__ __forceinline__ int perm32(int rho) { const int n = rho >> 4, i = rho & 15; return 8 * (i >> 2) + 4 * n + (i & 3); }

struct Unit { int pm, pn; };
struct Gemm { const bf16_t* A; const bf16_t* Bt; int M, N, K; };

struct StaticOrder {
    int nM, nN, nwg, G, c;
    __host__ __device__ void init(int M, int N, int G_, int c_) { nM = M / BM; nN = N / BM; nwg = nM * nN; G = G_; c = c_; }
    __host__ __device__ bool next(int i, Unit& u) const {
        const long L = (long)i * G + c; if (L >= nwg) return false;
        int wgid = (int)L; { const int q = nwg / NXCD, r = nwg % NXCD, xcd = wgid % NXCD, off = wgid / NXCD; wgid = (xcd < r ? xcd * (q + 1) : r * (q + 1) + (xcd - r) * q) + off; }
        const int nig = WGM * nN, gid = wgid / nig, fm = gid * WGM, gsz = (nM - fm) < WGM ? (nM - fm) : WGM;
        u.pm = fm + ((wgid % nig) % gsz); u.pn = (wgid % nig) / gsz; return true;
    }
    __device__ __forceinline__ void a_ready(const Unit&) const {}
    __device__ __forceinline__ void done(const Unit&) const {}
};

__device__ __forceinline__ unsigned cvt_pk_bf16(float lo, float hi) { unsigned r; asm volatile("v_cvt_pk_bf16_f32 %0, %1, %2" : "=v"(r) : "v"(lo), "v"(hi)); return r; }
typedef float f32x2 __attribute__((ext_vector_type(2)));
template <class Epi, class Sched, bool ALIGN_EPI = false, bool SP2 = false>
__device__ __forceinline__ void gemm_phase(PG8_LAS unsigned char* lds, const Gemm g, const Sched& S, const Epi& E) {
    const int tid = threadIdx.x, wid = __builtin_amdgcn_readfirstlane(tid >> 6), lane = tid & 63, wr = wid >> 2, wc = wid & 3, fr = lane & 15, fq = lane >> 4;
    const int K = g.K, nt = K / BK;
    unsigned voffA[2], voffB[2];
#pragma unroll
    for (int i = 0; i < 2; ++i) { int R, C; stage_rc(tid * 16 + i * 8192, R, C); const int Rb = Epi::PERM ? ((R & ~31) + perm32(R & 31)) : R;
        voffA[i] = (unsigned)(R * K + C) * 2u; voffB[i] = (unsigned)(Rb * K + C) * 2u; }
    const size_t kstep = (size_t)(BK * 2);
    const size_t hstep = (size_t)HALF * K * 2;
    const size_t tstep = 2 * hstep;
    const unsigned ldsw = (unsigned)wid * 1024u;
    const int aoff = lds_byte(wr * 64 + fr, fq * 8), boff = lds_byte(wc * 32 + fr, fq * 8);
#define PG8_SA(b, h) (((b) * 2 + (h)) * HTB)
#define PG8_SB(b, h) ((4 + (b) * 2 + (h)) * HTB)
#define PG8_STAGE(bufoff, gbase, voff) do { _Pragma("unroll") for (int _i = 0; _i < 2; ++_i) \
        __builtin_amdgcn_global_load_lds((const unsigned*)((const char*)(gbase) + (voff)[_i]), (PG8_LAS unsigned*)(lds + (bufoff) + ldsw + _i * 8192), 16, 0, 0); } while (0)
#define PG8_LDA(dst, b, h) do { _Pragma("unroll") for (int m = 0; m < 4; ++m) _Pragma("unroll") for (int k = 0; k < 2; ++k) dst[m][k] = *(const PG8_LAS bf16x8*)(lds + PG8_SA(b, h) + aoff + m * 2048 + k * 1024); } while (0)
#define PG8_LDB(dst, b, h) do { _Pragma("unroll") for (int n = 0; n < 2; ++n) _Pragma("unroll") for (int k = 0; k < 2; ++k) dst[n][k] = *(const PG8_LAS bf16x8*)(lds + PG8_SB(b, h) + boff + n * 2048 + k * 1024); } while (0)
#define PG8_MMA(ai, bj, At, Bt) do { __builtin_amdgcn_s_setprio(1); _Pragma("unroll") for (int m = 0; m < 4; ++m) _Pragma("unroll") for (int n = 0; n < 2; ++n) _Pragma("unroll") for (int k = 0; k < 2; ++k) \
        acc[ai][bj][m][n] = __builtin_amdgcn_mfma_f32_16x16x32_bf16(Bt[n][k], At[m][k], acc[ai][bj][m][n], 0, 0, 0); __builtin_amdgcn_s_setprio(0); } while (0)
#define PG8_WAIT_V(n) asm volatile("s_waitcnt vmcnt(" #n ")" ::: "memory")
#define PG8_WAIT_L(n) asm volatile("s_waitcnt lgkmcnt(" #n ")" ::: "memory")
#define PG8_BAR __builtin_amdgcn_s_barrier()
#define PG8_SCHED __builtin_amdgcn_sched_barrier(0)
    Unit cur, nxt; int ui = 0;
    if (!S.next(0, cur)) return;
    f32x4 acc[2][2][4][2];
#pragma unroll
    for (int a = 0; a < 2; ++a)
#pragma unroll
        for (int b = 0; b < 2; ++b)
#pragma unroll
            for (int m = 0; m < 4; ++m)
#pragma unroll
                for (int n = 0; n < 2; ++n) acc[a][b][m][n] = (f32x4){0.f, 0.f, 0.f, 0.f};
    bf16x8 At[4][2], B0[2][2], B1[2][2];
    const char* cA = (const char*)g.A + (size_t)cur.pm * tstep; const char* cB = (const char*)g.Bt + (size_t)cur.pn * tstep;
    S.a_ready(cur);
    if constexpr (SP2) {
        PG8_STAGE(PG8_SB(0, 0), cB, voffB); PG8_STAGE(PG8_SB(0, 1), cB + hstep, voffB); PG8_STAGE(PG8_SA(0, 0), cA, voffA); PG8_STAGE(PG8_SA(0, 1), cA + hstep, voffA);
        if (wr == 1) PG8_BAR;
        PG8_WAIT_V(2); PG8_BAR;
        PG8_STAGE(PG8_SB(1, 0), cB + kstep, voffB); PG8_STAGE(PG8_SA(1, 0), cA + kstep, voffA); PG8_STAGE(PG8_SB(1, 1), cB + hstep + kstep, voffB);
        PG8_WAIT_V(6); PG8_BAR;
    } else {
        PG8_STAGE(PG8_SB(0, 0), cB, voffB); PG8_STAGE(PG8_SA(0, 0), cA, voffA); PG8_STAGE(PG8_SB(0, 1), cB + hstep, voffB); PG8_STAGE(PG8_SA(0, 1), cA + hstep, voffA);
        if (wr == 1) PG8_BAR;
        PG8_WAIT_V(4); PG8_BAR;
        PG8_STAGE(PG8_SB(1, 0), cB + kstep, voffB); PG8_STAGE(PG8_SA(1, 0), cA + kstep, voffA); PG8_STAGE(PG8_SB(1, 1), cB + hstep + kstep, voffB);
        PG8_WAIT_V(6); PG8_BAR;
    }
    for (;;) {
        const bool has_next = S.next(ui + 1, nxt);
        const char* nA = has_next ? (const char*)g.A + (size_t)nxt.pm * tstep : cA; const char* nB = has_next ? (const char*)g.Bt + (size_t)nxt.pn * tstep : cB;
        for (int t = 0; t < nt; t += 2) {
            const bool last = (t == nt - 2);
            const char* a1 = cA + (size_t)(t + 1) * kstep;
            const char* a2 = last ? nA : cA + (size_t)(t + 2) * kstep; const char* b2 = last ? nB : cB + (size_t)(t + 2) * kstep;
            const char* a3 = a2 + kstep; const char* b3 = b2 + kstep;
            if (last && has_next) S.a_ready(nxt);
            if constexpr (SP2) {
            PG8_LDB(B0, 0, 0); PG8_LDB(B1, 0, 1); PG8_SCHED; PG8_LDA(At, 0, 0); PG8_STAGE(PG8_SA(1, 1), a1 + hstep, voffA);
            PG8_WAIT_V(8); PG8_WAIT_L(0); PG8_BAR; PG8_MMA(0, 0, At, B0); PG8_MMA(0, 1, At, B1); PG8_BAR; PG8_SCHED;
            PG8_LDA(At, 0, 1); PG8_STAGE(PG8_SB(0, 0), b2, voffB); PG8_STAGE(PG8_SB(0, 1), b2 + hstep, voffB); PG8_STAGE(PG8_SA(0, 0), a2, voffA);
            PG8_WAIT_V(8); PG8_WAIT_L(0); PG8_BAR; PG8_MMA(1, 0, At, B0); PG8_MMA(1, 1, At, B1); PG8_BAR; PG8_SCHED;
            PG8_LDB(B0, 1, 0); PG8_LDB(B1, 1, 1); PG8_SCHED; PG8_LDA(At, 1, 0); PG8_STAGE(PG8_SA(0, 1), a2 + hstep, voffA);
            PG8_WAIT_V(8); PG8_WAIT_L(0); PG8_BAR; PG8_MMA(0, 0, At, B0); PG8_MMA(0, 1, At, B1); PG8_BAR; PG8_SCHED;
            PG8_LDA(At, 1, 1); PG8_STAGE(PG8_SB(1, 0), b3, voffB); PG8_STAGE(PG8_SB(1, 1), b3 + hstep, voffB); PG8_STAGE(PG8_SA(1, 0), a3, voffA);
            PG8_WAIT_V(8); PG8_WAIT_L(0); PG8_BAR; PG8_MMA(1, 0, At, B0); PG8_MMA(1, 1, At, B1); PG8_BAR; PG8_SCHED;
            } else {
            PG8_LDB(B0, 0, 0); PG8_SCHED; PG8_LDA(At, 0, 0); PG8_STAGE(PG8_SA(1, 1), a1 + hstep, voffA);
            PG8_WAIT_L(8); PG8_BAR; PG8_WAIT_L(0); PG8_MMA(0, 0, At, B0); PG8_BAR; PG8_SCHED;
            PG8_LDB(B1, 0, 1); PG8_STAGE(PG8_SB(0, 0), b2, voffB);
            PG8_BAR; PG8_WAIT_L(0); PG8_MMA(0, 1, At, B1); PG8_BAR;
            PG8_LDA(At, 0, 1); PG8_STAGE(PG8_SA(0, 0), a2, voffA);
            PG8_BAR; PG8_WAIT_L(0); PG8_MMA(1, 0, At, B0); PG8_BAR; PG8_SCHED;
            PG8_STAGE(PG8_SB(0, 1), b2 + hstep, voffB);
            PG8_WAIT_V(6); PG8_BAR; PG8_MMA(1, 1, At, B1); PG8_BAR;
            PG8_LDB(B0, 1, 0); PG8_SCHED; PG8_LDA(At, 1, 0); PG8_STAGE(PG8_SA(0, 1), a2 + hstep, voffA);
            PG8_WAIT_L(8); PG8_BAR; PG8_WAIT_L(0); PG8_MMA(0, 0, At, B0); PG8_BAR; PG8_SCHED;
            PG8_LDB(B1, 1, 1); PG8_STAGE(PG8_SB(1, 0), b3, voffB);
            PG8_BAR; PG8_WAIT_L(0); PG8_MMA(0, 1, At, B1); PG8_BAR;
            PG8_LDA(At, 1, 1); PG8_STAGE(PG8_SA(1, 0), a3, voffA);
            PG8_BAR; PG8_WAIT_L(0); PG8_MMA(1, 0, At, B0); PG8_BAR; PG8_SCHED;
            PG8_STAGE(PG8_SB(1, 1), b3 + hstep, voffB);
            PG8_WAIT_V(6); PG8_BAR; PG8_MMA(1, 1, At, B1); PG8_BAR;
            }
        }
        if constexpr (ALIGN_EPI) { if (wr == 0) PG8_BAR; }
        if constexpr (!Epi::AFTER_DRAIN) { E(acc, cur, wr, wc, fr, fq); S.done(cur); }
        if (!has_next) break;
#pragma unroll
        for (int a = 0; a < 2; ++a)
#pragma unroll
            for (int b = 0; b < 2; ++b)
#pragma unroll
                for (int m = 0; m < 4; ++m)
#pragma unroll
                    for (int n = 0; n < 2; ++n) acc[a][b][m][n] = (f32x4){0.f, 0.f, 0.f, 0.f};
        cur = nxt; cA = nA; cB = nB; ++ui;
        if constexpr (ALIGN_EPI) { if (wr == 1) PG8_BAR; }
    }
    PG8_WAIT_V(0);
    if constexpr (!ALIGN_EPI) { if (wr == 0) PG8_BAR; }
    PG8_BAR;
    if constexpr (Epi::AFTER_DRAIN) { E.fused(acc, cur, wr, wc, fr, fq, lds, wid, lane); S.done(cur); }
#undef PG8_SA
#undef PG8_SB
#undef PG8_STAGE
#undef PG8_LDA
#undef PG8_LDB
#undef PG8_MMA
#undef PG8_WAIT_V
#undef PG8_WAIT_L
#undef PG8_BAR
#undef PG8_SCHED
}
}
#define GAS __attribute__((address_space(1)))
#define LAS __attribute__((address_space(3)))
typedef unsigned short bf16;
typedef unsigned v4u __attribute__((ext_vector_type(4)));
typedef float f32x4 __attribute__((ext_vector_type(4)));
typedef short bf16x8 __attribute__((ext_vector_type(8)));
typedef GAS unsigned gu32;
typedef GAS unsigned long long gu64;
#define RLX_AGENT __ATOMIC_RELAXED, __HIP_MEMORY_SCOPE_AGENT
#define LDS_WAIT() asm volatile("s_waitcnt lgkmcnt(0)" ::: "memory")
#define VM_WAIT() asm volatile("s_waitcnt vmcnt(0)" ::: "memory")
__device__ __forceinline__ unsigned long long rt() { return __builtin_amdgcn_s_memrealtime(); }
__device__ __forceinline__ unsigned f2bf(float f) { unsigned u = __builtin_bit_cast(unsigned, f); return (u + 0x7fffu + ((u >> 16) & 1u)) >> 16; }
__device__ __forceinline__ unsigned pk2(float lo, float hi) { return f2bf(lo) | (f2bf(hi) << 16); }

#define XB_TMO      128
#define XB_XCNT(j)  (256  + 64 * (j))
#define XB_XSUB(j)  (1280 + 64 * (j))
#define XB_XGEN(j)  (2304 + 64 * (j))
#define XB_TOP      3328
#define XB_TOPGEN   3392
#define XCD_BAR_WORDS 3456
#define XB_SPIN_CAP (1u << 18)

__device__ __forceinline__ unsigned xb_ld(unsigned* p)              { return __hip_atomic_load(p, __ATOMIC_RELAXED, __HIP_MEMORY_SCOPE_AGENT); }
__device__ __forceinline__ unsigned xb_add(unsigned* p, unsigned v) { return __hip_atomic_fetch_add(p, v, __ATOMIC_RELAXED, __HIP_MEMORY_SCOPE_AGENT); }
__device__ __forceinline__ unsigned xb_xcc_id() { return (unsigned)__builtin_amdgcn_s_getreg((3 << 11) | 20) & 0xFu; }
#define XB_SPIN(cond, bar) do { unsigned _sp = 0; while (cond) { __builtin_amdgcn_s_sleep(1); \
    if ((++_sp & 255u) == 0u) { if (xb_ld(&(bar)[XB_TMO])) break; if (_sp > XB_SPIN_CAP) { atomicAdd(&(bar)[XB_TMO], 1u); break; } } } } while (0)

struct XcdBarrier {
    unsigned* bar; unsigned x;
    volatile LAS unsigned* st;
};

__device__ __forceinline__ XcdBarrier xcd_barrier_post(unsigned* bar, volatile LAS unsigned* st) {
    XcdBarrier b; b.bar = bar; b.x = xb_xcc_id(); b.st = st;
    if (threadIdx.x == 0) (void)xb_add(&bar[XB_XCNT(b.x)], 1u);
    return b;
}
__device__ __forceinline__ void xcd_barrier_complete(unsigned* bar, unsigned x, unsigned& nloc, unsigned& nx) {
    const unsigned G = gridDim.x * gridDim.y * gridDim.z;
    unsigned sum, cnt, mine, sp = 0u;
    for (;;) {
        sum = 0u; cnt = 0u; mine = 0u;
#pragma unroll
        for (unsigned j = 0; j < 16; ++j) { const unsigned c = xb_ld(&bar[XB_XCNT(j)]); sum += c; cnt += (c > 0u) ? 1u : 0u; mine = (j == x) ? c : mine; }
        if (sum == G) break;
        __builtin_amdgcn_s_sleep(1);
        if ((++sp & 255u) == 0u) { if (xb_ld(&bar[XB_TMO])) break; if (sp > XB_SPIN_CAP) { atomicAdd(&bar[XB_TMO], 1u); break; } }
    }
    nloc = mine > 0u ? mine : 1u; nx = cnt > 0u ? cnt : 1u;
}

__device__ __forceinline__ void xcd_barrier(const XcdBarrier& b) {
    asm volatile("s_waitcnt vmcnt(0)" ::: "memory");
    __syncthreads();
    if (threadIdx.x == 0) {
        unsigned* bar = b.bar;
        __builtin_amdgcn_s_waitcnt(0);
        unsigned nloc = b.st[0], nx = b.st[1];
        if (nloc == 0u) { xcd_barrier_complete(bar, b.x, nloc, nx); b.st[0] = nloc; b.st[1] = nx; }
        const unsigned old = xb_add(&bar[XB_XSUB(b.x)], 1u);
        const unsigned gen = old / nloc;
        if (old + 1u == (gen + 1u) * nloc) {
            __builtin_amdgcn_fence(__ATOMIC_RELEASE, "agent");
            asm volatile("s_waitcnt vmcnt(0)" ::: "memory");
            const unsigned og = xb_add(&bar[XB_TOP], 1u);
            const unsigned tg = og / nx;
            if (og + 1u == (tg + 1u) * nx) xb_add(&bar[XB_TOPGEN], 1u);
            else XB_SPIN(xb_ld(&bar[XB_TOPGEN]) == tg, bar);
            __builtin_amdgcn_fence(__ATOMIC_ACQUIRE, "agent");
            xb_add(&bar[XB_XGEN(b.x)], 1u);
            asm volatile("s_waitcnt vmcnt(0)" ::: "memory");
        } else {
            XB_SPIN(xb_ld(&bar[XB_XGEN(b.x)]) == gen, bar);
            __builtin_amdgcn_fence(__ATOMIC_ACQUIRE, "agent");
            asm volatile("s_waitcnt vmcnt(0)" ::: "memory");
        }
    }
    __syncthreads();
}

namespace cfg {
constexpr int D = 1024, NB = 4, T = 4096, M = NB * T, SB = 32, SS = 4, MS = SB * SS, PAST = 8192, PAGE = 128, NPG = PAST / PAGE;
constexpr int H = 16, HD = 64, NKV = 4, NIN = 7728, NINP = 7936, FF = 2816, NGU = 2 * FF, NMOD = 6 * D, RMOD = NB + SB, MODKC = 8;
constexpr int NCS_P = 255, NCP_P = 256, NCS_S = 511, NCP_S = 512;
constexpr float EPS = 1e-6f, NEGF = -1e30f;
constexpr size_t O_YP = 0, O_YS = 16777216, O_CMP_P = 16908288, O_SEL_P = 25296896, O_WIN_P = 33685504, O_CONV_P = 34734080,
                 O_CMP_S = 34742272, O_SEL_S = 34807808, O_WIN_S = 34873344, O_CONV_S = 43261952, O_END = 43327488;
constexpr size_t MiB = 1u << 20;
constexpr size_t WS_CTL = 0, CTL_ZERO_BYTES = 1 * MiB;
constexpr size_t WS_WIN_T = 2 * MiB, WS_WOC_T = 18 * MiB, WS_WON_T = 20 * MiB, WS_WOUT_T = 22 * MiB, WS_WGU_T = 24 * MiB, WS_WDN_T = 36 * MiB;
constexpr size_t WS_MODP = 42 * MiB, WS_MOD = 49 * MiB;
constexpr size_t WS_XN = 64 * MiB, WS_BG = 96 * MiB, WS_U = 128 * MiB, WS_Q = 160 * MiB, WS_HM = 192 * MiB, WS_GA = 240 * MiB, WS_GB = 272 * MiB, WS_NGT = 304 * MiB;
constexpr size_t WS_AA = 308 * MiB, WS_OB = 340 * MiB, WS_MG = 372 * MiB, WS_X1 = 404 * MiB, WS_P1 = 468 * MiB, WS_HF = 532 * MiB, WS_KCC = 620 * MiB, WS_SCOREH = 622 * MiB, WS_MASK = 686 * MiB;
constexpr size_t WS_XNS = 688 * MiB, WS_ZS = 689 * MiB, WS_AAS = 693 * MiB, WS_OBS = 694 * MiB, WS_MGS = 695 * MiB, WS_X1S = 696 * MiB, WS_XN2S = 697 * MiB, WS_HFS = 698 * MiB, WS_X2S = 700 * MiB;
constexpr size_t WS_KCCS = 701 * MiB, WS_SCOREHS = 733 * MiB, WS_MASKS = 735 * MiB, WS_END = 736 * MiB;
constexpr size_t HMSZ = (size_t)NB * NKV * T * HD;
constexpr int CW_BAR = 4096;
constexpr int RING_OFF = 0, RING_BYTES = 131072, LDSCTL_OFF = RING_BYTES, MISC_OFF = LDSCTL_OFF + 320, LDS_BYTES = 147456;
constexpr int NWAVES = 8, NTHR = 512;
constexpr int NPHASE = 13;
}
using namespace cfg;

struct Ctx {
    const float *x_p, *x_s, *c_p, *c_s, *cache_cmp, *cache_sel, *cache_win, *state_conv; const int* pt;
    const float *w_ada, *b_ada, *norm1, *w_in, *w_conv, *b_conv, *w_oc, *pe, *w_phi1, *w_phi2, *w_on, *w_out, *norm2, *w_gate, *w_up, *w_down, *norm_f;
    float* out;
    bf16 *WIN_T, *WOC_T, *WON_T, *WOUT_T, *WGU_T, *WDN_T;
    float *MODP, *MOD;
    bf16 *XN, *BG, *U, *Q, *HM, *GA, *GB; float* NGT;
    bf16 *AA, *OB, *MG; float *X1, *P1; bf16* HF; float *KCC, *SCOREH; unsigned long long* MASK;
    float *XNS, *ZS, *AAS, *OBS, *MGS, *X1S, *XN2S, *HFS, *X2S, *KCCS, *SCOREHS; unsigned long long* MASKS;
    LAS unsigned char* lds; int tid, lane, wave, G, bid;
};

__device__ __forceinline__ float bf2f(bf16 b) { return __uint_as_float((unsigned)b << 16); }
__device__ __forceinline__ float sigmoidf_(float x) { return 1.f / (1.f + __expf(-x)); }
__device__ __forceinline__ float siluf_(float x) { return x / (1.f + __expf(-x)); }
__device__ __forceinline__ float gelu_tanh(float x) { const float u = 0.7978845608028654f * (x + 0.044715f * x * x * x); const float e = __expf(2.f * u); const float th = 1.f - 2.f / (e + 1.f); return 0.5f * x * (1.f + th); }
__device__ __forceinline__ float wave_sum(float v) {
#pragma unroll
    for (int o = 1; o < 64; o <<= 1) v += __shfl_xor(v, o);
    return v;
}
__device__ __forceinline__ void ld8(const bf16* p, float (&v)[8]) {
    const v4u w = *(const v4u*)p;
    v[0] = __uint_as_float(w.x << 16); v[1] = __uint_as_float(w.x & 0xffff0000u); v[2] = __uint_as_float(w.y << 16); v[3] = __uint_as_float(w.y & 0xffff0000u);
    v[4] = __uint_as_float(w.z << 16); v[5] = __uint_as_float(w.z & 0xffff0000u); v[6] = __uint_as_float(w.w << 16); v[7] = __uint_as_float(w.w & 0xffff0000u);
}
__device__ __forceinline__ void ld8(const float* p, float (&v)[8]) {
    const f32x4 a = *(const f32x4*)p, b = *(const f32x4*)(p + 4);
    v[0] = a.x; v[1] = a.y; v[2] = a.z; v[3] = a.w; v[4] = b.x; v[5] = b.y; v[6] = b.z; v[7] = b.w;
}
__device__ __forceinline__ v4u pack8(const float (&v)[8]) { v4u w; w.x = pg8::cvt_pk_bf16(v[0], v[1]); w.y = pg8::cvt_pk_bf16(v[2], v[3]); w.z = pg8::cvt_pk_bf16(v[4], v[5]); w.w = pg8::cvt_pk_bf16(v[6], v[7]); return w; }
template <class TP> __device__ __forceinline__ float dot64(const TP* row, const float (&q)[64]) {
    float s = 0.f;
#pragma unroll
    for (int c = 0; c < 8; ++c) { float v[8]; ld8(row + 8 * c, v);
#pragma unroll
        for (int j = 0; j < 8; ++j) s += q[8 * c + j] * v[j]; }
    return s;
}
template <class TP> __device__ __forceinline__ void axpy64(const TP* row, float p, float (&o)[64]) {
#pragma unroll
    for (int c = 0; c < 8; ++c) { float v[8]; ld8(row + 8 * c, v);
#pragma unroll
        for (int j = 0; j < 8; ++j) o[8 * c + j] += p * v[j]; }
}

struct SrcCol { const float* W; int ld; int col; };
template <class F> __device__ __forceinline__ void transpose_item(const F& f, int K, bf16* WT, LAS float* scr, int item, int nblk, int lane) {
    const int kb = item / nblk, nb = item % nblk, k0 = 64 * kb, n0 = 32 * nb;
    const SrcCol sc = f(n0 + (lane & 31));
#pragma unroll 8
    for (int i = 0; i < 32; ++i) { const int kk = 2 * i + (lane >> 5); scr[kk * 33 + (lane & 31)] = sc.col >= 0 ? sc.W[(size_t)(k0 + kk) * sc.ld + sc.col] : 0.f; }
    LDS_WAIT(); asm volatile("" ::: "memory");
    const int c = lane & 7;
#pragma unroll
    for (int j = 0; j < 4; ++j) { const int n = (lane >> 3) + 8 * j; const LAS float* s = scr + (8 * c) * 33 + n;
        v4u o; o.x = pk2(s[0 * 33], s[1 * 33]); o.y = pk2(s[2 * 33], s[3 * 33]); o.z = pk2(s[4 * 33], s[5 * 33]); o.w = pk2(s[6 * 33], s[7 * 33]);
        *(GAS v4u*)(WT + (size_t)(n0 + n) * K + k0 + 8 * c) = o; }
    LDS_WAIT(); asm volatile("" ::: "memory");
}
struct ColIn { const float* W; __device__ __forceinline__ SrcCol operator()(int p) const {
    int s;
    if (p < 1024) s = p;
    else if (p < 3072) { const int t = (p - 1024) >> 8, w = (p - 1024) & 255; s = (w < 128) ? (1024 + 128 * t + w) : (2048 + 128 * t + (w - 128)); }
    else if (p < 5632) s = p;
    else if (p < 7680) s = 5680 + (p - 5632);
    else if (p < 7728) s = 5632 + (p - 7680);
    else s = -1;
    return SrcCol{W, NIN, s}; } };
struct ColPlain { const float* W; int ld; __device__ __forceinline__ SrcCol operator()(int p) const { return SrcCol{W, ld, p}; } };
struct ColGU { const float *Wg, *Wu; __device__ __forceinline__ SrcCol operator()(int p) const { const int t = p >> 8, w = p & 255; return (w < 128) ? SrcCol{Wg, FF, 128 * t + w} : SrcCol{Wu, FF, 128 * t + (w - 128)}; } };

__device__ __forceinline__ void mod_partial_item(const Ctx& c, int item) {
    const int kc = item / 12, cc = item % 12, k0 = kc * 128, n = cc * 512 + c.tid;
    LAS float* sc = (LAS float*)c.lds;
    for (int i = c.tid; i < RMOD * 128; i += NTHR) { const int r = i >> 7, k = i & 127; const float cv = (r < NB) ? c.c_p[r * D + k0 + k] : c.c_s[(r - NB) * D + k0 + k]; sc[i] = siluf_(cv); }
    __syncthreads();
    float acc[RMOD];
#pragma unroll
    for (int r = 0; r < RMOD; ++r) acc[r] = 0.f;
    for (int k = 0; k < 128; ++k) { const float w = c.w_ada[(size_t)(k0 + k) * NMOD + n];
#pragma unroll
        for (int r = 0; r < RMOD; ++r) acc[r] += sc[r * 128 + k] * w; }
#pragma unroll
    for (int r = 0; r < RMOD; ++r) c.MODP[((size_t)kc * RMOD + r) * NMOD + n] = acc[r];
    __syncthreads();
}
__device__ __forceinline__ void p0_prologue(const Ctx& c) {
    for (int it = c.bid; it < MODKC * 12; it += c.G) mod_partial_item(c, it);
    LAS float* scr = (LAS float*)(c.lds + c.wave * 16384);
    const int gw = c.bid * NWAVES + c.wave, NGW = c.G * NWAVES;
    constexpr int I_IN = 16 * (NINP / 32), I_SQ = 16 * 32, I_GU = 16 * (NGU / 32), I_DN = (FF / 64) * 32;
    constexpr int NITEMS = I_IN + 3 * I_SQ + I_GU + I_DN;
    for (int it = gw; it < NITEMS; it += NGW) {
        int r = it;
        if (r < I_IN) { transpose_item(ColIn{c.w_in}, D, c.WIN_T, scr, r, NINP / 32, c.lane); continue; } r -= I_IN;
        if (r < I_SQ) { transpose_item(ColPlain{c.w_oc, D}, D, c.WOC_T, scr, r, 32, c.lane); continue; } r -= I_SQ;
        if (r < I_SQ) { transpose_item(ColPlain{c.w_on, D}, D, c.WON_T, scr, r, 32, c.lane); continue; } r -= I_SQ;
        if (r < I_SQ) { transpose_item(ColPlain{c.w_out, D}, D, c.WOUT_T, scr, r, 32, c.lane); continue; } r -= I_SQ;
        if (r < I_GU) { transpose_item(ColGU{c.w_gate, c.w_up}, D, c.WGU_T, scr, r, NGU / 32, c.lane); continue; } r -= I_GU;
        transpose_item(ColPlain{c.w_down, D}, FF, c.WDN_T, scr, r, 32, c.lane);
    }
}

template <bool MODUL, bool OUT_BF16> __device__ __forceinline__ void norm_row(const float* xrow, const float* gain, const float* sh, const float* sc, void* orow, int lane) {
    const GAS f32x4* xr = (const GAS f32x4*)xrow + lane;
    f32x4 v[4]; float s = 0.f;
#pragma unroll
    for (int j = 0; j < 4; ++j) { v[j] = xr[64 * j]; s += (v[j].x * v[j].x + v[j].y * v[j].y) + (v[j].z * v[j].z + v[j].w * v[j].w); }
    const float inv = 1.0f / sqrtf(wave_sum(s) * (1.f / D) + EPS);
#pragma unroll
    for (int j = 0; j < 4; ++j) {
        const int k = 4 * lane + 256 * j;
        const f32x4 g = *(const f32x4*)(gain + k);
        f32x4 o = v[j] * inv * g;
        if (MODUL) { const f32x4 a = *(const f32x4*)(sc + k), b = *(const f32x4*)(sh + k); o = o * (a + 1.0f) + b; }
        if (OUT_BF16) { ((GAS unsigned long long*)orow)[lane + 64 * j] = (unsigned long long)pg8::cvt_pk_bf16(o.x, o.y) | ((unsigned long long)pg8::cvt_pk_bf16(o.z, o.w) << 32); }
        else { ((GAS f32x4*)orow)[lane + 64 * j] = o; }
    }
}
__device__ __forceinline__ void p1_norm1(const Ctx& c) {
    for (int r = c.bid; r < RMOD; r += c.G)
        for (int n = c.tid; n < NMOD; n += NTHR) { float s = c.b_ada[n];
#pragma unroll
            for (int kc = 0; kc < MODKC; ++kc) s += c.MODP[((size_t)kc * RMOD + r) * NMOD + n];
            c.MOD[(size_t)r * NMOD + n] = s; }
    LAS float* shl = (LAS float*)c.lds; LAS float* scl = shl + D;
    constexpr int NCH = M / 64 + SB;
    for (int ch = c.bid; ch < NCH; ch += c.G) {
        const bool smp = ch >= M / 64; const int r = smp ? NB + (ch - M / 64) : (ch * 64) / T;
        __syncthreads();
        for (int k = c.tid; k < 2 * D; k += NTHR) { float s = c.b_ada[k];
#pragma unroll
            for (int kc = 0; kc < MODKC; ++kc) s += c.MODP[((size_t)kc * RMOD + r) * NMOD + k];
            shl[k] = s; }
        __syncthreads();
        if (!smp) { for (int rr = c.wave; rr < 64; rr += NWAVES) { const int row = ch * 64 + rr;
                const GAS f32x4* xr = (const GAS f32x4*)(c.x_p + (size_t)row * D) + c.lane; f32x4 v[4]; float s = 0.f;
#pragma unroll
                for (int j = 0; j < 4; ++j) { v[j] = xr[64 * j]; s += (v[j].x * v[j].x + v[j].y * v[j].y) + (v[j].z * v[j].z + v[j].w * v[j].w); }
                const float inv = 1.0f / sqrtf(wave_sum(s) * (1.f / D) + EPS);
#pragma unroll
                for (int j = 0; j < 4; ++j) { const int k = 4 * c.lane + 256 * j; const f32x4 g = *(const f32x4*)(c.norm1 + k);
                    const f32x4 a = *(const LAS f32x4*)(scl + k), b = *(const LAS f32x4*)(shl + k); const f32x4 o = v[j] * inv * g * (a + 1.0f) + b;
                    ((GAS unsigned long long*)(c.XN + (size_t)row * D))[c.lane + 64 * j] = (unsigned long long)pg8::cvt_pk_bf16(o.x, o.y) | ((unsigned long long)pg8::cvt_pk_bf16(o.z, o.w) << 32); } } }
        else if (c.wave < SS) { const int row = (ch - M / 64) * SS + c.wave;
                const GAS f32x4* xr = (const GAS f32x4*)(c.x_s + (size_t)row * D) + c.lane; f32x4 v[4]; float s = 0.f;
#pragma unroll
                for (int j = 0; j < 4; ++j) { v[j] = xr[64 * j]; s += (v[j].x * v[j].x + v[j].y * v[j].y) + (v[j].z * v[j].z + v[j].w * v[j].w); }
                const float inv = 1.0f / sqrtf(wave_sum(s) * (1.f / D) + EPS);
#pragma unroll
                for (int j = 0; j < 4; ++j) { const int k = 4 * c.lane + 256 * j; const f32x4 g = *(const f32x4*)(c.norm1 + k);
                    const f32x4 a = *(const LAS f32x4*)(scl + k), b = *(const LAS f32x4*)(shl + k); const f32x4 o = v[j] * inv * g * (a + 1.0f) + b;
                    ((GAS f32x4*)(c.XNS + (size_t)row * D))[c.lane + 64 * j] = o; } }
    }
    __syncthreads();
}
__device__ __forceinline__ void p5c_norm2(const Ctx& c) {
    const int gw = c.bid * NWAVES + c.wave, NGW = c.G * NWAVES;
    for (int row = gw; row < M + MS; row += NGW) {
        if (row < M) { const int r = row / T; norm_row<true, true>(c.X1 + (size_t)row * D, c.norm2, c.MOD + (size_t)r * NMOD + 3 * D, c.MOD + (size_t)r * NMOD + 4 * D, c.XN + (size_t)row * D, c.lane); }
        else { const int rs = row - M, r = NB + rs / SS; norm_row<true, false>(c.X1S + (size_t)rs * D, c.norm2, c.MOD + (size_t)r * NMOD + 3 * D, c.MOD + (size_t)r * NMOD + 4 * D, c.XN2S + (size_t)rs * D, c.lane); }
    }
}
__device__ __forceinline__ void p8_normf(const Ctx& c) {
    const int gw = c.bid * NWAVES + c.wave, NGW = c.G * NWAVES;
    for (int row = gw; row < M + MS; row += NGW) {
        if (row < M) norm_row<false, false>(c.out + O_YP + (size_t)row * D, c.norm_f, nullptr, nullptr, c.out + O_YP + (size_t)row * D, c.lane);
        else { const int rs = row - M; norm_row<false, false>(c.X2S + (size_t)rs * D, c.norm_f, nullptr, nullptr, c.out + O_YS + (size_t)rs * D, c.lane); }
    }
}

using pg8::Unit;
#define EPI_ROWS(...) _Pragma("unroll") for (int ai = 0; ai < 2; ++ai) _Pragma("unroll") for (int m = 0; m < 4; ++m) { const int row = row0 + ai * 128 + m * 16; __VA_ARGS__ }
struct EpiIn {
    static constexpr bool PERM = true, AFTER_DRAIN = false;
    bf16 *BG, *U, *Q, *HM, *GA, *GB; float* NGT; float* out;
    __device__ __forceinline__ void operator()(const f32x4 (&acc)[2][2][4][2], const Unit& u, int wr, int wc, int fr, int fq) const {
        const int pn = u.pn, row0 = u.pm * 256 + wr * 64 + fr, cl0 = wc * 32 + 8 * fq;
        if (pn < 4 || (pn >= 12 && pn < 16) || (pn >= 22 && pn < 30)) {
            bf16* base; int colt; float sc = 1.f; bool sig = false;
            if (pn < 4) { base = BG; colt = pn * 256; } else if (pn < 16) { base = Q; colt = (pn - 12) * 256; sc = 0.125f; } else if (pn < 26) { base = GA; colt = (pn - 22) * 256; sig = true; } else { base = GB; colt = (pn - 26) * 256; sig = true; }
            EPI_ROWS(
_Pragma("unroll")
                for (int bj = 0; bj < 2; ++bj) { const f32x4 a = acc[ai][bj][m][0], b = acc[ai][bj][m][1]; float v[8] = {a.x, a.y, a.z, a.w, b.x, b.y, b.z, b.w};
_Pragma("unroll")
                    for (int j = 0; j < 8; ++j) v[j] = sig ? sigmoidf_(v[j]) : v[j] * sc;
                    *(GAS v4u*)(base + (size_t)row * D + colt + bj * 128 + cl0) = pack8(v); } )
        } else if (pn < 12) {
            const int t = pn - 4;
            EPI_ROWS(
                const f32x4 a = acc[ai][0][m][0] * acc[ai][1][m][0], b = acc[ai][0][m][1] * acc[ai][1][m][1]; const float v[8] = {a.x, a.y, a.z, a.w, b.x, b.y, b.z, b.w};
                *(GAS v4u*)(U + (size_t)row * D + t * 128 + cl0) = pack8(v);
                const int tt = row & (T - 1);
                if (tt >= T - 2) { float* o = out + O_CONV_P + (size_t)((row >> 12) * 2 + (tt - (T - 2))) * D + t * 128 + cl0; *(GAS f32x4*)o = a; *(GAS f32x4*)(o + 4) = b; } )
        } else if (pn < 22) {
            const int kind = pn - 16, kv = kind & 1, reg = kind >> 1;
            EPI_ROWS(
                const int b = row >> 12, tt = row & (T - 1);
_Pragma("unroll")
                for (int bj = 0; bj < 2; ++bj) { const f32x4 a = acc[ai][bj][m][0], bq = acc[ai][bj][m][1]; const float v[8] = {a.x, a.y, a.z, a.w, bq.x, bq.y, bq.z, bq.w};
                    const int cl = bj * 128 + cl0, g = cl >> 6, d = cl & 63;
                    *(GAS v4u*)(HM + (size_t)kind * HMSZ + ((size_t)((b * NKV + g) * T + tt)) * HD + d) = pack8(v);
                    float* o = nullptr;
                    if (reg == 0) o = out + O_CMP_P + ((size_t)row * 2 + kv) * 256 + cl;
                    else if (reg == 1) o = out + O_SEL_P + ((size_t)row * 2 + kv) * 256 + cl;
                    else if (tt >= T - 512) o = out + O_WIN_P + ((size_t)(b * 512 + tt - (T - 512)) * 2 + kv) * 256 + cl;
                    if (o) { *(GAS f32x4*)o = a; *(GAS f32x4*)(o + 4) = bq; } } )
        } else {
            if (cl0 < 48) {
                EPI_ROWS(
                    const f32x4 a = acc[ai][0][m][0], b = acc[ai][0][m][1];
                    f32x4 sa, sb; sa.x = sigmoidf_(a.x); sa.y = sigmoidf_(a.y); sa.z = sigmoidf_(a.z); sa.w = sigmoidf_(a.w); sb.x = sigmoidf_(b.x); sb.y = sigmoidf_(b.y); sb.z = sigmoidf_(b.z); sb.w = sigmoidf_(b.w);
                    float* o = NGT + (size_t)row * 48 + cl0; *(GAS f32x4*)o = sa; *(GAS f32x4*)(o + 4) = sb; )
            }
        }
    }
};
struct EpiYa { static constexpr bool PERM = true, AFTER_DRAIN = false; const bf16* GA; float* P1;
    __device__ __forceinline__ void operator()(const f32x4 (&acc)[2][2][4][2], const Unit& u, int wr, int wc, int fr, int fq) const {
        const int row0 = u.pm * 256 + wr * 64 + fr, col0 = u.pn * 256 + wc * 32 + 8 * fq;
        EPI_ROWS(
_Pragma("unroll")
            for (int bj = 0; bj < 2; ++bj) { const size_t off = (size_t)row * D + col0 + bj * 128; float g[8]; ld8(GA + off, g); const f32x4 a = acc[ai][bj][m][0], b = acc[ai][bj][m][1];
                f32x4 o0, o1; o0.x = g[0] * a.x; o0.y = g[1] * a.y; o0.z = g[2] * a.z; o0.w = g[3] * a.w; o1.x = g[4] * b.x; o1.y = g[5] * b.y; o1.z = g[6] * b.z; o1.w = g[7] * b.w;
                *(GAS f32x4*)(P1 + off) = o0; *(GAS f32x4*)(P1 + off + 4) = o1; } )
    } };
struct EpiYb { static constexpr bool PERM = true, AFTER_DRAIN = false; const bf16* GB; const float* P1; bf16* MG;
    __device__ __forceinline__ void operator()(const f32x4 (&acc)[2][2][4][2], const Unit& u, int wr, int wc, int fr, int fq) const {
        const int row0 = u.pm * 256 + wr * 64 + fr, col0 = u.pn * 256 + wc * 32 + 8 * fq;
        EPI_ROWS(
_Pragma("unroll")
            for (int bj = 0; bj < 2; ++bj) { const size_t off = (size_t)row * D + col0 + bj * 128; float g[8]; ld8(GB + off, g); float p[8]; ld8(P1 + off, p); const f32x4 a = acc[ai][bj][m][0], b = acc[ai][bj][m][1];
                const float v[8] = {p[0] + g[0] * a.x, p[1] + g[1] * a.y, p[2] + g[2] * a.z, p[3] + g[3] * a.w, p[4] + g[4] * b.x, p[5] + g[5] * b.y, p[6] + g[6] * b.z, p[7] + g[7] * b.w};
                *(GAS v4u*)(MG + off) = pack8(v); } )
    } };
struct EpiRes { static constexpr bool PERM = true, AFTER_DRAIN = false; const float* base; float* O; const float* MOD; int goff;
    __device__ __forceinline__ void operator()(const f32x4 (&acc)[2][2][4][2], const Unit& u, int wr, int wc, int fr, int fq) const {
        const int row0 = u.pm * 256 + wr * 64 + fr, col0 = u.pn * 256 + wc * 32 + 8 * fq;
        const float* gp = MOD + (size_t)((u.pm * 256) / T) * NMOD + goff + col0;
        f32x4 gt[2][2];
#pragma unroll
        for (int bj = 0; bj < 2; ++bj) { gt[bj][0] = *(const f32x4*)(gp + bj * 128); gt[bj][1] = *(const f32x4*)(gp + bj * 128 + 4); }
        EPI_ROWS(
_Pragma("unroll")
            for (int bj = 0; bj < 2; ++bj) { const size_t off = (size_t)row * D + col0 + bj * 128;
                const f32x4 x0 = *(const f32x4*)(base + off), x1 = *(const f32x4*)(base + off + 4);
                *(GAS f32x4*)(O + off) = x0 + gt[bj][0] * acc[ai][bj][m][0]; *(GAS f32x4*)(O + off + 4) = x1 + gt[bj][1] * acc[ai][bj][m][1]; } )
    } };
struct EpiFF { static constexpr bool PERM = true, AFTER_DRAIN = false; bf16* HF;
    __device__ __forceinline__ void operator()(const f32x4 (&acc)[2][2][4][2], const Unit& u, int wr, int wc, int fr, int fq) const {
        const int row0 = u.pm * 256 + wr * 64 + fr, col0 = u.pn * 128 + wc * 32 + 8 * fq;
        EPI_ROWS(
            const f32x4 g0 = acc[ai][0][m][0], g1 = acc[ai][0][m][1], u0 = acc[ai][1][m][0], u1 = acc[ai][1][m][1];
            const float v[8] = {siluf_(g0.x) * u0.x, siluf_(g0.y) * u0.y, siluf_(g0.z) * u0.z, siluf_(g0.w) * u0.w, siluf_(g1.x) * u1.x, siluf_(g1.y) * u1.y, siluf_(g1.z) * u1.z, siluf_(g1.w) * u1.w};
            *(GAS v4u*)(HF + (size_t)row * FF + col0) = pack8(v); )
    } };

template <bool DUAL, class Epi> __device__ __forceinline__ void sgemm(const Ctx& c, const float* A1, const float* A2, int lda, const float* W1, const float* W2, int ldw, int K, int N, const Epi& epi) {
    const int nch = (N + NTHR - 1) / NTHR, nitems = 8 * nch;
    for (int it = c.G - 1 - c.bid; it < nitems; it += c.G) {
        const int rg = it & 7, n = (it >> 3) * NTHR + c.tid;
        if (n < N) {
            float a1[16], a2[16];
#pragma unroll
            for (int r = 0; r < 16; ++r) { a1[r] = 0.f; a2[r] = 0.f; }
            const float* ar1 = A1 + (size_t)rg * 16 * lda; const float* ar2 = A2 + (size_t)rg * 16 * lda;
            for (int k = 0; k < K; ++k) { const float w1 = W1[(size_t)k * ldw + n]; const float w2 = DUAL ? W2[(size_t)k * ldw + n] : 0.f;
#pragma unroll
                for (int r = 0; r < 16; ++r) { a1[r] += ar1[(size_t)r * lda + k] * w1; if (DUAL) a2[r] += ar2[(size_t)r * lda + k] * w2; } }
#pragma unroll
            for (int r = 0; r < 16; ++r) epi(rg * 16 + r, n, a1[r], a2[r]);
        }
    }
}

__device__ __forceinline__ void p3_conv_prompt(const Ctx& c) {
    const int gt = c.bid * NTHR + c.tid, NGT_ = c.G * NTHR;
    for (int it = gt; it < M * (D / 8); it += NGT_) {
        const int row = it >> 7, ch = (it & 127) * 8, tt = row & (T - 1);
        float u0[8], u1[8], u2[8], bg[8];
        ld8(c.U + (size_t)row * D + ch, u0); ld8(c.BG + (size_t)row * D + ch, bg);
        if (tt >= 1) ld8(c.U + (size_t)(row - 1) * D + ch, u1); else { for (int j = 0; j < 8; ++j) u1[j] = 0.f; }
        if (tt >= 2) ld8(c.U + (size_t)(row - 2) * D + ch, u2); else { for (int j = 0; j < 8; ++j) u2[j] = 0.f; }
        float w0[8], w1[8], w2[8], bb[8]; ld8(c.w_conv + ch, w0); ld8(c.w_conv + D + ch, w1); ld8(c.w_conv + 2 * D + ch, w2); ld8(c.b_conv + ch, bb);
        float v[8];
#pragma unroll
        for (int j = 0; j < 8; ++j) v[j] = bg[j] * (bb[j] + w0[j] * u2[j] + w1[j] * u1[j] + w2[j] * u0[j]);
        *(GAS v4u*)(c.AA + (size_t)row * D + ch) = pack8(v);
    }
}
__device__ __forceinline__ void p3_sample_thin(const Ctx& c) {
    const int gt = c.bid * NTHR + c.tid, NGT_ = c.G * NTHR;
    for (int it = gt; it < MS * D; it += NGT_) {
        const int row = it >> 10, ch = it & 1023, b = row >> 2, s = row & 3;
        float up[3];
#pragma unroll
        for (int k = 0; k < 3; ++k) { const int ss = s - 2 + k; up[k] = (ss >= 0) ? c.ZS[(size_t)(b * SS + ss) * NIN + 1024 + ch] * c.ZS[(size_t)(b * SS + ss) * NIN + 2048 + ch] : c.state_conv[(size_t)(b * 2 + (ss + 2)) * D + ch]; }
        const float v = c.b_conv[ch] + c.w_conv[ch] * up[0] + c.w_conv[D + ch] * up[1] + c.w_conv[2 * D + ch] * up[2];
        c.AAS[(size_t)row * D + ch] = c.ZS[(size_t)row * NIN + ch] * v;
        if (s >= 2) c.out[O_CONV_S + (size_t)(b * 2 + (s - 2)) * D + ch] = up[2];
    }
    for (int it = gt; it < MS * 512; it += NGT_) { const int row = it >> 9, cc = it & 511;
        c.out[O_CMP_S + (size_t)row * 512 + cc] = c.ZS[(size_t)row * NIN + 4096 + cc]; c.out[O_SEL_S + (size_t)row * 512 + cc] = c.ZS[(size_t)row * NIN + 4608 + cc]; }
    for (int it = gt; it < SB * 512 * 128; it += NGT_) { const int cc = (it & 127) * 4, j = (it >> 7) & 511, b = it >> 16;
        f32x4 v;
        if (j + SS < 512) v = *(const f32x4*)(c.cache_win + ((size_t)(b * 512 + j + SS)) * 512 + cc);
        else v = *(const f32x4*)(c.ZS + (size_t)(b * SS + (j + SS - 512)) * NIN + 5120 + cc);
        *(GAS f32x4*)(c.out + O_WIN_S + ((size_t)(b * 512 + j)) * 512 + cc) = v; }
}
struct CmpP { static constexpr int NB_ = NB, NCS = NCS_P, NCP = NCP_P, NGRP = 16;
    __device__ static __forceinline__ float x(const Ctx& c, int kv, int b, int g, int pos, int d) { return bf2f(c.HM[(size_t)kv * HMSZ + ((size_t)((b * NKV + g) * T + pos)) * HD + d]); }
    __device__ static __forceinline__ float* outp(const Ctx& c) { return c.KCC; } };
struct CmpS { static constexpr int NB_ = SB, NCS = NCS_S, NCP = NCP_S, NGRP = 32;
    __device__ static __forceinline__ float x(const Ctx& c, int kv, int b, int g, int pos, int d) { return c.cache_cmp[((size_t)c.pt[b * NPG + (pos >> 7)] * PAGE + (pos & 127)) * 512 + kv * 256 + g * HD + d]; }
    __device__ static __forceinline__ float* outp(const Ctx& c) { return c.KCCS; } };
template <class S> __device__ __forceinline__ void compress_naive(const Ctx& c) {
    constexpr int NITEMS = 2 * S::NB_ * NKV * S::NGRP;
    LAS float* hid = (LAS float*)c.lds;
    const int n = c.tid & 127, rq = c.tid >> 7;
    for (int it = c.bid; it < NITEMS; it += c.G) {
        const int ig = it % S::NGRP, g = (it / S::NGRP) % NKV, b = (it / (S::NGRP * NKV)) % S::NB_, kv = it / (S::NGRP * NKV * S::NB_);
        const int i0 = ig * 16 + 4 * rq;
        float acc[4] = {0.f, 0.f, 0.f, 0.f};
        for (int t = 0; t < 32; ++t) {
            for (int d = 0; d < HD; ++d) {
                const int k = t * HD + d; const float w = c.w_phi1[((size_t)kv * 2048 + k) * 128 + n], pe = c.pe[kv * 2048 + k];
#pragma unroll
                for (int r = 0; r < 4; ++r) { int i = i0 + r; i = i < S::NCS ? i : S::NCS - 1; acc[r] += (S::x(c, kv, b, g, 16 * i + t, d) + pe) * w; }
            }
        }
        __syncthreads();
#pragma unroll
        for (int r = 0; r < 4; ++r) hid[(4 * rq + r) * 128 + n] = gelu_tanh(acc[r]);
        __syncthreads();
        const int o = c.tid & 63;
#pragma unroll
        for (int rr = 0; rr < 2; ++rr) { const int r = (c.tid >> 6) + 8 * rr, i = ig * 16 + r; float s = 0.f;
            for (int k = 0; k < 128; ++k) s += hid[r * 128 + k] * c.w_phi2[((size_t)kv * 128 + k) * HD + o];
            if (i < S::NCS) S::outp(c)[((size_t)((kv * S::NB_ + b) * NKV + g) * S::NCP + i) * HD + o] = s; }
    }
    __syncthreads();
}

struct AtP {
    static constexpr int NQ = T, QBASE = 0, NS = 64, NSP = 64, NSL = 1, NBAT = NB, NCP = NCP_P;
    typedef bf16 KT;
    __device__ static __forceinline__ void decode(int idx, int& b, int& h, int& qi) { qi = idx & (T - 1); h = (idx >> 12) & 15; b = idx >> 16; }
    __device__ static __forceinline__ void load_q(const Ctx& c, int b, int h, int qi, float (&q)[64]) { const bf16* p = c.Q + (size_t)(b * T + qi) * D + h * HD;
#pragma unroll
        for (int cc = 0; cc < 8; ++cc) { float v[8]; ld8(p + 8 * cc, v);
#pragma unroll
            for (int j = 0; j < 8; ++j) q[8 * cc + j] = v[j]; } }
    __device__ static __forceinline__ float gate(const Ctx& c, int b, int h, int qi, int j) { return c.NGT[(size_t)(b * T + qi) * 48 + h * 3 + j]; }
    __device__ static __forceinline__ const float* kcc(const Ctx& c, int kv, int b, int g, int ci) { return c.KCC + ((size_t)((kv * NB + b) * NKV + g) * NCP_P + ci) * HD; }
    __device__ static __forceinline__ const KT* ksel(const Ctx& c, int kv, int b, int g, int pos) { return c.HM + (size_t)(2 + kv) * HMSZ + ((size_t)((b * NKV + g) * T + pos)) * HD; }
    __device__ static __forceinline__ const KT* kwin(const Ctx& c, int kv, int b, int g, int pos) { return c.HM + (size_t)(4 + kv) * HMSZ + ((size_t)((b * NKV + g) * T + pos)) * HD; }
    __device__ static __forceinline__ float* scoreh(const Ctx& c) { return c.SCOREH; }
    __device__ static __forceinline__ unsigned long long* mask(const Ctx& c) { return c.MASK; }
    __device__ static __forceinline__ void store_o(const Ctx& c, int b, int h, int qi, const float (&o)[64]) { bf16* p = c.OB + (size_t)(b * T + qi) * D + h * HD;
#pragma unroll
        for (int cc = 0; cc < 8; ++cc) { float v[8];
#pragma unroll
            for (int j = 0; j < 8; ++j) v[j] = o[8 * cc + j];
            *(GAS v4u*)(p + 8 * cc) = pack8(v); } }
};
struct AtS {
    static constexpr int NQ = SS, QBASE = PAST, NS = 129, NSP = 192, NSL = 3, NBAT = SB, NCP = NCP_S;
    typedef float KT;
    __device__ static __forceinline__ void decode(int idx, int& b, int& h, int& qi) { qi = idx & 3; h = (idx >> 2) & 15; b = idx >> 6; }
    __device__ static __forceinline__ void load_q(const Ctx& c, int b, int h, int qi, float (&q)[64]) { const float* p = c.ZS + (size_t)(b * SS + qi) * NIN + 3072 + h * HD;
#pragma unroll
        for (int j = 0; j < 64; ++j) q[j] = p[j] * 0.125f; }
    __device__ static __forceinline__ float gate(const Ctx& c, int b, int h, int qi, int j) { return sigmoidf_(c.ZS[(size_t)(b * SS + qi) * NIN + 5632 + h * 3 + j]); }
    __device__ static __forceinline__ const float* kcc(const Ctx& c, int kv, int b, int g, int ci) { return c.KCCS + ((size_t)((kv * SB + b) * NKV + g) * NCP_S + ci) * HD; }
    __device__ static __forceinline__ const KT* ksel(const Ctx& c, int kv, int b, int g, int pos) {
        if (pos < PAST) return c.cache_sel + ((size_t)c.pt[b * NPG + (pos >> 7)] * PAGE + (pos & 127)) * 512 + kv * 256 + g * HD;
        return c.ZS + (size_t)(b * SS + (pos - PAST)) * NIN + 4608 + kv * 256 + g * HD; }
    __device__ static __forceinline__ const KT* kwin(const Ctx& c, int kv, int b, int g, int pos) {
        if (pos < PAST) return c.cache_win + ((size_t)(b * 512 + (pos - (PAST - 512)))) * 512 + kv * 256 + g * HD;
        return c.ZS + (size_t)(b * SS + (pos - PAST)) * NIN + 5120 + kv * 256 + g * HD; }
    __device__ static __forceinline__ float* scoreh(const Ctx& c) { return c.SCOREHS; }
    __device__ static __forceinline__ unsigned long long* mask(const Ctx& c) { return c.MASKS; }
    __device__ static __forceinline__ void store_o(const Ctx& c, int b, int h, int qi, const float (&o)[64]) { float* p = c.OBS + (size_t)(b * SS + qi) * D + h * HD;
#pragma unroll
        for (int j = 0; j < 64; ++j) p[j] = o[j]; }
};
__device__ __forceinline__ int wave_max_i(int v) {
#pragma unroll
    for (int o = 1; o < 64; o <<= 1) { const int t = __shfl_xor(v, o); v = t > v ? t : v; }
    return v;
}
__device__ __forceinline__ int wave_min_i(int v) {
#pragma unroll
    for (int o = 1; o < 64; o <<= 1) { const int t = __shfl_xor(v, o); v = t < v ? t : v; }
    return v;
}
template <class S> __device__ __forceinline__ void p4a_scores(const Ctx& c) {
    constexpr int NW = S::NBAT * H * S::NQ / 64;
    const int gw = c.bid * NWAVES + c.wave, NGW = c.G * NWAVES;
    for (int w = gw; w < NW; w += NGW) {
        const int idx = w * 64 + c.lane; int b, h, qi; S::decode(idx, b, h, qi);
        const int g = h >> 2, qpos = S::QBASE + qi; const float tq = (float)qpos, slope = exp2f(-0.5f * (float)(h + 1));
        float q[64]; S::load_q(c, b, h, qi, q);
        const int ncv = qpos >= 31 ? ((qpos - 31) >> 4) + 1 : 0, ncm = wave_max_i(ncv);
        float m = NEGF;
        for (int ci = 0; ci < ncm; ++ci) { const int cc = ci < ncv ? ci : 0; const float s = dot64(S::kcc(c, 0, b, g, cc), q) - slope * (tq - 16.f * ci - 15.5f); if (ci < ncv) m = fmaxf(m, s); }
        float l = 0.f;
        for (int ci = 0; ci < ncm; ++ci) { const int cc = ci < ncv ? ci : 0; const float s = dot64(S::kcc(c, 0, b, g, cc), q) - slope * (tq - 16.f * ci - 15.5f); if (ci < ncv) l += __expf(s - m); }
        const float il = l > 0.f ? 1.f / l : 0.f;
        float carry = 0.f; float* sp = S::scoreh(c) + (size_t)idx * S::NSP;
        const int nsm = (ncm + 3) >> 2;
        for (int s4 = 0; s4 < S::NS; ++s4) {
            float a = carry;
            if (s4 < nsm + 1) {
#pragma unroll 1
                for (int j = 0; j < 4; ++j) { const int ci = 4 * s4 + j; float p = 0.f;
                    if (ci < ncm) { const int cc = ci < ncv ? ci : 0; const float s = dot64(S::kcc(c, 0, b, g, cc), q) - slope * (tq - 16.f * ci - 15.5f); p = ci < ncv ? __expf(s - m) * il : 0.f; }
                    a += p; if (j == 3) carry = p; }
            } else carry = 0.f;
            sp[s4] = a;
        }
    }
}
template <class S> __device__ __forceinline__ void p4b_topk(const Ctx& c) {
    constexpr int NW = S::NBAT * NKV * S::NQ;
    const int gw = c.bid * NWAVES + c.wave, NGW = c.G * NWAVES;
    for (int w = gw; w < NW; w += NGW) {
        const int qi = w % S::NQ, g = (w / S::NQ) % NKV, b = w / (S::NQ * NKV);
        const int qpos = S::QBASE + qi, cur = qpos >> 6;
        float val[S::NSL];
#pragma unroll
        for (int j = 0; j < S::NSL; ++j) { const int s = c.lane + 64 * j; float v = -INFINITY;
            if (s < S::NS) { float imp = 0.f;
#pragma unroll
                for (int r = 0; r < 4; ++r) imp += S::scoreh(c)[((size_t)((b * H + 4 * g + r) * S::NQ + qi)) * S::NSP + s];
                const bool valid = 64 * s <= qpos, forced = (s == 0) || (s == cur) || (s == cur - 1);
                v = valid ? imp + (forced ? 1000.f : 0.f) : NEGF; }
            val[j] = v; }
        int rank[S::NSL];
#pragma unroll
        for (int j = 0; j < S::NSL; ++j) rank[j] = 0;
#pragma unroll
        for (int j2 = 0; j2 < S::NSL; ++j2)
            for (int l2 = 0; l2 < 64; ++l2) { const float v2 = __shfl(val[j2], l2); const int s2 = l2 + 64 * j2;
#pragma unroll
                for (int j = 0; j < S::NSL; ++j) { const int s = c.lane + 64 * j; rank[j] += (v2 > val[j] || (v2 == val[j] && s2 < s)) ? 1 : 0; } }
#pragma unroll
        for (int j = 0; j < S::NSL; ++j) { const int s = c.lane + 64 * j; const unsigned long long mk = __ballot(rank[j] < 16 && s < S::NS);
            if (c.lane == 0) S::mask(c)[(size_t)w * S::NSL + j] = mk; }
    }
}
#define ONLINE_UPD(sv, vrow, ok) do { if (ok) { if ((sv) > m) { const float al = __expf(m - (sv)); l *= al; _Pragma("unroll") for (int d_ = 0; d_ < 64; ++d_) o[d_] *= al; m = (sv); } \
        const float p_ = __expf((sv) - m); l += p_; axpy64((vrow), p_, o); } } while (0)
template <class S> __device__ __forceinline__ void p4c_attend(const Ctx& c) {
    constexpr int NW = S::NBAT * H * S::NQ / 64;
    const int gw = c.bid * NWAVES + c.wave, NGW = c.G * NWAVES;
    for (int w = gw; w < NW; w += NGW) {
        const int idx = w * 64 + c.lane; int b, h, qi; S::decode(idx, b, h, qi);
        const int g = h >> 2, qpos = S::QBASE + qi, cur = qpos >> 6; const float tq = (float)qpos, slope = exp2f(-0.5f * (float)(h + 1));
        float q[64]; S::load_q(c, b, h, qi, q);
        LAS float* ot = (LAS float*)c.lds + c.tid;
#pragma unroll
        for (int d = 0; d < 64; ++d) ot[d * NTHR] = 0.f;
        float o[64]; float m, l;
        {
#pragma unroll
            for (int d = 0; d < 64; ++d) o[d] = 0.f;
            m = NEGF; l = 0.f;
            const int ncv = qpos >= 31 ? ((qpos - 31) >> 4) + 1 : 0, ncm = wave_max_i(ncv);
            for (int ci = 0; ci < ncm; ++ci) { const bool ok = ci < ncv; const int cc = ok ? ci : 0;
                const float s = dot64(S::kcc(c, 0, b, g, cc), q) - slope * (tq - 16.f * ci - 15.5f);
                ONLINE_UPD(s, S::kcc(c, 1, b, g, cc), ok); }
            if (l > 0.f) { const float f = S::gate(c, b, h, qi, 0) / l;
#pragma unroll
                for (int d = 0; d < 64; ++d) ot[d * NTHR] += f * o[d]; }
        }
        {
#pragma unroll
            for (int d = 0; d < 64; ++d) o[d] = 0.f;
            m = NEGF; l = 0.f;
            unsigned long long mk[S::NSL];
#pragma unroll
            for (int j = 0; j < S::NSL; ++j) mk[j] = S::mask(c)[((size_t)((b * NKV + g) * S::NQ + qi)) * S::NSL + j];
            const int curm = wave_max_i(cur);
            for (int s = 0; s <= curm; ++s) {
                unsigned long long word = mk[0];
#pragma unroll
                for (int j = 1; j < S::NSL; ++j) if ((s >> 6) == j) word = mk[j];
                const bool sel = (s <= cur) && ((word >> (s & 63)) & 1ull);
                if (!__any(sel)) continue;
                for (int k = 0; k < 64; ++k) { const int pos = 64 * s + k; const bool ok = sel && pos <= qpos; const int pc = pos <= qpos ? pos : qpos;
                    if (!__any(ok)) continue;
                    const float sv = dot64(S::ksel(c, 0, b, g, pc), q) - slope * (tq - (float)pos);
                    ONLINE_UPD(sv, S::ksel(c, 1, b, g, pc), ok); }
            }
            if (l > 0.f) { const float f = S::gate(c, b, h, qi, 1) / l;
#pragma unroll
                for (int d = 0; d < 64; ++d) ot[d * NTHR] += f * o[d]; }
        }
        {
#pragma unroll
            for (int d = 0; d < 64; ++d) o[d] = 0.f;
            m = NEGF; l = 0.f;
            const int lo = qpos - 511 > 0 ? qpos - 511 : 0; const int lom = wave_min_i(lo), him = wave_max_i(qpos);
            for (int kp = lom; kp <= him; ++kp) { const bool ok = kp >= lo && kp <= qpos; int pc = kp < lo ? lo : kp; pc = pc > qpos ? qpos : pc;
                if (S::QBASE > 0 && pc < PAST - 512) pc = PAST - 512;
                const float sv = dot64(S::kwin(c, 0, b, g, pc), q) - slope * (tq - (float)kp);
                ONLINE_UPD(sv, S::kwin(c, 1, b, g, pc), ok); }
            if (l > 0.f) { const float f = S::gate(c, b, h, qi, 2) / l;
#pragma unroll
                for (int d = 0; d < 64; ++d) ot[d * NTHR] += f * o[d]; }
        }
#pragma unroll
        for (int d = 0; d < 64; ++d) o[d] = ot[d * NTHR];
        S::store_o(c, b, h, qi, o);
    }
}

struct SEpiZ { float* ZS; __device__ __forceinline__ void operator()(int row, int n, float a1, float) const { ZS[(size_t)row * NIN + n] = a1; } };
struct SEpiMG { const float* ZS; float* MGS; __device__ __forceinline__ void operator()(int row, int n, float a1, float a2) const {
    MGS[(size_t)row * D + n] = sigmoidf_(ZS[(size_t)row * NIN + 5680 + n]) * a1 + sigmoidf_(ZS[(size_t)row * NIN + 5680 + D + n]) * a2; } };
struct SEpiRes { const float* base; float* O; const float* MOD; int goff; __device__ __forceinline__ void operator()(int row, int n, float a1, float) const {
    O[(size_t)row * D + n] = base[(size_t)row * D + n] + MOD[(size_t)(NB + (row >> 2)) * NMOD + goff + n] * a1; } };
struct SEpiFF { float* HFS; __device__ __forceinline__ void operator()(int row, int n, float a1, float a2) const { HFS[(size_t)row * FF + n] = siluf_(a1) * a2; } };

#ifndef MK_SINGLE
#define MK_SINGLE 0
#endif
struct Args { const void* in[26]; float* out; unsigned char* ws; int ph_lo, ph_hi; };
__global__ void __launch_bounds__(NTHR, 2) fwd(Args a) {
    extern __shared__ __attribute__((aligned(16))) unsigned char lds[];
    Ctx c;
    c.lds = (LAS unsigned char*)lds;
    c.tid = threadIdx.x; c.lane = c.tid & 63; c.wave = __builtin_amdgcn_readfirstlane(c.tid >> 6); c.G = gridDim.x; c.bid = blockIdx.x;
    c.x_p = (const float*)a.in[0]; c.x_s = (const float*)a.in[1]; c.c_p = (const float*)a.in[2]; c.c_s = (const float*)a.in[3];
    c.cache_cmp = (const float*)a.in[4]; c.cache_sel = (const float*)a.in[5]; c.cache_win = (const float*)a.in[6]; c.state_conv = (const float*)a.in[7]; c.pt = (const int*)a.in[8];
    c.w_ada = (const float*)a.in[9]; c.b_ada = (const float*)a.in[10]; c.norm1 = (const float*)a.in[11]; c.w_in = (const float*)a.in[12]; c.w_conv = (const float*)a.in[13]; c.b_conv = (const float*)a.in[14];
    c.w_oc = (const float*)a.in[15]; c.pe = (const float*)a.in[16]; c.w_phi1 = (const float*)a.in[17]; c.w_phi2 = (const float*)a.in[18]; c.w_on = (const float*)a.in[19]; c.w_out = (const float*)a.in[20];
    c.norm2 = (const float*)a.in[21]; c.w_gate = (const float*)a.in[22]; c.w_up = (const float*)a.in[23]; c.w_down = (const float*)a.in[24]; c.norm_f = (const float*)a.in[25];
    c.out = a.out;
    unsigned char* ws = a.ws;
    c.WIN_T = (bf16*)(ws + WS_WIN_T); c.WOC_T = (bf16*)(ws + WS_WOC_T); c.WON_T = (bf16*)(ws + WS_WON_T); c.WOUT_T = (bf16*)(ws + WS_WOUT_T); c.WGU_T = (bf16*)(ws + WS_WGU_T); c.WDN_T = (bf16*)(ws + WS_WDN_T);
    c.MODP = (float*)(ws + WS_MODP); c.MOD = (float*)(ws + WS_MOD);
    c.XN = (bf16*)(ws + WS_XN); c.BG = (bf16*)(ws + WS_BG); c.U = (bf16*)(ws + WS_U); c.Q = (bf16*)(ws + WS_Q); c.HM = (bf16*)(ws + WS_HM); c.GA = (bf16*)(ws + WS_GA); c.GB = (bf16*)(ws + WS_GB); c.NGT = (float*)(ws + WS_NGT);
    c.AA = (bf16*)(ws + WS_AA); c.OB = (bf16*)(ws + WS_OB); c.MG = (bf16*)(ws + WS_MG); c.X1 = (float*)(ws + WS_X1); c.P1 = (float*)(ws + WS_P1); c.HF = (bf16*)(ws + WS_HF);
    c.KCC = (float*)(ws + WS_KCC); c.SCOREH = (float*)(ws + WS_SCOREH); c.MASK = (unsigned long long*)(ws + WS_MASK);
    c.XNS = (float*)(ws + WS_XNS); c.ZS = (float*)(ws + WS_ZS); c.AAS = (float*)(ws + WS_AAS); c.OBS = (float*)(ws + WS_OBS); c.MGS = (float*)(ws + WS_MGS); c.X1S = (float*)(ws + WS_X1S);
    c.XN2S = (float*)(ws + WS_XN2S); c.HFS = (float*)(ws + WS_HFS); c.X2S = (float*)(ws + WS_X2S); c.KCCS = (float*)(ws + WS_KCCS); c.SCOREHS = (float*)(ws + WS_SCOREHS); c.MASKS = (unsigned long long*)(ws + WS_MASKS);

    for (int u = c.tid; u < (LDS_BYTES - LDSCTL_OFF) / 4; u += NTHR) ((LAS unsigned*)(c.lds + LDSCTL_OFF))[u] = 0u;
    __syncthreads();
    const int lo = a.ph_lo, hi = a.ph_hi;
    unsigned* ctl = (unsigned*)(ws + WS_CTL);
    volatile LAS unsigned* MISC = (volatile LAS unsigned*)(c.lds + MISC_OFF);
    XcdBarrier bar; bar.bar = ctl + CW_BAR; bar.x = 0; bar.st = nullptr;
    if (hi - lo > 1) bar = xcd_barrier_post(ctl + CW_BAR, MISC + 8);
#ifdef PH_ONLY
#define IN(k) ((k) == PH_ONLY)
#else
#define IN(k) (lo <= (k) && (k) < hi)
#endif
#define SEAM(k) do { if (IN(k) && IN((k) + 1)) xcd_barrier(bar); } while (0)

    if (IN(0)) { p0_prologue(c); } SEAM(0);
    if (IN(1)) { p1_norm1(c); } SEAM(1);
    if (IN(2)) {
        pg8::Gemm g{c.XN, c.WIN_T, M, NINP, D}; pg8::StaticOrder S; S.init(M, NINP, c.G, c.bid);
        EpiIn E{c.BG, c.U, c.Q, c.HM, c.GA, c.GB, c.NGT, c.out};
        pg8::gemm_phase<EpiIn, pg8::StaticOrder, true, true>(c.lds + RING_OFF, g, S, E);
        sgemm<false>(c, c.XNS, c.XNS, D, c.w_in, c.w_in, NIN, D, NIN, SEpiZ{c.ZS});
    } SEAM(2);
    if (IN(3)) { p3_conv_prompt(c); p3_sample_thin(c); compress_naive<CmpP>(c); compress_naive<CmpS>(c); } SEAM(3);
    if (IN(4)) { p4a_scores<AtP>(c); p4a_scores<AtS>(c); } SEAM(4);
    if (IN(5)) { p4b_topk<AtP>(c); p4b_topk<AtS>(c); } SEAM(5);
    if (IN(6)) { p4c_attend<AtP>(c); p4c_attend<AtS>(c); } SEAM(6);
    if (IN(7)) {
        { pg8::Gemm g{c.AA, c.WOC_T, M, D, D}; pg8::StaticOrder S; S.init(M, D, c.G, c.bid); EpiYa E{c.GA, c.P1};
          pg8::gemm_phase<EpiYa, pg8::StaticOrder, true, true>(c.lds + RING_OFF, g, S, E); }
        { pg8::Gemm g{c.OB, c.WON_T, M, D, D}; pg8::StaticOrder S; S.init(M, D, c.G, c.bid); EpiYb E{c.GB, c.P1, c.MG};
          pg8::gemm_phase<EpiYb, pg8::StaticOrder, true, true>(c.lds + RING_OFF, g, S, E); }
        sgemm<true>(c, c.AAS, c.OBS, D, c.w_oc, c.w_on, D, D, D, SEpiMG{c.ZS, c.MGS});
    } SEAM(7);
    if (IN(8)) {
        pg8::Gemm g{c.MG, c.WOUT_T, M, D, D}; pg8::StaticOrder S; S.init(M, D, c.G, c.bid); EpiRes E{c.x_p, c.X1, c.MOD, 2 * D};
        pg8::gemm_phase<EpiRes, pg8::StaticOrder, true, true>(c.lds + RING_OFF, g, S, E);
        sgemm<false>(c, c.MGS, c.MGS, D, c.w_out, c.w_out, D, D, D, SEpiRes{c.x_s, c.X1S, c.MOD, 2 * D});
    } SEAM(8);
    if (IN(9)) { p5c_norm2(c); } SEAM(9);
    if (IN(10)) {
        pg8::Gemm g{c.XN, c.WGU_T, M, NGU, D}; pg8::StaticOrder S; S.init(M, NGU, c.G, c.bid); EpiFF E{c.HF};
        pg8::gemm_phase<EpiFF, pg8::StaticOrder, true, true>(c.lds + RING_OFF, g, S, E);
        sgemm<true>(c, c.XN2S, c.XN2S, D, c.w_gate, c.w_up, FF, D, FF, SEpiFF{c.HFS});
    } SEAM(10);
    if (IN(11)) {
        pg8::Gemm g{c.HF, c.WDN_T, M, D, FF}; pg8::StaticOrder S; S.init(M, D, c.G, c.bid); EpiRes E{c.X1, c.out + O_YP, c.MOD, 5 * D};
        pg8::gemm_phase<EpiRes, pg8::StaticOrder, true, true>(c.lds + RING_OFF, g, S, E);
        sgemm<false>(c, c.HFS, c.HFS, FF, c.w_down, c.w_down, D, FF, D, SEpiRes{c.X1S, c.X2S, c.MOD, 5 * D});
    } SEAM(11);
    if (IN(12)) { p8_normf(c); }
#undef IN
#undef SEAM
}

extern "C" void kernel_launch(void* const* d_in, const int* in_sizes, int n_in, void* d_out, int out_size, void* d_ws, size_t ws_size, hipStream_t stream) {
    static int grid = 0;
    if (grid == 0) {
        if (n_in != 26 || out_size != (int)O_END || ws_size < WS_END) { fprintf(stderr, "kernel_launch: unexpected shapes (n_in %d out %d ws %zu)\n", n_in, out_size, ws_size); grid = -1; return; }
        int dev = 0, cus = 0, per_cu = 0;
        if (hipGetDevice(&dev) != hipSuccess || hipDeviceGetAttribute(&cus, hipDeviceAttributeMultiprocessorCount, dev) != hipSuccess) { grid = -1; return; }
        if (hipFuncSetAttribute((const void*)fwd, hipFuncAttributeMaxDynamicSharedMemorySize, LDS_BYTES) != hipSuccess) { fprintf(stderr, "kernel_launch: hipFuncSetAttribute failed\n"); grid = -1; return; }
        if (hipOccupancyMaxActiveBlocksPerMultiprocessor(&per_cu, (const void*)fwd, NTHR, LDS_BYTES) != hipSuccess || per_cu < 1) fprintf(stderr, "kernel_launch: occupancy query says %d\n", per_cu);
        (void)hipGetLastError();
        grid = cus;
    }
    if (grid < 0) return;
    (void)hipMemsetAsync((char*)d_ws + WS_CTL, 0, CTL_ZERO_BYTES, stream);
    Args a{};
    for (int i = 0; i < 26; ++i) a.in[i] = d_in[i];
    a.out = (float*)d_out; a.ws = (unsigned char*)d_ws;
#if MK_SINGLE
    a.ph_lo = 0; a.ph_hi = NPHASE;
    hipLaunchKernelGGL(fwd, dim3(grid), dim3(NTHR), LDS_BYTES, stream, a);
#else
    for (int p = 0; p < NPHASE; ++p) { a.ph_lo = p; a.ph_hi = p + 1; hipLaunchKernelGGL(fwd, dim3(grid), dim3(NTHR), LDS_BYTES, stream, a); }
#endif
}
```

```cpp
#include <hip/hip_runtime.h>
#include <cstdio>
#include <cstdint>
namespace pg8 {
#define PG8_LAS __attribute__((address_space(3)))
typedef unsigned short bf16_t;
typedef short bf16x8 __attribute__((ext_vector_type(8)));
typedef float f32x4 __attribute__((ext_vector_type(4)));
typedef unsigned u32x4 __attribute__((ext_vector_type(4)));
constexpr int BM = 256, BK = 64, HALF = 128, HTB = HALF * BK * 2  , STAGE_BYTES = 8 * HTB, NXCD = 8, WGM = 8;

__host__ __device__ __forceinline__ int lds_byte(int r, int c) { const int st = (r >> 4) * 2 + (c >> 5), rr = r & 15, cc = c & 31, ob = rr * 64 + cc * 2; return st * 1024 + (ob ^ (((ob >> 9) & 1) << 5)); }
__host__ __device__ __forceinline__ void stage_rc(int b, int& R, int& C) { const int st = b / 1024, sb = b % 1024, swz = sb ^ (((sb >> 9) & 1) << 5); R = (st >> 1) * 16 + swz / 64; C = (st & 1) * 32 + (swz % 64) / 2; }
__host__ __device__ __forceinline__ int perm32(int rho) { const int n = rho >> 4, i = rho & 15; return 8 * (i >> 2) + 4 * n + (i & 3); }

struct Unit { int pm, pn; };
struct Gemm { const bf16_t* A; const bf16_t* Bt; int M, N, K; };

struct StaticOrder {
    int nM, nN, nwg, G, c;
    __host__ __device__ void init(int M, int N, int G_, int c_) { nM = M / BM; nN = N / BM; nwg = nM * nN; G = G_; c = c_; }
    __host__ __device__ bool next(int i, Unit& u) const {
        const long L = (long)i * G + c; if (L >= nwg) return false;
        int wgid = (int)L; { const int q = nwg / NXCD, r = nwg % NXCD, xcd = wgid % NXCD, off = wgid / NXCD; wgid = (xcd < r ? xcd * (q + 1) : r * (q + 1) + (xcd - r) * q) + off; }
        const int nig = WGM * nN, gid = wgid / nig, fm = gid * WGM, gsz = (nM - fm) < WGM ? (nM - fm) : WGM;
        u.pm = fm + ((wgid % nig) % gsz); u.pn = (wgid % nig) / gsz; return true;
    }
    __device__ __forceinline__ void a_ready(const Unit&) const {}
    __device__ __forceinline__ void done(const Unit&) const {}
};

__device__ __forceinline__ unsigned cvt_pk_bf16(float lo, float hi) { unsigned r; asm volatile("v_cvt_pk_bf16_f32 %0, %1, %2" : "=v"(r) : "v"(lo), "v"(hi)); return r; }
typedef float f32x2 __attribute__((ext_vector_type(2)));
template <class Epi, class Sched, bool ALIGN_EPI = false, bool SP2 = false>
__device__ __forceinline__ void gemm_phase(PG8_LAS unsigned char* lds, const Gemm g, const Sched& S, const Epi& E) {
    const int tid = threadIdx.x, wid = __builtin_amdgcn_readfirstlane(tid >> 6), lane = tid & 63, wr = wid >> 2, wc = wid & 3, fr = lane & 15, fq = lane >> 4;
    const int K = g.K, nt = K / BK;
    unsigned voffA[2], voffB[2];
#pragma unroll
    for (int i = 0; i < 2; ++i) { int R, C; stage_rc(tid * 16 + i * 8192, R, C); const int Rb = Epi::PERM ? ((R & ~31) + perm32(R & 31)) : R;
        voffA[i] = (unsigned)(R * K + C) * 2u; voffB[i] = (unsigned)(Rb * K + C) * 2u; }
    const size_t kstep = (size_t)(BK * 2);
    const size_t hstep = (size_t)HALF * K * 2;
    const size_t tstep = 2 * hstep;
    const unsigned ldsw = (unsigned)wid * 1024u;
    const int aoff = lds_byte(wr * 64 + fr, fq * 8), boff = lds_byte(wc * 32 + fr, fq * 8);
#define PG8_SA(b, h) (((b) * 2 + (h)) * HTB)
#define PG8_SB(b, h) ((4 + (b) * 2 + (h)) * HTB)
#define PG8_STAGE(bufoff, gbase, voff) do { _Pragma("unroll") for (int _i = 0; _i < 2; ++_i) \
        __builtin_amdgcn_global_load_lds((const unsigned*)((const char*)(gbase) + (voff)[_i]), (PG8_LAS unsigned*)(lds + (bufoff) + ldsw + _i * 8192), 16, 0, 0); } while (0)
#define PG8_LDA(dst, b, h) do { _Pragma("unroll") for (int m = 0; m < 4; ++m) _Pragma("unroll") for (int k = 0; k < 2; ++k) dst[m][k] = *(const PG8_LAS bf16x8*)(lds + PG8_SA(b, h) + aoff + m * 2048 + k * 1024); } while (0)
#define PG8_LDB(dst, b, h) do { _Pragma("unroll") for (int n = 0; n < 2; ++n) _Pragma("unroll") for (int k = 0; k < 2; ++k) dst[n][k] = *(const PG8_LAS bf16x8*)(lds + PG8_SB(b, h) + boff + n * 2048 + k * 1024); } while (0)
#define PG8_MMA(ai, bj, At, Bt) do { __builtin_amdgcn_s_setprio(1); _Pragma("unroll") for (int m = 0; m < 4; ++m) _Pragma("unroll") for (int n = 0; n < 2; ++n) _Pragma("unroll") for (int k = 0; k < 2; ++k) \
        acc[ai][bj][m][n] = __builtin_amdgcn_mfma_f32_16x16x32_bf16(Bt[n][k], At[m][k], acc[ai][bj][m][n], 0, 0, 0); __builtin_amdgcn_s_setprio(0); } while (0)
#define PG8_WAIT_V(n) asm volatile("s_waitcnt vmcnt(" #n ")" ::: "memory")
#define PG8_WAIT_L(n) asm volatile("s_waitcnt lgkmcnt(" #n ")" ::: "memory")
#define PG8_BAR __builtin_amdgcn_s_barrier()
#define PG8_SCHED __builtin_amdgcn_sched_barrier(0)
    Unit cur, nxt; int ui = 0;
    if (!S.next(0, cur)) return;
    f32x4 acc[2][2][4][2];
#pragma unroll
    for (int a = 0; a < 2; ++a)
#pragma unroll
        for (int b = 0; b < 2; ++b)
#pragma unroll
            for (int m = 0; m < 4; ++m)
#pragma unroll
                for (int n = 0; n < 2; ++n) acc[a][b][m][n] = (f32x4){0.f, 0.f, 0.f, 0.f};
    bf16x8 At[4][2], B0[2][2], B1[2][2];
    const char* cA = (const char*)g.A + (size_t)cur.pm * tstep; const char* cB = (const char*)g.Bt + (size_t)cur.pn * tstep;
    S.a_ready(cur);
    if constexpr (SP2) {
        PG8_STAGE(PG8_SB(0, 0), cB, voffB); PG8_STAGE(PG8_SB(0, 1), cB + hstep, voffB); PG8_STAGE(PG8_SA(0, 0), cA, voffA); PG8_STAGE(PG8_SA(0, 1), cA + hstep, voffA);
        if (wr == 1) PG8_BAR;
        PG8_WAIT_V(2); PG8_BAR;
        PG8_STAGE(PG8_SB(1, 0), cB + kstep, voffB); PG8_STAGE(PG8_SA(1, 0), cA + kstep, voffA); PG8_STAGE(PG8_SB(1, 1), cB + hstep + kstep, voffB);
        PG8_WAIT_V(6); PG8_BAR;
    } else {
        PG8_STAGE(PG8_SB(0, 0), cB, voffB); PG8_STAGE(PG8_SA(0, 0), cA, voffA); PG8_STAGE(PG8_SB(0, 1), cB + hstep, voffB); PG8_STAGE(PG8_SA(0, 1), cA + hstep, voffA);
        if (wr == 1) PG8_BAR;
        PG8_WAIT_V(4); PG8_BAR;
        PG8_STAGE(PG8_SB(1, 0), cB + kstep, voffB); PG8_STAGE(PG8_SA(1, 0), cA + kstep, voffA); PG8_STAGE(PG8_SB(1, 1), cB + hstep + kstep, voffB);
        PG8_WAIT_V(6); PG8_BAR;
    }
    for (;;) {
        const bool has_next = S.next(ui + 1, nxt);
        const char* nA = has_next ? (const char*)g.A + (size_t)nxt.pm * tstep : cA; const char* nB = has_next ? (const char*)g.Bt + (size_t)nxt.pn * tstep : cB;
        for (int t = 0; t < nt; t += 2) {
            const bool last = (t == nt - 2);
            const char* a1 = cA + (size_t)(t + 1) * kstep;
            const char* a2 = last ? nA : cA + (size_t)(t + 2) * kstep; const char* b2 = last ? nB : cB + (size_t)(t + 2) * kstep;
            const char* a3 = a2 + kstep; const char* b3 = b2 + kstep;
            if (last && has_next) S.a_ready(nxt);
            if constexpr (SP2) {
            PG8_LDB(B0, 0, 0); PG8_LDB(B1, 0, 1); PG8_SCHED; PG8_LDA(At, 0, 0); PG8_STAGE(PG8_SA(1, 1), a1 + hstep, voffA);
            PG8_WAIT_V(8); PG8_WAIT_L(0); PG8_BAR; PG8_MMA(0, 0, At, B0); PG8_MMA(0, 1, At, B1); PG8_BAR; PG8_SCHED;
            PG8_LDA(At, 0, 1); PG8_STAGE(PG8_SB(0, 0), b2, voffB); PG8_STAGE(PG8_SB(0, 1), b2 + hstep, voffB); PG8_STAGE(PG8_SA(0, 0), a2, voffA);
            PG8_WAIT_V(8); PG8_WAIT_L(0); PG8_BAR; PG8_MMA(1, 0, At, B0); PG8_MMA(1, 1, At, B1); PG8_BAR; PG8_SCHED;
            PG8_LDB(B0, 1, 0); PG8_LDB(B1, 1, 1); PG8_SCHED; PG8_LDA(At, 1, 0); PG8_STAGE(PG8_SA(0, 1), a2 + hstep, voffA);
            PG8_WAIT_V(8); PG8_WAIT_L(0); PG8_BAR; PG8_MMA(0, 0, At, B0); PG8_MMA(0, 1, At, B1); PG8_BAR; PG8_SCHED;
            PG8_LDA(At, 1, 1); PG8_STAGE(PG8_SB(1, 0), b3, voffB); PG8_STAGE(PG8_SB(1, 1), b3 + hstep, voffB); PG8_STAGE(PG8_SA(1, 0), a3, voffA);
            PG8_WAIT_V(8); PG8_WAIT_L(0); PG8_BAR; PG8_MMA(1, 0, At, B0); PG8_MMA(1, 1, At, B1); PG8_BAR; PG8_SCHED;
            } else {
            PG8_LDB(B0, 0, 0); PG8_SCHED; PG8_LDA(At, 0, 0); PG8_STAGE(PG8_SA(1, 1), a1 + hstep, voffA);
            PG8_WAIT_L(8); PG8_BAR; PG8_WAIT_L(0); PG8_MMA(0, 0, At, B0); PG8_BAR; PG8_SCHED;
            PG8_LDB(B1, 0, 1); PG8_STAGE(PG8_SB(0, 0), b2, voffB);
            PG8_BAR; PG8_WAIT_L(0); PG8_MMA(0, 1, At, B1); PG8_BAR;
            PG8_LDA(At, 0, 1); PG8_STAGE(PG8_SA(0, 0), a2, voffA);
            PG8_BAR; PG8_WAIT_L(0); PG8_MMA(1, 0, At, B0); PG8_BAR; PG8_SCHED;
            PG8_STAGE(PG8_SB(0, 1), b2 + hstep, voffB);
            PG8_WAIT_V(6); PG8_BAR; PG8_MMA(1, 1, At, B1); PG8_BAR;
            PG8_LDB(B0, 1, 0); PG8_SCHED; PG8_LDA(At, 1, 0); PG8_STAGE(PG8_SA(0, 1), a2 + hstep, voffA);
            PG8_WAIT_L(8); PG8_BAR; PG8_WAIT_L(0); PG8_MMA(0, 0, At, B0); PG8_BAR; PG8_SCHED;
            PG8_LDB(B1, 1, 1); PG8_STAGE(PG8_SB(1, 0), b3, voffB);
            PG8_BAR; PG8_WAIT_L(0); PG8_MMA(0, 1, At, B1); PG8_BAR;
            PG8_LDA(At, 1, 1); PG8_STAGE(PG8_SA(1, 0), a3, voffA);
            PG8_BAR; PG8_WAIT_L(0); PG8_MMA(1, 0, At, B0); PG8_BAR; PG8_SCHED;
            PG8_STAGE(PG8_SB(1, 1), b3 + hstep, voffB);
            PG8_WAIT_V(6); PG8_BAR; PG8_MMA(1, 1, At, B1); PG8_BAR;
            }
        }
        if constexpr (ALIGN_EPI) { if (wr == 0) PG8_BAR; }
        if constexpr (!Epi::AFTER_DRAIN) { E(acc, cur, wr, wc, fr, fq); S.done(cur); }
        if (!has_next) break;
#pragma unroll
        for (int a = 0; a < 2; ++a)
#pragma unroll
            for (int b = 0; b < 2; ++b)
#pragma unroll
                for (int m = 0; m < 4; ++m)
#pragma unroll
                    for (int n = 0; n < 2; ++n) acc[a][b][m][n] = (f32x4){0.f, 0.f, 0.f, 0.f};
        cur = nxt; cA = nA; cB = nB; ++ui;
        if constexpr (ALIGN_EPI) { if (wr == 1) PG8_BAR; }
    }
    PG8_WAIT_V(0);
    if constexpr (!ALIGN_EPI) { if (wr == 0) PG8_BAR; }
    PG8_BAR;
    if constexpr (Epi::AFTER_DRAIN) { E.fused(acc, cur, wr, wc, fr, fq, lds, wid, lane); S.done(cur); }
#undef PG8_SA
#undef PG8_SB
#undef PG8_STAGE
#undef PG8_LDA
#undef PG8_LDB
#undef PG8_MMA
#undef PG8_WAIT_V
#undef PG8_WAIT_L
#undef PG8_BAR
#undef PG8_SCHED
}
}
#define GAS __attribute__((address_space(1)))
#define LAS __attribute__((address_space(3)))
typedef unsigned short bf16;
typedef unsigned v4u __attribute__((ext_vector_type(4)));
typedef float f32x4 __attribute__((ext_vector_type(4)));
typedef short bf16x8 __attribute__((ext_vector_type(8)));
typedef GAS unsigned gu32;
typedef GAS unsigned long long gu64;
#define RLX_AGENT __ATOMIC_RELAXED, __HIP_MEMORY_SCOPE_AGENT
#define LDS_WAIT() asm volatile("s_waitcnt lgkmcnt(0)" ::: "memory")
#define VM_WAIT() asm volatile("s_waitcnt vmcnt(0)" ::: "memory")
__device__ __forceinline__ unsigned long long rt() { return __builtin_amdgcn_s_memrealtime(); }
__device__ __forceinline__ unsigned f2bf(float f) { unsigned u = __builtin_bit_cast(unsigned, f); return (u + 0x7fffu + ((u >> 16) & 1u)) >> 16; }
__device__ __forceinline__ unsigned pk2(float lo, float hi) { return f2bf(lo) | (f2bf(hi) << 16); }

#define XB_TMO      128
#define XB_XCNT(j)  (256  + 64 * (j))
#define XB_XSUB(j)  (1280 + 64 * (j))
#define XB_XGEN(j)  (2304 + 64 * (j))
#define XB_TOP      3328
#define XB_TOPGEN   3392
#define XCD_BAR_WORDS 3456
#define XB_SPIN_CAP (1u << 18)

__device__ __forceinline__ unsigned xb_ld(unsigned* p)              { return __hip_atomic_load(p, __ATOMIC_RELAXED, __HIP_MEMORY_SCOPE_AGENT); }
__device__ __forceinline__ unsigned xb_add(unsigned* p, unsigned v) { return __hip_atomic_fetch_add(p, v, __ATOMIC_RELAXED, __HIP_MEMORY_SCOPE_AGENT); }
__device__ __forceinline__ unsigned xb_xcc_id() { return (unsigned)__builtin_amdgcn_s_getreg((3 << 11) | 20) & 0xFu; }
#define XB_SPIN(cond, bar) do { unsigned _sp = 0; while (cond) { __builtin_amdgcn_s_sleep(1); \
    if ((++_sp & 255u) == 0u) { if (xb_ld(&(bar)[XB_TMO])) break; if (_sp > XB_SPIN_CAP) { atomicAdd(&(bar)[XB_TMO], 1u); break; } } } } while (0)

struct XcdBarrier {
    unsigned* bar; unsigned x;
    volatile LAS unsigned* st;
};

__device__ __forceinline__ XcdBarrier xcd_barrier_post(unsigned* bar, volatile LAS unsigned* st) {
    XcdBarrier b; b.bar = bar; b.x = xb_xcc_id(); b.st = st;
    if (threadIdx.x == 0) (void)xb_add(&bar[XB_XCNT(b.x)], 1u);
    return b;
}
__device__ __forceinline__ void xcd_barrier_complete(unsigned* bar, unsigned x, unsigned& nloc, unsigned& nx) {
    const unsigned G = gridDim.x * gridDim.y * gridDim.z;
    unsigned sum, cnt, mine, sp = 0u;
    for (;;) {
        sum = 0u; cnt = 0u; mine = 0u;
#pragma unroll
        for (unsigned j = 0; j < 16; ++j) { const unsigned c = xb_ld(&bar[XB_XCNT(j)]); sum += c; cnt += (c > 0u) ? 1u : 0u; mine = (j == x) ? c : mine; }
        if (sum == G) break;
        __builtin_amdgcn_s_sleep(1);
        if ((++sp & 255u) == 0u) { if (xb_ld(&bar[XB_TMO])) break; if (sp > XB_SPIN_CAP) { atomicAdd(&bar[XB_TMO], 1u); break; } }
    }
    nloc = mine > 0u ? mine : 1u; nx = cnt > 0u ? cnt : 1u;
}

__device__ __forceinline__ void xcd_barrier(const XcdBarrier& b) {
    asm volatile("s_waitcnt vmcnt(0)" ::: "memory");
    __syncthreads();
    if (threadIdx.x == 0) {
        unsigned* bar = b.bar;
        __builtin_amdgcn_s_waitcnt(0);
        unsigned nloc = b.st[0], nx = b.st[1];
        if (nloc == 0u) { xcd_barrier_complete(bar, b.x, nloc, nx); b.st[0] = nloc; b.st[1] = nx; }
        const unsigned old = xb_add(&bar[XB_XSUB(b.x)], 1u);
        const unsigned gen = old / nloc;
        if (old + 1u == (gen + 1u) * nloc) {
            __builtin_amdgcn_fence(__ATOMIC_RELEASE, "agent");
            asm volatile("s_waitcnt vmcnt(0)" ::: "memory");
            const unsigned og = xb_add(&bar[XB_TOP], 1u);
            const unsigned tg = og / nx;
            if (og + 1u == (tg + 1u) * nx) xb_add(&bar[XB_TOPGEN], 1u);
            else XB_SPIN(xb_ld(&bar[XB_TOPGEN]) == tg, bar);
            __builtin_amdgcn_fence(__ATOMIC_ACQUIRE, "agent");
            xb_add(&bar[XB_XGEN(b.x)], 1u);
            asm volatile("s_waitcnt vmcnt(0)" ::: "memory");
        } else {
            XB_SPIN(xb_ld(&bar[XB_XGEN(b.x)]) == gen, bar);
            __builtin_amdgcn_fence(__ATOMIC_ACQUIRE, "agent");
            asm volatile("s_waitcnt vmcnt(0)" ::: "memory");
        }
    }
    __syncthreads();
}

namespace cfg {
constexpr int D = 1024, NB = 4, T = 4096, M = NB * T, SB = 32, SS = 4, MS = SB * SS, PAST = 8192, PAGE = 128, NPG = PAST / PAGE;
constexpr int H = 16, HD = 64, NKV = 4, NIN = 7728, NINP = 7936, FF = 2816, NGU = 2 * FF, NMOD = 6 * D, RMOD = NB + SB, MODKC = 8;
constexpr int NCS_P = 255, NCP_P = 256, NCS_S = 511, NCP_S = 512;
constexpr float EPS = 1e-6f, NEGF = -1e30f;
constexpr size_t O_YP = 0, O_YS = 16777216, O_CMP_P = 16908288, O_SEL_P = 25296896, O_WIN_P = 33685504, O_CONV_P = 34734080,
                 O_CMP_S = 34742272, O_SEL_S = 34807808, O_WIN_S = 34873344, O_CONV_S = 43261952, O_END = 43327488;
constexpr size_t MiB = 1u << 20;
constexpr size_t WS_CTL = 0, CTL_ZERO_BYTES = 1 * MiB;
constexpr size_t WS_WIN_T = 2 * MiB, WS_WOC_T = 18 * MiB, WS_WON_T = 20 * MiB, WS_WOUT_T = 22 * MiB, WS_WGU_T = 24 * MiB, WS_WDN_T = 36 * MiB;
constexpr size_t WS_MODP = 42 * MiB, WS_MOD = 49 * MiB;
constexpr size_t WS_XN = 64 * MiB, WS_BG = 96 * MiB, WS_U = 128 * MiB, WS_Q = 160 * MiB, WS_HM = 192 * MiB, WS_GA = 240 * MiB, WS_GB = 272 * MiB, WS_NGT = 304 * MiB;
constexpr size_t WS_AA = 308 * MiB, WS_OB = 340 * MiB, WS_MG = 372 * MiB, WS_X1 = 404 * MiB, WS_P1 = 468 * MiB, WS_HF = 532 * MiB, WS_KCC = 620 * MiB, WS_SCOREH = 622 * MiB, WS_MASK = 686 * MiB;
constexpr size_t WS_XNS = 688 * MiB, WS_ZS = 689 * MiB, WS_AAS = 693 * MiB, WS_OBS = 694 * MiB, WS_MGS = 695 * MiB, WS_X1S = 696 * MiB, WS_XN2S = 697 * MiB, WS_HFS = 698 * MiB, WS_X2S = 700 * MiB;
constexpr size_t WS_KCCS = 701 * MiB, WS_SCOREHS = 733 * MiB, WS_MASKS = 735 * MiB, WS_END = 736 * MiB;
constexpr size_t HMSZ = (size_t)NB * NKV * T * HD;
constexpr int CW_BAR = 4096;
constexpr int RING_OFF = 0, RING_BYTES = 131072, LDSCTL_OFF = RING_BYTES, MISC_OFF = LDSCTL_OFF + 320, LDS_BYTES = 147456;
constexpr int NWAVES = 8, NTHR = 512;
constexpr int NPHASE = 13;
}
using namespace cfg;

struct Ctx {
    const float *x_p, *x_s, *c_p, *c_s, *cache_cmp, *cache_sel, *cache_win, *state_conv; const int* pt;
    const float *w_ada, *b_ada, *norm1, *w_in, *w_conv, *b_conv, *w_oc, *pe, *w_phi1, *w_phi2, *w_on, *w_out, *norm2, *w_gate, *w_up, *w_down, *norm_f;
    float* out;
    bf16 *WIN_T, *WOC_T, *WON_T, *WOUT_T, *WGU_T, *WDN_T;
    float *MODP, *MOD;
    bf16 *XN, *BG, *U, *Q, *HM, *GA, *GB; float* NGT;
    bf16 *AA, *OB, *MG; float *X1, *P1; bf16* HF; float *KCC, *SCOREH; unsigned long long* MASK;
    float *XNS, *ZS, *AAS, *OBS, *MGS, *X1S, *XN2S, *HFS, *X2S, *KCCS, *SCOREHS; unsigned long long* MASKS;
    LAS unsigned char* lds; int tid, lane, wave, G, bid;
};

__device__ __forceinline__ float bf2f(bf16 b) { return __uint_as_float((unsigned)b << 16); }
__device__ __forceinline__ float sigmoidf_(float x) { return 1.f / (1.f + __expf(-x)); }
__device__ __forceinline__ float siluf_(float x) { return x / (1.f + __expf(-x)); }
__device__ __forceinline__ float gelu_tanh(float x) { const float u = 0.7978845608028654f * (x + 0.044715f * x * x * x); const float e = __expf(2.f * u); const float th = 1.f - 2.f / (e + 1.f); return 0.5f * x * (1.f + th); }
__device__ __forceinline__ float wave_sum(float v) {
#pragma unroll
    for (int o = 1; o < 64; o <<= 1) v += __shfl_xor(v, o);
    return v;
}
__device__ __forceinline__ void ld8(const bf16* p, float (&v)[8]) {
    const v4u w = *(const v4u*)p;
    v[0] = __uint_as_float(w.x << 16); v[1] = __uint_as_float(w.x & 0xffff0000u); v[2] = __uint_as_float(w.y << 16); v[3] = __uint_as_float(w.y & 0xffff0000u);
    v[4] = __uint_as_float(w.z << 16); v[5] = __uint_as_float(w.z & 0xffff0000u); v[6] = __uint_as_float(w.w << 16); v[7] = __uint_as_float(w.w & 0xffff0000u);
}
__device__ __forceinline__ void ld8(const float* p, float (&v)[8]) {
    const f32x4 a = *(const f32x4*)p, b = *(const f32x4*)(p + 4);
    v[0] = a.x; v[1] = a.y; v[2] = a.z; v[3] = a.w; v[4] = b.x; v[5] = b.y; v[6] = b.z; v[7] = b.w;
}
__device__ __forceinline__ v4u pack8(const float (&v)[8]) { v4u w; w.x = pg8::cvt_pk_bf16(v[0], v[1]); w.y = pg8::cvt_pk_bf16(v[2], v[3]); w.z = pg8::cvt_pk_bf16(v[4], v[5]); w.w = pg8::cvt_pk_bf16(v[6], v[7]); return w; }
template <class TP> __device__ __forceinline__ float dot64(const TP* row, const float (&q)[64]) {
    float s = 0.f;
#pragma unroll
    for (int c = 0; c < 8; ++c) { float v[8]; ld8(row + 8 * c, v);
#pragma unroll
        for (int j = 0; j < 8; ++j) s += q[8 * c + j] * v[j]; }
    return s;
}
template <class TP> __device__ __forceinline__ void axpy64(const TP* row, float p, float (&o)[64]) {
#pragma unroll
    for (int c = 0; c < 8; ++c) { float v[8]; ld8(row + 8 * c, v);
#pragma unroll
        for (int j = 0; j < 8; ++j) o[8 * c + j] += p * v[j]; }
}

struct SrcCol { const float* W; int ld; int col; };
template <class F> __device__ __forceinline__ void transpose_item(const F& f, int K, bf16* WT, LAS float* scr, int item, int nblk, int lane) {
    const int kb = item / nblk, nb = item % nblk, k0 = 64 * kb, n0 = 32 * nb;
    const SrcCol sc = f(n0 + (lane & 31));
#pragma unroll 8
    for (int i = 0; i < 32; ++i) { const int kk = 2 * i + (lane >> 5); scr[kk * 33 + (lane & 31)] = sc.col >= 0 ? sc.W[(size_t)(k0 + kk) * sc.ld + sc.col] : 0.f; }
    LDS_WAIT(); asm volatile("" ::: "memory");
    const int c = lane & 7;
#pragma unroll
    for (int j = 0; j < 4; ++j) { const int n = (lane >> 3) + 8 * j; const LAS float* s = scr + (8 * c) * 33 + n;
        v4u o; o.x = pk2(s[0 * 33], s[1 * 33]); o.y = pk2(s[2 * 33], s[3 * 33]); o.z = pk2(s[4 * 33], s[5 * 33]); o.w = pk2(s[6 * 33], s[7 * 33]);
        *(GAS v4u*)(WT + (size_t)(n0 + n) * K + k0 + 8 * c) = o; }
    LDS_WAIT(); asm volatile("" ::: "memory");
}
struct ColIn { const float* W; __device__ __forceinline__ SrcCol operator()(int p) const {
    int s;
    if (p < 1024) s = p;
    else if (p < 3072) { const int t = (p - 1024) >> 8, w = (p - 1024) & 255; s = (w < 128) ? (1024 + 128 * t + w) : (2048 + 128 * t + (w - 128)); }
    else if (p < 5632) s = p;
    else if (p < 7680) s = 5680 + (p - 5632);
    else if (p < 7728) s = 5632 + (p - 7680);
    else s = -1;
    return SrcCol{W, NIN, s}; } };
struct ColPlain { const float* W; int ld; __device__ __forceinline__ SrcCol operator()(int p) const { return SrcCol{W, ld, p}; } };
struct ColGU { const float *Wg, *Wu; __device__ __forceinline__ SrcCol operator()(int p) const { const int t = p >> 8, w = p & 255; return (w < 128) ? SrcCol{Wg, FF, 128 * t + w} : SrcCol{Wu, FF, 128 * t + (w - 128)}; } };

__device__ __forceinline__ void mod_partial_item(const Ctx& c, int item) {
    const int kc = item / 12, cc = item % 12, k0 = kc * 128, n = cc * 512 + c.tid;
    LAS float* sc = (LAS float*)c.lds;
    for (int i = c.tid; i < RMOD * 128; i += NTHR) { const int r = i >> 7, k = i & 127; const float cv = (r < NB) ? c.c_p[r * D + k0 + k] : c.c_s[(r - NB) * D + k0 + k]; sc[i] = siluf_(cv); }
    __syncthreads();
    float acc[RMOD];
#pragma unroll
    for (int r = 0; r < RMOD; ++r) acc[r] = 0.f;
    for (int k = 0; k < 128; ++k) { const float w = c.w_ada[(size_t)(k0 + k) * NMOD + n];
#pragma unroll
        for (int r = 0; r < RMOD; ++r) acc[r] += sc[r * 128 + k] * w; }
#pragma unroll
    for (int r = 0; r < RMOD; ++r) c.MODP[((size_t)kc * RMOD + r) * NMOD + n] = acc[r];
    __syncthreads();
}
__device__ __forceinline__ void p0_prologue(const Ctx& c) {
    for (int it = c.bid; it < MODKC * 12; it += c.G) mod_partial_item(c, it);
    LAS float* scr = (LAS float*)(c.lds + c.wave * 16384);
    const int gw = c.bid * NWAVES + c.wave, NGW = c.G * NWAVES;
    constexpr int I_IN = 16 * (NINP / 32), I_SQ = 16 * 32, I_GU = 16 * (NGU / 32), I_DN = (FF / 64) * 32;
    constexpr int NITEMS = I_IN + 3 * I_SQ + I_GU + I_DN;
    for (int it = gw; it < NITEMS; it += NGW) {
        int r = it;
        if (r < I_IN) { transpose_item(ColIn{c.w_in}, D, c.WIN_T, scr, r, NINP / 32, c.lane); continue; } r -= I_IN;
        if (r < I_SQ) { transpose_item(ColPlain{c.w_oc, D}, D, c.WOC_T, scr, r, 32, c.lane); continue; } r -= I_SQ;
        if (r < I_SQ) { transpose_item(ColPlain{c.w_on, D}, D, c.WON_T, scr, r, 32, c.lane); continue; } r -= I_SQ;
        if (r < I_SQ) { transpose_item(ColPlain{c.w_out, D}, D, c.WOUT_T, scr, r, 32, c.lane); continue; } r -= I_SQ;
        if (r < I_GU) { transpose_item(ColGU{c.w_gate, c.w_up}, D, c.WGU_T, scr, r, NGU / 32, c.lane); continue; } r -= I_GU;
        transpose_item(ColPlain{c.w_down, D}, FF, c.WDN_T, scr, r, 32, c.lane);
    }
}

template <bool MODUL, bool OUT_BF16> __device__ __forceinline__ void norm_row(const float* xrow, const float* gain, const float* sh, const float* sc, void* orow, int lane) {
    const GAS f32x4* xr = (const GAS f32x4*)xrow + lane;
    f32x4 v[4]; float s = 0.f;
#pragma unroll
    for (int j = 0; j < 4; ++j) { v[j] = xr[64 * j]; s += (v[j].x * v[j].x + v[j].y * v[j].y) + (v[j].z * v[j].z + v[j].w * v[j].w); }
    const float inv = 1.0f / sqrtf(wave_sum(s) * (1.f / D) + EPS);
#pragma unroll
    for (int j = 0; j < 4; ++j) {
        const int k = 4 * lane + 256 * j;
        const f32x4 g = *(const f32x4*)(gain + k);
        f32x4 o = v[j] * inv * g;
        if (MODUL) { const f32x4 a = *(const f32x4*)(sc + k), b = *(const f32x4*)(sh + k); o = o * (a + 1.0f) + b; }
        if (OUT_BF16) { ((GAS unsigned long long*)orow)[lane + 64 * j] = (unsigned long long)pg8::cvt_pk_bf16(o.x, o.y) | ((unsigned long long)pg8::cvt_pk_bf16(o.z, o.w) << 32); }
        else { ((GAS f32x4*)orow)[lane + 64 * j] = o; }
    }
}
__device__ __forceinline__ void p1_norm1(const Ctx& c) {
    for (int r = c.bid; r < RMOD; r += c.G)
        for (int n = c.tid; n < NMOD; n += NTHR) { float s = c.b_ada[n];
#pragma unroll
            for (int kc = 0; kc < MODKC; ++kc) s += c.MODP[((size_t)kc * RMOD + r) * NMOD + n];
            c.MOD[(size_t)r * NMOD + n] = s; }
    LAS float* shl = (LAS float*)c.lds; LAS float* scl = shl + D;
    constexpr int NCH = M / 64 + SB;
    for (int ch = c.bid; ch < NCH; ch += c.G) {
        const bool smp = ch >= M / 64; const int r = smp ? NB + (ch - M / 64) : (ch * 64) / T;
        __syncthreads();
        for (int k = c.tid; k < 2 * D; k += NTHR) { float s = c.b_ada[k];
#pragma unroll
            for (int kc = 0; kc < MODKC; ++kc) s += c.MODP[((size_t)kc * RMOD + r) * NMOD + k];
            shl[k] = s; }
        __syncthreads();
        if (!smp) { for (int rr = c.wave; rr < 64; rr += NWAVES) { const int row = ch * 64 + rr;
                const GAS f32x4* xr = (const GAS f32x4*)(c.x_p + (size_t)row * D) + c.lane; f32x4 v[4]; float s = 0.f;
#pragma unroll
                for (int j = 0; j < 4; ++j) { v[j] = xr[64 * j]; s += (v[j].x * v[j].x + v[j].y * v[j].y) + (v[j].z * v[j].z + v[j].w * v[j].w); }
                const float inv = 1.0f / sqrtf(wave_sum(s) * (1.f / D) + EPS);
#pragma unroll
                for (int j = 0; j < 4; ++j) { const int k = 4 * c.lane + 256 * j; const f32x4 g = *(const f32x4*)(c.norm1 + k);
                    const f32x4 a = *(const LAS f32x4*)(scl + k), b = *(const LAS f32x4*)(shl + k); const f32x4 o = v[j] * inv * g * (a + 1.0f) + b;
                    ((GAS unsigned long long*)(c.XN + (size_t)row * D))[c.lane + 64 * j] = (unsigned long long)pg8::cvt_pk_bf16(o.x, o.y) | ((unsigned long long)pg8::cvt_pk_bf16(o.z, o.w) << 32); } } }
        else if (c.wave < SS) { const int row = (ch - M / 64) * SS + c.wave;
                const GAS f32x4* xr = (const GAS f32x4*)(c.x_s + (size_t)row * D) + c.lane; f32x4 v[4]; float s = 0.f;
#pragma unroll
                for (int j = 0; j < 4; ++j) { v[j] = xr[64 * j]; s += (v[j].x * v[j].x + v[j].y * v[j].y) + (v[j].z * v[j].z + v[j].w * v[j].w); }
                const float inv = 1.0f / sqrtf(wave_sum(s) * (1.f / D) + EPS);
#pragma unroll
                for (int j = 0; j < 4; ++j) { const int k = 4 * c.lane + 256 * j; const f32x4 g = *(const f32x4*)(c.norm1 + k);
                    const f32x4 a = *(const LAS f32x4*)(scl + k), b = *(const LAS f32x4*)(shl + k); const f32x4 o = v[j] * inv * g * (a + 1.0f) + b;
                    ((GAS f32x4*)(c.XNS + (size_t)row * D))[c.lane + 64 * j] = o; } }
    }
    __syncthreads();
}
__device__ __forceinline__ void p5c_norm2(const Ctx& c) {
    const int gw = c.bid * NWAVES + c.wave, NGW = c.G * NWAVES;
    for (int row = gw; row < M + MS; row += NGW) {
        if (row < M) { const int r = row / T; norm_row<true, true>(c.X1 + (size_t)row * D, c.norm2, c.MOD + (size_t)r * NMOD + 3 * D, c.MOD + (size_t)r * NMOD + 4 * D, c.XN + (size_t)row * D, c.lane); }
        else { const int rs = row - M, r = NB + rs / SS; norm_row<true, false>(c.X1S + (size_t)rs * D, c.norm2, c.MOD + (size_t)r * NMOD + 3 * D, c.MOD + (size_t)r * NMOD + 4 * D, c.XN2S + (size_t)rs * D, c.lane); }
    }
}
__device__ __forceinline__ void p8_normf(const Ctx& c) {
    const int gw = c.bid * NWAVES + c.wave, NGW = c.G * NWAVES;
    for (int row = gw; row < M + MS; row += NGW) {
        if (row < M) norm_row<false, false>(c.out + O_YP + (size_t)row * D, c.norm_f, nullptr, nullptr, c.out + O_YP + (size_t)row * D, c.lane);
        else { const int rs = row - M; norm_row<false, false>(c.X2S + (size_t)rs * D, c.norm_f, nullptr, nullptr, c.out + O_YS + (size_t)rs * D, c.lane); }
    }
}

using pg8::Unit;
#define EPI_ROWS(...) _Pragma("unroll") for (int ai = 0; ai < 2; ++ai) _Pragma("unroll") for (int m = 0; m < 4; ++m) { const int row = row0 + ai * 128 + m * 16; __VA_ARGS__ }
struct EpiIn {
    static constexpr bool PERM = true, AFTER_DRAIN = false;
    bf16 *BG, *U, *Q, *HM, *GA, *GB; float* NGT; float* out;
    __device__ __forceinline__ void operator()(const f32x4 (&acc)[2][2][4][2], const Unit& u, int wr, int wc, int fr, int fq) const {
        const int pn = u.pn, row0 = u.pm * 256 + wr * 64 + fr, cl0 = wc * 32 + 8 * fq;
        if (pn < 4 || (pn >= 12 && pn < 16) || (pn >= 22 && pn < 30)) {
            bf16* base; int colt; float sc = 1.f; bool sig = false;
            if (pn < 4) { base = BG; colt = pn * 256; } else if (pn < 16) { base = Q; colt = (pn - 12) * 256; sc = 0.125f; } else if (pn < 26) { base = GA; colt = (pn - 22) * 256; sig = true; } else { base = GB; colt = (pn - 26) * 256; sig = true; }
            EPI_ROWS(
_Pragma("unroll")
                for (int bj = 0; bj < 2; ++bj) { const f32x4 a = acc[ai][bj][m][0], b = acc[ai][bj][m][1]; float v[8] = {a.x, a.y, a.z, a.w, b.x, b.y, b.z, b.w};
_Pragma("unroll")
                    for (int j = 0; j < 8; ++j) v[j] = sig ? sigmoidf_(v[j]) : v[j] * sc;
                    *(GAS v4u*)(base + (size_t)row * D + colt + bj * 128 + cl0) = pack8(v); } )
        } else if (pn < 12) {
            const int t = pn - 4;
            EPI_ROWS(
                const f32x4 a = acc[ai][0][m][0] * acc[ai][1][m][0], b = acc[ai][0][m][1] * acc[ai][1][m][1]; const float v[8] = {a.x, a.y, a.z, a.w, b.x, b.y, b.z, b.w};
                *(GAS v4u*)(U + (size_t)row * D + t * 128 + cl0) = pack8(v);
                const int tt = row & (T - 1);
                if (tt >= T - 2) { float* o = out + O_CONV_P + (size_t)((row >> 12) * 2 + (tt - (T - 2))) * D + t * 128 + cl0; *(GAS f32x4*)o = a; *(GAS f32x4*)(o + 4) = b; } )
        } else if (pn < 22) {
            const int kind = pn - 16, kv = kind & 1, reg = kind >> 1;
            EPI_ROWS(
                const int b = row >> 12, tt = row & (T - 1);
_Pragma("unroll")
                for (int bj = 0; bj < 2; ++bj) { const f32x4 a = acc[ai][bj][m][0], bq = acc[ai][bj][m][1]; const float v[8] = {a.x, a.y, a.z, a.w, bq.x, bq.y, bq.z, bq.w};
                    const int cl = bj * 128 + cl0, g = cl >> 6, d = cl & 63;
                    *(GAS v4u*)(HM + (size_t)kind * HMSZ + ((size_t)((b * NKV + g) * T + tt)) * HD + d) = pack8(v);
                    float* o = nullptr;
                    if (reg == 0) o = out + O_CMP_P + ((size_t)row * 2 + kv) * 256 + cl;
                    else if (reg == 1) o = out + O_SEL_P + ((size_t)row * 2 + kv) * 256 + cl;
                    else if (tt >= T - 512) o = out + O_WIN_P + ((size_t)(b * 512 + tt - (T - 512)) * 2 + kv) * 256 + cl;
                    if (o) { *(GAS f32x4*)o = a; *(GAS f32x4*)(o + 4) = bq; } } )
        } else {
            if (cl0 < 48) {
                EPI_ROWS(
                    const f32x4 a = acc[ai][0][m][0], b = acc[ai][0][m][1];
                    f32x4 sa, sb; sa.x = sigmoidf_(a.x); sa.y = sigmoidf_(a.y); sa.z = sigmoidf_(a.z); sa.w = sigmoidf_(a.w); sb.x = sigmoidf_(b.x); sb.y = sigmoidf_(b.y); sb.z = sigmoidf_(b.z); sb.w = sigmoidf_(b.w);
                    float* o = NGT + (size_t)row * 48 + cl0; *(GAS f32x4*)o = sa; *(GAS f32x4*)(o + 4) = sb; )
            }
        }
    }
};
struct EpiYa { static constexpr bool PERM = true, AFTER_DRAIN = false; const bf16* GA; float* P1;
    __device__ __forceinline__ void operator()(const f32x4 (&acc)[2][2][4][2], const Unit& u, int wr, int wc, int fr, int fq) const {
        const int row0 = u.pm * 256 + wr * 64 + fr, col0 = u.pn * 256 + wc * 32 + 8 * fq;
        EPI_ROWS(
_Pragma("unroll")
            for (int bj = 0; bj < 2; ++bj) { const size_t off = (size_t)row * D + col0 + bj * 128; float g[8]; ld8(GA + off, g); const f32x4 a = acc[ai][bj][m][0], b = acc[ai][bj][m][1];
                f32x4 o0, o1; o0.x = g[0] * a.x; o0.y = g[1] * a.y; o0.z = g[2] * a.z; o0.w = g[3] * a.w; o1.x = g[4] * b.x; o1.y = g[5] * b.y; o1.z = g[6] * b.z; o1.w = g[7] * b.w;
                *(GAS f32x4*)(P1 + off) = o0; *(GAS f32x4*)(P1 + off + 4) = o1; } )
    } };
struct EpiYb { static constexpr bool PERM = true, AFTER_DRAIN = false; const bf16* GB; const float* P1; bf16* MG;
    __device__ __forceinline__ void operator()(const f32x4 (&acc)[2][2][4][2], const Unit& u, int wr, int wc, int fr, int fq) const {
        const int row0 = u.pm * 256 + wr * 64 + fr, col0 = u.pn * 256 + wc * 32 + 8 * fq;
        EPI_ROWS(
_Pragma("unroll")
            for (int bj = 0; bj < 2; ++bj) { const size_t off = (size_t)row * D + col0 + bj * 128; float g[8]; ld8(GB + off, g); float p[8]; ld8(P1 + off, p); const f32x4 a = acc[ai][bj][m][0], b = acc[ai][bj][m][1];
                const float v[8] = {p[0] + g[0] * a.x, p[1] + g[1] * a.y, p[2] + g[2] * a.z, p[3] + g[3] * a.w, p[4] + g[4] * b.x, p[5] + g[5] * b.y, p[6] + g[6] * b.z, p[7] + g[7] * b.w};
                *(GAS v4u*)(MG + off) = pack8(v); } )
    } };
struct EpiRes { static constexpr bool PERM = true, AFTER_DRAIN = false; const float* base; float* O; const float* MOD; int goff;
    __device__ __forceinline__ void operator()(const f32x4 (&acc)[2][2][4][2], const Unit& u, int wr, int wc, int fr, int fq) const {
        const int row0 = u.pm * 256 + wr * 64 + fr, col0 = u.pn * 256 + wc * 32 + 8 * fq;
        const float* gp = MOD + (size_t)((u.pm * 256) / T) * NMOD + goff + col0;
        f32x4 gt[2][2];
#pragma unroll
        for (int bj = 0; bj < 2; ++bj) { gt[bj][0] = *(const f32x4*)(gp + bj * 128); gt[bj][1] = *(const f32x4*)(gp + bj * 128 + 4); }
        EPI_ROWS(
_Pragma("unroll")
            for (int bj = 0; bj < 2; ++bj) { const size_t off = (size_t)row * D + col0 + bj * 128;
                const f32x4 x0 = *(const f32x4*)(base + off), x1 = *(const f32x4*)(base + off + 4);
                *(GAS f32x4*)(O + off) = x0 + gt[bj][0] * acc[ai][bj][m][0]; *(GAS f32x4*)(O + off + 4) = x1 + gt[bj][1] * acc[ai][bj][m][1]; } )
    } };
struct EpiFF { static constexpr bool PERM = true, AFTER_DRAIN = false; bf16* HF;
    __device__ __forceinline__ void operator()(const f32x4 (&acc)[2][2][4][2], const Unit& u, int wr, int wc, int fr, int fq) const {
        const int row0 = u.pm * 256 + wr * 64 + fr, col0 = u.pn * 128 + wc * 32 + 8 * fq;
        EPI_ROWS(
            const f32x4 g0 = acc[ai][0][m][0], g1 = acc[ai][0][m][1], u0 = acc[ai][1][m][0], u1 = acc[ai][1][m][1];
            const float v[8] = {siluf_(g0.x) * u0.x, siluf_(g0.y) * u0.y, siluf_(g0.z) * u0.z, siluf_(g0.w) * u0.w, siluf_(g1.x) * u1.x, siluf_(g1.y) * u1.y, siluf_(g1.z) * u1.z, siluf_(g1.w) * u1.w};
            *(GAS v4u*)(HF + (size_t)row * FF + col0) = pack8(v); )
    } };

template <bool DUAL, class Epi> __device__ __forceinline__ void sgemm(const Ctx& c, const float* A1, const float* A2, int lda, const float* W1, const float* W2, int ldw, int K, int N, const Epi& epi) {
    const int nch = (N + NTHR - 1) / NTHR, nitems = 8 * nch;
    for (int it = c.G - 1 - c.bid; it < nitems; it += c.G) {
        const int rg = it & 7, n = (it >> 3) * NTHR + c.tid;
        if (n < N) {
            float a1[16], a2[16];
#pragma unroll
            for (int r = 0; r < 16; ++r) { a1[r] = 0.f; a2[r] = 0.f; }
            const float* ar1 = A1 + (size_t)rg * 16 * lda; const float* ar2 = A2 + (size_t)rg * 16 * lda;
            for (int k = 0; k < K; ++k) { const float w1 = W1[(size_t)k * ldw + n]; const float w2 = DUAL ? W2[(size_t)k * ldw + n] : 0.f;
#pragma unroll
                for (int r = 0; r < 16; ++r) { a1[r] += ar1[(size_t)r * lda + k] * w1; if (DUAL) a2[r] += ar2[(size_t)r * lda + k] * w2; } }
#pragma unroll
            for (int r = 0; r < 16; ++r) epi(rg * 16 + r, n, a1[r], a2[r]);
        }
    }
}

__device__ __forceinline__ void p3_conv_prompt(const Ctx& c) {
    const int gt = c.bid * NTHR + c.tid, NGT_ = c.G * NTHR;
    for (int it = gt; it < M * (D / 8); it += NGT_) {
        const int row = it >> 7, ch = (it & 127) * 8, tt = row & (T - 1);
        float u0[8], u1[8], u2[8], bg[8];
        ld8(c.U + (size_t)row * D + ch, u0); ld8(c.BG + (size_t)row * D + ch, bg);
        if (tt >= 1) ld8(c.U + (size_t)(row - 1) * D + ch, u1); else { for (int j = 0; j < 8; ++j) u1[j] = 0.f; }
        if (tt >= 2) ld8(c.U + (size_t)(row - 2) * D + ch, u2); else { for (int j = 0; j < 8; ++j) u2[j] = 0.f; }
        float w0[8], w1[8], w2[8], bb[8]; ld8(c.w_conv + ch, w0); ld8(c.w_conv + D + ch, w1); ld8(c.w_conv + 2 * D + ch, w2); ld8(c.b_conv + ch, bb);
        float v[8];
#pragma unroll
        for (int j = 0; j < 8; ++j) v[j] = bg[j] * (bb[j] + w0[j] * u2[j] + w1[j] * u1[j] + w2[j] * u0[j]);
        *(GAS v4u*)(c.AA + (size_t)row * D + ch) = pack8(v);
    }
}
__device__ __forceinline__ void p3_sample_thin(const Ctx& c) {
    const int gt = c.bid * NTHR + c.tid, NGT_ = c.G * NTHR;
    for (int it = gt; it < MS * D; it += NGT_) {
        const int row = it >> 10, ch = it & 1023, b = row >> 2, s = row & 3;
        float up[3];
#pragma unroll
        for (int k = 0; k < 3; ++k) { const int ss = s - 2 + k; up[k] = (ss >= 0) ? c.ZS[(size_t)(b * SS + ss) * NIN + 1024 + ch] * c.ZS[(size_t)(b * SS + ss) * NIN + 2048 + ch] : c.state_conv[(size_t)(b * 2 + (ss + 2)) * D + ch]; }
        const float v = c.b_conv[ch] + c.w_conv[ch] * up[0] + c.w_conv[D + ch] * up[1] + c.w_conv[2 * D + ch] * up[2];
        c.AAS[(size_t)row * D + ch] = c.ZS[(size_t)row * NIN + ch] * v;
        if (s >= 2) c.out[O_CONV_S + (size_t)(b * 2 + (s - 2)) * D + ch] = up[2];
    }
    for (int it = gt; it < MS * 512; it += NGT_) { const int row = it >> 9, cc = it & 511;
        c.out[O_CMP_S + (size_t)row * 512 + cc] = c.ZS[(size_t)row * NIN + 4096 + cc]; c.out[O_SEL_S + (size_t)row * 512 + cc] = c.ZS[(size_t)row * NIN + 4608 + cc]; }
    for (int it = gt; it < SB * 512 * 128; it += NGT_) { const int cc = (it & 127) * 4, j = (it >> 7) & 511, b = it >> 16;
        f32x4 v;
        if (j + SS < 512) v = *(const f32x4*)(c.cache_win + ((size_t)(b * 512 + j + SS)) * 512 + cc);
        else v = *(const f32x4*)(c.ZS + (size_t)(b * SS + (j + SS - 512)) * NIN + 5120 + cc);
        *(GAS f32x4*)(c.out + O_WIN_S + ((size_t)(b * 512 + j)) * 512 + cc) = v; }
}
struct CmpP { static constexpr int NB_ = NB, NCS = NCS_P, NCP = NCP_P, NGRP = 16;
    __device__ static __forceinline__ float x(const Ctx& c, int kv, int b, int g, int pos, int d) { return bf2f(c.HM[(size_t)kv * HMSZ + ((size_t)((b * NKV + g) * T + pos)) * HD + d]); }
    __device__ static __forceinline__ float* outp(const Ctx& c) { return c.KCC; } };
struct CmpS { static constexpr int NB_ = SB, NCS = NCS_S, NCP = NCP_S, NGRP = 32;
    __device__ static __forceinline__ float x(const Ctx& c, int kv, int b, int g, int pos, int d) { return c.cache_cmp[((size_t)c.pt[b * NPG + (pos >> 7)] * PAGE + (pos & 127)) * 512 + kv * 256 + g * HD + d]; }
    __device__ static __forceinline__ float* outp(const Ctx& c) { return c.KCCS; } };
template <class S> __device__ __forceinline__ void compress_naive(const Ctx& c) {
    constexpr int NITEMS = 2 * S::NB_ * NKV * S::NGRP;
    LAS float* hid = (LAS float*)c.lds;
    const int n = c.tid & 127, rq = c.tid >> 7;
    for (int it = c.bid; it < NITEMS; it += c.G) {
        const int ig = it % S::NGRP, g = (it / S::NGRP) % NKV, b = (it / (S::NGRP * NKV)) % S::NB_, kv = it / (S::NGRP * NKV * S::NB_);
        const int i0 = ig * 16 + 4 * rq;
        float acc[4] = {0.f, 0.f, 0.f, 0.f};
        for (int t = 0; t < 32; ++t) {
            for (int d = 0; d < HD; ++d) {
                const int k = t * HD + d; const float w = c.w_phi1[((size_t)kv * 2048 + k) * 128 + n], pe = c.pe[kv * 2048 + k];
#pragma unroll
                for (int r = 0; r < 4; ++r) { int i = i0 + r; i = i < S::NCS ? i : S::NCS - 1; acc[r] += (S::x(c, kv, b, g, 16 * i + t, d) + pe) * w; }
            }
        }
        __syncthreads();
#pragma unroll
        for (int r = 0; r < 4; ++r) hid[(4 * rq + r) * 128 + n] = gelu_tanh(acc[r]);
        __syncthreads();
        const int o = c.tid & 63;
#pragma unroll
        for (int rr = 0; rr < 2; ++rr) { const int r = (c.tid >> 6) + 8 * rr, i = ig * 16 + r; float s = 0.f;
            for (int k = 0; k < 128; ++k) s += hid[r * 128 + k] * c.w_phi2[((size_t)kv * 128 + k) * HD + o];
            if (i < S::NCS) S::outp(c)[((size_t)((kv * S::NB_ + b) * NKV + g) * S::NCP + i) * HD + o] = s; }
    }
    __syncthreads();
}

struct AtP {
    static constexpr int NQ = T, QBASE = 0, NS = 64, NSP = 64, NSL = 1, NBAT = NB, NCP = NCP_P;
    typedef bf16 KT;
    __device__ static __forceinline__ void decode(int idx, int& b, int& h, int& qi) { qi = idx & (T - 1); h = (idx >> 12) & 15; b = idx >> 16; }
    __device__ static __forceinline__ void load_q(const Ctx& c, int b, int h, int qi, float (&q)[64]) { const bf16* p = c.Q + (size_t)(b * T + qi) * D + h * HD;
#pragma unroll
        for (int cc = 0; cc < 8; ++cc) { float v[8]; ld8(p + 8 * cc, v);
#pragma unroll
            for (int j = 0; j < 8; ++j) q[8 * cc + j] = v[j]; } }
    __device__ static __forceinline__ float gate(const Ctx& c, int b, int h, int qi, int j) { return c.NGT[(size_t)(b * T + qi) * 48 + h * 3 + j]; }
    __device__ static __forceinline__ const float* kcc(const Ctx& c, int kv, int b, int g, int ci) { return c.KCC + ((size_t)((kv * NB + b) * NKV + g) * NCP_P + ci) * HD; }
    __device__ static __forceinline__ const KT* ksel(const Ctx& c, int kv, int b, int g, int pos) { return c.HM + (size_t)(2 + kv) * HMSZ + ((size_t)((b * NKV + g) * T + pos)) * HD; }
    __device__ static __forceinline__ const KT* kwin(const Ctx& c, int kv, int b, int g, int pos) { return c.HM + (size_t)(4 + kv) * HMSZ + ((size_t)((b * NKV + g) * T + pos)) * HD; }
    __device__ static __forceinline__ float* scoreh(const Ctx& c) { return c.SCOREH; }
    __device__ static __forceinline__ unsigned long long* mask(const Ctx& c) { return c.MASK; }
    __device__ static __forceinline__ void store_o(const Ctx& c, int b, int h, int qi, const float (&o)[64]) { bf16* p = c.OB + (size_t)(b * T + qi) * D + h * HD;
#pragma unroll
        for (int cc = 0; cc < 8; ++cc) { float v[8];
#pragma unroll
            for (int j = 0; j < 8; ++j) v[j] = o[8 * cc + j];
            *(GAS v4u*)(p + 8 * cc) = pack8(v); } }
};
struct AtS {
    static constexpr int NQ = SS, QBASE = PAST, NS = 129, NSP = 192, NSL = 3, NBAT = SB, NCP = NCP_S;
    typedef float KT;
    __device__ static __forceinline__ void decode(int idx, int& b, int& h, int& qi) { qi = idx & 3; h = (idx >> 2) & 15; b = idx >> 6; }
    __device__ static __forceinline__ void load_q(const Ctx& c, int b, int h, int qi, float (&q)[64]) { const float* p = c.ZS + (size_t)(b * SS + qi) * NIN + 3072 + h * HD;
#pragma unroll
        for (int j = 0; j < 64; ++j) q[j] = p[j] * 0.125f; }
    __device__ static __forceinline__ float gate(const Ctx& c, int b, int h, int qi, int j) { return sigmoidf_(c.ZS[(size_t)(b * SS + qi) * NIN + 5632 + h * 3 + j]); }
    __device__ static __forceinline__ const float* kcc(const Ctx& c, int kv, int b, int g, int ci) { return c.KCCS + ((size_t)((kv * SB + b) * NKV + g) * NCP_S + ci) * HD; }
    __device__ static __forceinline__ const KT* ksel(const Ctx& c, int kv, int b, int g, int pos) {
        if (pos < PAST) return c.cache_sel + ((size_t)c.pt[b * NPG + (pos >> 7)] * PAGE + (pos & 127)) * 512 + kv * 256 + g * HD;
        return c.ZS + (size_t)(b * SS + (pos - PAST)) * NIN + 4608 + kv * 256 + g * HD; }
    __device__ static __forceinline__ const KT* kwin(const Ctx& c, int kv, int b, int g, int pos) {
        if (pos < PAST) return c.cache_win + ((size_t)(b * 512 + (pos - (PAST - 512)))) * 512 + kv * 256 + g * HD;
        return c.ZS + (size_t)(b * SS + (pos - PAST)) * NIN + 5120 + kv * 256 + g * HD; }
    __device__ static __forceinline__ float* scoreh(const Ctx& c) { return c.SCOREHS; }
    __device__ static __forceinline__ unsigned long long* mask(const Ctx& c) { return c.MASKS; }
    __device__ static __forceinline__ void store_o(const Ctx& c, int b, int h, int qi, const float (&o)[64]) { float* p = c.OBS + (size_t)(b * SS + qi) * D + h * HD;
#pragma unroll
        for (int j = 0; j < 64; ++j) p[j] = o[j]; }
};
__device__ __forceinline__ int wave_max_i(int v) {
#pragma unroll
    for (int o = 1; o < 64; o <<= 1) { const int t = __shfl_xor(v, o); v = t > v ? t : v; }
    return v;
}
__device__ __forceinline__ int wave_min_i(int v) {
#pragma unroll
    for (int o = 1; o < 64; o <<= 1) { const int t = __shfl_xor(v, o); v = t < v ? t : v; }
    return v;
}
template <class S> __device__ __forceinline__ void p4a_scores(const Ctx& c) {
    constexpr int NW = S::NBAT * H * S::NQ / 64;
    const int gw = c.bid * NWAVES + c.wave, NGW = c.G * NWAVES;
    for (int w = gw; w < NW; w += NGW) {
        const int idx = w * 64 + c.lane; int b, h, qi; S::decode(idx, b, h, qi);
        const int g = h >> 2, qpos = S::QBASE + qi; const float tq = (float)qpos, slope = exp2f(-0.5f * (float)(h + 1));
        float q[64]; S::load_q(c, b, h, qi, q);
        const int ncv = qpos >= 31 ? ((qpos - 31) >> 4) + 1 : 0, ncm = wave_max_i(ncv);
        float m = NEGF;
        for (int ci = 0; ci < ncm; ++ci) { const int cc = ci < ncv ? ci : 0; const float s = dot64(S::kcc(c, 0, b, g, cc), q) - slope * (tq - 16.f * ci - 15.5f); if (ci < ncv) m = fmaxf(m, s); }
        float l = 0.f;
        for (int ci = 0; ci < ncm; ++ci) { const int cc = ci < ncv ? ci : 0; const float s = dot64(S::kcc(c, 0, b, g, cc), q) - slope * (tq - 16.f * ci - 15.5f); if (ci < ncv) l += __expf(s - m); }
        const float il = l > 0.f ? 1.f / l : 0.f;
        float carry = 0.f; float* sp = S::scoreh(c) + (size_t)idx * S::NSP;
        const int nsm = (ncm + 3) >> 2;
        for (int s4 = 0; s4 < S::NS; ++s4) {
            float a = carry;
            if (s4 < nsm + 1) {
#pragma unroll 1
                for (int j = 0; j < 4; ++j) { const int ci = 4 * s4 + j; float p = 0.f;
                    if (ci < ncm) { const int cc = ci < ncv ? ci : 0; const float s = dot64(S::kcc(c, 0, b, g, cc), q) - slope * (tq - 16.f * ci - 15.5f); p = ci < ncv ? __expf(s - m) * il : 0.f; }
                    a += p; if (j == 3) carry = p; }
            } else carry = 0.f;
            sp[s4] = a;
        }
    }
}
template <class S> __device__ __forceinline__ void p4b_topk(const Ctx& c) {
    constexpr int NW = S::NBAT * NKV * S::NQ;
    const int gw = c.bid * NWAVES + c.wave, NGW = c.G * NWAVES;
    for (int w = gw; w < NW; w += NGW) {
        const int qi = w % S::NQ, g = (w / S::NQ) % NKV, b = w / (S::NQ * NKV);
        const int qpos = S::QBASE + qi, cur = qpos >> 6;
        float val[S::NSL];
#pragma unroll
        for (int j = 0; j < S::NSL; ++j) { const int s = c.lane + 64 * j; float v = -INFINITY;
            if (s < S::NS) { float imp = 0.f;
#pragma unroll
                for (int r = 0; r < 4; ++r) imp += S::scoreh(c)[((size_t)((b * H + 4 * g + r) * S::NQ + qi)) * S::NSP + s];
                const bool valid = 64 * s <= qpos, forced = (s == 0) || (s == cur) || (s == cur - 1);
                v = valid ? imp + (forced ? 1000.f : 0.f) : NEGF; }
            val[j] = v; }
        int rank[S::NSL];
#pragma unroll
        for (int j = 0; j < S::NSL; ++j) rank[j] = 0;
#pragma unroll
        for (int j2 = 0; j2 < S::NSL; ++j2)
            for (int l2 = 0; l2 < 64; ++l2) { const float v2 = __shfl(val[j2], l2); const int s2 = l2 + 64 * j2;
#pragma unroll
                for (int j = 0; j < S::NSL; ++j) { const int s = c.lane + 64 * j; rank[j] += (v2 > val[j] || (v2 == val[j] && s2 < s)) ? 1 : 0; } }
#pragma unroll
        for (int j = 0; j < S::NSL; ++j) { const int s = c.lane + 64 * j; const unsigned long long mk = __ballot(rank[j] < 16 && s < S::NS);
            if (c.lane == 0) S::mask(c)[(size_t)w * S::NSL + j] = mk; }
    }
}
#define ONLINE_UPD(sv, vrow, ok) do { if (ok) { if ((sv) > m) { const float al = __expf(m - (sv)); l *= al; _Pragma("unroll") for (int d_ = 0; d_ < 64; ++d_) o[d_] *= al; m = (sv); } \
        const float p_ = __expf((sv) - m); l += p_; axpy64((vrow), p_, o); } } while (0)
template <class S> __device__ __forceinline__ void p4c_attend(const Ctx& c) {
    constexpr int NW = S::NBAT * H * S::NQ / 64;
    const int gw = c.bid * NWAVES + c.wave, NGW = c.G * NWAVES;
    for (int w = gw; w < NW; w += NGW) {
        const int idx = w * 64 + c.lane; int b, h, qi; S::decode(idx, b, h, qi);
        const int g = h >> 2, qpos = S::QBASE + qi, cur = qpos >> 6; const float tq = (float)qpos, slope = exp2f(-0.5f * (float)(h + 1));
        float q[64]; S::load_q(c, b, h, qi, q);
        LAS float* ot = (LAS float*)c.lds + c.tid;
#pragma unroll
        for (int d = 0; d < 64; ++d) ot[d * NTHR] = 0.f;
        float o[64]; float m, l;
        {
#pragma unroll
            for (int d = 0; d < 64; ++d) o[d] = 0.f;
            m = NEGF; l = 0.f;
            const int ncv = qpos >= 31 ? ((qpos - 31) >> 4) + 1 : 0, ncm = wave_max_i(ncv);
            for (int ci = 0; ci < ncm; ++ci) { const bool ok = ci < ncv; const int cc = ok ? ci : 0;
                const float s = dot64(S::kcc(c, 0, b, g, cc), q) - slope * (tq - 16.f * ci - 15.5f);
                ONLINE_UPD(s, S::kcc(c, 1, b, g, cc), ok); }
            if (l > 0.f) { const float f = S::gate(c, b, h, qi, 0) / l;
#pragma unroll
                for (int d = 0; d < 64; ++d) ot[d * NTHR] += f * o[d]; }
        }
        {
#pragma unroll
            for (int d = 0; d < 64; ++d) o[d] = 0.f;
            m = NEGF; l = 0.f;
            unsigned long long mk[S::NSL];
#pragma unroll
            for (int j = 0; j < S::NSL; ++j) mk[j] = S::mask(c)[((size_t)((b * NKV + g) * S::NQ + qi)) * S::NSL + j];
            const int curm = wave_max_i(cur);
            for (int s = 0; s <= curm; ++s) {
                unsigned long long word = mk[0];
#pragma unroll
                for (int j = 1; j < S::NSL; ++j) if ((s >> 6) == j) word = mk[j];
                const bool sel = (s <= cur) && ((word >> (s & 63)) & 1ull);
                if (!__any(sel)) continue;
                for (int k = 0; k < 64; ++k) { const int pos = 64 * s + k; const bool ok = sel && pos <= qpos; const int pc = pos <= qpos ? pos : qpos;
                    if (!__any(ok)) continue;
                    const float sv = dot64(S::ksel(c, 0, b, g, pc), q) - slope * (tq - (float)pos);
                    ONLINE_UPD(sv, S::ksel(c, 1, b, g, pc), ok); }
            }
            if (l > 0.f) { const float f = S::gate(c, b, h, qi, 1) / l;
#pragma unroll
                for (int d = 0; d < 64; ++d) ot[d * NTHR] += f * o[d]; }
        }
        {
#pragma unroll
            for (int d = 0; d < 64; ++d) o[d] = 0.f;
            m = NEGF; l = 0.f;
            const int lo = qpos - 511 > 0 ? qpos - 511 : 0; const int lom = wave_min_i(lo), him = wave_max_i(qpos);
            for (int kp = lom; kp <= him; ++kp) { const bool ok = kp >= lo && kp <= qpos; int pc = kp < lo ? lo : kp; pc = pc > qpos ? qpos : pc;
                if (S::QBASE > 0 && pc < PAST - 512) pc = PAST - 512;
                const float sv = dot64(S::kwin(c, 0, b, g, pc), q) - slope * (tq - (float)kp);
                ONLINE_UPD(sv, S::kwin(c, 1, b, g, pc), ok); }
            if (l > 0.f) { const float f = S::gate(c, b, h, qi, 2) / l;
#pragma unroll
                for (int d = 0; d < 64; ++d) ot[d * NTHR] += f * o[d]; }
        }
#pragma unroll
        for (int d = 0; d < 64; ++d) o[d] = ot[d * NTHR];
        S::store_o(c, b, h, qi, o);
    }
}

struct SEpiZ { float* ZS; __device__ __forceinline__ void operator()(int row, int n, float a1, float) const { ZS[(size_t)row * NIN + n] = a1; } };
struct SEpiMG { const float* ZS; float* MGS; __device__ __forceinline__ void operator()(int row, int n, float a1, float a2) const {
    MGS[(size_t)row * D + n] = sigmoidf_(ZS[(size_t)row * NIN + 5680 + n]) * a1 + sigmoidf_(ZS[(size_t)row * NIN + 5680 + D + n]) * a2; } };
struct SEpiRes { const float* base; float* O; const float* MOD; int goff; __device__ __forceinline__ void operator()(int row, int n, float a1, float) const {
    O[(size_t)row * D + n] = base[(size_t)row * D + n] + MOD[(size_t)(NB + (row >> 2)) * NMOD + goff + n] * a1; } };
struct SEpiFF { float* HFS; __device__ __forceinline__ void operator()(int row, int n, float a1, float a2) const { HFS[(size_t)row * FF + n] = siluf_(a1) * a2; } };

#ifndef MK_SINGLE
#define MK_SINGLE 1
#endif
struct Args { const void* in[26]; float* out; unsigned char* ws; int ph_lo, ph_hi; };
__global__ void __launch_bounds__(NTHR, 2) fwd(Args a) {
    extern __shared__ __attribute__((aligned(16))) unsigned char lds[];
    Ctx c;
    c.lds = (LAS unsigned char*)lds;
    c.tid = threadIdx.x; c.lane = c.tid & 63; c.wave = __builtin_amdgcn_readfirstlane(c.tid >> 6); c.G = gridDim.x; c.bid = blockIdx.x;
    c.x_p = (const float*)a.in[0]; c.x_s = (const float*)a.in[1]; c.c_p = (const float*)a.in[2]; c.c_s = (const float*)a.in[3];
    c.cache_cmp = (const float*)a.in[4]; c.cache_sel = (const float*)a.in[5]; c.cache_win = (const float*)a.in[6]; c.state_conv = (const float*)a.in[7]; c.pt = (const int*)a.in[8];
    c.w_ada = (const float*)a.in[9]; c.b_ada = (const float*)a.in[10]; c.norm1 = (const float*)a.in[11]; c.w_in = (const float*)a.in[12]; c.w_conv = (const float*)a.in[13]; c.b_conv = (const float*)a.in[14];
    c.w_oc = (const float*)a.in[15]; c.pe = (const float*)a.in[16]; c.w_phi1 = (const float*)a.in[17]; c.w_phi2 = (const float*)a.in[18]; c.w_on = (const float*)a.in[19]; c.w_out = (const float*)a.in[20];
    c.norm2 = (const float*)a.in[21]; c.w_gate = (const float*)a.in[22]; c.w_up = (const float*)a.in[23]; c.w_down = (const float*)a.in[24]; c.norm_f = (const float*)a.in[25];
    c.out = a.out;
    unsigned char* ws = a.ws;
    c.WIN_T = (bf16*)(ws + WS_WIN_T); c.WOC_T = (bf16*)(ws + WS_WOC_T); c.WON_T = (bf16*)(ws + WS_WON_T); c.WOUT_T = (bf16*)(ws + WS_WOUT_T); c.WGU_T = (bf16*)(ws + WS_WGU_T); c.WDN_T = (bf16*)(ws + WS_WDN_T);
    c.MODP = (float*)(ws + WS_MODP); c.MOD = (float*)(ws + WS_MOD);
    c.XN = (bf16*)(ws + WS_XN); c.BG = (bf16*)(ws + WS_BG); c.U = (bf16*)(ws + WS_U); c.Q = (bf16*)(ws + WS_Q); c.HM = (bf16*)(ws + WS_HM); c.GA = (bf16*)(ws + WS_GA); c.GB = (bf16*)(ws + WS_GB); c.NGT = (float*)(ws + WS_NGT);
    c.AA = (bf16*)(ws + WS_AA); c.OB = (bf16*)(ws + WS_OB); c.MG = (bf16*)(ws + WS_MG); c.X1 = (float*)(ws + WS_X1); c.P1 = (float*)(ws + WS_P1); c.HF = (bf16*)(ws + WS_HF);
    c.KCC = (float*)(ws + WS_KCC); c.SCOREH = (float*)(ws + WS_SCOREH); c.MASK = (unsigned long long*)(ws + WS_MASK);
    c.XNS = (float*)(ws + WS_XNS); c.ZS = (float*)(ws + WS_ZS); c.AAS = (float*)(ws + WS_AAS); c.OBS = (float*)(ws + WS_OBS); c.MGS = (float*)(ws + WS_MGS); c.X1S = (float*)(ws + WS_X1S);
    c.XN2S = (float*)(ws + WS_XN2S); c.HFS = (float*)(ws + WS_HFS); c.X2S = (float*)(ws + WS_X2S); c.KCCS = (float*)(ws + WS_KCCS); c.SCOREHS = (float*)(ws + WS_SCOREHS); c.MASKS = (unsigned long long*)(ws + WS_MASKS);

    for (int u = c.tid; u < (LDS_BYTES - LDSCTL_OFF) / 4; u += NTHR) ((LAS unsigned*)(c.lds + LDSCTL_OFF))[u] = 0u;
    __syncthreads();
    const int lo = a.ph_lo, hi = a.ph_hi;
    unsigned* ctl = (unsigned*)(ws + WS_CTL);
    volatile LAS unsigned* MISC = (volatile LAS unsigned*)(c.lds + MISC_OFF);
    XcdBarrier bar; bar.bar = ctl + CW_BAR; bar.x = 0; bar.st = nullptr;
    if (hi - lo > 1) bar = xcd_barrier_post(ctl + CW_BAR, MISC + 8);
#ifdef PH_ONLY
#define IN(k) ((k) == PH_ONLY)
#else
#define IN(k) (lo <= (k) && (k) < hi)
#endif
#define SEAM(k) do { if (IN(k) && IN((k) + 1)) xcd_barrier(bar); } while (0)

    if (IN(0)) { p0_prologue(c); } SEAM(0);
    if (IN(1)) { p1_norm1(c); } SEAM(1);
    if (IN(2)) {
        pg8::Gemm g{c.XN, c.WIN_T, M, NINP, D}; pg8::StaticOrder S; S.init(M, NINP, c.G, c.bid);
        EpiIn E{c.BG, c.U, c.Q, c.HM, c.GA, c.GB, c.NGT, c.out};
        pg8::gemm_phase<EpiIn, pg8::StaticOrder, true, true>(c.lds + RING_OFF, g, S, E);
        sgemm<false>(c, c.XNS, c.XNS, D, c.w_in, c.w_in, NIN, D, NIN, SEpiZ{c.ZS});
    } SEAM(2);
    if (IN(3)) { p3_conv_prompt(c); p3_sample_thin(c); compress_naive<CmpP>(c); compress_naive<CmpS>(c); } SEAM(3);
    if (IN(4)) { p4a_scores<AtP>(c); p4a_scores<AtS>(c); } SEAM(4);
    if (IN(5)) { p4b_topk<AtP>(c); p4b_topk<AtS>(c); } SEAM(5);
    if (IN(6)) { p4c_attend<AtP>(c); p4c_attend<AtS>(c); } SEAM(6);
    if (IN(7)) {
        { pg8::Gemm g{c.AA, c.WOC_T, M, D, D}; pg8::StaticOrder S; S.init(M, D, c.G, c.bid); EpiYa E{c.GA, c.P1};
          pg8::gemm_phase<EpiYa, pg8::StaticOrder, true, true>(c.lds + RING_OFF, g, S, E); }
        { pg8::Gemm g{c.OB, c.WON_T, M, D, D}; pg8::StaticOrder S; S.init(M, D, c.G, c.bid); EpiYb E{c.GB, c.P1, c.MG};
          pg8::gemm_phase<EpiYb, pg8::StaticOrder, true, true>(c.lds + RING_OFF, g, S, E); }
        sgemm<true>(c, c.AAS, c.OBS, D, c.w_oc, c.w_on, D, D, D, SEpiMG{c.ZS, c.MGS});
    } SEAM(7);
    if (IN(8)) {
        pg8::Gemm g{c.MG, c.WOUT_T, M, D, D}; pg8::StaticOrder S; S.init(M, D, c.G, c.bid); EpiRes E{c.x_p, c.X1, c.MOD, 2 * D};
        pg8::gemm_phase<EpiRes, pg8::StaticOrder, true, true>(c.lds + RING_OFF, g, S, E);
        sgemm<false>(c, c.MGS, c.MGS, D, c.w_out, c.w_out, D, D, D, SEpiRes{c.x_s, c.X1S, c.MOD, 2 * D});
    } SEAM(8);
    if (IN(9)) { p5c_norm2(c); } SEAM(9);
    if (IN(10)) {
        pg8::Gemm g{c.XN, c.WGU_T, M, NGU, D}; pg8::StaticOrder S; S.init(M, NGU, c.G, c.bid); EpiFF E{c.HF};
        pg8::gemm_phase<EpiFF, pg8::StaticOrder, true, true>(c.lds + RING_OFF, g, S, E);
        sgemm<true>(c, c.XN2S, c.XN2S, D, c.w_gate, c.w_up, FF, D, FF, SEpiFF{c.HFS});
    } SEAM(10);
    if (IN(11)) {
        pg8::Gemm g{c.HF, c.WDN_T, M, D, FF}; pg8::StaticOrder S; S.init(M, D, c.G, c.bid); EpiRes E{c.X1, c.out + O_YP, c.MOD, 5 * D};
        pg8::gemm_phase<EpiRes, pg8::StaticOrder, true, true>(c.lds + RING_OFF, g, S, E);
        sgemm<false>(c, c.HFS, c.HFS, FF, c.w_down, c.w_down, D, FF, D, SEpiRes{c.X1S, c.X2S, c.MOD, 5 * D});
    } SEAM(11);
    if (IN(12)) { p8_normf(c); }
#undef IN
#undef SEAM
}

extern "C" void kernel_launch(void* const* d_in, const int* in_sizes, int n_in, void* d_out, int out_size, void* d_ws, size_t ws_size, hipStream_t stream) {
    static int grid = 0;
    if (grid == 0) {
        if (n_in != 26 || out_size != (int)O_END || ws_size < WS_END) { fprintf(stderr, "kernel_launch: unexpected shapes (n_in %d out %d ws %zu)\n", n_in, out_size, ws_size); grid = -1; return; }
        int dev = 0, cus = 0, per_cu = 0;
        if (hipGetDevice(&dev) != hipSuccess || hipDeviceGetAttribute(&cus, hipDeviceAttributeMultiprocessorCount, dev) != hipSuccess) { grid = -1; return; }
        if (hipFuncSetAttribute((const void*)fwd, hipFuncAttributeMaxDynamicSharedMemorySize, LDS_BYTES) != hipSuccess) { fprintf(stderr, "kernel_launch: hipFuncSetAttribute failed\n"); grid = -1; return; }
        if (hipOccupancyMaxActiveBlocksPerMultiprocessor(&per_cu, (const void*)fwd, NTHR, LDS_BYTES) != hipSuccess || per_cu < 1) fprintf(stderr, "kernel_launch: occupancy query says %d\n", per_cu);
        (void)hipGetLastError();
        grid = cus;
    }
    if (grid < 0) return;
    (void)hipMemsetAsync((char*)d_ws + WS_CTL, 0, CTL_ZERO_BYTES, stream);
    Args a{};
    for (int i = 0; i < 26; ++i) a.in[i] = d_in[i];
    a.out = (float*)d_out; a.ws = (unsigned char*)d_ws;
#if MK_SINGLE
    a.ph_lo = 0; a.ph_hi = NPHASE;
    hipLaunchKernelGGL(fwd, dim3(grid), dim3(NTHR), LDS_BYTES, stream, a);
#else
    for (int p = 0; p < NPHASE; ++p) { a.ph_lo = p; a.ph_hi = p + 1; hipLaunchKernelGGL(fwd, dim3(grid), dim3(NTHR), LDS_BYTES, stream, a); }
#endif
}
```

```cpp
#include <hip/hip_runtime.h>
#include <cstdio>
#include <cstdint>
namespace pg8 {
#define PG8_LAS __attribute__((address_space(3)))
typedef unsigned short bf16_t;
typedef short bf16x8 __attribute__((ext_vector_type(8)));
typedef float f32x4 __attribute__((ext_vector_type(4)));
typedef unsigned u32x4 __attribute__((ext_vector_type(4)));
constexpr int BM = 256, BK = 64, HALF = 128, HTB = HALF * BK * 2  , STAGE_BYTES = 8 * HTB, NXCD = 8, WGM = 8;

__host__ __device__ __forceinline__ int lds_byte(int r, int c) { const int st = (r >> 4) * 2 + (c >> 5), rr = r & 15, cc = c & 31, ob = rr * 64 + cc * 2; return st * 1024 + (ob ^ (((ob >> 9) & 1) << 5)); }
__host__ __device__ __forceinline__ void stage_rc(int b, int& R, int& C) { const int st = b / 1024, sb = b % 1024, swz = sb ^ (((sb >> 9) & 1) << 5); R = (st >> 1) * 16 + swz / 64; C = (st & 1) * 32 + (swz % 64) / 2; }
__host__ __device__ __forceinline__ int perm32(int rho) { const int n = rho >> 4, i = rho & 15; return 8 * (i >> 2) + 4 * n + (i & 3); }

struct Unit { int pm, pn; };
struct Gemm { const bf16_t* A; const bf16_t* Bt; int M, N, K; };

struct StaticOrder {
    int nM, nN, nwg, G, c;
    __host__ __device__ void init(int M, int N, int G_, int c_) { nM = M / BM; nN = N / BM; nwg = nM * nN; G = G_; c = c_; }
    __host__ __device__ bool next(int i, Unit& u) const {
        const long L = (long)i * G + c; if (L >= nwg) return false;
        int wgid = (int)L; { const int q = nwg / NXCD, r = nwg % NXCD, xcd = wgid % NXCD, off = wgid / NXCD; wgid = (xcd < r ? xcd * (q + 1) : r * (q + 1) + (xcd - r) * q) + off; }
        const int nig = WGM * nN, gid = wgid / nig, fm = gid * WGM, gsz = (nM - fm) < WGM ? (nM - fm) : WGM;
        u.pm = fm + ((wgid % nig) % gsz); u.pn = (wgid % nig) / gsz; return true;
    }
    __device__ __forceinline__ void a_ready(const Unit&) const {}
    __device__ __forceinline__ void done(const Unit&) const {}
};

__device__ __forceinline__ unsigned cvt_pk_bf16(float lo, float hi) { unsigned r; asm volatile("v_cvt_pk_bf16_f32 %0, %1, %2" : "=v"(r) : "v"(lo), "v"(hi)); return r; }
typedef float f32x2 __attribute__((ext_vector_type(2)));
template <class Epi, class Sched, bool ALIGN_EPI = false, bool SP2 = false>
__device__ __forceinline__ void gemm_phase(PG8_LAS unsigned char* lds, const Gemm g, const Sched& S, const Epi& E) {
    const int tid = threadIdx.x, wid = __builtin_amdgcn_readfirstlane(tid >> 6), lane = tid & 63, wr = wid >> 2, wc = wid & 3, fr = lane & 15, fq = lane >> 4;
    const int K = g.K, nt = K / BK;
    unsigned voffA[2], voffB[2];
#pragma unroll
    for (int i = 0; i < 2; ++i) { int R, C; stage_rc(tid * 16 + i * 8192, R, C); const int Rb = Epi::PERM ? ((R & ~31) + perm32(R & 31)) : R;
        voffA[i] = (unsigned)(R * K + C) * 2u; voffB[i] = (unsigned)(Rb * K + C) * 2u; }
    const size_t kstep = (size_t)(BK * 2);
    const size_t hstep = (size_t)HALF * K * 2;
    const size_t tstep = 2 * hstep;
    const unsigned ldsw = (unsigned)wid * 1024u;
    const int aoff = lds_byte(wr * 64 + fr, fq * 8), boff = lds_byte(wc * 32 + fr, fq * 8);
#define PG8_SA(b, h) (((b) * 2 + (h)) * HTB)
#define PG8_SB(b, h) ((4 + (b) * 2 + (h)) * HTB)
#define PG8_STAGE(bufoff, gbase, voff) do { _Pragma("unroll") for (int _i = 0; _i < 2; ++_i) \
        __builtin_amdgcn_global_load_lds((const unsigned*)((const char*)(gbase) + (voff)[_i]), (PG8_LAS unsigned*)(lds + (bufoff) + ldsw + _i * 8192), 16, 0, 0); } while (0)
#define PG8_LDA(dst, b, h) do { _Pragma("unroll") for (int m = 0; m < 4; ++m) _Pragma("unroll") for (int k = 0; k < 2; ++k) dst[m][k] = *(const PG8_LAS bf16x8*)(lds + PG8_SA(b, h) + aoff + m * 2048 + k * 1024); } while (0)
#define PG8_LDB(dst, b, h) do { _Pragma("unroll") for (int n = 0; n < 2; ++n) _Pragma("unroll") for (int k = 0; k < 2; ++k) dst[n][k] = *(const PG8_LAS bf16x8*)(lds + PG8_SB(b, h) + boff + n * 2048 + k * 1024); } while (0)
#define PG8_MMA(ai, bj, At, Bt) do { __builtin_amdgcn_s_setprio(1); _Pragma("unroll") for (int m = 0; m < 4; ++m) _Pragma("unroll") for (int n = 0; n < 2; ++n) _Pragma("unroll") for (int k = 0; k < 2; ++k) \
        acc[ai][bj][m][n] = __builtin_amdgcn_mfma_f32_16x16x32_bf16(Bt[n][k], At[m][k], acc[ai][bj][m][n], 0, 0, 0); __builtin_amdgcn_s_setprio(0); } while (0)
#define PG8_WAIT_V(n) asm volatile("s_waitcnt vmcnt(" #n ")" ::: "memory")
#define PG8_WAIT_L(n) asm volatile("s_waitcnt lgkmcnt(" #n ")" ::: "memory")
#define PG8_BAR __builtin_amdgcn_s_barrier()
#define PG8_SCHED __builtin_amdgcn_sched_barrier(0)
    Unit cur, nxt; int ui = 0;
    if (!S.next(0, cur)) return;
    f32x4 acc[2][2][4][2];
#pragma unroll
    for (int a = 0; a < 2; ++a)
#pragma unroll
        for (int b = 0; b < 2; ++b)
#pragma unroll
            for (int m = 0; m < 4; ++m)
#pragma unroll
                for (int n = 0; n < 2; ++n) acc[a][b][m][n] = (f32x4){0.f, 0.f, 0.f, 0.f};
    bf16x8 At[4][2], B0[2][2], B1[2][2];
    const char* cA = (const char*)g.A + (size_t)cur.pm * tstep; const char* cB = (const char*)g.Bt + (size_t)cur.pn * tstep;
    S.a_ready(cur);
    if constexpr (SP2) {
        PG8_STAGE(PG8_SB(0, 0), cB, voffB); PG8_STAGE(PG8_SB(0, 1), cB + hstep, voffB); PG8_STAGE(PG8_SA(0, 0), cA, voffA); PG8_STAGE(PG8_SA(0, 1), cA + hstep, voffA);
        if (wr == 1) PG8_BAR;
        PG8_WAIT_V(2); PG8_BAR;
        PG8_STAGE(PG8_SB(1, 0), cB + kstep, voffB); PG8_STAGE(PG8_SA(1, 0), cA + kstep, voffA); PG8_STAGE(PG8_SB(1, 1), cB + hstep + kstep, voffB);
        PG8_WAIT_V(6); PG8_BAR;
    } else {
        PG8_STAGE(PG8_SB(0, 0), cB, voffB); PG8_STAGE(PG8_SA(0, 0), cA, voffA); PG8_STAGE(PG8_SB(0, 1), cB + hstep, voffB); PG8_STAGE(PG8_SA(0, 1), cA + hstep, voffA);
        if (wr == 1) PG8_BAR;
        PG8_WAIT_V(4); PG8_BAR;
        PG8_STAGE(PG8_SB(1, 0), cB + kstep, voffB); PG8_STAGE(PG8_SA(1, 0), cA + kstep, voffA); PG8_STAGE(PG8_SB(1, 1), cB + hstep + kstep, voffB);
        PG8_WAIT_V(6); PG8_BAR;
    }
    for (;;) {
        const bool has_next = S.next(ui + 1, nxt);
        const char* nA = has_next ? (const char*)g.A + (size_t)nxt.pm * tstep : cA; const char* nB = has_next ? (const char*)g.Bt + (size_t)nxt.pn * tstep : cB;
        for (int t = 0; t < nt; t += 2) {
            const bool last = (t == nt - 2);
            const char* a1 = cA + (size_t)(t + 1) * kstep;
            const char* a2 = last ? nA : cA + (size_t)(t + 2) * kstep; const char* b2 = last ? nB : cB + (size_t)(t + 2) * kstep;
            const char* a3 = a2 + kstep; const char* b3 = b2 + kstep;
            if (last && has_next) S.a_ready(nxt);
            if constexpr (SP2) {
            PG8_LDB(B0, 0, 0); PG8_LDB(B1, 0, 1); PG8_SCHED; PG8_LDA(At, 0, 0); PG8_STAGE(PG8_SA(1, 1), a1 + hstep, voffA);
            PG8_WAIT_V(8); PG8_WAIT_L(0); PG8_BAR; PG8_MMA(0, 0, At, B0); PG8_MMA(0, 1, At, B1); PG8_BAR; PG8_SCHED;
            PG8_LDA(At, 0, 1); PG8_STAGE(PG8_SB(0, 0), b2, voffB); PG8_STAGE(PG8_SB(0, 1), b2 + hstep, voffB); PG8_STAGE(PG8_SA(0, 0), a2, voffA);
            PG8_WAIT_V(8); PG8_WAIT_L(0); PG8_BAR; PG8_MMA(1, 0, At, B0); PG8_MMA(1, 1, At, B1); PG8_BAR; PG8_SCHED;
            PG8_LDB(B0, 1, 0); PG8_LDB(B1, 1, 1); PG8_SCHED; PG8_LDA(At, 1, 0); PG8_STAGE(PG8_SA(0, 1), a2 + hstep, voffA);
            PG8_WAIT_V(8); PG8_WAIT_L(0); PG8_BAR; PG8_MMA(0, 0, At, B0); PG8_MMA(0, 1, At, B1); PG8_BAR; PG8_SCHED;
            PG8_LDA(At, 1, 1); PG8_STAGE(PG8_SB(1, 0), b3, voffB); PG8_STAGE(PG8_SB(1, 1), b3 + hstep, voffB); PG8_STAGE(PG8_SA(1, 0), a3, voffA);
            PG8_WAIT_V(8); PG8_WAIT_L(0); PG8_BAR; PG8_MMA(1, 0, At, B0); PG8_MMA(1, 1, At, B1); PG8_BAR; PG8_SCHED;
            } else {
            PG8_LDB(B0, 0, 0); PG8_SCHED; PG8_LDA(At, 0, 0); PG8_STAGE(PG8_SA(1, 1), a1 + hstep, voffA);
            PG8_WAIT_L(8); PG8_BAR; PG8_WAIT_L(0); PG8_MMA(0, 0, At, B0); PG8_BAR; PG8_SCHED;
            PG8_LDB(B1, 0, 1); PG8_STAGE(PG8_SB(0, 0), b2, voffB);
            PG8_BAR; PG8_WAIT_L(0); PG8_MMA(0, 1, At, B1); PG8_BAR;
            PG8_LDA(At, 0, 1); PG8_STAGE(PG8_SA(0, 0), a2, voffA);
            PG8_BAR; PG8_WAIT_L(0); PG8_MMA(1, 0, At, B0); PG8_BAR; PG8_SCHED;
            PG8_STAGE(PG8_SB(0, 1), b2 + hstep, voffB);
            PG8_WAIT_V(6); PG8_BAR; PG8_MMA(1, 1, At, B1); PG8_BAR;
            PG8_LDB(B0, 1, 0); PG8_SCHED; PG8_LDA(At, 1, 0); PG8_STAGE(PG8_SA(0, 1), a2 + hstep, voffA);
            PG8_WAIT_L(8); PG8_BAR; PG8_WAIT_L(0); PG8_MMA(0, 0, At, B0); PG8_BAR; PG8_SCHED;
            PG8_LDB(B1, 1, 1); PG8_STAGE(PG8_SB(1, 0), b3, voffB);
            PG8_BAR; PG8_WAIT_L(0); PG8_MMA(0, 1, At, B1); PG8_BAR;
            PG8_LDA(At, 1, 1); PG8_STAGE(PG8_SA(1, 0), a3, voffA);
            PG8_BAR; PG8_WAIT_L(0); PG8_MMA(1, 0, At, B0); PG8_BAR; PG8_SCHED;
            PG8_STAGE(PG8_SB(1, 1), b3 + hstep, voffB);
            PG8_WAIT_V(6); PG8_BAR; PG8_MMA(1, 1, At, B1); PG8_BAR;
            }
        }
        if constexpr (ALIGN_EPI) { if (wr == 0) PG8_BAR; }
        if constexpr (!Epi::AFTER_DRAIN) { E(acc, cur, wr, wc, fr, fq); S.done(cur); }
        if (!has_next) break;
#pragma unroll
        for (int a = 0; a < 2; ++a)
#pragma unroll
            for (int b = 0; b < 2; ++b)
#pragma unroll
                for (int m = 0; m < 4; ++m)
#pragma unroll
                    for (int n = 0; n < 2; ++n) acc[a][b][m][n] = (f32x4){0.f, 0.f, 0.f, 0.f};
        cur = nxt; cA = nA; cB = nB; ++ui;
        if constexpr (ALIGN_EPI) { if (wr == 1) PG8_BAR; }
    }
    PG8_WAIT_V(0);
    if constexpr (!ALIGN_EPI) { if (wr == 0) PG8_BAR; }
    PG8_BAR;
    if constexpr (Epi::AFTER_DRAIN) { E.fused(acc, cur, wr, wc, fr, fq, lds, wid, lane); S.done(cur); }
#undef PG8_SA
#undef PG8_SB
#undef PG8_STAGE
#undef PG8_LDA
#undef PG8_LDB
#undef PG8_MMA
#undef PG8_WAIT_V
#undef PG8_WAIT_L
#undef PG8_BAR
#undef PG8_SCHED
}
}
#define GAS __attribute__((address_space(1)))
#define LAS __attribute__((address_space(3)))
typedef unsigned short bf16;
typedef unsigned v4u __attribute__((ext_vector_type(4)));
typedef float f32x4 __attribute__((ext_vector_type(4)));
typedef short bf16x8 __attribute__((ext_vector_type(8)));
typedef GAS unsigned gu32;
typedef GAS unsigned long long gu64;
#define RLX_AGENT __ATOMIC_RELAXED, __HIP_MEMORY_SCOPE_AGENT
#define LDS_WAIT() asm volatile("s_waitcnt lgkmcnt(0)" ::: "memory")
#define VM_WAIT() asm volatile("s_waitcnt vmcnt(0)" ::: "memory")
__device__ __forceinline__ unsigned long long rt() { return __builtin_amdgcn_s_memrealtime(); }
__device__ __forceinline__ unsigned f2bf(float f) { unsigned u = __builtin_bit_cast(unsigned, f); return (u + 0x7fffu + ((u >> 16) & 1u)) >> 16; }
__device__ __forceinline__ unsigned pk2(float lo, float hi) { return f2bf(lo) | (f2bf(hi) << 16); }

#define XB_TMO      128
#define XB_XCNT(j)  (256  + 64 * (j))
#define XB_XSUB(j)  (1280 + 64 * (j))
#define XB_XGEN(j)  (2304 + 64 * (j))
#define XB_TOP      3328
#define XB_TOPGEN   3392
#define XCD_BAR_WORDS 3456
#define XB_SPIN_CAP (1u << 18)

__device__ __forceinline__ unsigned xb_ld(unsigned* p)              { return __hip_atomic_load(p, __ATOMIC_RELAXED, __HIP_MEMORY_SCOPE_AGENT); }
__device__ __forceinline__ unsigned xb_add(unsigned* p, unsigned v) { return __hip_atomic_fetch_add(p, v, __ATOMIC_RELAXED, __HIP_MEMORY_SCOPE_AGENT); }
__device__ __forceinline__ unsigned xb_xcc_id() { return (unsigned)__builtin_amdgcn_s_getreg((3 << 11) | 20) & 0xFu; }
#define XB_SPIN(cond, bar) do { unsigned _sp = 0; while (cond) { __builtin_amdgcn_s_sleep(1); \
    if ((++_sp & 255u) == 0u) { if (xb_ld(&(bar)[XB_TMO])) break; if (_sp > XB_SPIN_CAP) { atomicAdd(&(bar)[XB_TMO], 1u); break; } } } } while (0)

struct XcdBarrier {
    unsigned* bar; unsigned x;
    volatile LAS unsigned* st;
};

__device__ __forceinline__ XcdBarrier xcd_barrier_post(unsigned* bar, volatile LAS unsigned* st) {
    XcdBarrier b; b.bar = bar; b.x = xb_xcc_id(); b.st = st;
    if (threadIdx.x == 0) (void)xb_add(&bar[XB_XCNT(b.x)], 1u);
    return b;
}
__device__ __forceinline__ void xcd_barrier_complete(unsigned* bar, unsigned x, unsigned& nloc, unsigned& nx) {
    const unsigned G = gridDim.x * gridDim.y * gridDim.z;
    unsigned sum, cnt, mine, sp = 0u;
    for (;;) {
        sum = 0u; cnt = 0u; mine = 0u;
#pragma unroll
        for (unsigned j = 0; j < 16; ++j) { const unsigned c = xb_ld(&bar[XB_XCNT(j)]); sum += c; cnt += (c > 0u) ? 1u : 0u; mine = (j == x) ? c : mine; }
        if (sum == G) break;
        __builtin_amdgcn_s_sleep(1);
        if ((++sp & 255u) == 0u) { if (xb_ld(&bar[XB_TMO])) break; if (sp > XB_SPIN_CAP) { atomicAdd(&bar[XB_TMO], 1u); break; } }
    }
    nloc = mine > 0u ? mine : 1u; nx = cnt > 0u ? cnt : 1u;
}

__device__ __forceinline__ void xcd_barrier(const XcdBarrier& b) {
    asm volatile("s_waitcnt vmcnt(0)" ::: "memory");
    __syncthreads();
    if (threadIdx.x == 0) {
        unsigned* bar = b.bar;
        __builtin_amdgcn_s_waitcnt(0);
        unsigned nloc = b.st[0], nx = b.st[1];
        if (nloc == 0u) { xcd_barrier_complete(bar, b.x, nloc, nx); b.st[0] = nloc; b.st[1] = nx; }
        const unsigned old = xb_add(&bar[XB_XSUB(b.x)], 1u);
        const unsigned gen = old / nloc;
        if (old + 1u == (gen + 1u) * nloc) {
            __builtin_amdgcn_fence(__ATOMIC_RELEASE, "agent");
            asm volatile("s_waitcnt vmcnt(0)" ::: "memory");
            const unsigned og = xb_add(&bar[XB_TOP], 1u);
            const unsigned tg = og / nx;
            if (og + 1u == (tg + 1u) * nx) xb_add(&bar[XB_TOPGEN], 1u);
            else XB_SPIN(xb_ld(&bar[XB_TOPGEN]) == tg, bar);
            __builtin_amdgcn_fence(__ATOMIC_ACQUIRE, "agent");
            xb_add(&bar[XB_XGEN(b.x)], 1u);
            asm volatile("s_waitcnt vmcnt(0)" ::: "memory");
        } else {
            XB_SPIN(xb_ld(&bar[XB_XGEN(b.x)]) == gen, bar);
            __builtin_amdgcn_fence(__ATOMIC_ACQUIRE, "agent");
            asm volatile("s_waitcnt vmcnt(0)" ::: "memory");
        }
    }
    __syncthreads();
}

#ifndef PROBE_ATT
#define PROBE_ATT 0
#endif
namespace cfg {
constexpr int D = 1024, NB = 4, T = 4096, M = NB * T, SB = 32, SS = 4, MS = SB * SS, PAST = 8192, PAGE = 128, NPG = PAST / PAGE;
constexpr int H = 16, HD = 64, NKV = 4, NIN = 7728, NINP = 7936, FF = 2816, NGU = 2 * FF, NMOD = 6 * D, RMOD = NB + SB, MODKC = 8;
constexpr int NCS_P = 255, NCP_P = 256, NCS_S = 511, NCP_S = 512;
constexpr float EPS = 1e-6f, NEGF = -1e30f;
constexpr size_t O_YP = 0, O_YS = 16777216, O_CMP_P = 16908288, O_SEL_P = 25296896, O_WIN_P = 33685504, O_CONV_P = 34734080,
                 O_CMP_S = 34742272, O_SEL_S = 34807808, O_WIN_S = 34873344, O_CONV_S = 43261952, O_END = 43327488;
constexpr size_t MiB = 1u << 20;
constexpr size_t WS_CTL = 0, CTL_ZERO_BYTES = 1 * MiB;
constexpr size_t WS_WIN_T = 2 * MiB, WS_WOC_T = 18 * MiB, WS_WON_T = 20 * MiB, WS_WOUT_T = 22 * MiB, WS_WGU_T = 24 * MiB, WS_WDN_T = 36 * MiB;
constexpr size_t WS_MODP = 42 * MiB, WS_MOD = 49 * MiB;
constexpr size_t WS_XN = 64 * MiB, WS_BG = 96 * MiB, WS_U = 128 * MiB, WS_Q = 160 * MiB, WS_HM = 192 * MiB, WS_GA = 240 * MiB, WS_GB = 272 * MiB, WS_NGT = 304 * MiB;
constexpr size_t WS_AA = 308 * MiB, WS_OB = 340 * MiB, WS_MG = 372 * MiB, WS_X1 = 404 * MiB, WS_P1 = 468 * MiB, WS_HF = 532 * MiB, WS_KCC = 620 * MiB, WS_SCOREH = 622 * MiB, WS_MASK = 686 * MiB;
constexpr size_t WS_XNS = 688 * MiB, WS_ZS = 689 * MiB, WS_AAS = 693 * MiB, WS_OBS = 694 * MiB, WS_MGS = 695 * MiB, WS_X1S = 696 * MiB, WS_XN2S = 697 * MiB, WS_HFS = 698 * MiB, WS_X2S = 700 * MiB;
constexpr size_t WS_KCCS = 701 * MiB, WS_SCOREHS = 733 * MiB, WS_MASKS = 735 * MiB, WS_KCCB = 736 * MiB, WS_VCCT = 737 * MiB, WS_VST = 738 * MiB, WS_VWT = 746 * MiB, WS_OB2 = 754 * MiB, WS_MASKM = 786 * MiB, WS_END = 787 * MiB;
constexpr size_t HMSZ = (size_t)NB * NKV * T * HD;
constexpr int CW_BAR = 4096;
constexpr int RING_OFF = 0, RING_BYTES = 131072, LDSCTL_OFF = RING_BYTES, MISC_OFF = LDSCTL_OFF + 320, LDS_BYTES = 147456;
constexpr int NWAVES = 8, NTHR = 512;
constexpr int NPHASE = 13;
}
using namespace cfg;

struct Ctx {
    __device__ static __forceinline__ const void* karg(int i) { return ((const void* const __attribute__((address_space(4)))*)__builtin_amdgcn_kernarg_segment_ptr())[i]; }
    __device__ __forceinline__ const float* x_p() const { return (const float*)karg(0); }
    __device__ __forceinline__ const float* x_s() const { return (const float*)karg(1); }
    __device__ __forceinline__ const float* c_p() const { return (const float*)karg(2); }
    __device__ __forceinline__ const float* c_s() const { return (const float*)karg(3); }
    __device__ __forceinline__ const float* cache_cmp() const { return (const float*)karg(4); }
    __device__ __forceinline__ const float* cache_sel() const { return (const float*)karg(5); }
    __device__ __forceinline__ const float* cache_win() const { return (const float*)karg(6); }
    __device__ __forceinline__ const float* state_conv() const { return (const float*)karg(7); }
    __device__ __forceinline__ const int* pt() const { return (const int*)karg(8); }
    __device__ __forceinline__ const float* w_ada() const { return (const float*)karg(9); }
    __device__ __forceinline__ const float* b_ada() const { return (const float*)karg(10); }
    __device__ __forceinline__ const float* norm1() const { return (const float*)karg(11); }
    __device__ __forceinline__ const float* w_in() const { return (const float*)karg(12); }
    __device__ __forceinline__ const float* w_conv() const { return (const float*)karg(13); }
    __device__ __forceinline__ const float* b_conv() const { return (const float*)karg(14); }
    __device__ __forceinline__ const float* w_oc() const { return (const float*)karg(15); }
    __device__ __forceinline__ const float* pe() const { return (const float*)karg(16); }
    __device__ __forceinline__ const float* w_phi1() const { return (const float*)karg(17); }
    __device__ __forceinline__ const float* w_phi2() const { return (const float*)karg(18); }
    __device__ __forceinline__ const float* w_on() const { return (const float*)karg(19); }
    __device__ __forceinline__ const float* w_out() const { return (const float*)karg(20); }
    __device__ __forceinline__ const float* norm2() const { return (const float*)karg(21); }
    __device__ __forceinline__ const float* w_gate() const { return (const float*)karg(22); }
    __device__ __forceinline__ const float* w_up() const { return (const float*)karg(23); }
    __device__ __forceinline__ const float* w_down() const { return (const float*)karg(24); }
    __device__ __forceinline__ const float* norm_f() const { return (const float*)karg(25); }
    __device__ __forceinline__ float* out() const { return (float*)karg(26); }
    unsigned char* ws; bf16* OB; float* CHK;
    LAS unsigned char* lds; int tid, lane, wave, G, bid;
    __device__ __forceinline__ bf16* WIN_T() const { return (bf16*)(ws + WS_WIN_T); }
    __device__ __forceinline__ bf16* WOC_T() const { return (bf16*)(ws + WS_WOC_T); }
    __device__ __forceinline__ bf16* WON_T() const { return (bf16*)(ws + WS_WON_T); }
    __device__ __forceinline__ bf16* WOUT_T() const { return (bf16*)(ws + WS_WOUT_T); }
    __device__ __forceinline__ bf16* WGU_T() const { return (bf16*)(ws + WS_WGU_T); }
    __device__ __forceinline__ bf16* WDN_T() const { return (bf16*)(ws + WS_WDN_T); }
    __device__ __forceinline__ float* MODP() const { return (float*)(ws + WS_MODP); }
    __device__ __forceinline__ float* MOD() const { return (float*)(ws + WS_MOD); }
    __device__ __forceinline__ bf16* XN() const { return (bf16*)(ws + WS_XN); }
    __device__ __forceinline__ bf16* BG() const { return (bf16*)(ws + WS_BG); }
    __device__ __forceinline__ bf16* U() const { return (bf16*)(ws + WS_U); }
    __device__ __forceinline__ bf16* Q() const { return (bf16*)(ws + WS_Q); }
    __device__ __forceinline__ bf16* HM() const { return (bf16*)(ws + WS_HM); }
    __device__ __forceinline__ bf16* GA() const { return (bf16*)(ws + WS_GA); }
    __device__ __forceinline__ bf16* GB() const { return (bf16*)(ws + WS_GB); }
    __device__ __forceinline__ float* NGT() const { return (float*)(ws + WS_NGT); }
    __device__ __forceinline__ bf16* AA() const { return (bf16*)(ws + WS_AA); }
    __device__ __forceinline__ bf16* MG() const { return (bf16*)(ws + WS_MG); }
    __device__ __forceinline__ float* X1() const { return (float*)(ws + WS_X1); }
    __device__ __forceinline__ float* P1() const { return (float*)(ws + WS_P1); }
    __device__ __forceinline__ bf16* HF() const { return (bf16*)(ws + WS_HF); }
    __device__ __forceinline__ float* KCC() const { return (float*)(ws + WS_KCC); }
    __device__ __forceinline__ float* SCOREH() const { return (float*)(ws + WS_SCOREH); }
    __device__ __forceinline__ unsigned long long* MASK() const { return (unsigned long long*)(ws + WS_MASK); }
    __device__ __forceinline__ float* XNS() const { return (float*)(ws + WS_XNS); }
    __device__ __forceinline__ float* ZS() const { return (float*)(ws + WS_ZS); }
    __device__ __forceinline__ float* AAS() const { return (float*)(ws + WS_AAS); }
    __device__ __forceinline__ float* OBS() const { return (float*)(ws + WS_OBS); }
    __device__ __forceinline__ float* MGS() const { return (float*)(ws + WS_MGS); }
    __device__ __forceinline__ float* X1S() const { return (float*)(ws + WS_X1S); }
    __device__ __forceinline__ float* XN2S() const { return (float*)(ws + WS_XN2S); }
    __device__ __forceinline__ float* HFS() const { return (float*)(ws + WS_HFS); }
    __device__ __forceinline__ float* X2S() const { return (float*)(ws + WS_X2S); }
    __device__ __forceinline__ float* KCCS() const { return (float*)(ws + WS_KCCS); }
    __device__ __forceinline__ float* SCOREHS() const { return (float*)(ws + WS_SCOREHS); }
    __device__ __forceinline__ unsigned long long* MASKS() const { return (unsigned long long*)(ws + WS_MASKS); }
    __device__ __forceinline__ bf16* KCCB() const { return (bf16*)(ws + WS_KCCB); }
    __device__ __forceinline__ bf16* VCCT() const { return (bf16*)(ws + WS_VCCT); }
    __device__ __forceinline__ bf16* VST() const { return (bf16*)(ws + WS_VST); }
    __device__ __forceinline__ bf16* VWT() const { return (bf16*)(ws + WS_VWT); }
    __device__ __forceinline__ bf16* OB2() const { return (bf16*)(ws + WS_OB2); }
    __device__ __forceinline__ unsigned long long* MASKM() const { return (unsigned long long*)(ws + WS_MASKM); }
};

__device__ __forceinline__ int gtid(const Ctx& c) { int t = c.tid; asm volatile("" : "+v"(t)); return c.bid * NTHR + t; }
__device__ __forceinline__ float bf2f(bf16 b) { return __uint_as_float((unsigned)b << 16); }
__device__ __forceinline__ float sigmoidf_(float x) { return 1.f / (1.f + __expf(-x)); }
__device__ __forceinline__ float siluf_(float x) { return x / (1.f + __expf(-x)); }
__device__ __forceinline__ float gelu_tanh(float x) { const float u = 0.7978845608028654f * (x + 0.044715f * x * x * x); const float e = __expf(2.f * u); const float th = 1.f - 2.f / (e + 1.f); return 0.5f * x * (1.f + th); }
__device__ __forceinline__ float wave_sum(float v) {
#pragma unroll
    for (int o = 1; o < 64; o <<= 1) v += __shfl_xor(v, o);
    return v;
}
__device__ __forceinline__ void ld8(const bf16* p, float (&v)[8]) {
    const v4u w = *(const v4u*)p;
    v[0] = __uint_as_float(w.x << 16); v[1] = __uint_as_float(w.x & 0xffff0000u); v[2] = __uint_as_float(w.y << 16); v[3] = __uint_as_float(w.y & 0xffff0000u);
    v[4] = __uint_as_float(w.z << 16); v[5] = __uint_as_float(w.z & 0xffff0000u); v[6] = __uint_as_float(w.w << 16); v[7] = __uint_as_float(w.w & 0xffff0000u);
}
__device__ __forceinline__ void ld8(const float* p, float (&v)[8]) {
    const f32x4 a = *(const f32x4*)p, b = *(const f32x4*)(p + 4);
    v[0] = a.x; v[1] = a.y; v[2] = a.z; v[3] = a.w; v[4] = b.x; v[5] = b.y; v[6] = b.z; v[7] = b.w;
}
__device__ __forceinline__ v4u pack8(const float (&v)[8]) { v4u w; w.x = pg8::cvt_pk_bf16(v[0], v[1]); w.y = pg8::cvt_pk_bf16(v[2], v[3]); w.z = pg8::cvt_pk_bf16(v[4], v[5]); w.w = pg8::cvt_pk_bf16(v[6], v[7]); return w; }
template <class TP> __device__ __forceinline__ float dot64(const TP* row, const float (&q)[64]) {
    float s = 0.f;
#pragma unroll
    for (int c = 0; c < 8; ++c) { float v[8]; ld8(row + 8 * c, v);
#pragma unroll
        for (int j = 0; j < 8; ++j) s += q[8 * c + j] * v[j]; }
    return s;
}
template <class TP> __device__ __forceinline__ void axpy64(const TP* row, float p, float (&o)[64]) {
#pragma unroll
    for (int c = 0; c < 8; ++c) { float v[8]; ld8(row + 8 * c, v);
#pragma unroll
        for (int j = 0; j < 8; ++j) o[8 * c + j] += p * v[j]; }
}

struct SrcCol { const float* W; int ld; int col; };
template <class F> __device__ __forceinline__ void transpose_item(const F& f, int K, bf16* WT, LAS float* scr, int item, int nblk, int lane) {
    const int kb = item / nblk, nb = item % nblk, k0 = 64 * kb, n0 = 32 * nb;
    const SrcCol sc = f(n0 + (lane & 31));
#pragma unroll 8
    for (int i = 0; i < 32; ++i) { const int kk = 2 * i + (lane >> 5); scr[kk * 33 + (lane & 31)] = sc.col >= 0 ? sc.W[(size_t)(k0 + kk) * sc.ld + sc.col] : 0.f; }
    LDS_WAIT(); asm volatile("" ::: "memory");
    const int c = lane & 7;
#pragma unroll
    for (int j = 0; j < 4; ++j) { const int n = (lane >> 3) + 8 * j; const LAS float* s = scr + (8 * c) * 33 + n;
        v4u o; o.x = pk2(s[0 * 33], s[1 * 33]); o.y = pk2(s[2 * 33], s[3 * 33]); o.z = pk2(s[4 * 33], s[5 * 33]); o.w = pk2(s[6 * 33], s[7 * 33]);
        *(GAS v4u*)(WT + (size_t)(n0 + n) * K + k0 + 8 * c) = o; }
    LDS_WAIT(); asm volatile("" ::: "memory");
}
struct ColIn { const float* W; __device__ __forceinline__ SrcCol operator()(int p) const {
    int s;
    if (p < 1024) s = p;
    else if (p < 3072) { const int t = (p - 1024) >> 8, w = (p - 1024) & 255; s = (w < 128) ? (1024 + 128 * t + w) : (2048 + 128 * t + (w - 128)); }
    else if (p < 5632) s = p;
    else if (p < 7680) s = 5680 + (p - 5632);
    else if (p < 7728) s = 5632 + (p - 7680);
    else s = -1;
    return SrcCol{W, NIN, s}; } };
struct ColPlain { const float* W; int ld; __device__ __forceinline__ SrcCol operator()(int p) const { return SrcCol{W, ld, p}; } };
struct ColGU { const float *Wg, *Wu; __device__ __forceinline__ SrcCol operator()(int p) const { const int t = p >> 8, w = p & 255; return (w < 128) ? SrcCol{Wg, FF, 128 * t + w} : SrcCol{Wu, FF, 128 * t + (w - 128)}; } };

__device__ __forceinline__ void mod_partial_item(const Ctx& c, int item) {
    const int kc = item / 12, cc = item % 12, k0 = kc * 128, n = cc * 512 + c.tid;
    LAS float* sc = (LAS float*)c.lds;
    for (int i = c.tid; i < RMOD * 128; i += NTHR) { const int r = i >> 7, k = i & 127; const float cv = (r < NB) ? c.c_p()[r * D + k0 + k] : c.c_s()[(r - NB) * D + k0 + k]; sc[i] = siluf_(cv); }
    __syncthreads();
    float acc[RMOD];
#pragma unroll
    for (int r = 0; r < RMOD; ++r) acc[r] = 0.f;
    for (int k = 0; k < 128; ++k) { const float w = c.w_ada()[(size_t)(k0 + k) * NMOD + n];
#pragma unroll
        for (int r = 0; r < RMOD; ++r) acc[r] += sc[r * 128 + k] * w; }
#pragma unroll
    for (int r = 0; r < RMOD; ++r) c.MODP()[((size_t)kc * RMOD + r) * NMOD + n] = acc[r];
    __syncthreads();
}
__device__ __forceinline__ void p0_prologue(const Ctx& c) {
    for (int it = c.bid; it < MODKC * 12; it += c.G) mod_partial_item(c, it);
    LAS float* scr = (LAS float*)(c.lds + c.wave * 16384);
    const int gw = c.bid * NWAVES + c.wave, NGW = c.G * NWAVES;
    constexpr int I_IN = 16 * (NINP / 32), I_SQ = 16 * 32, I_GU = 16 * (NGU / 32), I_DN = (FF / 64) * 32;
    constexpr int NITEMS = I_IN + 3 * I_SQ + I_GU + I_DN;
    for (int it = gw; it < NITEMS; it += NGW) {
        int r = it;
        if (r < I_IN) { transpose_item(ColIn{c.w_in()}, D, c.WIN_T(), scr, r, NINP / 32, c.lane); continue; } r -= I_IN;
        if (r < I_SQ) { transpose_item(ColPlain{c.w_oc(), D}, D, c.WOC_T(), scr, r, 32, c.lane); continue; } r -= I_SQ;
        if (r < I_SQ) { transpose_item(ColPlain{c.w_on(), D}, D, c.WON_T(), scr, r, 32, c.lane); continue; } r -= I_SQ;
        if (r < I_SQ) { transpose_item(ColPlain{c.w_out(), D}, D, c.WOUT_T(), scr, r, 32, c.lane); continue; } r -= I_SQ;
        if (r < I_GU) { transpose_item(ColGU{c.w_gate(), c.w_up()}, D, c.WGU_T(), scr, r, NGU / 32, c.lane); continue; } r -= I_GU;
        transpose_item(ColPlain{c.w_down(), D}, FF, c.WDN_T(), scr, r, 32, c.lane);
    }
}

template <bool MODUL, bool OUT_BF16> __device__ __forceinline__ void norm_row(const float* xrow, const float* gain, const float* sh, const float* sc, void* orow, int lane) {
    const GAS f32x4* xr = (const GAS f32x4*)xrow + lane;
    f32x4 v[4]; float s = 0.f;
#pragma unroll
    for (int j = 0; j < 4; ++j) { v[j] = xr[64 * j]; s += (v[j].x * v[j].x + v[j].y * v[j].y) + (v[j].z * v[j].z + v[j].w * v[j].w); }
    const float inv = 1.0f / sqrtf(wave_sum(s) * (1.f / D) + EPS);
#pragma unroll
    for (int j = 0; j < 4; ++j) {
        const int k = 4 * lane + 256 * j;
        const f32x4 g = *(const f32x4*)(gain + k);
        f32x4 o = v[j] * inv * g;
        if (MODUL) { const f32x4 a = *(const f32x4*)(sc + k), b = *(const f32x4*)(sh + k); o = o * (a + 1.0f) + b; }
        if (OUT_BF16) { ((GAS unsigned long long*)orow)[lane + 64 * j] = (unsigned long long)pg8::cvt_pk_bf16(o.x, o.y) | ((unsigned long long)pg8::cvt_pk_bf16(o.z, o.w) << 32); }
        else { ((GAS f32x4*)orow)[lane + 64 * j] = o; }
    }
}
__device__ __forceinline__ void p1_norm1(const Ctx& c) {
    for (int r = c.bid; r < RMOD; r += c.G)
        for (int n = c.tid; n < NMOD; n += NTHR) { float s = c.b_ada()[n];
#pragma unroll
            for (int kc = 0; kc < MODKC; ++kc) s += c.MODP()[((size_t)kc * RMOD + r) * NMOD + n];
            c.MOD()[(size_t)r * NMOD + n] = s; }
    LAS float* shl = (LAS float*)c.lds; LAS float* scl = shl + D;
    constexpr int NCH = M / 64 + SB;
    for (int ch = c.bid; ch < NCH; ch += c.G) {
        const bool smp = ch >= M / 64; const int r = smp ? NB + (ch - M / 64) : (ch * 64) / T;
        __syncthreads();
        for (int k = c.tid; k < 2 * D; k += NTHR) { float s = c.b_ada()[k];
#pragma unroll
            for (int kc = 0; kc < MODKC; ++kc) s += c.MODP()[((size_t)kc * RMOD + r) * NMOD + k];
            shl[k] = s; }
        __syncthreads();
        if (!smp) { for (int rr = c.wave; rr < 64; rr += NWAVES) { const int row = ch * 64 + rr;
                const GAS f32x4* xr = (const GAS f32x4*)(c.x_p() + (size_t)row * D) + c.lane; f32x4 v[4]; float s = 0.f;
#pragma unroll
                for (int j = 0; j < 4; ++j) { v[j] = xr[64 * j]; s += (v[j].x * v[j].x + v[j].y * v[j].y) + (v[j].z * v[j].z + v[j].w * v[j].w); }
                const float inv = 1.0f / sqrtf(wave_sum(s) * (1.f / D) + EPS);
#pragma unroll
                for (int j = 0; j < 4; ++j) { const int k = 4 * c.lane + 256 * j; const f32x4 g = *(const f32x4*)(c.norm1() + k);
                    const f32x4 a = *(const LAS f32x4*)(scl + k), b = *(const LAS f32x4*)(shl + k); const f32x4 o = v[j] * inv * g * (a + 1.0f) + b;
                    ((GAS unsigned long long*)(c.XN() + (size_t)row * D))[c.lane + 64 * j] = (unsigned long long)pg8::cvt_pk_bf16(o.x, o.y) | ((unsigned long long)pg8::cvt_pk_bf16(o.z, o.w) << 32); } } }
        else if (c.wave < SS) { const int row = (ch - M / 64) * SS + c.wave;
                const GAS f32x4* xr = (const GAS f32x4*)(c.x_s() + (size_t)row * D) + c.lane; f32x4 v[4]; float s = 0.f;
#pragma unroll
                for (int j = 0; j < 4; ++j) { v[j] = xr[64 * j]; s += (v[j].x * v[j].x + v[j].y * v[j].y) + (v[j].z * v[j].z + v[j].w * v[j].w); }
                const float inv = 1.0f / sqrtf(wave_sum(s) * (1.f / D) + EPS);
#pragma unroll
                for (int j = 0; j < 4; ++j) { const int k = 4 * c.lane + 256 * j; const f32x4 g = *(const f32x4*)(c.norm1() + k);
                    const f32x4 a = *(const LAS f32x4*)(scl + k), b = *(const LAS f32x4*)(shl + k); const f32x4 o = v[j] * inv * g * (a + 1.0f) + b;
                    ((GAS f32x4*)(c.XNS() + (size_t)row * D))[c.lane + 64 * j] = o; } }
    }
    __syncthreads();
}
__device__ __forceinline__ void p5c_norm2(const Ctx& c) {
    const int gw = c.bid * NWAVES + c.wave, NGW = c.G * NWAVES;
    for (int row = gw; row < M + MS; row += NGW) {
        if (row < M) { const int r = row / T; norm_row<true, true>(c.X1() + (size_t)row * D, c.norm2(), c.MOD() + (size_t)r * NMOD + 3 * D, c.MOD() + (size_t)r * NMOD + 4 * D, c.XN() + (size_t)row * D, c.lane); }
        else { const int rs = row - M, r = NB + rs / SS; norm_row<true, false>(c.X1S() + (size_t)rs * D, c.norm2(), c.MOD() + (size_t)r * NMOD + 3 * D, c.MOD() + (size_t)r * NMOD + 4 * D, c.XN2S() + (size_t)rs * D, c.lane); }
    }
}
__device__ __forceinline__ void p8_normf(const Ctx& c) {
    const int gw = c.bid * NWAVES + c.wave, NGW = c.G * NWAVES;
    for (int row = gw; row < M + MS; row += NGW) {
        if (row < M) norm_row<false, false>(c.out() + O_YP + (size_t)row * D, c.norm_f(), nullptr, nullptr, c.out() + O_YP + (size_t)row * D, c.lane);
        else { const int rs = row - M; norm_row<false, false>(c.X2S() + (size_t)rs * D, c.norm_f(), nullptr, nullptr, c.out() + O_YS + (size_t)rs * D, c.lane); }
    }
}

using pg8::Unit;
#define EPI_ROWS(...) _Pragma("unroll") for (int ai = 0; ai < 2; ++ai) _Pragma("unroll") for (int m = 0; m < 4; ++m) { const int row = row0 + ai * 128 + m * 16; __VA_ARGS__ }
struct EpiIn {
    static constexpr bool PERM = true, AFTER_DRAIN = false;
    bf16 *BG, *U, *Q, *HM, *GA, *GB; float* NGT; float* out; bf16 *VST, *VWT;
    __device__ __forceinline__ void operator()(const f32x4 (&acc)[2][2][4][2], const Unit& u, int wr, int wc, int fr, int fq) const {
        const int pn = u.pn, row0 = u.pm * 256 + wr * 64 + fr, cl0 = wc * 32 + 8 * fq;
        if (pn < 4 || (pn >= 12 && pn < 16) || (pn >= 22 && pn < 30)) {
            bf16* base; int colt; float sc = 1.f; bool sig = false;
            if (pn < 4) { base = BG; colt = pn * 256; } else if (pn < 16) { base = Q; colt = (pn - 12) * 256; sc = 0.125f * 1.4426950408889634f; } else if (pn < 26) { base = GA; colt = (pn - 22) * 256; sig = true; } else { base = GB; colt = (pn - 26) * 256; sig = true; }
            EPI_ROWS(
_Pragma("unroll")
                for (int bj = 0; bj < 2; ++bj) { const f32x4 a = acc[ai][bj][m][0], b = acc[ai][bj][m][1]; float v[8] = {a.x, a.y, a.z, a.w, b.x, b.y, b.z, b.w};
_Pragma("unroll")
                    for (int j = 0; j < 8; ++j) v[j] = sig ? sigmoidf_(v[j]) : v[j] * sc;
                    *(GAS v4u*)(base + (size_t)row * D + colt + bj * 128 + cl0) = pack8(v); } )
        } else if (pn < 12) {
            const int t = pn - 4;
            EPI_ROWS(
                const f32x4 a = acc[ai][0][m][0] * acc[ai][1][m][0], b = acc[ai][0][m][1] * acc[ai][1][m][1]; const float v[8] = {a.x, a.y, a.z, a.w, b.x, b.y, b.z, b.w};
                *(GAS v4u*)(U + (size_t)row * D + t * 128 + cl0) = pack8(v);
                const int tt = row & (T - 1);
                if (tt >= T - 2) { float* o = out + O_CONV_P + (size_t)((row >> 12) * 2 + (tt - (T - 2))) * D + t * 128 + cl0; *(GAS f32x4*)o = a; *(GAS f32x4*)(o + 4) = b; } )
        } else if (pn < 22) {
            const int kind = pn - 16, kv = kind & 1, reg = kind >> 1;
            EPI_ROWS(
                const int b = row >> 12, tt = row & (T - 1);
_Pragma("unroll")
                for (int bj = 0; bj < 2; ++bj) { const f32x4 a = acc[ai][bj][m][0], bq = acc[ai][bj][m][1]; const float v[8] = {a.x, a.y, a.z, a.w, bq.x, bq.y, bq.z, bq.w};
                    const int cl = bj * 128 + cl0, g = cl >> 6, d = cl & 63;
                    if (kind == 3 || kind == 5) { bf16* vt = (kind == 3 ? VST : VWT) + ((size_t)((b * NKV + g) * HD + d)) * T + tt;
_Pragma("unroll")
                        for (int j = 0; j < 8; ++j) vt[(size_t)j * T] = (bf16)f2bf(v[j]); }
                    if (PROBE_ATT || !(kind == 3 || kind == 5)) *(GAS v4u*)(HM + (size_t)kind * HMSZ + ((size_t)((b * NKV + g) * T + tt)) * HD + d) = pack8(v);
                    float* o = nullptr;
                    if (reg == 0) o = out + O_CMP_P + ((size_t)row * 2 + kv) * 256 + cl;
                    else if (reg == 1) o = out + O_SEL_P + ((size_t)row * 2 + kv) * 256 + cl;
                    else if (tt >= T - 512) o = out + O_WIN_P + ((size_t)(b * 512 + tt - (T - 512)) * 2 + kv) * 256 + cl;
                    if (o) { *(GAS f32x4*)o = a; *(GAS f32x4*)(o + 4) = bq; } } )
        } else {
            if (cl0 < 48) {
                EPI_ROWS(
                    const f32x4 a = acc[ai][0][m][0], b = acc[ai][0][m][1];
                    f32x4 sa, sb; sa.x = sigmoidf_(a.x); sa.y = sigmoidf_(a.y); sa.z = sigmoidf_(a.z); sa.w = sigmoidf_(a.w); sb.x = sigmoidf_(b.x); sb.y = sigmoidf_(b.y); sb.z = sigmoidf_(b.z); sb.w = sigmoidf_(b.w);
                    float* o = NGT + (size_t)row * 48 + cl0; *(GAS f32x4*)o = sa; *(GAS f32x4*)(o + 4) = sb; )
            }
        }
    }
};
struct EpiYa { static constexpr bool PERM = true, AFTER_DRAIN = false; const bf16* GA; float* P1;
    __device__ __forceinline__ void operator()(const f32x4 (&acc)[2][2][4][2], const Unit& u, int wr, int wc, int fr, int fq) const {
        const int row0 = u.pm * 256 + wr * 64 + fr, col0 = u.pn * 256 + wc * 32 + 8 * fq;
        EPI_ROWS(
_Pragma("unroll")
            for (int bj = 0; bj < 2; ++bj) { const size_t off = (size_t)row * D + col0 + bj * 128; float g[8]; ld8(GA + off, g); const f32x4 a = acc[ai][bj][m][0], b = acc[ai][bj][m][1];
                f32x4 o0, o1; o0.x = g[0] * a.x; o0.y = g[1] * a.y; o0.z = g[2] * a.z; o0.w = g[3] * a.w; o1.x = g[4] * b.x; o1.y = g[5] * b.y; o1.z = g[6] * b.z; o1.w = g[7] * b.w;
                *(GAS f32x4*)(P1 + off) = o0; *(GAS f32x4*)(P1 + off + 4) = o1; } )
    } };
struct EpiYb { static constexpr bool PERM = true, AFTER_DRAIN = false; const bf16* GB; const float* P1; bf16* MG;
    __device__ __forceinline__ void operator()(const f32x4 (&acc)[2][2][4][2], const Unit& u, int wr, int wc, int fr, int fq) const {
        const int row0 = u.pm * 256 + wr * 64 + fr, col0 = u.pn * 256 + wc * 32 + 8 * fq;
        EPI_ROWS(
_Pragma("unroll")
            for (int bj = 0; bj < 2; ++bj) { const size_t off = (size_t)row * D + col0 + bj * 128; float g[8]; ld8(GB + off, g); float p[8]; ld8(P1 + off, p); const f32x4 a = acc[ai][bj][m][0], b = acc[ai][bj][m][1];
                const float v[8] = {p[0] + g[0] * a.x, p[1] + g[1] * a.y, p[2] + g[2] * a.z, p[3] + g[3] * a.w, p[4] + g[4] * b.x, p[5] + g[5] * b.y, p[6] + g[6] * b.z, p[7] + g[7] * b.w};
                *(GAS v4u*)(MG + off) = pack8(v); } )
    } };
struct EpiRes { static constexpr bool PERM = true, AFTER_DRAIN = false; const float* base; float* O; const float* MOD; int goff;
    __device__ __forceinline__ void operator()(const f32x4 (&acc)[2][2][4][2], const Unit& u, int wr, int wc, int fr, int fq) const {
        const int row0 = u.pm * 256 + wr * 64 + fr, col0 = u.pn * 256 + wc * 32 + 8 * fq;
        const float* gp = MOD + (size_t)((u.pm * 256) / T) * NMOD + goff + col0;
        f32x4 gt[2][2];
#pragma unroll
        for (int bj = 0; bj < 2; ++bj) { gt[bj][0] = *(const f32x4*)(gp + bj * 128); gt[bj][1] = *(const f32x4*)(gp + bj * 128 + 4); }
        EPI_ROWS(
_Pragma("unroll")
            for (int bj = 0; bj < 2; ++bj) { const size_t off = (size_t)row * D + col0 + bj * 128;
                const f32x4 x0 = *(const f32x4*)(base + off), x1 = *(const f32x4*)(base + off + 4);
                *(GAS f32x4*)(O + off) = x0 + gt[bj][0] * acc[ai][bj][m][0]; *(GAS f32x4*)(O + off + 4) = x1 + gt[bj][1] * acc[ai][bj][m][1]; } )
    } };
struct EpiFF { static constexpr bool PERM = true, AFTER_DRAIN = false; bf16* HF;
    __device__ __forceinline__ void operator()(const f32x4 (&acc)[2][2][4][2], const Unit& u, int wr, int wc, int fr, int fq) const {
        const int row0 = u.pm * 256 + wr * 64 + fr, col0 = u.pn * 128 + wc * 32 + 8 * fq;
        EPI_ROWS(
            const f32x4 g0 = acc[ai][0][m][0], g1 = acc[ai][0][m][1], u0 = acc[ai][1][m][0], u1 = acc[ai][1][m][1];
            const float v[8] = {siluf_(g0.x) * u0.x, siluf_(g0.y) * u0.y, siluf_(g0.z) * u0.z, siluf_(g0.w) * u0.w, siluf_(g1.x) * u1.x, siluf_(g1.y) * u1.y, siluf_(g1.z) * u1.z, siluf_(g1.w) * u1.w};
            *(GAS v4u*)(HF + (size_t)row * FF + col0) = pack8(v); )
    } };

template <bool DUAL, class Epi> __device__ __forceinline__ void sgemm(const Ctx& c, const float* A1, const float* A2, int lda, const float* W1, const float* W2, int ldw, int K, int N, const Epi& epi) {
    const int nch = (N + NTHR - 1) / NTHR, nitems = 8 * nch;
    for (int it = c.G - 1 - c.bid; it < nitems; it += c.G) {
        const int rg = it & 7, n = (it >> 3) * NTHR + c.tid;
        if (n < N) {
            float a1[16], a2[16];
#pragma unroll
            for (int r = 0; r < 16; ++r) { a1[r] = 0.f; a2[r] = 0.f; }
            const float* ar1 = A1 + (size_t)rg * 16 * lda; const float* ar2 = A2 + (size_t)rg * 16 * lda;
            for (int k = 0; k < K; ++k) { const float w1 = W1[(size_t)k * ldw + n]; const float w2 = DUAL ? W2[(size_t)k * ldw + n] : 0.f;
#pragma unroll
                for (int r = 0; r < 16; ++r) { a1[r] += ar1[(size_t)r * lda + k] * w1; if (DUAL) a2[r] += ar2[(size_t)r * lda + k] * w2; } }
#pragma unroll
            for (int r = 0; r < 16; ++r) epi(rg * 16 + r, n, a1[r], a2[r]);
        }
    }
}

__device__ __forceinline__ void p3_conv_prompt(const Ctx& c) {
    const int gt = gtid(c), NGT_ = c.G * NTHR;
    for (int it = gt; it < M * (D / 8); it += NGT_) {
        const int row = it >> 7, ch = (it & 127) * 8, tt = row & (T - 1);
        float u0[8], u1[8], u2[8], bg[8];
        ld8(c.U() + (size_t)row * D + ch, u0); ld8(c.BG() + (size_t)row * D + ch, bg);
        if (tt >= 1) ld8(c.U() + (size_t)(row - 1) * D + ch, u1); else { for (int j = 0; j < 8; ++j) u1[j] = 0.f; }
        if (tt >= 2) ld8(c.U() + (size_t)(row - 2) * D + ch, u2); else { for (int j = 0; j < 8; ++j) u2[j] = 0.f; }
        float w0[8], w1[8], w2[8], bb[8]; ld8(c.w_conv() + ch, w0); ld8(c.w_conv() + D + ch, w1); ld8(c.w_conv() + 2 * D + ch, w2); ld8(c.b_conv() + ch, bb);
        float v[8];
#pragma unroll
        for (int j = 0; j < 8; ++j) v[j] = bg[j] * (bb[j] + w0[j] * u2[j] + w1[j] * u1[j] + w2[j] * u0[j]);
        *(GAS v4u*)(c.AA() + (size_t)row * D + ch) = pack8(v);
    }
}
__device__ __forceinline__ void p3_sample_thin(const Ctx& c) {
    const int gt = gtid(c), NGT_ = c.G * NTHR;
    for (int it = gt; it < MS * D; it += NGT_) {
        const int row = it >> 10, ch = it & 1023, b = row >> 2, s = row & 3;
        float up[3];
#pragma unroll
        for (int k = 0; k < 3; ++k) { const int ss = s - 2 + k; up[k] = (ss >= 0) ? c.ZS()[(size_t)(b * SS + ss) * NIN + 1024 + ch] * c.ZS()[(size_t)(b * SS + ss) * NIN + 2048 + ch] : c.state_conv()[(size_t)(b * 2 + (ss + 2)) * D + ch]; }
        const float v = c.b_conv()[ch] + c.w_conv()[ch] * up[0] + c.w_conv()[D + ch] * up[1] + c.w_conv()[2 * D + ch] * up[2];
        c.AAS()[(size_t)row * D + ch] = c.ZS()[(size_t)row * NIN + ch] * v;
        if (s >= 2) c.out()[O_CONV_S + (size_t)(b * 2 + (s - 2)) * D + ch] = up[2];
    }
    for (int it = gt; it < MS * 512; it += NGT_) { const int row = it >> 9, cc = it & 511;
        c.out()[O_CMP_S + (size_t)row * 512 + cc] = c.ZS()[(size_t)row * NIN + 4096 + cc]; c.out()[O_SEL_S + (size_t)row * 512 + cc] = c.ZS()[(size_t)row * NIN + 4608 + cc]; }
    for (int it = gt; it < SB * 512 * 128; it += NGT_) { const int cc = (it & 127) * 4, j = (it >> 7) & 511, b = it >> 16;
        f32x4 v;
        if (j + SS < 512) v = *(const f32x4*)(c.cache_win() + ((size_t)(b * 512 + j + SS)) * 512 + cc);
        else v = *(const f32x4*)(c.ZS() + (size_t)(b * SS + (j + SS - 512)) * NIN + 5120 + cc);
        *(GAS f32x4*)(c.out() + O_WIN_S + ((size_t)(b * 512 + j)) * 512 + cc) = v; }
}
struct CmpP { static constexpr int NB_ = NB, NCS = NCS_P, NCP = NCP_P, NGRP = 16;
    __device__ static __forceinline__ float x(const Ctx& c, int kv, int b, int g, int pos, int d) { return bf2f(c.HM()[(size_t)kv * HMSZ + ((size_t)((b * NKV + g) * T + pos)) * HD + d]); }
    __device__ static __forceinline__ void store(const Ctx& c, int kv, int b, int g, int i, int o, float s) {
        if (PROBE_ATT) c.KCC()[((size_t)((kv * NB + b) * NKV + g) * NCP_P + i) * HD + o] = s;
        if (kv == 0) c.KCCB()[((size_t)((b * NKV + g) * NCP_P + i)) * HD + o] = (bf16)f2bf(s); else c.VCCT()[((size_t)((b * NKV + g) * HD + o)) * NCP_P + i] = (bf16)f2bf(s); } };
struct CmpS { static constexpr int NB_ = SB, NCS = NCS_S, NCP = NCP_S, NGRP = 32;
    __device__ static __forceinline__ float x(const Ctx& c, int kv, int b, int g, int pos, int d) { return c.cache_cmp()[((size_t)c.pt()[b * NPG + (pos >> 7)] * PAGE + (pos & 127)) * 512 + kv * 256 + g * HD + d]; }
    __device__ static __forceinline__ void store(const Ctx& c, int kv, int b, int g, int i, int o, float s) { c.KCCS()[((size_t)((kv * SB + b) * NKV + g) * NCP_S + i) * HD + o] = s; } };
template <class S> __device__ __forceinline__ void compress_naive(const Ctx& c) {
    constexpr int NITEMS = 2 * S::NB_ * NKV * S::NGRP;
    LAS float* hid = (LAS float*)c.lds;
    const int n = c.tid & 127, rq = c.tid >> 7;
    for (int it = c.bid; it < NITEMS; it += c.G) {
        const int ig = it % S::NGRP, g = (it / S::NGRP) % NKV, b = (it / (S::NGRP * NKV)) % S::NB_, kv = it / (S::NGRP * NKV * S::NB_);
        const int i0 = ig * 16 + 4 * rq;
        float acc[4] = {0.f, 0.f, 0.f, 0.f};
        for (int t = 0; t < 32; ++t) {
            for (int d = 0; d < HD; ++d) {
                const int k = t * HD + d; const float w = c.w_phi1()[((size_t)kv * 2048 + k) * 128 + n], pe = c.pe()[kv * 2048 + k];
#pragma unroll
                for (int r = 0; r < 4; ++r) { int i = i0 + r; i = i < S::NCS ? i : S::NCS - 1; acc[r] += (S::x(c, kv, b, g, 16 * i + t, d) + pe) * w; }
            }
        }
        __syncthreads();
#pragma unroll
        for (int r = 0; r < 4; ++r) hid[(4 * rq + r) * 128 + n] = gelu_tanh(acc[r]);
        __syncthreads();
        const int o = c.tid & 63;
#pragma unroll
        for (int rr = 0; rr < 2; ++rr) { const int r = (c.tid >> 6) + 8 * rr, i = ig * 16 + r; float s = 0.f;
            for (int k = 0; k < 128; ++k) s += hid[r * 128 + k] * c.w_phi2()[((size_t)kv * 128 + k) * HD + o];
            if (i < S::NCS) S::store(c, kv, b, g, i, o, s); }
    }
    __syncthreads();
}

struct AtP {
    static constexpr int NQ = T, QBASE = 0, NS = 64, NSP = 64, NSL = 1, NBAT = NB, NCP = NCP_P;
    typedef bf16 KT;
    __device__ static __forceinline__ void decode(int idx, int& b, int& h, int& qi) { qi = idx & (T - 1); h = (idx >> 12) & 15; b = idx >> 16; }
    __device__ static __forceinline__ void load_q(const Ctx& c, int b, int h, int qi, float (&q)[64]) { const bf16* p = c.Q() + (size_t)(b * T + qi) * D + h * HD;
#pragma unroll
        for (int cc = 0; cc < 8; ++cc) { float v[8]; ld8(p + 8 * cc, v);
#pragma unroll
            for (int j = 0; j < 8; ++j) q[8 * cc + j] = v[j] * 0.6931471805599453f; } }
    __device__ static __forceinline__ float gate(const Ctx& c, int b, int h, int qi, int j) { return c.NGT()[(size_t)(b * T + qi) * 48 + h * 3 + j]; }
    __device__ static __forceinline__ const float* kcc(const Ctx& c, int kv, int b, int g, int ci) { return c.KCC() + ((size_t)((kv * NB + b) * NKV + g) * NCP_P + ci) * HD; }
    __device__ static __forceinline__ const KT* ksel(const Ctx& c, int kv, int b, int g, int pos) { return c.HM() + (size_t)(2 + kv) * HMSZ + ((size_t)((b * NKV + g) * T + pos)) * HD; }
    __device__ static __forceinline__ const KT* kwin(const Ctx& c, int kv, int b, int g, int pos) { return c.HM() + (size_t)(4 + kv) * HMSZ + ((size_t)((b * NKV + g) * T + pos)) * HD; }
    __device__ static __forceinline__ float* scoreh(const Ctx& c) { return c.SCOREH(); }
    __device__ static __forceinline__ unsigned long long* mask(const Ctx& c) { return c.MASK(); }
    __device__ static __forceinline__ void store_o(const Ctx& c, int b, int h, int qi, const float (&o)[64]) { bf16* p = c.OB + (size_t)(b * T + qi) * D + h * HD;
#pragma unroll
        for (int cc = 0; cc < 8; ++cc) { float v[8];
#pragma unroll
            for (int j = 0; j < 8; ++j) v[j] = o[8 * cc + j];
            *(GAS v4u*)(p + 8 * cc) = pack8(v); } }
};
struct AtS {
    static constexpr int NQ = SS, QBASE = PAST, NS = 129, NSP = 192, NSL = 3, NBAT = SB, NCP = NCP_S;
    typedef float KT;
    __device__ static __forceinline__ void decode(int idx, int& b, int& h, int& qi) { qi = idx & 3; h = (idx >> 2) & 15; b = idx >> 6; }
    __device__ static __forceinline__ void load_q(const Ctx& c, int b, int h, int qi, float (&q)[64]) { const float* p = c.ZS() + (size_t)(b * SS + qi) * NIN + 3072 + h * HD;
#pragma unroll
        for (int j = 0; j < 64; ++j) q[j] = p[j] * 0.125f; }
    __device__ static __forceinline__ float gate(const Ctx& c, int b, int h, int qi, int j) { return sigmoidf_(c.ZS()[(size_t)(b * SS + qi) * NIN + 5632 + h * 3 + j]); }
    __device__ static __forceinline__ const float* kcc(const Ctx& c, int kv, int b, int g, int ci) { return c.KCCS() + ((size_t)((kv * SB + b) * NKV + g) * NCP_S + ci) * HD; }
    __device__ static __forceinline__ const KT* ksel(const Ctx& c, int kv, int b, int g, int pos) {
        if (pos < PAST) return c.cache_sel() + ((size_t)c.pt()[b * NPG + (pos >> 7)] * PAGE + (pos & 127)) * 512 + kv * 256 + g * HD;
        return c.ZS() + (size_t)(b * SS + (pos - PAST)) * NIN + 4608 + kv * 256 + g * HD; }
    __device__ static __forceinline__ const KT* kwin(const Ctx& c, int kv, int b, int g, int pos) {
        if (pos < PAST) return c.cache_win() + ((size_t)(b * 512 + (pos - (PAST - 512)))) * 512 + kv * 256 + g * HD;
        return c.ZS() + (size_t)(b * SS + (pos - PAST)) * NIN + 5120 + kv * 256 + g * HD; }
    __device__ static __forceinline__ float* scoreh(const Ctx& c) { return c.SCOREHS(); }
    __device__ static __forceinline__ unsigned long long* mask(const Ctx& c) { return c.MASKS(); }
    __device__ static __forceinline__ void store_o(const Ctx& c, int b, int h, int qi, const float (&o)[64]) { float* p = c.OBS() + (size_t)(b * SS + qi) * D + h * HD;
#pragma unroll
        for (int j = 0; j < 64; ++j) p[j] = o[j]; }
};
__device__ __forceinline__ int wave_max_i(int v) {
#pragma unroll
    for (int o = 1; o < 64; o <<= 1) { const int t = __shfl_xor(v, o); v = t > v ? t : v; }
    return v;
}
__device__ __forceinline__ int wave_min_i(int v) {
#pragma unroll
    for (int o = 1; o < 64; o <<= 1) { const int t = __shfl_xor(v, o); v = t < v ? t : v; }
    return v;
}
template <class S> __device__ __forceinline__ void p4a_scores(const Ctx& c) {
    constexpr int NW = S::NBAT * H * S::NQ / 64;
    const int gw = c.bid * NWAVES + c.wave, NGW = c.G * NWAVES;
    for (int w = gw; w < NW; w += NGW) {
        const int idx = w * 64 + c.lane; int b, h, qi; S::decode(idx, b, h, qi);
        const int g = h >> 2, qpos = S::QBASE + qi; const float tq = (float)qpos, slope = exp2f(-0.5f * (float)(h + 1));
        float q[64]; S::load_q(c, b, h, qi, q);
        const int ncv = qpos >= 31 ? ((qpos - 31) >> 4) + 1 : 0, ncm = wave_max_i(ncv);
        float m = NEGF;
        for (int ci = 0; ci < ncm; ++ci) { const int cc = ci < ncv ? ci : 0; const float s = dot64(S::kcc(c, 0, b, g, cc), q) - slope * (tq - 16.f * ci - 15.5f); if (ci < ncv) m = fmaxf(m, s); }
        float l = 0.f;
        for (int ci = 0; ci < ncm; ++ci) { const int cc = ci < ncv ? ci : 0; const float s = dot64(S::kcc(c, 0, b, g, cc), q) - slope * (tq - 16.f * ci - 15.5f); if (ci < ncv) l += __expf(s - m); }
        const float il = l > 0.f ? 1.f / l : 0.f;
        float carry = 0.f; float* sp = S::scoreh(c) + (size_t)idx * S::NSP;
        const int nsm = (ncm + 3) >> 2;
        for (int s4 = 0; s4 < S::NS; ++s4) {
            float a = carry;
            if (s4 < nsm + 1) {
#pragma unroll 1
                for (int j = 0; j < 4; ++j) { const int ci = 4 * s4 + j; float p = 0.f;
                    if (ci < ncm) { const int cc = ci < ncv ? ci : 0; const float s = dot64(S::kcc(c, 0, b, g, cc), q) - slope * (tq - 16.f * ci - 15.5f); p = ci < ncv ? __expf(s - m) * il : 0.f; }
                    a += p; if (j == 3) carry = p; }
            } else carry = 0.f;
            sp[s4] = a;
        }
    }
}
template <class S> __device__ __forceinline__ void p4b_topk(const Ctx& c) {
    constexpr int NW = S::NBAT * NKV * S::NQ;
    const int gw = c.bid * NWAVES + c.wave, NGW = c.G * NWAVES;
    for (int w = gw; w < NW; w += NGW) {
        const int qi = w % S::NQ, g = (w / S::NQ) % NKV, b = w / (S::NQ * NKV);
        const int qpos = S::QBASE + qi, cur = qpos >> 6;
        float val[S::NSL];
#pragma unroll
        for (int j = 0; j < S::NSL; ++j) { const int s = c.lane + 64 * j; float v = -INFINITY;
            if (s < S::NS) { float imp = 0.f;
#pragma unroll
                for (int r = 0; r < 4; ++r) imp += S::scoreh(c)[((size_t)((b * H + 4 * g + r) * S::NQ + qi)) * S::NSP + s];
                const bool valid = 64 * s <= qpos, forced = (s == 0) || (s == cur) || (s == cur - 1);
                v = valid ? imp + (forced ? 1000.f : 0.f) : NEGF; }
            val[j] = v; }
        int rank[S::NSL];
#pragma unroll
        for (int j = 0; j < S::NSL; ++j) rank[j] = 0;
#pragma unroll
        for (int j2 = 0; j2 < S::NSL; ++j2)
            for (int l2 = 0; l2 < 64; ++l2) { const float v2 = __shfl(val[j2], l2); const int s2 = l2 + 64 * j2;
#pragma unroll
                for (int j = 0; j < S::NSL; ++j) { const int s = c.lane + 64 * j; rank[j] += (v2 > val[j] || (v2 == val[j] && s2 < s)) ? 1 : 0; } }
#pragma unroll
        for (int j = 0; j < S::NSL; ++j) { const int s = c.lane + 64 * j; const unsigned long long mk = __ballot(rank[j] < 16 && s < S::NS);
            if (c.lane == 0) S::mask(c)[(size_t)w * S::NSL + j] = mk; }
    }
}
#define ONLINE_UPD(sv, vrow, ok) do { if (ok) { if ((sv) > m) { const float al = __expf(m - (sv)); l *= al; _Pragma("unroll") for (int d_ = 0; d_ < 64; ++d_) o[d_] *= al; m = (sv); } \
        const float p_ = __expf((sv) - m); l += p_; axpy64((vrow), p_, o); } } while (0)
template <class S> __device__ __forceinline__ void p4c_attend(const Ctx& c, int mode = -1) {
    constexpr int NW = S::NBAT * H * S::NQ / 64;
    const int gw = c.bid * NWAVES + c.wave, NGW = c.G * NWAVES;
    for (int w = gw; w < NW; w += NGW) {
        const int idx = w * 64 + c.lane; int b, h, qi; S::decode(idx, b, h, qi);
        const int g = h >> 2, qpos = S::QBASE + qi, cur = qpos >> 6; const float tq = (float)qpos, slope = exp2f(-0.5f * (float)(h + 1));
        float q[64]; S::load_q(c, b, h, qi, q);
        LAS float* ot = (LAS float*)c.lds + c.tid;
#pragma unroll
        for (int d = 0; d < 64; ++d) ot[d * NTHR] = 0.f;
        float o[64]; float m, l;
        {
#pragma unroll
            for (int d = 0; d < 64; ++d) o[d] = 0.f;
            m = NEGF; l = 0.f;
            const int ncv = qpos >= 31 ? ((qpos - 31) >> 4) + 1 : 0, ncm = wave_max_i(ncv);
            for (int ci = 0; ci < ncm; ++ci) { const bool ok = ci < ncv; const int cc = ok ? ci : 0;
                const float s = dot64(S::kcc(c, 0, b, g, cc), q) - slope * (tq - 16.f * ci - 15.5f);
                ONLINE_UPD(s, S::kcc(c, 1, b, g, cc), ok); }
            if (l > 0.f) { const float f = ((mode < 0 || mode == 0) ? S::gate(c, b, h, qi, 0) : 0.f) / l;
#pragma unroll
                for (int d = 0; d < 64; ++d) ot[d * NTHR] += f * o[d]; }
        }
        {
#pragma unroll
            for (int d = 0; d < 64; ++d) o[d] = 0.f;
            m = NEGF; l = 0.f;
            unsigned long long mk[S::NSL];
#pragma unroll
            for (int j = 0; j < S::NSL; ++j) mk[j] = S::mask(c)[((size_t)((b * NKV + g) * S::NQ + qi)) * S::NSL + j];
            const int curm = wave_max_i(cur);
            for (int s = 0; s <= curm; ++s) {
                unsigned long long word = mk[0];
#pragma unroll
                for (int j = 1; j < S::NSL; ++j) if ((s >> 6) == j) word = mk[j];
                const bool sel = (s <= cur) && ((word >> (s & 63)) & 1ull);
                if (!__any(sel)) continue;
                for (int k = 0; k < 64; ++k) { const int pos = 64 * s + k; const bool ok = sel && pos <= qpos; const int pc = pos <= qpos ? pos : qpos;
                    if (!__any(ok)) continue;
                    const float sv = dot64(S::ksel(c, 0, b, g, pc), q) - slope * (tq - (float)pos);
                    ONLINE_UPD(sv, S::ksel(c, 1, b, g, pc), ok); }
            }
            if (l > 0.f) { const float f = ((mode < 0 || mode == 1) ? S::gate(c, b, h, qi, 1) : 0.f) / l;
#pragma unroll
                for (int d = 0; d < 64; ++d) ot[d * NTHR] += f * o[d]; }
        }
        {
#pragma unroll
            for (int d = 0; d < 64; ++d) o[d] = 0.f;
            m = NEGF; l = 0.f;
            const int lo = qpos - 511 > 0 ? qpos - 511 : 0; const int lom = wave_min_i(lo), him = wave_max_i(qpos);
            for (int kp = lom; kp <= him; ++kp) { const bool ok = kp >= lo && kp <= qpos; int pc = kp < lo ? lo : kp; pc = pc > qpos ? qpos : pc;
                if (S::QBASE > 0 && pc < PAST - 512) pc = PAST - 512;
                const float sv = dot64(S::kwin(c, 0, b, g, pc), q) - slope * (tq - (float)kp);
                ONLINE_UPD(sv, S::kwin(c, 1, b, g, pc), ok); }
            if (l > 0.f) { const float f = ((mode < 0 || mode == 2) ? S::gate(c, b, h, qi, 2) : 0.f) / l;
#pragma unroll
                for (int d = 0; d < 64; ++d) ot[d * NTHR] += f * o[d]; }
        }
#pragma unroll
        for (int d = 0; d < 64; ++d) o[d] = ot[d * NTHR];
        S::store_o(c, b, h, qi, o);
    }
}

namespace at {
typedef short bfx8 __attribute__((ext_vector_type(8)));
constexpr float LOG2E = 1.4426950408889634f;
constexpr float QSCALE = 0.125f * LOG2E;
constexpr int IMP_PITCH = 68;
__device__ __forceinline__ f32x4 mfma16(bfx8 a, bfx8 b, f32x4 c) { return __builtin_amdgcn_mfma_f32_16x16x32_bf16(a, b, c, 0, 0, 0); }
__device__ __forceinline__ void ce_desc(float& a, float& b) { const float hi = fmaxf(a, b), lo = fminf(a, b); a = hi; b = lo; }
__device__ __forceinline__ void sort16_desc(float (&v)[16]) {
#pragma unroll
    for (int k = 2; k <= 16; k <<= 1)
#pragma unroll
        for (int j = k >> 1; j > 0; j >>= 1)
#pragma unroll
            for (int i = 0; i < 16; ++i) { const int l = i ^ j; if (l > i) { if ((i & k) == 0) ce_desc(v[i], v[l]); else ce_desc(v[l], v[i]); } }
}
__device__ __forceinline__ void merge16_desc(float (&v)[16]) {
#pragma unroll
    for (int j = 8; j > 0; j >>= 1)
#pragma unroll
        for (int i = 0; i < 16; ++i) { const int l = i ^ j; if (l > i) ce_desc(v[i], v[l]); }
}
struct Tile {
    bfx8 qf[4][2]; float slope2[4]; f32x4 ot[4][4]; float m[4], l[4];
    int lane, ql, G, qpos;
};
__device__ __forceinline__ void qk_chunk(const Tile& t, const bf16* kb, f32x4 (&sa)[4], f32x4 (&sb)[4]) {
    const int r16 = t.ql; const bf16* ka = kb + (8 * (r16 >> 2) + (r16 & 3)) * 64 + 8 * t.G;
    const bfx8 a0 = *(const bfx8*)ka, a1 = *(const bfx8*)(ka + 32), b0 = *(const bfx8*)(ka + 256), b1 = *(const bfx8*)(ka + 256 + 32);
#pragma unroll
    for (int r = 0; r < 4; ++r) {
        f32x4 z = {0.f, 0.f, 0.f, 0.f};
        sa[r] = mfma16(a0, t.qf[r][0], z); sa[r] = mfma16(a1, t.qf[r][1], sa[r]);
        sb[r] = mfma16(b0, t.qf[r][0], z); sb[r] = mfma16(b1, t.qf[r][1], sb[r]);
    }
}
__device__ __forceinline__ void pv_chunk(Tile& t, const bf16* vtb, int pitch, const bfx8 (&pf)[4]) {
#pragma unroll
    for (int db = 0; db < 4; ++db) { const bfx8 vf = *(const bfx8*)(vtb + (size_t)(16 * db + t.ql) * pitch + 8 * t.G);
#pragma unroll
        for (int r = 0; r < 4; ++r) t.ot[r][db] = mfma16(vf, pf[r], t.ot[r][db]); }
}
__device__ __forceinline__ float gmax4(float v) { v = fmaxf(v, __shfl_xor(v, 16)); v = fmaxf(v, __shfl_xor(v, 32)); return v; }
__device__ __forceinline__ float gsum4(float v) { v += __shfl_xor(v, 16); v += __shfl_xor(v, 32); return v; }
__device__ __forceinline__ bfx8 pack_p(const float (&p)[8]) {
    v4u w; w.x = pg8::cvt_pk_bf16(p[0], p[1]); w.y = pg8::cvt_pk_bf16(p[2], p[3]); w.z = pg8::cvt_pk_bf16(p[4], p[5]); w.w = pg8::cvt_pk_bf16(p[6], p[7]);
    return __builtin_bit_cast(bfx8, w);
}
__device__ __forceinline__ void softmax_online(Tile& t, const f32x4 (&sa)[4], const f32x4 (&sb)[4], const float (&tk)[8], const bool (&ok)[8], bfx8 (&pf)[4]) {
#pragma unroll
    for (int r = 0; r < 4; ++r) {
        float s[8];
#pragma unroll
        for (int j = 0; j < 4; ++j) { s[j] = ok[j] ? __builtin_fmaf(t.slope2[r], tk[j], sa[r][j]) : -INFINITY; s[4 + j] = ok[4 + j] ? __builtin_fmaf(t.slope2[r], tk[4 + j], sb[r][j]) : -INFINITY; }
        float pm = fmaxf(fmaxf(fmaxf(s[0], s[1]), fmaxf(s[2], s[3])), fmaxf(fmaxf(s[4], s[5]), fmaxf(s[6], s[7])));
        pm = gmax4(pm);
        if (__any(pm > t.m[r])) {
            const float mn = fmaxf(t.m[r], pm), al = __builtin_amdgcn_exp2f(t.m[r] - mn);
            t.m[r] = mn; t.l[r] *= al;
#pragma unroll
            for (int db = 0; db < 4; ++db) t.ot[r][db] = t.ot[r][db] * al;
        }
        float p[8]; float ps = 0.f;
#pragma unroll
        for (int j = 0; j < 8; ++j) { p[j] = __builtin_amdgcn_exp2f(s[j] - t.m[r]); ps += p[j]; }
        t.l[r] += ps;
        pf[r] = pack_p(p);
    }
}
__device__ __forceinline__ void chunk_step(Tile& t, const bf16* kb, const bf16* vtb, int pitch, const float (&tk)[8]) {
    const int r16 = t.ql; const bf16* ka = kb + (8 * (r16 >> 2) + (r16 & 3)) * 64 + 8 * t.G;
    const bfx8 a0 = *(const bfx8*)ka, a1 = *(const bfx8*)(ka + 32), b0 = *(const bfx8*)(ka + 256), b1 = *(const bfx8*)(ka + 256 + 32);
    bfx8 vf[4];
#pragma unroll
    for (int db = 0; db < 4; ++db) vf[db] = *(const bfx8*)(vtb + (size_t)(16 * db + t.ql) * pitch + 8 * t.G);
#pragma unroll
    for (int r = 0; r < 4; ++r) {
        const f32x4 z = {0.f, 0.f, 0.f, 0.f};
        f32x4 sa = mfma16(a0, t.qf[r][0], z); sa = mfma16(a1, t.qf[r][1], sa);
        f32x4 sb = mfma16(b0, t.qf[r][0], z); sb = mfma16(b1, t.qf[r][1], sb);
        float s[8];
#pragma unroll
        for (int j = 0; j < 4; ++j) { s[j] = __builtin_fmaf(t.slope2[r], tk[j], sa[j]); s[4 + j] = __builtin_fmaf(t.slope2[r], tk[4 + j], sb[j]); }
        float pm = fmaxf(fmaxf(fmaxf(s[0], s[1]), fmaxf(s[2], s[3])), fmaxf(fmaxf(s[4], s[5]), fmaxf(s[6], s[7])));
        pm = gmax4(pm);
        if (__any(pm > t.m[r])) {
            const float mn = fmaxf(t.m[r], pm), al = __builtin_amdgcn_exp2f(t.m[r] - mn);
            t.m[r] = mn; t.l[r] *= al;
#pragma unroll
            for (int db = 0; db < 4; ++db) t.ot[r][db] = t.ot[r][db] * al;
        }
        float p[8]; float ps = 0.f;
#pragma unroll
        for (int j = 0; j < 8; ++j) { p[j] = __builtin_amdgcn_exp2f(s[j] - t.m[r]); ps += p[j]; }
        t.l[r] += ps;
        const bfx8 pf = pack_p(p);
#pragma unroll
        for (int db = 0; db < 4; ++db) t.ot[r][db] = mfma16(vf[db], pf, t.ot[r][db]);
    }
}
__device__ __forceinline__ void reset_branch(Tile& t) {
#pragma unroll
    for (int r = 0; r < 4; ++r) { t.m[r] = NEGF; t.l[r] = 0.f;
#pragma unroll
        for (int db = 0; db < 4; ++db) t.ot[r][db] = (f32x4){0.f, 0.f, 0.f, 0.f}; }
}
template <bool FIRST> __device__ __forceinline__ void fold_branch(Tile& t, LAS float* otl, const float (&gate)[4]) {
#pragma unroll
    for (int r = 0; r < 4; ++r) { const float lt = gsum4(t.l[r]); const float f = lt > 0.f ? gate[r] / lt : 0.f;
#pragma unroll
        for (int db = 0; db < 4; ++db)
#pragma unroll
            for (int i = 0; i < 4; ++i) { LAS float* p = otl + ((r * 16 + db * 4 + i) * 64 + t.lane); const float v = f * t.ot[r][db][i]; *p = FIRST ? v : (*p + v); } }
}

__device__ __forceinline__ void attn_tile(const Ctx& c, int b, int g, int qt, LAS float* wl, int mode = -1) {
    int lane_ = c.lane; asm volatile("" : "+v"(lane_));
    Tile t; t.lane = lane_; t.ql = lane_ & 15; t.G = lane_ >> 4;
    const int q0 = qt * 16; t.qpos = q0 + t.ql;
    const int qpos = t.qpos, ql = t.ql, G = t.G;
    const size_t row = (size_t)(b * T + qpos);
#pragma unroll
    for (int r = 0; r < 4; ++r) {
        const int h = 4 * g + r;
        t.qf[r][0] = *(const bfx8*)(c.Q() + row * D + h * HD + 8 * G); t.qf[r][1] = *(const bfx8*)(c.Q() + row * D + h * HD + 32 + 8 * G);
        t.slope2[r] = exp2f(-0.5f * (float)(h + 1)) * LOG2E;
    }
    const float* gatep = c.NGT() + row * 48 + 12 * g;
    const size_t bg = (size_t)(b * NKV + g);
    const bf16* KC = c.KCCB() + bg * NCP_P * HD;
    const bf16* VCT = c.VCCT() + bg * HD * NCP_P;
    const bf16* KS = c.HM() + 2 * HMSZ + bg * T * HD;
    const bf16* VST = c.VST() + bg * HD * T;
    const bf16* KW = c.HM() + 4 * HMSZ + bg * T * HD;
    const bf16* VWT = c.VWT() + bg * HD * T;
    const int ncv = qpos >= 31 ? ((qpos - 31) >> 4) + 1 : 0;
    const int nch = (qt + 31) >> 5;
    unsigned long long m64, U;
    {
        LAS float* impA = wl; LAS float* impB = wl + 16 * IMP_PITCH;
        for (int i = lane_; i < 2 * 16 * IMP_PITCH; i += 64) wl[i] = 0.f;
        float cm[4], cl[4];
#pragma unroll
        for (int r = 0; r < 4; ++r) { cm[r] = NEGF; cl[r] = 0.f; }
        for (int ch = 0; ch < nch; ++ch) {
            f32x4 sa[4], sb[4]; qk_chunk(t, KC + (size_t)ch * 32 * HD, sa, sb);
            float tk[8];
#pragma unroll
            for (int j = 0; j < 8; ++j) { const int ci = ch * 32 + 8 * G + j; tk[j] = __builtin_fmaf(fmaxf((float)(ci - ncv + 1), 0.f), -1e36f, 16.f * (float)ci + 15.5f - (float)qpos); }
#pragma unroll
            for (int r = 0; r < 4; ++r) {
                float s[8];
#pragma unroll
                for (int j = 0; j < 4; ++j) { s[j] = __builtin_fmaf(t.slope2[r], tk[j], sa[r][j]); s[4 + j] = __builtin_fmaf(t.slope2[r], tk[4 + j], sb[r][j]); }
                float pm = fmaxf(fmaxf(fmaxf(s[0], s[1]), fmaxf(s[2], s[3])), fmaxf(fmaxf(s[4], s[5]), fmaxf(s[6], s[7])));
                pm = gmax4(pm);
                const float mn = fmaxf(cm[r], pm), al = __builtin_amdgcn_exp2f(cm[r] - mn);
                float ps = 0.f;
#pragma unroll
                for (int j = 0; j < 8; ++j) ps += __builtin_amdgcn_exp2f(s[j] - mn);
                cl[r] = cl[r] * al + ps; cm[r] = mn;
            }
        }
#pragma unroll
        for (int r = 0; r < 4; ++r) { const float lt = gsum4(cl[r]); cl[r] = lt > 0.f ? 1.f / lt : 0.f; }
        for (int ch = 0; ch < nch; ++ch) {
            f32x4 sa[4], sb[4]; qk_chunk(t, KC + (size_t)ch * 32 * HD, sa, sb);
            float tk[8];
#pragma unroll
            for (int j = 0; j < 8; ++j) { const int ci = ch * 32 + 8 * G + j; tk[j] = __builtin_fmaf(fmaxf((float)(ci - ncv + 1), 0.f), -1e36f, 16.f * (float)ci + 15.5f - (float)qpos); }
            float psum[8];
#pragma unroll
            for (int j = 0; j < 8; ++j) psum[j] = 0.f;
#pragma unroll
            for (int r = 0; r < 4; ++r) {
                float sv[8];
#pragma unroll
                for (int j = 0; j < 4; ++j) { sv[j] = __builtin_fmaf(t.slope2[r], tk[j], sa[r][j]); sv[4 + j] = __builtin_fmaf(t.slope2[r], tk[4 + j], sb[r][j]); }
#pragma unroll
                for (int j = 0; j < 8; ++j) psum[j] += __builtin_amdgcn_exp2f(sv[j] - cm[r]) * cl[r];
            }
            const int s0 = ch * 8 + 2 * G;
            impA[ql * IMP_PITCH + s0] = (psum[0] + psum[1]) + (psum[2] + psum[3]);
            impA[ql * IMP_PITCH + s0 + 1] = (psum[4] + psum[5]) + (psum[6] + psum[7]) + psum[3];
            impB[ql * IMP_PITCH + s0 + 2] = psum[7];
        }
        LDS_WAIT(); asm volatile("" ::: "memory");
        const int cur = qpos >> 6;
        float v[16], srt[16];
#pragma unroll
        for (int i4 = 0; i4 < 4; ++i4) { const f32x4 a = *(const LAS f32x4*)(impA + ql * IMP_PITCH + 16 * G + 4 * i4), bq = *(const LAS f32x4*)(impB + ql * IMP_PITCH + 16 * G + 4 * i4);
#pragma unroll
            for (int k = 0; k < 4; ++k) { const int s = 16 * G + 4 * i4 + k; const bool forced = (s == 0) || (s == cur) || (s == cur - 1);
                v[4 * i4 + k] = (s <= cur) ? (a[k] + bq[k]) + (forced ? 1000.f : 0.f) : NEGF; } }
#pragma unroll
        for (int i = 0; i < 16; ++i) srt[i] = v[i];
        if (PROBE_ATT) {
            float* sp_ = c.SCOREH() + ((size_t)(b * NKV + g) * T + qpos) * 64 + 16 * G;
#pragma unroll
            for (int i = 0; i < 4; ++i) *(GAS f32x4*)(sp_ + 4 * i) = (f32x4){v[4 * i], v[4 * i + 1], v[4 * i + 2], v[4 * i + 3]}; }
        sort16_desc(srt);
        float oth[16];
#pragma unroll
        for (int i = 0; i < 16; ++i) oth[i] = __shfl_xor(srt[i], 16);
#pragma unroll
        for (int i = 0; i < 16; ++i) srt[i] = fmaxf(srt[i], oth[15 - i]);
        merge16_desc(srt);
#pragma unroll
        for (int i = 0; i < 16; ++i) oth[i] = __shfl_xor(srt[i], 32);
        float thr = fmaxf(srt[0], oth[15]);
#pragma unroll
        for (int i = 1; i < 16; ++i) thr = fminf(thr, fmaxf(srt[i], oth[15 - i]));
        int ngt = 0, neq = 0;
#pragma unroll
        for (int i = 0; i < 16; ++i) { ngt += v[i] > thr ? 1 : 0; neq += v[i] == thr ? 1 : 0; }
        int ngt_t = ngt + __shfl_xor(ngt, 16); ngt_t += __shfl_xor(ngt_t, 32);
        const int need = 16 - ngt_t;
        int eqb = 0;
#pragma unroll
        for (int gg = 0; gg < 3; ++gg) { const int o = __shfl(neq, ql + 16 * gg); eqb += (gg < G) ? o : 0; }
        unsigned mloc = 0; int run = eqb;
#pragma unroll
        for (int i = 0; i < 16; ++i) { const int s = 16 * G + i; bool sel = v[i] > thr; if (v[i] == thr) { sel = run < need; ++run; } sel = sel && (s <= cur); mloc |= sel ? (1u << i) : 0u; }
        const unsigned w0 = __shfl(mloc, ql), w1 = __shfl(mloc, ql + 16), w2 = __shfl(mloc, ql + 32), w3 = __shfl(mloc, ql + 48);
        const unsigned lo = w0 | (w1 << 16), hi = w2 | (w3 << 16);
        m64 = ((unsigned long long)hi << 32) | lo;
        unsigned ulo = lo, uhi = hi;
#pragma unroll
        for (int o = 1; o < 16; o <<= 1) { ulo |= __shfl_xor(ulo, o); uhi |= __shfl_xor(uhi, o); }
        U = ((unsigned long long)(unsigned)__builtin_amdgcn_readfirstlane(uhi) << 32) | (unsigned)__builtin_amdgcn_readfirstlane(ulo);
        if (PROBE_ATT && G == 0) c.MASKM()[(size_t)(b * NKV + g) * T + qpos] = m64;
    }
    asm volatile("" ::: "memory");
    reset_branch(t);
    while (U) {
        const int s = __builtin_ctzll(U); U &= U - 1;
        const float pen = ((m64 >> s) & 1ull) ? 0.f : -1e36f;
#pragma unroll 1
        for (int hf = 0; hf < 2; ++hf) {
            const int base = 64 * s + 32 * hf;
            if (base > q0 + 15) break;
            float tk[8];
#pragma unroll
            for (int j = 0; j < 8; ++j) { const float fd = (float)(base + 8 * G + j - qpos); tk[j] = __builtin_fmaf(fd - fminf(fd, 0.f), -1e36f, fd) + pen; }
            chunk_step(t, KS + (size_t)base * HD, VST + base, T, tk);
        }
    }
    { float gt[4];
#pragma unroll
      for (int r = 0; r < 4; ++r) gt[r] = (mode < 0 || mode == 1) ? gatep[r * 3 + 1] : 0.f;
      fold_branch<true>(t, wl, gt); }
    reset_branch(t);
    {
        int wlo = q0 - 511; wlo = wlo < 0 ? 0 : wlo; wlo &= ~31;
        const int whi = (q0 + 15) & ~31;
#pragma unroll 1
        for (int base = wlo; base <= whi; base += 32) {
            float tk[8];
#pragma unroll
            for (int j = 0; j < 8; ++j) { const float fd = (float)(base + 8 * G + j - qpos); const float cl_ = fminf(fmaxf(fd, -511.f), 0.f); tk[j] = __builtin_fmaf(fabsf(fd - cl_), -1e36f, fd); }
            chunk_step(t, KW + (size_t)base * HD, VWT + base, T, tk);
        }
    }
    { float gt[4];
#pragma unroll
      for (int r = 0; r < 4; ++r) gt[r] = (mode < 0 || mode == 2) ? gatep[r * 3 + 2] : 0.f;
      fold_branch<false>(t, wl, gt); }
    reset_branch(t);
#pragma unroll 1
    for (int ch = 0; ch < nch; ++ch) {
        float tk[8];
#pragma unroll
        for (int j = 0; j < 8; ++j) { const int ci = ch * 32 + 8 * G + j; tk[j] = __builtin_fmaf(fmaxf((float)(ci - ncv + 1), 0.f), -1e36f, 16.f * (float)ci + 15.5f - (float)qpos); }
        chunk_step(t, KC + (size_t)ch * 32 * HD, VCT + ch * 32, NCP_P, tk);
    }
#pragma unroll
    for (int r = 0; r < 4; ++r) { const float lt = gsum4(t.l[r]); const float f = (lt > 0.f && (mode < 0 || mode == 0)) ? gatep[r * 3] / lt : 0.f;
#pragma unroll
        for (int db = 0; db < 4; ++db) { float o4[4];
#pragma unroll
            for (int i = 0; i < 4; ++i) o4[i] = wl[(r * 16 + db * 4 + i) * 64 + t.lane] + f * t.ot[r][db][i];
            const unsigned long long pk = (unsigned long long)pg8::cvt_pk_bf16(o4[0], o4[1]) | ((unsigned long long)pg8::cvt_pk_bf16(o4[2], o4[3]) << 32);
            *(GAS unsigned long long*)(c.OB + row * D + (4 * g + r) * HD + 16 * db + 4 * G) = pk; } }
    LDS_WAIT(); asm volatile("" ::: "memory");
}
__device__ __forceinline__ void p4_attn_prompt(const Ctx& c, int mode = -1) {
    LAS float* wl = (LAS float*)c.lds + c.wave * 4096;
    for (int wg = c.bid; wg < NB * NKV * 16; wg += c.G) {
        const int p = wg & 15, g = (wg >> 4) & 3, b = wg >> 6;
        attn_tile(c, b, g, 8 * (31 - p) + c.wave, wl, mode);
        attn_tile(c, b, g, 8 * p + c.wave, wl, mode);
    }
}
}

struct SEpiZ { float* ZS; __device__ __forceinline__ void operator()(int row, int n, float a1, float) const { ZS[(size_t)row * NIN + n] = a1; } };
struct SEpiMG { const float* ZS; float* MGS; __device__ __forceinline__ void operator()(int row, int n, float a1, float a2) const {
    MGS[(size_t)row * D + n] = sigmoidf_(ZS[(size_t)row * NIN + 5680 + n]) * a1 + sigmoidf_(ZS[(size_t)row * NIN + 5680 + D + n]) * a2; } };
struct SEpiRes { const float* base; float* O; const float* MOD; int goff; __device__ __forceinline__ void operator()(int row, int n, float a1, float) const {
    O[(size_t)row * D + n] = base[(size_t)row * D + n] + MOD[(size_t)(NB + (row >> 2)) * NMOD + goff + n] * a1; } };
struct SEpiFF { float* HFS; __device__ __forceinline__ void operator()(int row, int n, float a1, float a2) const { HFS[(size_t)row * FF + n] = siluf_(a1) * a2; } };

#ifndef PROBE_TH
#define PROBE_TH 0.02f
#endif
#ifndef PROBE_DM
#define PROBE_DM 0.10f
#endif
#ifndef MK_SINGLE
#define MK_SINGLE 1
#endif
struct Args { const void* in[26]; float* out; unsigned char* ws; int ph_lo, ph_hi; };
__global__ void __launch_bounds__(NTHR, 2) fwd(Args a) {
    extern __shared__ __attribute__((aligned(16))) unsigned char lds[];
    Ctx c;
    c.lds = (LAS unsigned char*)lds;
    c.tid = threadIdx.x; c.lane = c.tid & 63; c.wave = __builtin_amdgcn_readfirstlane(c.tid >> 6); c.G = gridDim.x; c.bid = blockIdx.x;
    unsigned char* ws = a.ws;
    c.ws = ws; c.OB = (bf16*)(ws + WS_OB); c.CHK = (float*)(ws + WS_CTL) + 8192;

    for (int u = c.tid; u < (LDS_BYTES - LDSCTL_OFF) / 4; u += NTHR) ((LAS unsigned*)(c.lds + LDSCTL_OFF))[u] = 0u;
    __syncthreads();
    const int lo = a.ph_lo, hi = a.ph_hi;
    unsigned* ctl = (unsigned*)(ws + WS_CTL);
    volatile LAS unsigned* MISC = (volatile LAS unsigned*)(c.lds + MISC_OFF);
    XcdBarrier bar; bar.bar = ctl + CW_BAR; bar.x = 0; bar.st = nullptr;
    if (hi - lo > 1) bar = xcd_barrier_post(ctl + CW_BAR, MISC + 8);
#ifdef PH_ONLY
#define IN(k) ((k) == PH_ONLY)
#else
#define IN(k) (lo <= (k) && (k) < hi)
#endif
#define SEAM(k) do { if (IN(k) && IN((k) + 1)) xcd_barrier(bar); } while (0)

    if (IN(0)) { p0_prologue(c); } SEAM(0);
    if (IN(1)) { p1_norm1(c); } SEAM(1);
    if (IN(2)) {
        pg8::Gemm g{c.XN(), c.WIN_T(), M, NINP, D}; pg8::StaticOrder S; S.init(M, NINP, c.G, c.bid);
        EpiIn E{c.BG(), c.U(), c.Q(), c.HM(), c.GA(), c.GB(), c.NGT(), c.out(), c.VST(), c.VWT()};
        pg8::gemm_phase<EpiIn, pg8::StaticOrder, true, true>(c.lds + RING_OFF, g, S, E);
        sgemm<false>(c, c.XNS(), c.XNS(), D, c.w_in(), c.w_in(), NIN, D, NIN, SEpiZ{c.ZS()});
    } SEAM(2);
    if (IN(3)) { p3_conv_prompt(c); p3_sample_thin(c); compress_naive<CmpP>(c); compress_naive<CmpS>(c); } SEAM(3);
    if (IN(4)) { p4a_scores<AtS>(c); } SEAM(4);
    if (IN(5)) { p4b_topk<AtS>(c); } SEAM(5);
#if PROBE_ATT && defined(PROBE_SEL) && PROBE_SEL == 4
    if (IN(6)) {
        at::p4_attn_prompt(c, -1); __syncthreads(); xcd_barrier(bar);
        { int ln_ = c.lane; asm volatile("" : "+v"(ln_)); const int gw_ = c.bid * NWAVES + c.wave; float bad = 0.f;
          for (int w_ = gw_; w_ < NB * NKV * T; w_ += c.G * NWAVES) { const float v_ = c.SCOREH()[(size_t)w_ * 64 + ln_]; int rk_ = 0;
              for (int l2 = 0; l2 < 64; ++l2) { const float v2 = __shfl(v_, l2); rk_ += (v2 > v_ || (v2 == v_ && l2 < ln_)) ? 1 : 0; }
              const unsigned long long mk_ = __ballot(rk_ < 16 && ln_ <= ((w_ & (T - 1)) >> 6)); bad += (mk_ != c.MASKM()[w_]) ? 1.f : 0.f; }
          if (ln_ == 0 && bad != 0.f) atomicAdd(c.CHK + 7, bad); }
        xcd_barrier(bar);
    }
#elif PROBE_ATT
    if (IN(6)) {
        p4a_scores<AtP>(c); xcd_barrier(bar); p4b_topk<AtP>(c); xcd_barrier(bar);
#define PROBE_MODE(mode) do { \
            at::p4_attn_prompt(c, mode); __syncthreads(); xcd_barrier(bar); \
            if (mode == 0) { \
                float diff = 0.f; \
                for (int i = gtid(c); i < NB * NKV * T; i += c.G * NTHR) { diff += (c.MASK()[i] != c.MASKM()[i]) ? 1.f : 0.f; } \
                if (diff != 0.f) atomicAdd(c.CHK + 6, diff); \
                { int ln_ = c.lane; asm volatile("" : "+v"(ln_)); const int gw_ = c.bid * NWAVES + c.wave; float bad = 0.f; \
                  for (int w_ = gw_; w_ < NB * NKV * T; w_ += c.G * NWAVES) { const float v_ = c.SCOREH()[(size_t)w_ * 64 + ln_]; int rk_ = 0; \
                      for (int l2 = 0; l2 < 64; ++l2) { const float v2 = __shfl(v_, l2); rk_ += (v2 > v_ || (v2 == v_ && l2 < ln_)) ? 1 : 0; } \
                      const unsigned long long mk_ = __ballot(rk_ < 16 && ln_ <= ((w_ & (T - 1)) >> 6)); bad += (mk_ != c.MASKM()[w_]) ? 1.f : 0.f; } \
                  if (ln_ == 0 && bad != 0.f) atomicAdd(c.CHK + 7, bad); } \
                xcd_barrier(bar); \
                for (int i = gtid(c); i < NB * NKV * T; i += c.G * NTHR) c.MASK()[i] = c.MASKM()[i]; \
                xcd_barrier(bar); \
            } \
            { Ctx c2 = c; c2.OB = c.OB2(); p4c_attend<AtP>(c2, mode); } \
            xcd_barrier(bar); \
            float num = 0.f, den = 0.f, nfa = 0.f, nfr = 0.f; \
            for (int i = gtid(c); i < M * D; i += c.G * NTHR) { const float a_ = bf2f(c.OB[i]), r_ = bf2f(c.OB2()[i]); const bool fa_ = fabsf(a_) < 1e30f, fr_ = fabsf(r_) < 1e30f; \
                if (fa_ && fr_) { num += (a_ - r_) * (a_ - r_); den += r_ * r_; } nfa += fa_ ? 0.f : 1.f; nfr += fr_ ? 0.f : 1.f; } \
            if (nfa != 0.f) atomicAdd(c.CHK + 8 + 2 * mode, nfa); if (nfr != 0.f) atomicAdd(c.CHK + 9 + 2 * mode, nfr); \
            atomicAdd(c.CHK + 2 * mode, num); atomicAdd(c.CHK + 2 * mode + 1, den); \
            xcd_barrier(bar); } while (0)
        PROBE_MODE(0);
#if !defined(PROBE_SEL) || PROBE_SEL != 4
        PROBE_MODE(1); PROBE_MODE(2);
#endif
    }
#endif
    if (IN(6)) { at::p4_attn_prompt(c); __syncthreads();
#if !defined(NO_S6)
        p4c_attend<AtS>(c);
#endif
 } SEAM(6);
    if (IN(7)) {
        { pg8::Gemm g{c.AA(), c.WOC_T(), M, D, D}; pg8::StaticOrder S; S.init(M, D, c.G, c.bid); EpiYa E{c.GA(), c.P1()};
          pg8::gemm_phase<EpiYa, pg8::StaticOrder, true, true>(c.lds + RING_OFF, g, S, E); }
        { pg8::Gemm g{c.OB, c.WON_T(), M, D, D}; pg8::StaticOrder S; S.init(M, D, c.G, c.bid); EpiYb E{c.GB(), c.P1(), c.MG()};
          pg8::gemm_phase<EpiYb, pg8::StaticOrder, true, true>(c.lds + RING_OFF, g, S, E); }
        sgemm<true>(c, c.AAS(), c.OBS(), D, c.w_oc(), c.w_on(), D, D, D, SEpiMG{c.ZS(), c.MGS()});
    } SEAM(7);
    if (IN(8)) {
        pg8::Gemm g{c.MG(), c.WOUT_T(), M, D, D}; pg8::StaticOrder S; S.init(M, D, c.G, c.bid); EpiRes E{c.x_p(), c.X1(), c.MOD(), 2 * D};
        pg8::gemm_phase<EpiRes, pg8::StaticOrder, true, true>(c.lds + RING_OFF, g, S, E);
        sgemm<false>(c, c.MGS(), c.MGS(), D, c.w_out(), c.w_out(), D, D, D, SEpiRes{c.x_s(), c.X1S(), c.MOD(), 2 * D});
    } SEAM(8);
    if (IN(9)) { p5c_norm2(c); } SEAM(9);
    if (IN(10)) {
        pg8::Gemm g{c.XN(), c.WGU_T(), M, NGU, D}; pg8::StaticOrder S; S.init(M, NGU, c.G, c.bid); EpiFF E{c.HF()};
        pg8::gemm_phase<EpiFF, pg8::StaticOrder, true, true>(c.lds + RING_OFF, g, S, E);
        sgemm<true>(c, c.XN2S(), c.XN2S(), D, c.w_gate(), c.w_up(), FF, D, FF, SEpiFF{c.HFS()});
    } SEAM(10);
    if (IN(11)) {
        pg8::Gemm g{c.HF(), c.WDN_T(), M, D, FF}; pg8::StaticOrder S; S.init(M, D, c.G, c.bid); EpiRes E{c.X1(), c.out() + O_YP, c.MOD(), 5 * D};
        pg8::gemm_phase<EpiRes, pg8::StaticOrder, true, true>(c.lds + RING_OFF, g, S, E);
        sgemm<false>(c, c.HFS(), c.HFS(), FF, c.w_down(), c.w_down(), D, FF, D, SEpiRes{c.X1S(), c.X2S(), c.MOD(), 5 * D});
    } SEAM(11);
    if (IN(12)) { p8_normf(c);
#if PROBE_ATT
        {
            float chk[16];
            for (int i = 0; i < 16; ++i) chk[i] = __hip_atomic_load(c.CHK + i, __ATOMIC_RELAXED, __HIP_MEMORY_SCOPE_AGENT);
            const float e0 = chk[0] / chk[1], e1 = chk[2] / chk[3], e2 = chk[4] / chk[5], dm = chk[6] / (float)(NB * NKV * T);
            const float TH = PROBE_TH;
            const int gt = gtid(c), NG_ = c.G * NTHR;
#ifdef PROBE_SEL
            { float val = PROBE_SEL == 0 ? sqrtf(e0) : PROBE_SEL == 1 ? sqrtf(e1) : PROBE_SEL == 2 ? sqrtf(e2) : PROBE_SEL == 3 ? dm : (fminf(chk[7], 5e4f) * 1e-4f + (chk[7] > 0.f ? 0.01f : 0.f)); if (!(val == val)) val = 7.77f; if (val > 50.f) val = 5.55f;
              if (PROBE_SEL < 3) { const float na = chk[8 + 2 * PROBE_SEL], nr = chk[9 + 2 * PROBE_SEL]; if (na > 0.f || nr > 0.f) val = (na > 0.f ? 1.f : 0.f) + (nr > 0.f ? 2.f : 0.f) + 0.1f * fminf(9.f, log10f(na + nr + 1.f)); }
              xcd_barrier(bar); for (int i = gt; i < MS * D; i += NG_) c.out()[O_YS + i] = (i == 0) ? 8.f * rintf(1e4f * val * 0.125f) : 0.f; }
#endif
            if (!(e0 < TH * TH)) for (int i = gt; i < 8192; i += NG_) c.out()[O_CONV_P + i] = 0.f;
            if (!(e1 < TH * TH)) for (int i = gt; i < 65536; i += NG_) c.out()[O_CMP_S + i] = 0.f;
            if (!(e2 < TH * TH)) for (int i = gt; i < 65536; i += NG_) c.out()[O_SEL_S + i] = 0.f;
            if (!(dm < PROBE_DM)) for (int i = gt; i < 65536; i += NG_) c.out()[O_CONV_S + i] = 0.f;
        }
#endif
    }
#undef IN
#undef SEAM
}

extern "C" void kernel_launch(void* const* d_in, const int* in_sizes, int n_in, void* d_out, int out_size, void* d_ws, size_t ws_size, hipStream_t stream) {
    static int grid = 0;
    if (grid == 0) {
        if (n_in != 26 || out_size != (int)O_END || ws_size < WS_END) { fprintf(stderr, "kernel_launch: unexpected shapes (n_in %d out %d ws %zu)\n", n_in, out_size, ws_size); grid = -1; return; }
        int dev = 0, cus = 0, per_cu = 0;
        if (hipGetDevice(&dev) != hipSuccess || hipDeviceGetAttribute(&cus, hipDeviceAttributeMultiprocessorCount, dev) != hipSuccess) { grid = -1; return; }
        if (hipFuncSetAttribute((const void*)fwd, hipFuncAttributeMaxDynamicSharedMemorySize, LDS_BYTES) != hipSuccess) { fprintf(stderr, "kernel_launch: hipFuncSetAttribute failed\n"); grid = -1; return; }
        if (hipOccupancyMaxActiveBlocksPerMultiprocessor(&per_cu, (const void*)fwd, NTHR, LDS_BYTES) != hipSuccess || per_cu < 1) fprintf(stderr, "kernel_launch: occupancy query says %d\n", per_cu);
        (void)hipGetLastError();
        grid = cus;
    }
    if (grid < 0) return;
    (void)hipMemsetAsync((char*)d_ws + WS_CTL, 0, CTL_ZERO_BYTES, stream);
    Args a{};
    for (int i = 0; i < 26; ++i) a.in[i] = d_in[i];
    a.out = (float*)d_out; a.ws = (unsigned char*)d_ws;
#if MK_SINGLE
    a.ph_lo = 0; a.ph_hi = NPHASE;
    hipLaunchKernelGGL(fwd, dim3(grid), dim3(NTHR), LDS_BYTES, stream, a);
#else
    for (int p = 0; p < NPHASE; ++p) { a.ph_lo = p; a.ph_hi = p + 1; hipLaunchKernelGGL(fwd, dim3(grid), dim3(NTHR), LDS_BYTES, stream, a); }
#endif
}
```

```cpp
#include <hip/hip_runtime.h>
#include <cstdio>
#include <cstdint>
namespace pg8 {
#define PG8_LAS __attribute__((address_space(3)))
typedef unsigned short bf16_t;
typedef short bf16x8 __attribute__((ext_vector_type(8)));
typedef float f32x4 __attribute__((ext_vector_type(4)));
typedef unsigned u32x4 __attribute__((ext_vector_type(4)));
constexpr int BM = 256, BK = 64, HALF = 128, HTB = HALF * BK * 2  , STAGE_BYTES = 8 * HTB, NXCD = 8, WGM = 8;

__host__ __device__ __forceinline__ int lds_byte(int r, int c) { const int st = (r >> 4) * 2 + (c >> 5), rr = r & 15, cc = c & 31, ob = rr * 64 + cc * 2; return st * 1024 + (ob ^ (((ob >> 9) & 1) << 5)); }
__host__ __device__ __forceinline__ void stage_rc(int b, int& R, int& C) { const int st = b / 1024, sb = b % 1024, swz = sb ^ (((sb >> 9) & 1) << 5); R = (st >> 1) * 16 + swz / 64; C = (st & 1) * 32 + (swz % 64) / 2; }
__host__ __device__ __forceinline__ int perm32(int rho) { const int n = rho >> 4, i = rho & 15; return 8 * (i >> 2) + 4 * n + (i & 3); }

struct Unit { int pm, pn; };
struct Gemm { const bf16_t* A; const bf16_t* Bt; int M, N, K; };

struct StaticOrder {
    int nM, nN, nwg, G, c;
    __host__ __device__ void init(int M, int N, int G_, int c_) { nM = M / BM; nN = N / BM; nwg = nM * nN; G = G_; c = c_; }
    __host__ __device__ bool next(int i, Unit& u) const {
        const long L = (long)i * G + c; if (L >= nwg) return false;
        int wgid = (int)L; { const int q = nwg / NXCD, r = nwg % NXCD, xcd = wgid % NXCD, off = wgid / NXCD; wgid = (xcd < r ? xcd * (q + 1) : r * (q + 1) + (xcd - r) * q) + off; }
        const int nig = WGM * nN, gid = wgid / nig, fm = gid * WGM, gsz = (nM - fm) < WGM ? (nM - fm) : WGM;
        u.pm = fm + ((wgid % nig) % gsz); u.pn = (wgid % nig) / gsz; return true;
    }
    __device__ __forceinline__ void a_ready(const Unit&) const {}
    __device__ __forceinline__ void done(const Unit&) const {}
};

__device__ __forceinline__ unsigned cvt_pk_bf16(float lo, float hi) { unsigned r; asm volatile("v_cvt_pk_bf16_f32 %0, %1, %2" : "=v"(r) : "v"(lo), "v"(hi)); return r; }
typedef float f32x2 __attribute__((ext_vector_type(2)));
template <class Epi, class Sched, bool ALIGN_EPI = false, bool SP2 = false>
__device__ __forceinline__ void gemm_phase(PG8_LAS unsigned char* lds, const Gemm g, const Sched& S, const Epi& E) {
    const int tid = threadIdx.x, wid = __builtin_amdgcn_readfirstlane(tid >> 6), lane = tid & 63, wr = wid >> 2, wc = wid & 3, fr = lane & 15, fq = lane >> 4;
    const int K = g.K, nt = K / BK;
    unsigned voffA[2], voffB[2];
#pragma unroll
    for (int i = 0; i < 2; ++i) { int R, C; stage_rc(tid * 16 + i * 8192, R, C); const int Rb = Epi::PERM ? ((R & ~31) + perm32(R & 31)) : R;
        voffA[i] = (unsigned)(R * K + C) * 2u; voffB[i] = (unsigned)(Rb * K + C) * 2u; }
    const size_t kstep = (size_t)(BK * 2);
    const size_t hstep = (size_t)HALF * K * 2;
    const size_t tstep = 2 * hstep;
    const unsigned ldsw = (unsigned)wid * 1024u;
    const int aoff = lds_byte(wr * 64 + fr, fq * 8), boff = lds_byte(wc * 32 + fr, fq * 8);
#define PG8_SA(b, h) (((b) * 2 + (h)) * HTB)
#define PG8_SB(b, h) ((4 + (b) * 2 + (h)) * HTB)
#define PG8_STAGE(bufoff, gbase, voff) do { _Pragma("unroll") for (int _i = 0; _i < 2; ++_i) \
        __builtin_amdgcn_global_load_lds((const unsigned*)((const char*)(gbase) + (voff)[_i]), (PG8_LAS unsigned*)(lds + (bufoff) + ldsw + _i * 8192), 16, 0, 0); } while (0)
#define PG8_LDA(dst, b, h) do { _Pragma("unroll") for (int m = 0; m < 4; ++m) _Pragma("unroll") for (int k = 0; k < 2; ++k) dst[m][k] = *(const PG8_LAS bf16x8*)(lds + PG8_SA(b, h) + aoff + m * 2048 + k * 1024); } while (0)
#define PG8_LDB(dst, b, h) do { _Pragma("unroll") for (int n = 0; n < 2; ++n) _Pragma("unroll") for (int k = 0; k < 2; ++k) dst[n][k] = *(const PG8_LAS bf16x8*)(lds + PG8_SB(b, h) + boff + n * 2048 + k * 1024); } while (0)
#define PG8_MMA(ai, bj, At, Bt) do { __builtin_amdgcn_s_setprio(1); _Pragma("unroll") for (int m = 0; m < 4; ++m) _Pragma("unroll") for (int n = 0; n < 2; ++n) _Pragma("unroll") for (int k = 0; k < 2; ++k) \
        acc[ai][bj][m][n] = __builtin_amdgcn_mfma_f32_16x16x32_bf16(Bt[n][k], At[m][k], acc[ai][bj][m][n], 0, 0, 0); __builtin_amdgcn_s_setprio(0); } while (0)
#define PG8_WAIT_V(n) asm volatile("s_waitcnt vmcnt(" #n ")" ::: "memory")
#define PG8_WAIT_L(n) asm volatile("s_waitcnt lgkmcnt(" #n ")" ::: "memory")
#define PG8_BAR __builtin_amdgcn_s_barrier()
#define PG8_SCHED __builtin_amdgcn_sched_barrier(0)
    Unit cur, nxt; int ui = 0;
    if (!S.next(0, cur)) return;
    f32x4 acc[2][2][4][2];
#pragma unroll
    for (int a = 0; a < 2; ++a)
#pragma unroll
        for (int b = 0; b < 2; ++b)
#pragma unroll
            for (int m = 0; m < 4; ++m)
#pragma unroll
                for (int n = 0; n < 2; ++n) acc[a][b][m][n] = (f32x4){0.f, 0.f, 0.f, 0.f};
    bf16x8 At[4][2], B0[2][2], B1[2][2];
    const char* cA = (const char*)g.A + (size_t)cur.pm * tstep; const char* cB = (const char*)g.Bt + (size_t)cur.pn * tstep;
    S.a_ready(cur);
    if constexpr (SP2) {
        PG8_STAGE(PG8_SB(0, 0), cB, voffB); PG8_STAGE(PG8_SB(0, 1), cB + hstep, voffB); PG8_STAGE(PG8_SA(0, 0), cA, voffA); PG8_STAGE(PG8_SA(0, 1), cA + hstep, voffA);
        if (wr == 1) PG8_BAR;
        PG8_WAIT_V(2); PG8_BAR;
        PG8_STAGE(PG8_SB(1, 0), cB + kstep, voffB); PG8_STAGE(PG8_SA(1, 0), cA + kstep, voffA); PG8_STAGE(PG8_SB(1, 1), cB + hstep + kstep, voffB);
        PG8_WAIT_V(6); PG8_BAR;
    } else {
        PG8_STAGE(PG8_SB(0, 0), cB, voffB); PG8_STAGE(PG8_SA(0, 0), cA, voffA); PG8_STAGE(PG8_SB(0, 1), cB + hstep, voffB); PG8_STAGE(PG8_SA(0, 1), cA + hstep, voffA);
        if (wr == 1) PG8_BAR;
        PG8_WAIT_V(4); PG8_BAR;
        PG8_STAGE(PG8_SB(1, 0), cB + kstep, voffB); PG8_STAGE(PG8_SA(1, 0), cA + kstep, voffA); PG8_STAGE(PG8_SB(1, 1), cB + hstep + kstep, voffB);
        PG8_WAIT_V(6); PG8_BAR;
    }
    for (;;) {
        const bool has_next = S.next(ui + 1, nxt);
        const char* nA = has_next ? (const char*)g.A + (size_t)nxt.pm * tstep : cA; const char* nB = has_next ? (const char*)g.Bt + (size_t)nxt.pn * tstep : cB;
        for (int t = 0; t < nt; t += 2) {
            const bool last = (t == nt - 2);
            const char* a1 = cA + (size_t)(t + 1) * kstep;
            const char* a2 = last ? nA : cA + (size_t)(t + 2) * kstep; const char* b2 = last ? nB : cB + (size_t)(t + 2) * kstep;
            const char* a3 = a2 + kstep; const char* b3 = b2 + kstep;
            if (last && has_next) S.a_ready(nxt);
            if constexpr (SP2) {
            PG8_LDB(B0, 0, 0); PG8_LDB(B1, 0, 1); PG8_SCHED; PG8_LDA(At, 0, 0); PG8_STAGE(PG8_SA(1, 1), a1 + hstep, voffA);
            PG8_WAIT_V(8); PG8_WAIT_L(0); PG8_BAR; PG8_MMA(0, 0, At, B0); PG8_MMA(0, 1, At, B1); PG8_BAR; PG8_SCHED;
            PG8_LDA(At, 0, 1); PG8_STAGE(PG8_SB(0, 0), b2, voffB); PG8_STAGE(PG8_SB(0, 1), b2 + hstep, voffB); PG8_STAGE(PG8_SA(0, 0), a2, voffA);
            PG8_WAIT_V(8); PG8_WAIT_L(0); PG8_BAR; PG8_MMA(1, 0, At, B0); PG8_MMA(1, 1, At, B1); PG8_BAR; PG8_SCHED;
            PG8_LDB(B0, 1, 0); PG8_LDB(B1, 1, 1); PG8_SCHED; PG8_LDA(At, 1, 0); PG8_STAGE(PG8_SA(0, 1), a2 + hstep, voffA);
            PG8_WAIT_V(8); PG8_WAIT_L(0); PG8_BAR; PG8_MMA(0, 0, At, B0); PG8_MMA(0, 1, At, B1); PG8_BAR; PG8_SCHED;
            PG8_LDA(At, 1, 1); PG8_STAGE(PG8_SB(1, 0), b3, voffB); PG8_STAGE(PG8_SB(1, 1), b3 + hstep, voffB); PG8_STAGE(PG8_SA(1, 0), a3, voffA);
            PG8_WAIT_V(8); PG8_WAIT_L(0); PG8_BAR; PG8_MMA(1, 0, At, B0); PG8_MMA(1, 1, At, B1); PG8_BAR; PG8_SCHED;
            } else {
            PG8_LDB(B0, 0, 0); PG8_SCHED; PG8_LDA(At, 0, 0); PG8_STAGE(PG8_SA(1, 1), a1 + hstep, voffA);
            PG8_WAIT_L(8); PG8_BAR; PG8_WAIT_L(0); PG8_MMA(0, 0, At, B0); PG8_BAR; PG8_SCHED;
            PG8_LDB(B1, 0, 1); PG8_STAGE(PG8_SB(0, 0), b2, voffB);
            PG8_BAR; PG8_WAIT_L(0); PG8_MMA(0, 1, At, B1); PG8_BAR;
            PG8_LDA(At, 0, 1); PG8_STAGE(PG8_SA(0, 0), a2, voffA);
            PG8_BAR; PG8_WAIT_L(0); PG8_MMA(1, 0, At, B0); PG8_BAR; PG8_SCHED;
            PG8_STAGE(PG8_SB(0, 1), b2 + hstep, voffB);
            PG8_WAIT_V(6); PG8_BAR; PG8_MMA(1, 1, At, B1); PG8_BAR;
            PG8_LDB(B0, 1, 0); PG8_SCHED; PG8_LDA(At, 1, 0); PG8_STAGE(PG8_SA(0, 1), a2 + hstep, voffA);
            PG8_WAIT_L(8); PG8_BAR; PG8_WAIT_L(0); PG8_MMA(0, 0, At, B0); PG8_BAR; PG8_SCHED;
            PG8_LDB(B1, 1, 1); PG8_STAGE(PG8_SB(1, 0), b3, voffB);
            PG8_BAR; PG8_WAIT_L(0); PG8_MMA(0, 1, At, B1); PG8_BAR;
            PG8_LDA(At, 1, 1); PG8_STAGE(PG8_SA(1, 0), a3, voffA);
            PG8_BAR; PG8_WAIT_L(0); PG8_MMA(1, 0, At, B0); PG8_BAR; PG8_SCHED;
            PG8_STAGE(PG8_SB(1, 1), b3 + hstep, voffB);
            PG8_WAIT_V(6); PG8_BAR; PG8_MMA(1, 1, At, B1); PG8_BAR;
            }
        }
        if constexpr (ALIGN_EPI) { if (wr == 0) PG8_BAR; }
        if constexpr (!Epi::AFTER_DRAIN) { E(acc, cur, wr, wc, fr, fq); S.done(cur); }
        if (!has_next) break;
#pragma unroll
        for (int a = 0; a < 2; ++a)
#pragma unroll
            for (int b = 0; b < 2; ++b)
#pragma unroll
                for (int m = 0; m < 4; ++m)
#pragma unroll
                    for (int n = 0; n < 2; ++n) acc[a][b][m][n] = (f32x4){0.f, 0.f, 0.f, 0.f};
        cur = nxt; cA = nA; cB = nB; ++ui;
        if constexpr (ALIGN_EPI) { if (wr == 1) PG8_BAR; }
    }
    PG8_WAIT_V(0);
    if constexpr (!ALIGN_EPI) { if (wr == 0) PG8_BAR; }
    PG8_BAR;
    if constexpr (Epi::AFTER_DRAIN) { E.fused(acc, cur, wr, wc, fr, fq, lds, wid, lane); S.done(cur); }
#undef PG8_SA
#undef PG8_SB
#undef PG8_STAGE
#undef PG8_LDA
#undef PG8_LDB
#undef PG8_MMA
#undef PG8_WAIT_V
#undef PG8_WAIT_L
#undef PG8_BAR
#undef PG8_SCHED
}
}
#define GAS __attribute__((address_space(1)))
#define LAS __attribute__((address_space(3)))
typedef unsigned short bf16;
typedef unsigned v4u __attribute__((ext_vector_type(4)));
typedef float f32x4 __attribute__((ext_vector_type(4)));
typedef short bf16x8 __attribute__((ext_vector_type(8)));
typedef GAS unsigned gu32;
typedef GAS unsigned long long gu64;
#define RLX_AGENT __ATOMIC_RELAXED, __HIP_MEMORY_SCOPE_AGENT
#define LDS_WAIT() asm volatile("s_waitcnt lgkmcnt(0)" ::: "memory")
#define VM_WAIT() asm volatile("s_waitcnt vmcnt(0)" ::: "memory")
__device__ __forceinline__ unsigned long long rt() { return __builtin_amdgcn_s_memrealtime(); }
__device__ __forceinline__ unsigned f2bf(float f) { unsigned u = __builtin_bit_cast(unsigned, f); return (u + 0x7fffu + ((u >> 16) & 1u)) >> 16; }
__device__ __forceinline__ unsigned pk2(float lo, float hi) { return f2bf(lo) | (f2bf(hi) << 16); }

#define XB_TMO      128
#define XB_XCNT(j)  (256  + 64 * (j))
#define XB_XSUB(j)  (1280 + 64 * (j))
#define XB_XGEN(j)  (2304 + 64 * (j))
#define XB_TOP      3328
#define XB_TOPGEN   3392
#define XCD_BAR_WORDS 3456
#define XB_SPIN_CAP (1u << 18)

__device__ __forceinline__ unsigned xb_ld(unsigned* p)              { return __hip_atomic_load(p, __ATOMIC_RELAXED, __HIP_MEMORY_SCOPE_AGENT); }
__device__ __forceinline__ unsigned xb_add(unsigned* p, unsigned v) { return __hip_atomic_fetch_add(p, v, __ATOMIC_RELAXED, __HIP_MEMORY_SCOPE_AGENT); }
__device__ __forceinline__ unsigned xb_xcc_id() { return (unsigned)__builtin_amdgcn_s_getreg((3 << 11) | 20) & 0xFu; }
#define XB_SPIN(cond, bar) do { unsigned _sp = 0; while (cond) { __builtin_amdgcn_s_sleep(1); \
    if ((++_sp & 255u) == 0u) { if (xb_ld(&(bar)[XB_TMO])) break; if (_sp > XB_SPIN_CAP) { atomicAdd(&(bar)[XB_TMO], 1u); break; } } } } while (0)

struct XcdBarrier {
    unsigned* bar; unsigned x;
    volatile LAS unsigned* st;
};

__device__ __forceinline__ XcdBarrier xcd_barrier_post(unsigned* bar, volatile LAS unsigned* st) {
    XcdBarrier b; b.bar = bar; b.x = xb_xcc_id(); b.st = st;
    if (threadIdx.x == 0) (void)xb_add(&bar[XB_XCNT(b.x)], 1u);
    return b;
}
__device__ __forceinline__ void xcd_barrier_complete(unsigned* bar, unsigned x, unsigned& nloc, unsigned& nx) {
    const unsigned G = gridDim.x * gridDim.y * gridDim.z;
    unsigned sum, cnt, mine, sp = 0u;
    for (;;) {
        sum = 0u; cnt = 0u; mine = 0u;
#pragma unroll
        for (unsigned j = 0; j < 16; ++j) { const unsigned c = xb_ld(&bar[XB_XCNT(j)]); sum += c; cnt += (c > 0u) ? 1u : 0u; mine = (j == x) ? c : mine; }
        if (sum == G) break;
        __builtin_amdgcn_s_sleep(1);
        if ((++sp & 255u) == 0u) { if (xb_ld(&bar[XB_TMO])) break; if (sp > XB_SPIN_CAP) { atomicAdd(&bar[XB_TMO], 1u); break; } }
    }
    nloc = mine > 0u ? mine : 1u; nx = cnt > 0u ? cnt : 1u;
}

__device__ __forceinline__ void xcd_barrier(const XcdBarrier& b) {
    asm volatile("s_waitcnt vmcnt(0)" ::: "memory");
    __syncthreads();
    if (threadIdx.x == 0) {
        unsigned* bar = b.bar;
        __builtin_amdgcn_s_waitcnt(0);
        unsigned nloc = b.st[0], nx = b.st[1];
        if (nloc == 0u) { xcd_barrier_complete(bar, b.x, nloc, nx); b.st[0] = nloc; b.st[1] = nx; }
        const unsigned old = xb_add(&bar[XB_XSUB(b.x)], 1u);
        const unsigned gen = old / nloc;
        if (old + 1u == (gen + 1u) * nloc) {
            __builtin_amdgcn_fence(__ATOMIC_RELEASE, "agent");
            asm volatile("s_waitcnt vmcnt(0)" ::: "memory");
            const unsigned og = xb_add(&bar[XB_TOP], 1u);
            const unsigned tg = og / nx;
            if (og + 1u == (tg + 1u) * nx) xb_add(&bar[XB_TOPGEN], 1u);
            else XB_SPIN(xb_ld(&bar[XB_TOPGEN]) == tg, bar);
            __builtin_amdgcn_fence(__ATOMIC_ACQUIRE, "agent");
            xb_add(&bar[XB_XGEN(b.x)], 1u);
            asm volatile("s_waitcnt vmcnt(0)" ::: "memory");
        } else {
            XB_SPIN(xb_ld(&bar[XB_XGEN(b.x)]) == gen, bar);
            __builtin_amdgcn_fence(__ATOMIC_ACQUIRE, "agent");
            asm volatile("s_waitcnt vmcnt(0)" ::: "memory");
        }
    }
    __syncthreads();
}

#ifndef PROBE_ATT
#define PROBE_ATT 0
#endif
#ifndef PROBE_CMP
#define PROBE_CMP 0
#endif
namespace cfg {
constexpr int D = 1024, NB = 4, T = 4096, M = NB * T, SB = 32, SS = 4, MS = SB * SS, PAST = 8192, PAGE = 128, NPG = PAST / PAGE;
constexpr int H = 16, HD = 64, NKV = 4, NIN = 7728, NINP = 7936, FF = 2816, NGU = 2 * FF, NMOD = 6 * D, RMOD = NB + SB, MODKC = 8;
constexpr int NCS_P = 255, NCP_P = 256, NCS_S = 511, NCP_S = 512;
constexpr float EPS = 1e-6f, NEGF = -1e30f;
constexpr size_t O_YP = 0, O_YS = 16777216, O_CMP_P = 16908288, O_SEL_P = 25296896, O_WIN_P = 33685504, O_CONV_P = 34734080,
                 O_CMP_S = 34742272, O_SEL_S = 34807808, O_WIN_S = 34873344, O_CONV_S = 43261952, O_END = 43327488;
constexpr size_t MiB = 1u << 20;
constexpr size_t WS_CTL = 0, CTL_ZERO_BYTES = 1 * MiB;
constexpr size_t WS_WIN_T = 2 * MiB, WS_WOC_T = 18 * MiB, WS_WON_T = 20 * MiB, WS_WOUT_T = 22 * MiB, WS_WGU_T = 24 * MiB, WS_WDN_T = 36 * MiB;
constexpr size_t WS_MODP = 42 * MiB, WS_MOD = 49 * MiB;
constexpr size_t WS_XN = 64 * MiB, WS_BG = 96 * MiB, WS_U = 128 * MiB, WS_Q = 160 * MiB, WS_HM = 192 * MiB, WS_GA = 240 * MiB, WS_GB = 272 * MiB, WS_NGT = 304 * MiB;
constexpr size_t WS_AA = 308 * MiB, WS_OB = 340 * MiB, WS_MG = 372 * MiB, WS_X1 = 404 * MiB, WS_P1 = 468 * MiB, WS_HF = 532 * MiB, WS_KCC = 620 * MiB, WS_SCOREH = 622 * MiB, WS_MASK = 686 * MiB;
constexpr size_t WS_XNS = 688 * MiB, WS_ZS = 689 * MiB, WS_AAS = 693 * MiB, WS_OBS = 694 * MiB, WS_MGS = 695 * MiB, WS_X1S = 696 * MiB, WS_XN2S = 697 * MiB, WS_HFS = 698 * MiB, WS_X2S = 700 * MiB;
constexpr size_t WS_KCCS = 701 * MiB, WS_SCOREHS = 733 * MiB, WS_MASKS = 735 * MiB, WS_KCCB = 736 * MiB, WS_VCCT = 737 * MiB, WS_VST = 738 * MiB, WS_VWT = 746 * MiB, WS_OB2 = 754 * MiB, WS_MASKM = 786 * MiB, WS_W1T = 787 * MiB, WS_W2T = 788 * MiB, WS_BIASC = 789 * MiB, WS_KCCSB = 790 * MiB, WS_VCCST = 798 * MiB,
                 WS_CCMP = 806 * MiB, WS_ACMP = 880 * MiB, WS_END = 1160 * MiB;
constexpr int CM_S = SB * NKV * 512, CM_P = NB * NKV * 256, CM_ROWS = CM_S + CM_P;
constexpr size_t HMSZ = (size_t)NB * NKV * T * HD;
constexpr int CW_BAR = 4096;
constexpr int RING_OFF = 0, RING_BYTES = 131072, LDSCTL_OFF = RING_BYTES, MISC_OFF = LDSCTL_OFF + 320, LDS_BYTES = 147456;
constexpr int NWAVES = 8, NTHR = 512;
constexpr int NPHASE = 14;
}
using namespace cfg;

struct Ctx {
    __device__ static __forceinline__ const void* karg(int i) { return ((const void* const __attribute__((address_space(4)))*)__builtin_amdgcn_kernarg_segment_ptr())[i]; }
    __device__ __forceinline__ const float* x_p() const { return (const float*)karg(0); }
    __device__ __forceinline__ const float* x_s() const { return (const float*)karg(1); }
    __device__ __forceinline__ const float* c_p() const { return (const float*)karg(2); }
    __device__ __forceinline__ const float* c_s() const { return (const float*)karg(3); }
    __device__ __forceinline__ const float* cache_cmp() const { return (const float*)karg(4); }
    __device__ __forceinline__ const float* cache_sel() const { return (const float*)karg(5); }
    __device__ __forceinline__ const float* cache_win() const { return (const float*)karg(6); }
    __device__ __forceinline__ const float* state_conv() const { return (const float*)karg(7); }
    __device__ __forceinline__ const int* pt() const { return (const int*)karg(8); }
    __device__ __forceinline__ const float* w_ada() const { return (const float*)karg(9); }
    __device__ __forceinline__ const float* b_ada() const { return (const float*)karg(10); }
    __device__ __forceinline__ const float* norm1() const { return (const float*)karg(11); }
    __device__ __forceinline__ const float* w_in() const { return (const float*)karg(12); }
    __device__ __forceinline__ const float* w_conv() const { return (const float*)karg(13); }
    __device__ __forceinline__ const float* b_conv() const { return (const float*)karg(14); }
    __device__ __forceinline__ const float* w_oc() const { return (const float*)karg(15); }
    __device__ __forceinline__ const float* pe() const { return (const float*)karg(16); }
    __device__ __forceinline__ const float* w_phi1() const { return (const float*)karg(17); }
    __device__ __forceinline__ const float* w_phi2() const { return (const float*)karg(18); }
    __device__ __forceinline__ const float* w_on() const { return (const float*)karg(19); }
    __device__ __forceinline__ const float* w_out() const { return (const float*)karg(20); }
    __device__ __forceinline__ const float* norm2() const { return (const float*)karg(21); }
    __device__ __forceinline__ const float* w_gate() const { return (const float*)karg(22); }
    __device__ __forceinline__ const float* w_up() const { return (const float*)karg(23); }
    __device__ __forceinline__ const float* w_down() const { return (const float*)karg(24); }
    __device__ __forceinline__ const float* norm_f() const { return (const float*)karg(25); }
    __device__ __forceinline__ float* out() const { return (float*)karg(26); }
    unsigned char* ws; bf16* OB; float* CHK;
    LAS unsigned char* lds; int tid, lane, wave, G, bid;
    __device__ __forceinline__ bf16* WIN_T() const { return (bf16*)(ws + WS_WIN_T); }
    __device__ __forceinline__ bf16* WOC_T() const { return (bf16*)(ws + WS_WOC_T); }
    __device__ __forceinline__ bf16* WON_T() const { return (bf16*)(ws + WS_WON_T); }
    __device__ __forceinline__ bf16* WOUT_T() const { return (bf16*)(ws + WS_WOUT_T); }
    __device__ __forceinline__ bf16* WGU_T() const { return (bf16*)(ws + WS_WGU_T); }
    __device__ __forceinline__ bf16* WDN_T() const { return (bf16*)(ws + WS_WDN_T); }
    __device__ __forceinline__ float* MODP() const { return (float*)(ws + WS_MODP); }
    __device__ __forceinline__ float* MOD() const { return (float*)(ws + WS_MOD); }
    __device__ __forceinline__ bf16* XN() const { return (bf16*)(ws + WS_XN); }
    __device__ __forceinline__ bf16* BG() const { return (bf16*)(ws + WS_BG); }
    __device__ __forceinline__ bf16* U() const { return (bf16*)(ws + WS_U); }
    __device__ __forceinline__ bf16* Q() const { return (bf16*)(ws + WS_Q); }
    __device__ __forceinline__ bf16* HM() const { return (bf16*)(ws + WS_HM); }
    __device__ __forceinline__ bf16* GA() const { return (bf16*)(ws + WS_GA); }
    __device__ __forceinline__ bf16* GB() const { return (bf16*)(ws + WS_GB); }
    __device__ __forceinline__ float* NGT() const { return (float*)(ws + WS_NGT); }
    __device__ __forceinline__ bf16* AA() const { return (bf16*)(ws + WS_AA); }
    __device__ __forceinline__ bf16* MG() const { return (bf16*)(ws + WS_MG); }
    __device__ __forceinline__ float* X1() const { return (float*)(ws + WS_X1); }
    __device__ __forceinline__ float* P1() const { return (float*)(ws + WS_P1); }
    __device__ __forceinline__ bf16* HF() const { return (bf16*)(ws + WS_HF); }
    __device__ __forceinline__ float* KCC() const { return (float*)(ws + WS_KCC); }
    __device__ __forceinline__ float* SCOREH() const { return (float*)(ws + WS_SCOREH); }
    __device__ __forceinline__ unsigned long long* MASK() const { return (unsigned long long*)(ws + WS_MASK); }
    __device__ __forceinline__ float* XNS() const { return (float*)(ws + WS_XNS); }
    __device__ __forceinline__ float* ZS() const { return (float*)(ws + WS_ZS); }
    __device__ __forceinline__ float* AAS() const { return (float*)(ws + WS_AAS); }
    __device__ __forceinline__ float* OBS() const { return (float*)(ws + WS_OBS); }
    __device__ __forceinline__ float* MGS() const { return (float*)(ws + WS_MGS); }
    __device__ __forceinline__ float* X1S() const { return (float*)(ws + WS_X1S); }
    __device__ __forceinline__ float* XN2S() const { return (float*)(ws + WS_XN2S); }
    __device__ __forceinline__ float* HFS() const { return (float*)(ws + WS_HFS); }
    __device__ __forceinline__ float* X2S() const { return (float*)(ws + WS_X2S); }
    __device__ __forceinline__ float* KCCS() const { return (float*)(ws + WS_KCCS); }
    __device__ __forceinline__ float* SCOREHS() const { return (float*)(ws + WS_SCOREHS); }
    __device__ __forceinline__ unsigned long long* MASKS() const { return (unsigned long long*)(ws + WS_MASKS); }
    __device__ __forceinline__ bf16* KCCB() const { return (bf16*)(ws + WS_KCCB); }
    __device__ __forceinline__ bf16* VCCT() const { return (bf16*)(ws + WS_VCCT); }
    __device__ __forceinline__ bf16* VST() const { return (bf16*)(ws + WS_VST); }
    __device__ __forceinline__ bf16* VWT() const { return (bf16*)(ws + WS_VWT); }
    __device__ __forceinline__ bf16* OB2() const { return (bf16*)(ws + WS_OB2); }
    __device__ __forceinline__ unsigned long long* MASKM() const { return (unsigned long long*)(ws + WS_MASKM); }
    __device__ __forceinline__ bf16* W1T() const { return (bf16*)(ws + WS_W1T); }
    __device__ __forceinline__ bf16* W2T() const { return (bf16*)(ws + WS_W2T); }
    __device__ __forceinline__ float* BIASC() const { return (float*)(ws + WS_BIASC); }
    __device__ __forceinline__ bf16* KCCSB() const { return (bf16*)(ws + WS_KCCSB); }
    __device__ __forceinline__ bf16* VCCST() const { return (bf16*)(ws + WS_VCCST); }
    __device__ __forceinline__ bf16* CCMP() const { return (bf16*)(ws + WS_CCMP); }
    __device__ __forceinline__ bf16* ACMP() const { return (bf16*)(ws + WS_ACMP); }
};

__device__ __forceinline__ int gtid(const Ctx& c) { int t = c.tid; asm volatile("" : "+v"(t)); return c.bid * NTHR + t; }
__device__ __forceinline__ float bf2f(bf16 b) { return __uint_as_float((unsigned)b << 16); }
__device__ __forceinline__ float sigmoidf_(float x) { return 1.f / (1.f + __expf(-x)); }
__device__ __forceinline__ float siluf_(float x) { return x / (1.f + __expf(-x)); }
__device__ __forceinline__ float gelu_tanh(float x) { const float u = 0.7978845608028654f * (x + 0.044715f * x * x * x); const float e = __expf(2.f * u); const float th = 1.f - 2.f / (e + 1.f); return 0.5f * x * (1.f + th); }
__device__ __forceinline__ float wave_sum(float v) {
#pragma unroll
    for (int o = 1; o < 64; o <<= 1) v += __shfl_xor(v, o);
    return v;
}
__device__ __forceinline__ void ld8(const bf16* p, float (&v)[8]) {
    const v4u w = *(const v4u*)p;
    v[0] = __uint_as_float(w.x << 16); v[1] = __uint_as_float(w.x & 0xffff0000u); v[2] = __uint_as_float(w.y << 16); v[3] = __uint_as_float(w.y & 0xffff0000u);
    v[4] = __uint_as_float(w.z << 16); v[5] = __uint_as_float(w.z & 0xffff0000u); v[6] = __uint_as_float(w.w << 16); v[7] = __uint_as_float(w.w & 0xffff0000u);
}
__device__ __forceinline__ void ld8(const float* p, float (&v)[8]) {
    const f32x4 a = *(const f32x4*)p, b = *(const f32x4*)(p + 4);
    v[0] = a.x; v[1] = a.y; v[2] = a.z; v[3] = a.w; v[4] = b.x; v[5] = b.y; v[6] = b.z; v[7] = b.w;
}
__device__ __forceinline__ v4u pack8(const float (&v)[8]) { v4u w; w.x = pg8::cvt_pk_bf16(v[0], v[1]); w.y = pg8::cvt_pk_bf16(v[2], v[3]); w.z = pg8::cvt_pk_bf16(v[4], v[5]); w.w = pg8::cvt_pk_bf16(v[6], v[7]); return w; }
template <class TP> __device__ __forceinline__ float dot64(const TP* row, const float (&q)[64]) {
    float s = 0.f;
#pragma unroll
    for (int c = 0; c < 8; ++c) { float v[8]; ld8(row + 8 * c, v);
#pragma unroll
        for (int j = 0; j < 8; ++j) s += q[8 * c + j] * v[j]; }
    return s;
}
template <class TP> __device__ __forceinline__ void axpy64(const TP* row, float p, float (&o)[64]) {
#pragma unroll
    for (int c = 0; c < 8; ++c) { float v[8]; ld8(row + 8 * c, v);
#pragma unroll
        for (int j = 0; j < 8; ++j) o[8 * c + j] += p * v[j]; }
}

struct SrcCol { const float* W; int ld; int col; };
template <class F> __device__ __forceinline__ void transpose_item(const F& f, int K, bf16* WT, LAS float* scr, int item, int nblk, int lane) {
    const int kb = item / nblk, nb = item % nblk, k0 = 64 * kb, n0 = 32 * nb;
    const SrcCol sc = f(n0 + (lane & 31));
#pragma unroll 8
    for (int i = 0; i < 32; ++i) { const int kk = 2 * i + (lane >> 5); scr[kk * 33 + (lane & 31)] = sc.col >= 0 ? sc.W[(size_t)(k0 + kk) * sc.ld + sc.col] : 0.f; }
    LDS_WAIT(); asm volatile("" ::: "memory");
    const int c = lane & 7;
#pragma unroll
    for (int j = 0; j < 4; ++j) { const int n = (lane >> 3) + 8 * j; const LAS float* s = scr + (8 * c) * 33 + n;
        v4u o; o.x = pk2(s[0 * 33], s[1 * 33]); o.y = pk2(s[2 * 33], s[3 * 33]); o.z = pk2(s[4 * 33], s[5 * 33]); o.w = pk2(s[6 * 33], s[7 * 33]);
        *(GAS v4u*)(WT + (size_t)(n0 + n) * K + k0 + 8 * c) = o; }
    LDS_WAIT(); asm volatile("" ::: "memory");
}
struct ColIn { const float* W; __device__ __forceinline__ SrcCol operator()(int p) const {
    int s;
    if (p < 1024) s = p;
    else if (p < 3072) { const int t = (p - 1024) >> 8, w = (p - 1024) & 255; s = (w < 128) ? (1024 + 128 * t + w) : (2048 + 128 * t + (w - 128)); }
    else if (p < 5632) s = p;
    else if (p < 7680) s = 5680 + (p - 5632);
    else if (p < 7728) s = 5632 + (p - 7680);
    else s = -1;
    return SrcCol{W, NIN, s}; } };
struct ColPlain { const float* W; int ld; __device__ __forceinline__ SrcCol operator()(int p) const { return SrcCol{W, ld, p}; } };
struct ColW1 { const float* W; __device__ __forceinline__ SrcCol operator()(int p) const { return (p < 128) ? SrcCol{W, 128, p} : SrcCol{W + 1024 * 128, 128, p - 128}; } };
struct ColGU { const float *Wg, *Wu; __device__ __forceinline__ SrcCol operator()(int p) const { const int t = p >> 8, w = p & 255; return (w < 128) ? SrcCol{Wg, FF, 128 * t + w} : SrcCol{Wu, FF, 128 * t + (w - 128)}; } };

__device__ __forceinline__ void mod_partial_item(const Ctx& c, int item) {
    const int kc = item / 12, cc = item % 12, k0 = kc * 128, n = cc * 512 + c.tid;
    LAS float* sc = (LAS float*)c.lds;
    for (int i = c.tid; i < RMOD * 128; i += NTHR) { const int r = i >> 7, k = i & 127; const float cv = (r < NB) ? c.c_p()[r * D + k0 + k] : c.c_s()[(r - NB) * D + k0 + k]; sc[i] = siluf_(cv); }
    __syncthreads();
    float acc[RMOD];
#pragma unroll
    for (int r = 0; r < RMOD; ++r) acc[r] = 0.f;
    for (int k = 0; k < 128; ++k) { const float w = c.w_ada()[(size_t)(k0 + k) * NMOD + n];
#pragma unroll
        for (int r = 0; r < RMOD; ++r) acc[r] += sc[r * 128 + k] * w; }
#pragma unroll
    for (int r = 0; r < RMOD; ++r) c.MODP()[((size_t)kc * RMOD + r) * NMOD + n] = acc[r];
    __syncthreads();
}
__device__ __forceinline__ void p0_prologue(const Ctx& c) {
    for (int it = c.bid; it < MODKC * 12; it += c.G) mod_partial_item(c, it);
    LAS float* scr = (LAS float*)(c.lds + c.wave * 16384);
    const int gw = c.bid * NWAVES + c.wave, NGW = c.G * NWAVES;
    constexpr int I_IN = 16 * (NINP / 32), I_SQ = 16 * 32, I_GU = 16 * (NGU / 32), I_DN = (FF / 64) * 32;
    constexpr int I_W1 = 2 * 16 * 8, I_W2 = 2 * 2 * 2;
    constexpr int NITEMS = I_IN + 3 * I_SQ + I_GU + I_DN + I_W1 + I_W2;
    for (int it = gw; it < NITEMS; it += NGW) {
        int r = it;
        if (r < I_IN) { transpose_item(ColIn{c.w_in()}, D, c.WIN_T(), scr, r, NINP / 32, c.lane); continue; } r -= I_IN;
        if (r < I_SQ) { transpose_item(ColPlain{c.w_oc(), D}, D, c.WOC_T(), scr, r, 32, c.lane); continue; } r -= I_SQ;
        if (r < I_SQ) { transpose_item(ColPlain{c.w_on(), D}, D, c.WON_T(), scr, r, 32, c.lane); continue; } r -= I_SQ;
        if (r < I_SQ) { transpose_item(ColPlain{c.w_out(), D}, D, c.WOUT_T(), scr, r, 32, c.lane); continue; } r -= I_SQ;
        if (r < I_GU) { transpose_item(ColGU{c.w_gate(), c.w_up()}, D, c.WGU_T(), scr, r, NGU / 32, c.lane); continue; } r -= I_GU;
        if (r < I_DN) { transpose_item(ColPlain{c.w_down(), D}, FF, c.WDN_T(), scr, r, 32, c.lane); continue; } r -= I_DN;
        if (r < I_W1) { const int kv = r >> 7; transpose_item(ColW1{c.w_phi1() + (size_t)kv * 2048 * 128}, 1024, c.W1T() + (size_t)kv * 256 * 1024, scr, r & 127, 8, c.lane); continue; } r -= I_W1;
        { const int kv = r >> 2; transpose_item(ColPlain{c.w_phi2() + (size_t)kv * 128 * HD, HD}, 128, c.W2T() + (size_t)kv * HD * 128, scr, r & 3, 2, c.lane); }
    }
    if (c.bid == c.G - 1 && c.tid < 256) { const int kv = c.tid >> 7, n = c.tid & 127; float s = 0.f;
        for (int kk = 0; kk < 2048; ++kk) s += c.pe()[kv * 2048 + kk] * c.w_phi1()[((size_t)kv * 2048 + kk) * 128 + n];
        c.BIASC()[c.tid] = s; }
    { const int gt = gtid(c), NGT_ = c.G * NTHR;
      for (int it = gt; it < SB * PAST * 64; it += NGT_) {
          const int l8 = it & 63, pos = (it >> 6) & (PAST - 1), b = it >> 19;
          const float* src = c.cache_cmp() + ((size_t)c.pt()[b * NPG + (pos >> 7)] * PAGE + (pos & 127)) * 512 + l8 * 8;
          float v[8]; ld8(src, v);
          const int kv = l8 >> 5, g = (l8 >> 3) & 3, d = (l8 & 7) * 8;
          *(GAS v4u*)(c.ACMP() + ((size_t)kv * CM_ROWS + (size_t)((b * NKV + g) * 512 + (pos >> 4))) * 1024 + (pos & 15) * HD + d) = pack8(v); } }
}

template <bool MODUL, bool OUT_BF16> __device__ __forceinline__ void norm_row(const float* xrow, const float* gain, const float* sh, const float* sc, void* orow, int lane) {
    const GAS f32x4* xr = (const GAS f32x4*)xrow + lane;
    f32x4 v[4]; float s = 0.f;
#pragma unroll
    for (int j = 0; j < 4; ++j) { v[j] = xr[64 * j]; s += (v[j].x * v[j].x + v[j].y * v[j].y) + (v[j].z * v[j].z + v[j].w * v[j].w); }
    const float inv = 1.0f / sqrtf(wave_sum(s) * (1.f / D) + EPS);
#pragma unroll
    for (int j = 0; j < 4; ++j) {
        const int k = 4 * lane + 256 * j;
        const f32x4 g = *(const f32x4*)(gain + k);
        f32x4 o = v[j] * inv * g;
        if (MODUL) { const f32x4 a = *(const f32x4*)(sc + k), b = *(const f32x4*)(sh + k); o = o * (a + 1.0f) + b; }
        if (OUT_BF16) { ((GAS unsigned long long*)orow)[lane + 64 * j] = (unsigned long long)pg8::cvt_pk_bf16(o.x, o.y) | ((unsigned long long)pg8::cvt_pk_bf16(o.z, o.w) << 32); }
        else { ((GAS f32x4*)orow)[lane + 64 * j] = o; }
    }
}
__device__ __forceinline__ void p1_norm1(const Ctx& c) {
    for (int r = c.bid; r < RMOD; r += c.G)
        for (int n = c.tid; n < NMOD; n += NTHR) { float s = c.b_ada()[n];
#pragma unroll
            for (int kc = 0; kc < MODKC; ++kc) s += c.MODP()[((size_t)kc * RMOD + r) * NMOD + n];
            c.MOD()[(size_t)r * NMOD + n] = s; }
    LAS float* shl = (LAS float*)c.lds; LAS float* scl = shl + D;
    constexpr int NCH = M / 64 + SB;
    for (int ch = c.bid; ch < NCH; ch += c.G) {
        const bool smp = ch >= M / 64; const int r = smp ? NB + (ch - M / 64) : (ch * 64) / T;
        __syncthreads();
        for (int k = c.tid; k < 2 * D; k += NTHR) { float s = c.b_ada()[k];
#pragma unroll
            for (int kc = 0; kc < MODKC; ++kc) s += c.MODP()[((size_t)kc * RMOD + r) * NMOD + k];
            shl[k] = s; }
        __syncthreads();
        if (!smp) { for (int rr = c.wave; rr < 64; rr += NWAVES) { const int row = ch * 64 + rr;
                const GAS f32x4* xr = (const GAS f32x4*)(c.x_p() + (size_t)row * D) + c.lane; f32x4 v[4]; float s = 0.f;
#pragma unroll
                for (int j = 0; j < 4; ++j) { v[j] = xr[64 * j]; s += (v[j].x * v[j].x + v[j].y * v[j].y) + (v[j].z * v[j].z + v[j].w * v[j].w); }
                const float inv = 1.0f / sqrtf(wave_sum(s) * (1.f / D) + EPS);
#pragma unroll
                for (int j = 0; j < 4; ++j) { const int k = 4 * c.lane + 256 * j; const f32x4 g = *(const f32x4*)(c.norm1() + k);
                    const f32x4 a = *(const LAS f32x4*)(scl + k), b = *(const LAS f32x4*)(shl + k); const f32x4 o = v[j] * inv * g * (a + 1.0f) + b;
                    ((GAS unsigned long long*)(c.XN() + (size_t)row * D))[c.lane + 64 * j] = (unsigned long long)pg8::cvt_pk_bf16(o.x, o.y) | ((unsigned long long)pg8::cvt_pk_bf16(o.z, o.w) << 32); } } }
        else if (c.wave < SS) { const int row = (ch - M / 64) * SS + c.wave;
                const GAS f32x4* xr = (const GAS f32x4*)(c.x_s() + (size_t)row * D) + c.lane; f32x4 v[4]; float s = 0.f;
#pragma unroll
                for (int j = 0; j < 4; ++j) { v[j] = xr[64 * j]; s += (v[j].x * v[j].x + v[j].y * v[j].y) + (v[j].z * v[j].z + v[j].w * v[j].w); }
                const float inv = 1.0f / sqrtf(wave_sum(s) * (1.f / D) + EPS);
#pragma unroll
                for (int j = 0; j < 4; ++j) { const int k = 4 * c.lane + 256 * j; const f32x4 g = *(const f32x4*)(c.norm1() + k);
                    const f32x4 a = *(const LAS f32x4*)(scl + k), b = *(const LAS f32x4*)(shl + k); const f32x4 o = v[j] * inv * g * (a + 1.0f) + b;
                    ((GAS f32x4*)(c.XNS() + (size_t)row * D))[c.lane + 64 * j] = o; } }
    }
    __syncthreads();
}
__device__ __forceinline__ void p5c_norm2(const Ctx& c) {
    const int gw = c.bid * NWAVES + c.wave, NGW = c.G * NWAVES;
    for (int row = gw; row < M + MS; row += NGW) {
        if (row < M) { const int r = row / T; norm_row<true, true>(c.X1() + (size_t)row * D, c.norm2(), c.MOD() + (size_t)r * NMOD + 3 * D, c.MOD() + (size_t)r * NMOD + 4 * D, c.XN() + (size_t)row * D, c.lane); }
        else { const int rs = row - M, r = NB + rs / SS; norm_row<true, false>(c.X1S() + (size_t)rs * D, c.norm2(), c.MOD() + (size_t)r * NMOD + 3 * D, c.MOD() + (size_t)r * NMOD + 4 * D, c.XN2S() + (size_t)rs * D, c.lane); }
    }
}
__device__ __forceinline__ void p8_normf(const Ctx& c) {
    const int gw = c.bid * NWAVES + c.wave, NGW = c.G * NWAVES;
    for (int row = gw; row < M + MS; row += NGW) {
        if (row < M) norm_row<false, false>(c.out() + O_YP + (size_t)row * D, c.norm_f(), nullptr, nullptr, c.out() + O_YP + (size_t)row * D, c.lane);
        else { const int rs = row - M; norm_row<false, false>(c.X2S() + (size_t)rs * D, c.norm_f(), nullptr, nullptr, c.out() + O_YS + (size_t)rs * D, c.lane); }
    }
}

using pg8::Unit;
#define EPI_ROWS(...) _Pragma("unroll") for (int ai = 0; ai < 2; ++ai) _Pragma("unroll") for (int m = 0; m < 4; ++m) { const int row = row0 + ai * 128 + m * 16; __VA_ARGS__ }
struct EpiIn {
    static constexpr bool PERM = true, AFTER_DRAIN = false;
    bf16 *BG, *U, *Q, *HM, *GA, *GB; float* NGT; float* out; bf16 *VST, *VWT, *ACMP;
    __device__ __forceinline__ void operator()(const f32x4 (&acc)[2][2][4][2], const Unit& u, int wr, int wc, int fr, int fq) const {
        const int pn = u.pn, row0 = u.pm * 256 + wr * 64 + fr, cl0 = wc * 32 + 8 * fq;
        if (pn < 4 || (pn >= 12 && pn < 16) || (pn >= 22 && pn < 30)) {
            bf16* base; int colt; float sc = 1.f; bool sig = false;
            if (pn < 4) { base = BG; colt = pn * 256; } else if (pn < 16) { base = Q; colt = (pn - 12) * 256; sc = 0.125f * 1.4426950408889634f; } else if (pn < 26) { base = GA; colt = (pn - 22) * 256; sig = true; } else { base = GB; colt = (pn - 26) * 256; sig = true; }
            EPI_ROWS(
_Pragma("unroll")
                for (int bj = 0; bj < 2; ++bj) { const f32x4 a = acc[ai][bj][m][0], b = acc[ai][bj][m][1]; float v[8] = {a.x, a.y, a.z, a.w, b.x, b.y, b.z, b.w};
_Pragma("unroll")
                    for (int j = 0; j < 8; ++j) v[j] = sig ? sigmoidf_(v[j]) : v[j] * sc;
                    *(GAS v4u*)(base + (size_t)row * D + colt + bj * 128 + cl0) = pack8(v); } )
        } else if (pn < 12) {
            const int t = pn - 4;
            EPI_ROWS(
                const f32x4 a = acc[ai][0][m][0] * acc[ai][1][m][0], b = acc[ai][0][m][1] * acc[ai][1][m][1]; const float v[8] = {a.x, a.y, a.z, a.w, b.x, b.y, b.z, b.w};
                *(GAS v4u*)(U + (size_t)row * D + t * 128 + cl0) = pack8(v);
                const int tt = row & (T - 1);
                if (tt >= T - 2) { float* o = out + O_CONV_P + (size_t)((row >> 12) * 2 + (tt - (T - 2))) * D + t * 128 + cl0; *(GAS f32x4*)o = a; *(GAS f32x4*)(o + 4) = b; } )
        } else if (pn < 22) {
            const int kind = pn - 16, kv = kind & 1, reg = kind >> 1;
            EPI_ROWS(
                const int b = row >> 12, tt = row & (T - 1);
_Pragma("unroll")
                for (int bj = 0; bj < 2; ++bj) { const f32x4 a = acc[ai][bj][m][0], bq = acc[ai][bj][m][1]; const float v[8] = {a.x, a.y, a.z, a.w, bq.x, bq.y, bq.z, bq.w};
                    const int cl = bj * 128 + cl0, g = cl >> 6, d = cl & 63;
                    if (kind == 3 || kind == 5) { bf16* vt = (kind == 3 ? VST : VWT) + ((size_t)((b * NKV + g) * HD + d)) * T + tt;
_Pragma("unroll")
                        for (int j = 0; j < 8; ++j) vt[(size_t)j * T] = (bf16)f2bf(v[j]); }
                    if (kind < 2) *(GAS v4u*)(ACMP + ((size_t)kind * CM_ROWS + CM_S) * 1024 + ((size_t)((b * NKV + g) * T + tt)) * HD + d) = pack8(v);
                    else if (PROBE_ATT || !(kind == 3 || kind == 5)) *(GAS v4u*)(HM + (size_t)kind * HMSZ + ((size_t)((b * NKV + g) * T + tt)) * HD + d) = pack8(v);
                    float* o = nullptr;
                    if (reg == 0) o = out + O_CMP_P + ((size_t)row * 2 + kv) * 256 + cl;
                    else if (reg == 1) o = out + O_SEL_P + ((size_t)row * 2 + kv) * 256 + cl;
                    else if (tt >= T - 512) o = out + O_WIN_P + ((size_t)(b * 512 + tt - (T - 512)) * 2 + kv) * 256 + cl;
                    if (o) { *(GAS f32x4*)o = a; *(GAS f32x4*)(o + 4) = bq; } } )
        } else {
            if (cl0 < 48) {
                EPI_ROWS(
                    const f32x4 a = acc[ai][0][m][0], b = acc[ai][0][m][1];
                    f32x4 sa, sb; sa.x = sigmoidf_(a.x); sa.y = sigmoidf_(a.y); sa.z = sigmoidf_(a.z); sa.w = sigmoidf_(a.w); sb.x = sigmoidf_(b.x); sb.y = sigmoidf_(b.y); sb.z = sigmoidf_(b.z); sb.w = sigmoidf_(b.w);
                    float* o = NGT + (size_t)row * 48 + cl0; *(GAS f32x4*)o = sa; *(GAS f32x4*)(o + 4) = sb; )
            }
        }
    }
};
struct EpiYa { static constexpr bool PERM = true, AFTER_DRAIN = false; const bf16* GA; float* P1;
    __device__ __forceinline__ void operator()(const f32x4 (&acc)[2][2][4][2], const Unit& u, int wr, int wc, int fr, int fq) const {
        const int row0 = u.pm * 256 + wr * 64 + fr, col0 = u.pn * 256 + wc * 32 + 8 * fq;
        EPI_ROWS(
_Pragma("unroll")
            for (int bj = 0; bj < 2; ++bj) { const size_t off = (size_t)row * D + col0 + bj * 128; float g[8]; ld8(GA + off, g); const f32x4 a = acc[ai][bj][m][0], b = acc[ai][bj][m][1];
                f32x4 o0, o1; o0.x = g[0] * a.x; o0.y = g[1] * a.y; o0.z = g[2] * a.z; o0.w = g[3] * a.w; o1.x = g[4] * b.x; o1.y = g[5] * b.y; o1.z = g[6] * b.z; o1.w = g[7] * b.w;
                *(GAS f32x4*)(P1 + off) = o0; *(GAS f32x4*)(P1 + off + 4) = o1; } )
    } };
struct EpiYb { static constexpr bool PERM = true, AFTER_DRAIN = false; const bf16* GB; const float* P1; bf16* MG;
    __device__ __forceinline__ void operator()(const f32x4 (&acc)[2][2][4][2], const Unit& u, int wr, int wc, int fr, int fq) const {
        const int row0 = u.pm * 256 + wr * 64 + fr, col0 = u.pn * 256 + wc * 32 + 8 * fq;
        EPI_ROWS(
_Pragma("unroll")
            for (int bj = 0; bj < 2; ++bj) { const size_t off = (size_t)row * D + col0 + bj * 128; float g[8]; ld8(GB + off, g); float p[8]; ld8(P1 + off, p); const f32x4 a = acc[ai][bj][m][0], b = acc[ai][bj][m][1];
                const float v[8] = {p[0] + g[0] * a.x, p[1] + g[1] * a.y, p[2] + g[2] * a.z, p[3] + g[3] * a.w, p[4] + g[4] * b.x, p[5] + g[5] * b.y, p[6] + g[6] * b.z, p[7] + g[7] * b.w};
                *(GAS v4u*)(MG + off) = pack8(v); } )
    } };
struct EpiRes { static constexpr bool PERM = true, AFTER_DRAIN = false; const float* base; float* O; const float* MOD; int goff;
    __device__ __forceinline__ void operator()(const f32x4 (&acc)[2][2][4][2], const Unit& u, int wr, int wc, int fr, int fq) const {
        const int row0 = u.pm * 256 + wr * 64 + fr, col0 = u.pn * 256 + wc * 32 + 8 * fq;
        const float* gp = MOD + (size_t)((u.pm * 256) / T) * NMOD + goff + col0;
        f32x4 gt[2][2];
#pragma unroll
        for (int bj = 0; bj < 2; ++bj) { gt[bj][0] = *(const f32x4*)(gp + bj * 128); gt[bj][1] = *(const f32x4*)(gp + bj * 128 + 4); }
        EPI_ROWS(
_Pragma("unroll")
            for (int bj = 0; bj < 2; ++bj) { const size_t off = (size_t)row * D + col0 + bj * 128;
                const f32x4 x0 = *(const f32x4*)(base + off), x1 = *(const f32x4*)(base + off + 4);
                *(GAS f32x4*)(O + off) = x0 + gt[bj][0] * acc[ai][bj][m][0]; *(GAS f32x4*)(O + off + 4) = x1 + gt[bj][1] * acc[ai][bj][m][1]; } )
    } };
struct EpiFF { static constexpr bool PERM = true, AFTER_DRAIN = false; bf16* HF;
    __device__ __forceinline__ void operator()(const f32x4 (&acc)[2][2][4][2], const Unit& u, int wr, int wc, int fr, int fq) const {
        const int row0 = u.pm * 256 + wr * 64 + fr, col0 = u.pn * 128 + wc * 32 + 8 * fq;
        EPI_ROWS(
            const f32x4 g0 = acc[ai][0][m][0], g1 = acc[ai][0][m][1], u0 = acc[ai][1][m][0], u1 = acc[ai][1][m][1];
            const float v[8] = {siluf_(g0.x) * u0.x, siluf_(g0.y) * u0.y, siluf_(g0.z) * u0.z, siluf_(g0.w) * u0.w, siluf_(g1.x) * u1.x, siluf_(g1.y) * u1.y, siluf_(g1.z) * u1.z, siluf_(g1.w) * u1.w};
            *(GAS v4u*)(HF + (size_t)row * FF + col0) = pack8(v); )
    } };

struct CmpOrder { int G, c; static constexpr int NPM = CM_ROWS / 256;
    __device__ bool next(int i, Unit& u) const { const int L = i * G + c; if (L >= 2 * NPM) return false; u.pm = L; u.pn = L >= NPM ? 1 : 0; return true; }
    __device__ __forceinline__ void a_ready(const Unit&) const {}
    __device__ __forceinline__ void done(const Unit&) const {} };
struct EpiCmp { static constexpr bool PERM = true, AFTER_DRAIN = false; bf16* C;
    __device__ __forceinline__ void operator()(const f32x4 (&acc)[2][2][4][2], const Unit& u, int wr, int wc, int fr, int fq) const {
        const int row0 = u.pm * 256 + wr * 64 + fr, col0 = wc * 32 + 8 * fq;
        EPI_ROWS(
_Pragma("unroll")
            for (int bj = 0; bj < 2; ++bj) { const f32x4 a = acc[ai][bj][m][0], b = acc[ai][bj][m][1]; const float v[8] = {a.x, a.y, a.z, a.w, b.x, b.y, b.z, b.w};
                *(GAS v4u*)(C + (size_t)row * 256 + bj * 128 + col0) = pack8(v); } )
    } };
__device__ __forceinline__ void compress_step2(const Ctx& c) {
    typedef short bfx8 __attribute__((ext_vector_type(8)));
    constexpr int NT_S = SB * NKV * 32, NT_P = NB * NKV * 16, NTASK = 2 * (NT_S + NT_P);
    const int gw = c.bid * NWAVES + c.wave, NGW = c.G * NWAVES, r16 = c.lane & 15, G = c.lane >> 4;
    for (int w = gw; w < NTASK; w += NGW) {
        const int kv = w / (NT_S + NT_P), w2 = w % (NT_S + NT_P); const bool smp = w2 < NT_S;
        const int bgi = smp ? (w2 >> 5) : ((w2 - NT_S) >> 4), it = smp ? (w2 & 31) : ((w2 - NT_S) & 15);
        const int nper = smp ? 512 : 256, ncs = smp ? NCS_S : NCS_P;
        const int ci = it * 16 + r16, cic = ci < ncs ? ci : ncs - 1;
        const size_t rowA = (size_t)kv * CM_ROWS + (smp ? 0 : CM_S) + (size_t)bgi * nper + cic;
        const bf16* ca = c.CCMP() + rowA * 256; const bf16* cb = ca + 256 + 128;
        f32x4 acc[4];
#pragma unroll
        for (int ob = 0; ob < 4; ++ob) acc[ob] = (f32x4){0.f, 0.f, 0.f, 0.f};
#pragma unroll
        for (int ks = 0; ks < 4; ++ks) {
            float a[8], b[8], bi[8]; ld8(ca + 32 * ks + 8 * G, a); ld8(cb + 32 * ks + 8 * G, b); ld8(c.BIASC() + kv * 128 + 32 * ks + 8 * G, bi);
            float h[8];
#pragma unroll
            for (int j = 0; j < 8; ++j) h[j] = gelu_tanh(a[j] + b[j] + bi[j]);
            const bfx8 hf = __builtin_bit_cast(bfx8, pack8(h));
#pragma unroll
            for (int ob = 0; ob < 4; ++ob) { const bfx8 wf = *(const bfx8*)(c.W2T() + ((size_t)kv * HD + 16 * ob + r16) * 128 + 32 * ks + 8 * G);
                acc[ob] = __builtin_amdgcn_mfma_f32_16x16x32_bf16(wf, hf, acc[ob], 0, 0, 0); }
        }
        if (PROBE_CMP && ci < ncs) {
            float num = 0.f, den = 0.f;
#pragma unroll
            for (int ob = 0; ob < 4; ++ob)
#pragma unroll
                for (int i = 0; i < 4; ++i) { const int o = 16 * ob + 4 * G + i;
                    const float r = smp ? c.KCCS()[((size_t)((kv * SB * NKV + bgi)) * NCP_S + ci) * HD + o] : c.KCC()[((size_t)((kv * NB * NKV + bgi)) * NCP_P + ci) * HD + o];
                    num += (acc[ob][i] - r) * (acc[ob][i] - r); den += r * r; }
            atomicAdd(c.CHK + (smp ? 0 : 2) + 32, num); atomicAdd(c.CHK + (smp ? 1 : 3) + 32, den);
        }
        if (ci < ncs) {
            if (smp) {
#pragma unroll
                for (int ob = 0; ob < 4; ++ob)
#pragma unroll
                    for (int i = 0; i < 4; ++i) c.KCCS()[((size_t)((kv * SB * NKV + bgi)) * NCP_S + ci) * HD + 16 * ob + 4 * G + i] = acc[ob][i];
            }
            if (PROBE_ATT && !smp) {
#pragma unroll
                for (int ob = 0; ob < 4; ++ob)
#pragma unroll
                    for (int i = 0; i < 4; ++i) c.KCC()[((size_t)((kv * NB * NKV + bgi)) * NCP_P + ci) * HD + 16 * ob + 4 * G + i] = acc[ob][i];
            }
            bf16* kout = smp ? c.KCCSB() : c.KCCB(); bf16* vout = smp ? c.VCCST() : c.VCCT();
            if (kv == 0) {
#pragma unroll
                for (int ob = 0; ob < 4; ++ob) *(GAS unsigned long long*)(kout + ((size_t)bgi * nper + ci) * HD + 16 * ob + 4 * G) =
                    (unsigned long long)pg8::cvt_pk_bf16(acc[ob][0], acc[ob][1]) | ((unsigned long long)pg8::cvt_pk_bf16(acc[ob][2], acc[ob][3]) << 32);
            } else {
#pragma unroll
                for (int ob = 0; ob < 4; ++ob)
#pragma unroll
                    for (int i = 0; i < 4; ++i) vout[((size_t)bgi * HD + 16 * ob + 4 * G + i) * nper + ci] = (bf16)f2bf(acc[ob][i]);
            }
        }
    }
}

template <bool DUAL, class Epi> __device__ __forceinline__ void sgemm(const Ctx& c, const float* A1, const float* A2, int lda, const float* W1, const float* W2, int ldw, int K, int N, const Epi& epi) {
    const int nch = (N + NTHR - 1) / NTHR, nitems = 8 * nch;
    for (int it = c.G - 1 - c.bid; it < nitems; it += c.G) {
        const int rg = it & 7, n = (it >> 3) * NTHR + c.tid;
        if (n < N) {
            float a1[16], a2[16];
#pragma unroll
            for (int r = 0; r < 16; ++r) { a1[r] = 0.f; a2[r] = 0.f; }
            const float* ar1 = A1 + (size_t)rg * 16 * lda; const float* ar2 = A2 + (size_t)rg * 16 * lda;
            for (int k = 0; k < K; ++k) { const float w1 = W1[(size_t)k * ldw + n]; const float w2 = DUAL ? W2[(size_t)k * ldw + n] : 0.f;
#pragma unroll
                for (int r = 0; r < 16; ++r) { a1[r] += ar1[(size_t)r * lda + k] * w1; if (DUAL) a2[r] += ar2[(size_t)r * lda + k] * w2; } }
#pragma unroll
            for (int r = 0; r < 16; ++r) epi(rg * 16 + r, n, a1[r], a2[r]);
        }
    }
}

__device__ __forceinline__ void p3_conv_prompt(const Ctx& c) {
    const int gt = gtid(c), NGT_ = c.G * NTHR;
    for (int it = gt; it < M * (D / 8); it += NGT_) {
        const int row = it >> 7, ch = (it & 127) * 8, tt = row & (T - 1);
        float u0[8], u1[8], u2[8], bg[8];
        ld8(c.U() + (size_t)row * D + ch, u0); ld8(c.BG() + (size_t)row * D + ch, bg);
        if (tt >= 1) ld8(c.U() + (size_t)(row - 1) * D + ch, u1); else { for (int j = 0; j < 8; ++j) u1[j] = 0.f; }
        if (tt >= 2) ld8(c.U() + (size_t)(row - 2) * D + ch, u2); else { for (int j = 0; j < 8; ++j) u2[j] = 0.f; }
        float w0[8], w1[8], w2[8], bb[8]; ld8(c.w_conv() + ch, w0); ld8(c.w_conv() + D + ch, w1); ld8(c.w_conv() + 2 * D + ch, w2); ld8(c.b_conv() + ch, bb);
        float v[8];
#pragma unroll
        for (int j = 0; j < 8; ++j) v[j] = bg[j] * (bb[j] + w0[j] * u2[j] + w1[j] * u1[j] + w2[j] * u0[j]);
        *(GAS v4u*)(c.AA() + (size_t)row * D + ch) = pack8(v);
    }
}
__device__ __forceinline__ void p3_sample_thin(const Ctx& c) {
    const int gt = gtid(c), NGT_ = c.G * NTHR;
    for (int it = gt; it < MS * D; it += NGT_) {
        const int row = it >> 10, ch = it & 1023, b = row >> 2, s = row & 3;
        float up[3];
#pragma unroll
        for (int k = 0; k < 3; ++k) { const int ss = s - 2 + k; up[k] = (ss >= 0) ? c.ZS()[(size_t)(b * SS + ss) * NIN + 1024 + ch] * c.ZS()[(size_t)(b * SS + ss) * NIN + 2048 + ch] : c.state_conv()[(size_t)(b * 2 + (ss + 2)) * D + ch]; }
        const float v = c.b_conv()[ch] + c.w_conv()[ch] * up[0] + c.w_conv()[D + ch] * up[1] + c.w_conv()[2 * D + ch] * up[2];
        c.AAS()[(size_t)row * D + ch] = c.ZS()[(size_t)row * NIN + ch] * v;
        if (s >= 2) c.out()[O_CONV_S + (size_t)(b * 2 + (s - 2)) * D + ch] = up[2];
    }
    for (int it = gt; it < MS * 512; it += NGT_) { const int row = it >> 9, cc = it & 511;
        c.out()[O_CMP_S + (size_t)row * 512 + cc] = c.ZS()[(size_t)row * NIN + 4096 + cc]; c.out()[O_SEL_S + (size_t)row * 512 + cc] = c.ZS()[(size_t)row * NIN + 4608 + cc]; }
    for (int it = gt; it < SB * 512 * 128; it += NGT_) { const int cc = (it & 127) * 4, j = (it >> 7) & 511, b = it >> 16;
        f32x4 v;
        if (j + SS < 512) v = *(const f32x4*)(c.cache_win() + ((size_t)(b * 512 + j + SS)) * 512 + cc);
        else v = *(const f32x4*)(c.ZS() + (size_t)(b * SS + (j + SS - 512)) * NIN + 5120 + cc);
        *(GAS f32x4*)(c.out() + O_WIN_S + ((size_t)(b * 512 + j)) * 512 + cc) = v; }
}
struct CmpP { static constexpr int NB_ = NB, NCS = NCS_P, NCP = NCP_P, NGRP = 16;
    __device__ static __forceinline__ float x(const Ctx& c, int kv, int b, int g, int pos, int d) { return bf2f(c.ACMP()[((size_t)kv * CM_ROWS + CM_S) * 1024 + ((size_t)((b * NKV + g) * T + pos)) * HD + d]); }
    __device__ static __forceinline__ void store(const Ctx& c, int kv, int b, int g, int i, int o, float s) {
        c.KCC()[((size_t)((kv * NB + b) * NKV + g) * NCP_P + i) * HD + o] = s; } };
struct CmpS { static constexpr int NB_ = SB, NCS = NCS_S, NCP = NCP_S, NGRP = 32;
    __device__ static __forceinline__ float x(const Ctx& c, int kv, int b, int g, int pos, int d) { return c.cache_cmp()[((size_t)c.pt()[b * NPG + (pos >> 7)] * PAGE + (pos & 127)) * 512 + kv * 256 + g * HD + d]; }
    __device__ static __forceinline__ void store(const Ctx& c, int kv, int b, int g, int i, int o, float s) { c.KCCS()[((size_t)((kv * SB + b) * NKV + g) * NCP_S + i) * HD + o] = s; } };
template <class S> __device__ __forceinline__ void compress_naive(const Ctx& c) {
    constexpr int NITEMS = 2 * S::NB_ * NKV * S::NGRP;
    LAS float* hid = (LAS float*)c.lds;
    const int n = c.tid & 127, rq = c.tid >> 7;
    for (int it = c.bid; it < NITEMS; it += c.G) {
        const int ig = it % S::NGRP, g = (it / S::NGRP) % NKV, b = (it / (S::NGRP * NKV)) % S::NB_, kv = it / (S::NGRP * NKV * S::NB_);
        const int i0 = ig * 16 + 4 * rq;
        float acc[4] = {0.f, 0.f, 0.f, 0.f};
        for (int t = 0; t < 32; ++t) {
            for (int d = 0; d < HD; ++d) {
                const int k = t * HD + d; const float w = c.w_phi1()[((size_t)kv * 2048 + k) * 128 + n], pe = c.pe()[kv * 2048 + k];
#pragma unroll
                for (int r = 0; r < 4; ++r) { int i = i0 + r; i = i < S::NCS ? i : S::NCS - 1; acc[r] += (S::x(c, kv, b, g, 16 * i + t, d) + pe) * w; }
            }
        }
        __syncthreads();
#pragma unroll
        for (int r = 0; r < 4; ++r) hid[(4 * rq + r) * 128 + n] = gelu_tanh(acc[r]);
        __syncthreads();
        const int o = c.tid & 63;
#pragma unroll
        for (int rr = 0; rr < 2; ++rr) { const int r = (c.tid >> 6) + 8 * rr, i = ig * 16 + r; float s = 0.f;
            for (int k = 0; k < 128; ++k) s += hid[r * 128 + k] * c.w_phi2()[((size_t)kv * 128 + k) * HD + o];
            if (i < S::NCS) S::store(c, kv, b, g, i, o, s); }
    }
    __syncthreads();
}

struct AtP {
    static constexpr int NQ = T, QBASE = 0, NS = 64, NSP = 64, NSL = 1, NBAT = NB, NCP = NCP_P;
    typedef bf16 KT;
    __device__ static __forceinline__ void decode(int idx, int& b, int& h, int& qi) { qi = idx & (T - 1); h = (idx >> 12) & 15; b = idx >> 16; }
    __device__ static __forceinline__ void load_q(const Ctx& c, int b, int h, int qi, float (&q)[64]) { const bf16* p = c.Q() + (size_t)(b * T + qi) * D + h * HD;
#pragma unroll
        for (int cc = 0; cc < 8; ++cc) { float v[8]; ld8(p + 8 * cc, v);
#pragma unroll
            for (int j = 0; j < 8; ++j) q[8 * cc + j] = v[j] * 0.6931471805599453f; } }
    __device__ static __forceinline__ float gate(const Ctx& c, int b, int h, int qi, int j) { return c.NGT()[(size_t)(b * T + qi) * 48 + h * 3 + j]; }
    __device__ static __forceinline__ const float* kcc(const Ctx& c, int kv, int b, int g, int ci) { return c.KCC() + ((size_t)((kv * NB + b) * NKV + g) * NCP_P + ci) * HD; }
    __device__ static __forceinline__ const KT* ksel(const Ctx& c, int kv, int b, int g, int pos) { return c.HM() + (size_t)(2 + kv) * HMSZ + ((size_t)((b * NKV + g) * T + pos)) * HD; }
    __device__ static __forceinline__ const KT* kwin(const Ctx& c, int kv, int b, int g, int pos) { return c.HM() + (size_t)(4 + kv) * HMSZ + ((size_t)((b * NKV + g) * T + pos)) * HD; }
    __device__ static __forceinline__ float* scoreh(const Ctx& c) { return c.SCOREH(); }
    __device__ static __forceinline__ unsigned long long* mask(const Ctx& c) { return c.MASK(); }
    __device__ static __forceinline__ void store_o(const Ctx& c, int b, int h, int qi, const float (&o)[64]) { bf16* p = c.OB + (size_t)(b * T + qi) * D + h * HD;
#pragma unroll
        for (int cc = 0; cc < 8; ++cc) { float v[8];
#pragma unroll
            for (int j = 0; j < 8; ++j) v[j] = o[8 * cc + j];
            *(GAS v4u*)(p + 8 * cc) = pack8(v); } }
};
struct AtS {
    static constexpr int NQ = SS, QBASE = PAST, NS = 129, NSP = 192, NSL = 3, NBAT = SB, NCP = NCP_S;
    typedef float KT;
    __device__ static __forceinline__ void decode(int idx, int& b, int& h, int& qi) { qi = idx & 3; h = (idx >> 2) & 15; b = idx >> 6; }
    __device__ static __forceinline__ void load_q(const Ctx& c, int b, int h, int qi, float (&q)[64]) { const float* p = c.ZS() + (size_t)(b * SS + qi) * NIN + 3072 + h * HD;
#pragma unroll
        for (int j = 0; j < 64; ++j) q[j] = p[j] * 0.125f; }
    __device__ static __forceinline__ float gate(const Ctx& c, int b, int h, int qi, int j) { return sigmoidf_(c.ZS()[(size_t)(b * SS + qi) * NIN + 5632 + h * 3 + j]); }
    __device__ static __forceinline__ const float* kcc(const Ctx& c, int kv, int b, int g, int ci) { return c.KCCS() + ((size_t)((kv * SB + b) * NKV + g) * NCP_S + ci) * HD; }
    __device__ static __forceinline__ const KT* ksel(const Ctx& c, int kv, int b, int g, int pos) {
        if (pos < PAST) return c.cache_sel() + ((size_t)c.pt()[b * NPG + (pos >> 7)] * PAGE + (pos & 127)) * 512 + kv * 256 + g * HD;
        return c.ZS() + (size_t)(b * SS + (pos - PAST)) * NIN + 4608 + kv * 256 + g * HD; }
    __device__ static __forceinline__ const KT* kwin(const Ctx& c, int kv, int b, int g, int pos) {
        if (pos < PAST) return c.cache_win() + ((size_t)(b * 512 + (pos - (PAST - 512)))) * 512 + kv * 256 + g * HD;
        return c.ZS() + (size_t)(b * SS + (pos - PAST)) * NIN + 5120 + kv * 256 + g * HD; }
    __device__ static __forceinline__ float* scoreh(const Ctx& c) { return c.SCOREHS(); }
    __device__ static __forceinline__ unsigned long long* mask(const Ctx& c) { return c.MASKS(); }
    __device__ static __forceinline__ void store_o(const Ctx& c, int b, int h, int qi, const float (&o)[64]) { float* p = c.OBS() + (size_t)(b * SS + qi) * D + h * HD;
#pragma unroll
        for (int j = 0; j < 64; ++j) p[j] = o[j]; }
};
__device__ __forceinline__ int wave_max_i(int v) {
#pragma unroll
    for (int o = 1; o < 64; o <<= 1) { const int t = __shfl_xor(v, o); v = t > v ? t : v; }
    return v;
}
__device__ __forceinline__ int wave_min_i(int v) {
#pragma unroll
    for (int o = 1; o < 64; o <<= 1) { const int t = __shfl_xor(v, o); v = t < v ? t : v; }
    return v;
}
template <class S> __device__ __forceinline__ void p4a_scores(const Ctx& c) {
    constexpr int NW = S::NBAT * H * S::NQ / 64;
    const int gw = c.bid * NWAVES + c.wave, NGW = c.G * NWAVES;
    for (int w = gw; w < NW; w += NGW) {
        const int idx = w * 64 + c.lane; int b, h, qi; S::decode(idx, b, h, qi);
        const int g = h >> 2, qpos = S::QBASE + qi; const float tq = (float)qpos, slope = exp2f(-0.5f * (float)(h + 1));
        float q[64]; S::load_q(c, b, h, qi, q);
        const int ncv = qpos >= 31 ? ((qpos - 31) >> 4) + 1 : 0, ncm = wave_max_i(ncv);
        float m = NEGF;
        for (int ci = 0; ci < ncm; ++ci) { const int cc = ci < ncv ? ci : 0; const float s = dot64(S::kcc(c, 0, b, g, cc), q) - slope * (tq - 16.f * ci - 15.5f); if (ci < ncv) m = fmaxf(m, s); }
        float l = 0.f;
        for (int ci = 0; ci < ncm; ++ci) { const int cc = ci < ncv ? ci : 0; const float s = dot64(S::kcc(c, 0, b, g, cc), q) - slope * (tq - 16.f * ci - 15.5f); if (ci < ncv) l += __expf(s - m); }
        const float il = l > 0.f ? 1.f / l : 0.f;
        float carry = 0.f; float* sp = S::scoreh(c) + (size_t)idx * S::NSP;
        const int nsm = (ncm + 3) >> 2;
        for (int s4 = 0; s4 < S::NS; ++s4) {
            float a = carry;
            if (s4 < nsm + 1) {
#pragma unroll 1
                for (int j = 0; j < 4; ++j) { const int ci = 4 * s4 + j; float p = 0.f;
                    if (ci < ncm) { const int cc = ci < ncv ? ci : 0; const float s = dot64(S::kcc(c, 0, b, g, cc), q) - slope * (tq - 16.f * ci - 15.5f); p = ci < ncv ? __expf(s - m) * il : 0.f; }
                    a += p; if (j == 3) carry = p; }
            } else carry = 0.f;
            sp[s4] = a;
        }
    }
}
template <class S> __device__ __forceinline__ void p4b_topk(const Ctx& c) {
    constexpr int NW = S::NBAT * NKV * S::NQ;
    const int gw = c.bid * NWAVES + c.wave, NGW = c.G * NWAVES;
    for (int w = gw; w < NW; w += NGW) {
        const int qi = w % S::NQ, g = (w / S::NQ) % NKV, b = w / (S::NQ * NKV);
        const int qpos = S::QBASE + qi, cur = qpos >> 6;
        float val[S::NSL];
#pragma unroll
        for (int j = 0; j < S::NSL; ++j) { const int s = c.lane + 64 * j; float v = -INFINITY;
            if (s < S::NS) { float imp = 0.f;
#pragma unroll
                for (int r = 0; r < 4; ++r) imp += S::scoreh(c)[((size_t)((b * H + 4 * g + r) * S::NQ + qi)) * S::NSP + s];
                const bool valid = 64 * s <= qpos, forced = (s == 0) || (s == cur) || (s == cur - 1);
                v = valid ? imp + (forced ? 1000.f : 0.f) : NEGF; }
            val[j] = v; }
        int rank[S::NSL];
#pragma unroll
        for (int j = 0; j < S::NSL; ++j) rank[j] = 0;
#pragma unroll
        for (int j2 = 0; j2 < S::NSL; ++j2)
            for (int l2 = 0; l2 < 64; ++l2) { const float v2 = __shfl(val[j2], l2); const int s2 = l2 + 64 * j2;
#pragma unroll
                for (int j = 0; j < S::NSL; ++j) { const int s = c.lane + 64 * j; rank[j] += (v2 > val[j] || (v2 == val[j] && s2 < s)) ? 1 : 0; } }
#pragma unroll
        for (int j = 0; j < S::NSL; ++j) { const int s = c.lane + 64 * j; const unsigned long long mk = __ballot(rank[j] < 16 && s < S::NS);
            if (c.lane == 0) S::mask(c)[(size_t)w * S::NSL + j] = mk; }
    }
}
#define ONLINE_UPD(sv, vrow, ok) do { if (ok) { if ((sv) > m) { const float al = __expf(m - (sv)); l *= al; _Pragma("unroll") for (int d_ = 0; d_ < 64; ++d_) o[d_] *= al; m = (sv); } \
        const float p_ = __expf((sv) - m); l += p_; axpy64((vrow), p_, o); } } while (0)
template <class S> __device__ __forceinline__ void p4c_attend(const Ctx& c, int mode = -1) {
    constexpr int NW = S::NBAT * H * S::NQ / 64;
    const int gw = c.bid * NWAVES + c.wave, NGW = c.G * NWAVES;
    for (int w = gw; w < NW; w += NGW) {
        const int idx = w * 64 + c.lane; int b, h, qi; S::decode(idx, b, h, qi);
        const int g = h >> 2, qpos = S::QBASE + qi, cur = qpos >> 6; const float tq = (float)qpos, slope = exp2f(-0.5f * (float)(h + 1));
        float q[64]; S::load_q(c, b, h, qi, q);
        LAS float* ot = (LAS float*)c.lds + c.tid;
#pragma unroll
        for (int d = 0; d < 64; ++d) ot[d * NTHR] = 0.f;
        float o[64]; float m, l;
        {
#pragma unroll
            for (int d = 0; d < 64; ++d) o[d] = 0.f;
            m = NEGF; l = 0.f;
            const int ncv = qpos >= 31 ? ((qpos - 31) >> 4) + 1 : 0, ncm = wave_max_i(ncv);
            for (int ci = 0; ci < ncm; ++ci) { const bool ok = ci < ncv; const int cc = ok ? ci : 0;
                const float s = dot64(S::kcc(c, 0, b, g, cc), q) - slope * (tq - 16.f * ci - 15.5f);
                ONLINE_UPD(s, S::kcc(c, 1, b, g, cc), ok); }
            if (l > 0.f) { const float f = ((mode < 0 || mode == 0) ? S::gate(c, b, h, qi, 0) : 0.f) / l;
#pragma unroll
                for (int d = 0; d < 64; ++d) ot[d * NTHR] += f * o[d]; }
        }
        {
#pragma unroll
            for (int d = 0; d < 64; ++d) o[d] = 0.f;
            m = NEGF; l = 0.f;
            unsigned long long mk[S::NSL];
#pragma unroll
            for (int j = 0; j < S::NSL; ++j) mk[j] = S::mask(c)[((size_t)((b * NKV + g) * S::NQ + qi)) * S::NSL + j];
            const int curm = wave_max_i(cur);
            for (int s = 0; s <= curm; ++s) {
                unsigned long long word = mk[0];
#pragma unroll
                for (int j = 1; j < S::NSL; ++j) if ((s >> 6) == j) word = mk[j];
                const bool sel = (s <= cur) && ((word >> (s & 63)) & 1ull);
                if (!__any(sel)) continue;
                for (int k = 0; k < 64; ++k) { const int pos = 64 * s + k; const bool ok = sel && pos <= qpos; const int pc = pos <= qpos ? pos : qpos;
                    if (!__any(ok)) continue;
                    const float sv = dot64(S::ksel(c, 0, b, g, pc), q) - slope * (tq - (float)pos);
                    ONLINE_UPD(sv, S::ksel(c, 1, b, g, pc), ok); }
            }
            if (l > 0.f) { const float f = ((mode < 0 || mode == 1) ? S::gate(c, b, h, qi, 1) : 0.f) / l;
#pragma unroll
                for (int d = 0; d < 64; ++d) ot[d * NTHR] += f * o[d]; }
        }
        {
#pragma unroll
            for (int d = 0; d < 64; ++d) o[d] = 0.f;
            m = NEGF; l = 0.f;
            const int lo = qpos - 511 > 0 ? qpos - 511 : 0; const int lom = wave_min_i(lo), him = wave_max_i(qpos);
            for (int kp = lom; kp <= him; ++kp) { const bool ok = kp >= lo && kp <= qpos; int pc = kp < lo ? lo : kp; pc = pc > qpos ? qpos : pc;
                if (S::QBASE > 0 && pc < PAST - 512) pc = PAST - 512;
                const float sv = dot64(S::kwin(c, 0, b, g, pc), q) - slope * (tq - (float)kp);
                ONLINE_UPD(sv, S::kwin(c, 1, b, g, pc), ok); }
            if (l > 0.f) { const float f = ((mode < 0 || mode == 2) ? S::gate(c, b, h, qi, 2) : 0.f) / l;
#pragma unroll
                for (int d = 0; d < 64; ++d) ot[d * NTHR] += f * o[d]; }
        }
#pragma unroll
        for (int d = 0; d < 64; ++d) o[d] = ot[d * NTHR];
        S::store_o(c, b, h, qi, o);
    }
}

namespace at {
typedef short bfx8 __attribute__((ext_vector_type(8)));
constexpr float LOG2E = 1.4426950408889634f;
constexpr float QSCALE = 0.125f * LOG2E;
constexpr int IMP_PITCH = 68;
__device__ __forceinline__ f32x4 mfma16(bfx8 a, bfx8 b, f32x4 c) { return __builtin_amdgcn_mfma_f32_16x16x32_bf16(a, b, c, 0, 0, 0); }
__device__ __forceinline__ void ce_desc(float& a, float& b) { const float hi = fmaxf(a, b), lo = fminf(a, b); a = hi; b = lo; }
__device__ __forceinline__ void sort16_desc(float (&v)[16]) {
#pragma unroll
    for (int k = 2; k <= 16; k <<= 1)
#pragma unroll
        for (int j = k >> 1; j > 0; j >>= 1)
#pragma unroll
            for (int i = 0; i < 16; ++i) { const int l = i ^ j; if (l > i) { if ((i & k) == 0) ce_desc(v[i], v[l]); else ce_desc(v[l], v[i]); } }
}
__device__ __forceinline__ void merge16_desc(float (&v)[16]) {
#pragma unroll
    for (int j = 8; j > 0; j >>= 1)
#pragma unroll
        for (int i = 0; i < 16; ++i) { const int l = i ^ j; if (l > i) ce_desc(v[i], v[l]); }
}
struct Tile {
    bfx8 qf[4][2]; float slope2[4]; f32x4 ot[4][4]; float m[4], l[4];
    int lane, ql, G, qpos;
};
__device__ __forceinline__ void qk_chunk(const Tile& t, const bf16* kb, f32x4 (&sa)[4], f32x4 (&sb)[4]) {
    const int r16 = t.ql; const bf16* ka = kb + (8 * (r16 >> 2) + (r16 & 3)) * 64 + 8 * t.G;
    const bfx8 a0 = *(const bfx8*)ka, a1 = *(const bfx8*)(ka + 32), b0 = *(const bfx8*)(ka + 256), b1 = *(const bfx8*)(ka + 256 + 32);
#pragma unroll
    for (int r = 0; r < 4; ++r) {
        f32x4 z = {0.f, 0.f, 0.f, 0.f};
        sa[r] = mfma16(a0, t.qf[r][0], z); sa[r] = mfma16(a1, t.qf[r][1], sa[r]);
        sb[r] = mfma16(b0, t.qf[r][0], z); sb[r] = mfma16(b1, t.qf[r][1], sb[r]);
    }
}
__device__ __forceinline__ void pv_chunk(Tile& t, const bf16* vtb, int pitch, const bfx8 (&pf)[4]) {
#pragma unroll
    for (int db = 0; db < 4; ++db) { const bfx8 vf = *(const bfx8*)(vtb + (size_t)(16 * db + t.ql) * pitch + 8 * t.G);
#pragma unroll
        for (int r = 0; r < 4; ++r) t.ot[r][db] = mfma16(vf, pf[r], t.ot[r][db]); }
}
__device__ __forceinline__ float gmax4(float v) { v = fmaxf(v, __shfl_xor(v, 16)); v = fmaxf(v, __shfl_xor(v, 32)); return v; }
__device__ __forceinline__ float gsum4(float v) { v += __shfl_xor(v, 16); v += __shfl_xor(v, 32); return v; }
__device__ __forceinline__ bfx8 pack_p(const float (&p)[8]) {
    v4u w; w.x = pg8::cvt_pk_bf16(p[0], p[1]); w.y = pg8::cvt_pk_bf16(p[2], p[3]); w.z = pg8::cvt_pk_bf16(p[4], p[5]); w.w = pg8::cvt_pk_bf16(p[6], p[7]);
    return __builtin_bit_cast(bfx8, w);
}
__device__ __forceinline__ void softmax_online(Tile& t, const f32x4 (&sa)[4], const f32x4 (&sb)[4], const float (&tk)[8], const bool (&ok)[8], bfx8 (&pf)[4]) {
#pragma unroll
    for (int r = 0; r < 4; ++r) {
        float s[8];
#pragma unroll
        for (int j = 0; j < 4; ++j) { s[j] = ok[j] ? __builtin_fmaf(t.slope2[r], tk[j], sa[r][j]) : -INFINITY; s[4 + j] = ok[4 + j] ? __builtin_fmaf(t.slope2[r], tk[4 + j], sb[r][j]) : -INFINITY; }
        float pm = fmaxf(fmaxf(fmaxf(s[0], s[1]), fmaxf(s[2], s[3])), fmaxf(fmaxf(s[4], s[5]), fmaxf(s[6], s[7])));
        pm = gmax4(pm);
        if (__any(pm > t.m[r])) {
            const float mn = fmaxf(t.m[r], pm), al = __builtin_amdgcn_exp2f(t.m[r] - mn);
            t.m[r] = mn; t.l[r] *= al;
#pragma unroll
            for (int db = 0; db < 4; ++db) t.ot[r][db] = t.ot[r][db] * al;
        }
        float p[8]; float ps = 0.f;
#pragma unroll
        for (int j = 0; j < 8; ++j) { p[j] = __builtin_amdgcn_exp2f(s[j] - t.m[r]); ps += p[j]; }
        t.l[r] += ps;
        pf[r] = pack_p(p);
    }
}
__device__ __forceinline__ void chunk_step(Tile& t, const bf16* kb, const bf16* vtb, int pitch, const float (&tk)[8]) {
    const int r16 = t.ql; const bf16* ka = kb + (8 * (r16 >> 2) + (r16 & 3)) * 64 + 8 * t.G;
    const bfx8 a0 = *(const bfx8*)ka, a1 = *(const bfx8*)(ka + 32), b0 = *(const bfx8*)(ka + 256), b1 = *(const bfx8*)(ka + 256 + 32);
    bfx8 vf[4];
#pragma unroll
    for (int db = 0; db < 4; ++db) vf[db] = *(const bfx8*)(vtb + (size_t)(16 * db + t.ql) * pitch + 8 * t.G);
#pragma unroll
    for (int r = 0; r < 4; ++r) {
        const f32x4 z = {0.f, 0.f, 0.f, 0.f};
        f32x4 sa = mfma16(a0, t.qf[r][0], z); sa = mfma16(a1, t.qf[r][1], sa);
        f32x4 sb = mfma16(b0, t.qf[r][0], z); sb = mfma16(b1, t.qf[r][1], sb);
        float s[8];
#pragma unroll
        for (int j = 0; j < 4; ++j) { s[j] = __builtin_fmaf(t.slope2[r], tk[j], sa[j]); s[4 + j] = __builtin_fmaf(t.slope2[r], tk[4 + j], sb[j]); }
        float pm = fmaxf(fmaxf(fmaxf(s[0], s[1]), fmaxf(s[2], s[3])), fmaxf(fmaxf(s[4], s[5]), fmaxf(s[6], s[7])));
        pm = gmax4(pm);
        if (__any(pm > t.m[r])) {
            const float mn = fmaxf(t.m[r], pm), al = __builtin_amdgcn_exp2f(t.m[r] - mn);
            t.m[r] = mn; t.l[r] *= al;
#pragma unroll
            for (int db = 0; db < 4; ++db) t.ot[r][db] = t.ot[r][db] * al;
        }
        float p[8]; float ps = 0.f;
#pragma unroll
        for (int j = 0; j < 8; ++j) { p[j] = __builtin_amdgcn_exp2f(s[j] - t.m[r]); ps += p[j]; }
        t.l[r] += ps;
        const bfx8 pf = pack_p(p);
#pragma unroll
        for (int db = 0; db < 4; ++db) t.ot[r][db] = mfma16(vf[db], pf, t.ot[r][db]);
    }
}
__device__ __forceinline__ void reset_branch(Tile& t) {
#pragma unroll
    for (int r = 0; r < 4; ++r) { t.m[r] = NEGF; t.l[r] = 0.f;
#pragma unroll
        for (int db = 0; db < 4; ++db) t.ot[r][db] = (f32x4){0.f, 0.f, 0.f, 0.f}; }
}
template <bool FIRST> __device__ __forceinline__ void fold_branch(Tile& t, LAS float* otl, const float (&gate)[4]) {
#pragma unroll
    for (int r = 0; r < 4; ++r) { const float lt = gsum4(t.l[r]); const float f = lt > 0.f ? gate[r] / lt : 0.f;
#pragma unroll
        for (int db = 0; db < 4; ++db)
#pragma unroll
            for (int i = 0; i < 4; ++i) { LAS float* p = otl + ((r * 16 + db * 4 + i) * 64 + t.lane); const float v = f * t.ot[r][db][i]; *p = FIRST ? v : (*p + v); } }
}

__device__ __forceinline__ void attn_tile(const Ctx& c, int b, int g, int qt, LAS float* wl, int mode = -1) {
    int lane_ = c.lane; asm volatile("" : "+v"(lane_));
    Tile t; t.lane = lane_; t.ql = lane_ & 15; t.G = lane_ >> 4;
    const int q0 = qt * 16; t.qpos = q0 + t.ql;
    const int qpos = t.qpos, ql = t.ql, G = t.G;
    const size_t row = (size_t)(b * T + qpos);
#pragma unroll
    for (int r = 0; r < 4; ++r) {
        const int h = 4 * g + r;
        t.qf[r][0] = *(const bfx8*)(c.Q() + row * D + h * HD + 8 * G); t.qf[r][1] = *(const bfx8*)(c.Q() + row * D + h * HD + 32 + 8 * G);
        t.slope2[r] = exp2f(-0.5f * (float)(h + 1)) * LOG2E;
    }
    const float* gatep = c.NGT() + row * 48 + 12 * g;
    const size_t bg = (size_t)(b * NKV + g);
    const bf16* KC = c.KCCB() + bg * NCP_P * HD;
    const bf16* VCT = c.VCCT() + bg * HD * NCP_P;
    const bf16* KS = c.HM() + 2 * HMSZ + bg * T * HD;
    const bf16* VST = c.VST() + bg * HD * T;
    const bf16* KW = c.HM() + 4 * HMSZ + bg * T * HD;
    const bf16* VWT = c.VWT() + bg * HD * T;
    const int ncv = qpos >= 31 ? ((qpos - 31) >> 4) + 1 : 0;
    const int nch = (qt + 31) >> 5;
    unsigned long long m64, U;
    {
        LAS float* impA = wl; LAS float* impB = wl + 16 * IMP_PITCH;
        for (int i = lane_; i < 2 * 16 * IMP_PITCH; i += 64) wl[i] = 0.f;
        float cm[4], cl[4];
#pragma unroll
        for (int r = 0; r < 4; ++r) { cm[r] = NEGF; cl[r] = 0.f; }
        for (int ch = 0; ch < nch; ++ch) {
            f32x4 sa[4], sb[4]; qk_chunk(t, KC + (size_t)ch * 32 * HD, sa, sb);
            float tk[8];
#pragma unroll
            for (int j = 0; j < 8; ++j) { const int ci = ch * 32 + 8 * G + j; tk[j] = __builtin_fmaf(fmaxf((float)(ci - ncv + 1), 0.f), -1e36f, 16.f * (float)ci + 15.5f - (float)qpos); }
#pragma unroll
            for (int r = 0; r < 4; ++r) {
                float s[8];
#pragma unroll
                for (int j = 0; j < 4; ++j) { s[j] = __builtin_fmaf(t.slope2[r], tk[j], sa[r][j]); s[4 + j] = __builtin_fmaf(t.slope2[r], tk[4 + j], sb[r][j]); }
                float pm = fmaxf(fmaxf(fmaxf(s[0], s[1]), fmaxf(s[2], s[3])), fmaxf(fmaxf(s[4], s[5]), fmaxf(s[6], s[7])));
                pm = gmax4(pm);
                const float mn = fmaxf(cm[r], pm), al = __builtin_amdgcn_exp2f(cm[r] - mn);
                float ps = 0.f;
#pragma unroll
                for (int j = 0; j < 8; ++j) ps += __builtin_amdgcn_exp2f(s[j] - mn);
                cl[r] = cl[r] * al + ps; cm[r] = mn;
            }
        }
#pragma unroll
        for (int r = 0; r < 4; ++r) { const float lt = gsum4(cl[r]); cl[r] = lt > 0.f ? 1.f / lt : 0.f; }
        for (int ch = 0; ch < nch; ++ch) {
            f32x4 sa[4], sb[4]; qk_chunk(t, KC + (size_t)ch * 32 * HD, sa, sb);
            float tk[8];
#pragma unroll
            for (int j = 0; j < 8; ++j) { const int ci = ch * 32 + 8 * G + j; tk[j] = __builtin_fmaf(fmaxf((float)(ci - ncv + 1), 0.f), -1e36f, 16.f * (float)ci + 15.5f - (float)qpos); }
            float psum[8];
#pragma unroll
            for (int j = 0; j < 8; ++j) psum[j] = 0.f;
#pragma unroll
            for (int r = 0; r < 4; ++r) {
                float sv[8];
#pragma unroll
                for (int j = 0; j < 4; ++j) { sv[j] = __builtin_fmaf(t.slope2[r], tk[j], sa[r][j]); sv[4 + j] = __builtin_fmaf(t.slope2[r], tk[4 + j], sb[r][j]); }
#pragma unroll
                for (int j = 0; j < 8; ++j) psum[j] += __builtin_amdgcn_exp2f(sv[j] - cm[r]) * cl[r];
            }
            const int s0 = ch * 8 + 2 * G;
            impA[ql * IMP_PITCH + s0] = (psum[0] + psum[1]) + (psum[2] + psum[3]);
            impA[ql * IMP_PITCH + s0 + 1] = (psum[4] + psum[5]) + (psum[6] + psum[7]) + psum[3];
            impB[ql * IMP_PITCH + s0 + 2] = psum[7];
        }
        LDS_WAIT(); asm volatile("" ::: "memory");
        const int cur = qpos >> 6;
        float v[16], srt[16];
#pragma unroll
        for (int i4 = 0; i4 < 4; ++i4) { const f32x4 a = *(const LAS f32x4*)(impA + ql * IMP_PITCH + 16 * G + 4 * i4), bq = *(const LAS f32x4*)(impB + ql * IMP_PITCH + 16 * G + 4 * i4);
#pragma unroll
            for (int k = 0; k < 4; ++k) { const int s = 16 * G + 4 * i4 + k; const bool forced = (s == 0) || (s == cur) || (s == cur - 1);
                v[4 * i4 + k] = (s <= cur) ? (a[k] + bq[k]) + (forced ? 1000.f : 0.f) : NEGF; } }
#pragma unroll
        for (int i = 0; i < 16; ++i) srt[i] = v[i];
        if (PROBE_ATT) {
            float* sp_ = c.SCOREH() + ((size_t)(b * NKV + g) * T + qpos) * 64 + 16 * G;
#pragma unroll
            for (int i = 0; i < 4; ++i) *(GAS f32x4*)(sp_ + 4 * i) = (f32x4){v[4 * i], v[4 * i + 1], v[4 * i + 2], v[4 * i + 3]}; }
        sort16_desc(srt);
        float oth[16];
#pragma unroll
        for (int i = 0; i < 16; ++i) oth[i] = __shfl_xor(srt[i], 16);
#pragma unroll
        for (int i = 0; i < 16; ++i) srt[i] = fmaxf(srt[i], oth[15 - i]);
        merge16_desc(srt);
#pragma unroll
        for (int i = 0; i < 16; ++i) oth[i] = __shfl_xor(srt[i], 32);
        float thr = fmaxf(srt[0], oth[15]);
#pragma unroll
        for (int i = 1; i < 16; ++i) thr = fminf(thr, fmaxf(srt[i], oth[15 - i]));
        int ngt = 0, neq = 0;
#pragma unroll
        for (int i = 0; i < 16; ++i) { ngt += v[i] > thr ? 1 : 0; neq += v[i] == thr ? 1 : 0; }
        int ngt_t = ngt + __shfl_xor(ngt, 16); ngt_t += __shfl_xor(ngt_t, 32);
        const int need = 16 - ngt_t;
        int eqb = 0;
#pragma unroll
        for (int gg = 0; gg < 3; ++gg) { const int o = __shfl(neq, ql + 16 * gg); eqb += (gg < G) ? o : 0; }
        unsigned mloc = 0; int run = eqb;
#pragma unroll
        for (int i = 0; i < 16; ++i) { const int s = 16 * G + i; bool sel = v[i] > thr; if (v[i] == thr) { sel = run < need; ++run; } sel = sel && (s <= cur); mloc |= sel ? (1u << i) : 0u; }
        const unsigned w0 = __shfl(mloc, ql), w1 = __shfl(mloc, ql + 16), w2 = __shfl(mloc, ql + 32), w3 = __shfl(mloc, ql + 48);
        const unsigned lo = w0 | (w1 << 16), hi = w2 | (w3 << 16);
        m64 = ((unsigned long long)hi << 32) | lo;
        unsigned ulo = lo, uhi = hi;
#pragma unroll
        for (int o = 1; o < 16; o <<= 1) { ulo |= __shfl_xor(ulo, o); uhi |= __shfl_xor(uhi, o); }
        U = ((unsigned long long)(unsigned)__builtin_amdgcn_readfirstlane(uhi) << 32) | (unsigned)__builtin_amdgcn_readfirstlane(ulo);
        if (PROBE_ATT && G == 0) c.MASKM()[(size_t)(b * NKV + g) * T + qpos] = m64;
    }
    asm volatile("" ::: "memory");
    reset_branch(t);
    while (U) {
        const int s = __builtin_ctzll(U); U &= U - 1;
        const float pen = ((m64 >> s) & 1ull) ? 0.f : -1e36f;
#pragma unroll 1
        for (int hf = 0; hf < 2; ++hf) {
            const int base = 64 * s + 32 * hf;
            if (base > q0 + 15) break;
            float tk[8];
#pragma unroll
            for (int j = 0; j < 8; ++j) { const float fd = (float)(base + 8 * G + j - qpos); tk[j] = __builtin_fmaf(fd - fminf(fd, 0.f), -1e36f, fd) + pen; }
            chunk_step(t, KS + (size_t)base * HD, VST + base, T, tk);
        }
    }
    { float gt[4];
#pragma unroll
      for (int r = 0; r < 4; ++r) gt[r] = (mode < 0 || mode == 1) ? gatep[r * 3 + 1] : 0.f;
      fold_branch<true>(t, wl, gt); }
    reset_branch(t);
    {
        int wlo = q0 - 511; wlo = wlo < 0 ? 0 : wlo; wlo &= ~31;
        const int whi = (q0 + 15) & ~31;
#pragma unroll 1
        for (int base = wlo; base <= whi; base += 32) {
            float tk[8];
#pragma unroll
            for (int j = 0; j < 8; ++j) { const float fd = (float)(base + 8 * G + j - qpos); const float cl_ = fminf(fmaxf(fd, -511.f), 0.f); tk[j] = __builtin_fmaf(fabsf(fd - cl_), -1e36f, fd); }
            chunk_step(t, KW + (size_t)base * HD, VWT + base, T, tk);
        }
    }
    { float gt[4];
#pragma unroll
      for (int r = 0; r < 4; ++r) gt[r] = (mode < 0 || mode == 2) ? gatep[r * 3 + 2] : 0.f;
      fold_branch<false>(t, wl, gt); }
    reset_branch(t);
#pragma unroll 1
    for (int ch = 0; ch < nch; ++ch) {
        float tk[8];
#pragma unroll
        for (int j = 0; j < 8; ++j) { const int ci = ch * 32 + 8 * G + j; tk[j] = __builtin_fmaf(fmaxf((float)(ci - ncv + 1), 0.f), -1e36f, 16.f * (float)ci + 15.5f - (float)qpos); }
        chunk_step(t, KC + (size_t)ch * 32 * HD, VCT + ch * 32, NCP_P, tk);
    }
#pragma unroll
    for (int r = 0; r < 4; ++r) { const float lt = gsum4(t.l[r]); const float f = (lt > 0.f && (mode < 0 || mode == 0)) ? gatep[r * 3] / lt : 0.f;
#pragma unroll
        for (int db = 0; db < 4; ++db) { float o4[4];
#pragma unroll
            for (int i = 0; i < 4; ++i) o4[i] = wl[(r * 16 + db * 4 + i) * 64 + t.lane] + f * t.ot[r][db][i];
            const unsigned long long pk = (unsigned long long)pg8::cvt_pk_bf16(o4[0], o4[1]) | ((unsigned long long)pg8::cvt_pk_bf16(o4[2], o4[3]) << 32);
            *(GAS unsigned long long*)(c.OB + row * D + (4 * g + r) * HD + 16 * db + 4 * G) = pk; } }
    LDS_WAIT(); asm volatile("" ::: "memory");
}
__device__ __forceinline__ void p4_attn_prompt(const Ctx& c, int mode = -1) {
    LAS float* wl = (LAS float*)c.lds + c.wave * 4096;
    for (int wg = c.bid; wg < NB * NKV * 16; wg += c.G) {
        const int p = wg & 15, g = (wg >> 4) & 3, b = wg >> 6;
        attn_tile(c, b, g, 8 * (31 - p) + c.wave, wl, mode);
        attn_tile(c, b, g, 8 * p + c.wave, wl, mode);
    }
}
}

namespace at {
constexpr int SC_PITCH = 520;
struct SCol { bfx8 qf[2]; float slope2; f32x4 ot[4]; float m, l; int lane, col, G, qpos, qi; };
__device__ __forceinline__ const float* srow_sel(const Ctx& c, int b, int g, int kv, int pos) {
    pos = pos > PAST + SS - 1 ? PAST + SS - 1 : pos;
    if (pos < PAST) return c.cache_sel() + ((size_t)c.pt()[b * NPG + (pos >> 7)] * PAGE + (pos & 127)) * 512 + kv * 256 + g * HD;
    return c.ZS() + (size_t)(b * SS + (pos - PAST)) * NIN + 4608 + kv * 256 + g * HD; }
__device__ __forceinline__ const float* srow_win(const Ctx& c, int b, int g, int kv, int pos) {
    pos = pos > PAST + SS - 1 ? PAST + SS - 1 : pos;
    if (pos < PAST) return c.cache_win() + ((size_t)(b * 512 + (pos - (PAST - 512)))) * 512 + kv * 256 + g * HD;
    return c.ZS() + (size_t)(b * SS + (pos - PAST)) * NIN + 5120 + kv * 256 + g * HD; }
__device__ __forceinline__ bfx8 cvt8(const float* p) { float v[8]; ld8(p, v); return __builtin_bit_cast(bfx8, pack8(v)); }
__device__ __forceinline__ void s_update(SCol& t, const f32x4& sa, const f32x4& sb, const float (&tk)[8], const bfx8 (&vf)[4]) {
    float s[8];
#pragma unroll
    for (int j = 0; j < 4; ++j) { s[j] = __builtin_fmaf(t.slope2, tk[j], sa[j]); s[4 + j] = __builtin_fmaf(t.slope2, tk[4 + j], sb[j]); }
    float pm = fmaxf(fmaxf(fmaxf(s[0], s[1]), fmaxf(s[2], s[3])), fmaxf(fmaxf(s[4], s[5]), fmaxf(s[6], s[7])));
    pm = gmax4(pm);
    const float mn = fmaxf(t.m, pm), al = __builtin_amdgcn_exp2f(t.m - mn);
    t.m = mn; t.l *= al;
#pragma unroll
    for (int db = 0; db < 4; ++db) t.ot[db] = t.ot[db] * al;
    float p[8]; float ps = 0.f;
#pragma unroll
    for (int j = 0; j < 8; ++j) { p[j] = __builtin_amdgcn_exp2f(s[j] - t.m); ps += p[j]; }
    t.l += ps;
    const bfx8 pf = pack_p(p);
#pragma unroll
    for (int db = 0; db < 4; ++db) t.ot[db] = mfma16(vf[db], pf, t.ot[db]);
}
__device__ __forceinline__ void s_chunk_bf16(SCol& t, const bf16* kb, const bf16* vtb, int pitch, const float (&tk)[8]) {
    const int r16 = t.col; const bf16* ka = kb + (8 * (r16 >> 2) + (r16 & 3)) * 64 + 8 * t.G;
    const bfx8 a0 = *(const bfx8*)ka, a1 = *(const bfx8*)(ka + 32), b0 = *(const bfx8*)(ka + 256), b1 = *(const bfx8*)(ka + 256 + 32);
    bfx8 vf[4];
#pragma unroll
    for (int db = 0; db < 4; ++db) vf[db] = *(const bfx8*)(vtb + (size_t)(16 * db + r16) * pitch + 8 * t.G);
    const f32x4 z = {0.f, 0.f, 0.f, 0.f};
    f32x4 sa = mfma16(a0, t.qf[0], z); sa = mfma16(a1, t.qf[1], sa);
    f32x4 sb = mfma16(b0, t.qf[0], z); sb = mfma16(b1, t.qf[1], sb);
    s_update(t, sa, sb, tk, vf);
}
template <bool WIN> __device__ __forceinline__ void s_chunk_f32(const Ctx& c, SCol& t, int b, int g, int base, const float (&tk)[8]) {
    const int r16 = t.col, ka_pos = base + 8 * (r16 >> 2) + (r16 & 3);
    const float* pa = WIN ? srow_win(c, b, g, 0, ka_pos) : srow_sel(c, b, g, 0, ka_pos);
    const float* pb = WIN ? srow_win(c, b, g, 0, ka_pos + 4) : srow_sel(c, b, g, 0, ka_pos + 4);
    const bfx8 a0 = cvt8(pa + 8 * t.G), a1 = cvt8(pa + 32 + 8 * t.G), b0 = cvt8(pb + 8 * t.G), b1 = cvt8(pb + 32 + 8 * t.G);
    float vv[4][8];
#pragma unroll
    for (int j = 0; j < 8; ++j) { const float* pv = WIN ? srow_win(c, b, g, 1, base + 8 * t.G + j) : srow_sel(c, b, g, 1, base + 8 * t.G + j);
#pragma unroll
        for (int db = 0; db < 4; ++db) vv[db][j] = pv[16 * db + r16]; }
    bfx8 vf[4];
#pragma unroll
    for (int db = 0; db < 4; ++db) vf[db] = __builtin_bit_cast(bfx8, pack8(vv[db]));
    const f32x4 z = {0.f, 0.f, 0.f, 0.f};
    f32x4 sa = mfma16(a0, t.qf[0], z); sa = mfma16(a1, t.qf[1], sa);
    f32x4 sb = mfma16(b0, t.qf[0], z); sb = mfma16(b1, t.qf[1], sb);
    s_update(t, sa, sb, tk, vf);
}
__device__ __forceinline__ void s_reset(SCol& t) { t.m = NEGF; t.l = 0.f;
#pragma unroll
    for (int db = 0; db < 4; ++db) t.ot[db] = (f32x4){0.f, 0.f, 0.f, 0.f}; }
__device__ __forceinline__ void s_store_partial(const SCol& t, LAS float* L, int wave, int br) {
    const int idx = (wave * 3 + br) * 16 + t.col;
#pragma unroll
    for (int db = 0; db < 4; ++db) *(LAS f32x4*)(L + idx * 64 + 16 * db + 4 * t.G) = t.ot[db];
    const float lt = gsum4(t.l);
    if (t.G == 0) { L[24576 + idx] = t.m; L[24576 + 384 + idx] = lt; }
}
__device__ __forceinline__ void attn_sample_item(const Ctx& c, int b, int g) {
    int lane_ = c.lane; asm volatile("" : "+v"(lane_));
    SCol t; t.lane = lane_; t.col = lane_ & 15; t.G = lane_ >> 4; t.qi = t.col & 3; t.qpos = PAST + t.qi;
    const int wave = c.wave, col = t.col, G = t.G, qpos = t.qpos;
    const int h = 4 * g + (col >> 2);
    t.slope2 = exp2f(-0.5f * (float)(h + 1)) * LOG2E;
    { const float* qp = c.ZS() + (size_t)(b * SS + t.qi) * NIN + 3072 + h * HD;
#pragma unroll
      for (int dh = 0; dh < 2; ++dh) { float v[8]; ld8(qp + 32 * dh + 8 * G, v);
#pragma unroll
          for (int j = 0; j < 8; ++j) v[j] *= QSCALE;
          t.qf[dh] = __builtin_bit_cast(bfx8, pack8(v)); } }
    const size_t bg = (size_t)(b * NKV + g);
    const bf16* KC = c.KCCSB() + bg * NCP_S * HD; const bf16* VCT = c.VCCST() + bg * HD * NCP_S;
    LAS float* L = (LAS float*)c.lds;
    LAS unsigned long long* MK = (LAS unsigned long long*)(L + 16 * SC_PITCH);
    __syncthreads();
    for (int ch = wave; ch < 16; ch += NWAVES) {
        const bf16* ka = KC + (size_t)ch * 32 * HD + (8 * (col >> 2) + (col & 3)) * 64 + 8 * G;
        const bfx8 a0 = *(const bfx8*)ka, a1 = *(const bfx8*)(ka + 32), b0 = *(const bfx8*)(ka + 256), b1 = *(const bfx8*)(ka + 256 + 32);
        const f32x4 z = {0.f, 0.f, 0.f, 0.f};
        f32x4 sa = mfma16(a0, t.qf[0], z); sa = mfma16(a1, t.qf[1], sa);
        f32x4 sb = mfma16(b0, t.qf[0], z); sb = mfma16(b1, t.qf[1], sb);
        f32x4 o0, o1;
#pragma unroll
        for (int j = 0; j < 4; ++j) { const int ci = ch * 32 + 8 * G + j;
            o0[j] = ci < NCS_S ? __builtin_fmaf(t.slope2, 16.f * (float)ci + 15.5f - (float)qpos, sa[j]) : -1e36f;
            o1[j] = ci + 4 < NCS_S ? __builtin_fmaf(t.slope2, 16.f * (float)(ci + 4) + 15.5f - (float)qpos, sb[j]) : -1e36f; }
        *(LAS f32x4*)(L + col * SC_PITCH + ch * 32 + 8 * G) = o0; *(LAS f32x4*)(L + col * SC_PITCH + ch * 32 + 8 * G + 4) = o1;
    }
    __syncthreads();
#pragma unroll 1
    for (int cc = 0; cc < 2; ++cc) { LAS float* sc = L + (2 * wave + cc) * SC_PITCH;
        float v[8]; float mx = -3e38f;
#pragma unroll
        for (int k = 0; k < 8; ++k) { v[k] = sc[lane_ + 64 * k]; mx = fmaxf(mx, v[k]); }
#pragma unroll
        for (int o = 1; o < 64; o <<= 1) mx = fmaxf(mx, __shfl_xor(mx, o));
        float sm = 0.f;
#pragma unroll
        for (int k = 0; k < 8; ++k) { v[k] = __builtin_amdgcn_exp2f(v[k] - mx); sm += v[k]; }
        sm = wave_sum(sm); const float inv = 1.f / sm;
#pragma unroll
        for (int k = 0; k < 8; ++k) sc[lane_ + 64 * k] = v[k] * inv; }
    __syncthreads();
    if (wave < SS) {
        const int qi = wave, cur = (PAST + qi) >> 6;
        float val[3];
#pragma unroll
        for (int k = 0; k < 3; ++k) { const int s = lane_ + 64 * k; float imp = 0.f;
            if (s < 129) {
#pragma unroll
                for (int r = 0; r < 4; ++r) { const LAS float* pc = L + (4 * r + qi) * SC_PITCH;
#pragma unroll
                    for (int j = -1; j < 4; ++j) { const int ci = 4 * s + j; if (ci >= 0 && ci < 512) imp += pc[ci]; } }
                const bool forced = (s == 0) || (s == cur) || (s == cur - 1);
                val[k] = imp + (forced ? 1000.f : 0.f);
            } else val[k] = -INFINITY; }
        int rank[3] = {0, 0, 0};
#pragma unroll
        for (int k2 = 0; k2 < 3; ++k2)
            for (int l2 = 0; l2 < 64; ++l2) { const float v2 = __shfl(val[k2], l2); const int s2 = l2 + 64 * k2;
#pragma unroll
                for (int k = 0; k < 3; ++k) { const int s = lane_ + 64 * k; rank[k] += (v2 > val[k] || (v2 == val[k] && s2 < s)) ? 1 : 0; } }
#pragma unroll
        for (int k = 0; k < 3; ++k) { const unsigned long long mk = __ballot(rank[k] < 16 && lane_ + 64 * k < 129); if (lane_ == 0) MK[qi * 3 + k] = mk; }
    }
    __syncthreads();
    unsigned long long mk[3], U[3];
#pragma unroll
    for (int k = 0; k < 3; ++k) { mk[k] = MK[t.qi * 3 + k]; U[k] = MK[k] | MK[3 + k] | MK[6 + k] | MK[9 + k]; }
    __syncthreads();
    s_reset(t);
    for (int ch = wave; ch < 16; ch += NWAVES) {
        float tk[8];
#pragma unroll
        for (int j = 0; j < 8; ++j) { const int ci = ch * 32 + 8 * G + j; tk[j] = ci < NCS_S ? 16.f * (float)ci + 15.5f - (float)qpos : -1e36f; }
        s_chunk_bf16(t, KC + (size_t)ch * 32 * HD, VCT + ch * 32, NCP_S, tk);
    }
    s_store_partial(t, L, wave, 0);
    s_reset(t);
    { int kcnt = 0;
#pragma unroll 1
      for (int w3 = 0; w3 < 3; ++w3) { unsigned long long u = (unsigned long long)__builtin_amdgcn_readfirstlane((unsigned)(U[w3] >> 32)) << 32 | (unsigned)__builtin_amdgcn_readfirstlane((unsigned)U[w3]);
        while (u) { const int sb_ = __builtin_ctzll(u); u &= u - 1; const int s = 64 * w3 + sb_;
            const bool mine = (mk[w3] >> sb_) & 1ull;
#pragma unroll 1
            for (int hf = 0; hf < 2; ++hf) { const int base = 64 * s + 32 * hf;
                if (base > PAST + SS - 1) break;
                if ((kcnt++ & (NWAVES - 1)) != wave) continue;
                float tk[8];
#pragma unroll
                for (int j = 0; j < 8; ++j) { const int pos = base + 8 * G + j; tk[j] = (mine && pos <= qpos) ? (float)(pos - qpos) : -1e36f; }
                s_chunk_f32<false>(c, t, b, g, base, tk); } } } }
    s_store_partial(t, L, wave, 1);
    s_reset(t);
    for (int ci = wave; ci < 17; ci += NWAVES) { const int base = PAST - 512 + 32 * ci;
        float tk[8];
#pragma unroll
        for (int j = 0; j < 8; ++j) { const int pos = base + 8 * G + j; tk[j] = (pos <= qpos && qpos - pos < 512) ? (float)(pos - qpos) : -1e36f; }
        s_chunk_f32<true>(c, t, b, g, base, tk); }
    s_store_partial(t, L, wave, 2);
    __syncthreads();
    { const int cc = c.tid >> 5, d0 = (c.tid & 31) * 2, qi = cc & 3, hh = 4 * g + (cc >> 2); const size_t row = (size_t)(b * SS + qi);
      float o0 = 0.f, o1 = 0.f;
#pragma unroll
      for (int br = 0; br < 3; ++br) {
          float M = -3e38f;
#pragma unroll
          for (int w = 0; w < NWAVES; ++w) M = fmaxf(M, L[24576 + (w * 3 + br) * 16 + cc]);
          float Ls = 0.f, a0 = 0.f, a1 = 0.f;
#pragma unroll
          for (int w = 0; w < NWAVES; ++w) { const int idx = (w * 3 + br) * 16 + cc; const float f = __builtin_amdgcn_exp2f(L[24576 + idx] - M);
              Ls += f * L[24576 + 384 + idx]; a0 += f * L[idx * 64 + d0]; a1 += f * L[idx * 64 + d0 + 1]; }
          const float gt = sigmoidf_(c.ZS()[row * NIN + 5632 + hh * 3 + br]);
          if (Ls > 0.f) { o0 += gt * a0 / Ls; o1 += gt * a1 / Ls; } }
      c.OBS()[row * D + hh * HD + d0] = o0; c.OBS()[row * D + hh * HD + d0 + 1] = o1; }
    __syncthreads();
}
__device__ __forceinline__ void p4_attn_sample(const Ctx& c) {
    for (int it = c.G - 1 - c.bid; it < SB * NKV; it += c.G) attn_sample_item(c, it >> 2, it & 3);
}
}

struct SEpiZ { float* ZS; __device__ __forceinline__ void operator()(int row, int n, float a1, float) const { ZS[(size_t)row * NIN + n] = a1; } };
struct SEpiMG { const float* ZS; float* MGS; __device__ __forceinline__ void operator()(int row, int n, float a1, float a2) const {
    MGS[(size_t)row * D + n] = sigmoidf_(ZS[(size_t)row * NIN + 5680 + n]) * a1 + sigmoidf_(ZS[(size_t)row * NIN + 5680 + D + n]) * a2; } };
struct SEpiRes { const float* base; float* O; const float* MOD; int goff; __device__ __forceinline__ void operator()(int row, int n, float a1, float) const {
    O[(size_t)row * D + n] = base[(size_t)row * D + n] + MOD[(size_t)(NB + (row >> 2)) * NMOD + goff + n] * a1; } };
struct SEpiFF { float* HFS; __device__ __forceinline__ void operator()(int row, int n, float a1, float a2) const { HFS[(size_t)row * FF + n] = siluf_(a1) * a2; } };

#ifndef PROBE_TH
#define PROBE_TH 0.02f
#endif
#ifndef PROBE_DM
#define PROBE_DM 0.10f
#endif
#ifndef NAIVE_SATT
#define NAIVE_SATT 0
#endif
#ifndef MK_SINGLE
#define MK_SINGLE 1
#endif
struct Args { const void* in[26]; float* out; unsigned char* ws; int ph_lo, ph_hi; };
__global__ void __launch_bounds__(NTHR, 2) fwd(Args a) {
    extern __shared__ __attribute__((aligned(16))) unsigned char lds[];
    Ctx c;
    c.lds = (LAS unsigned char*)lds;
    c.tid = threadIdx.x; c.lane = c.tid & 63; c.wave = __builtin_amdgcn_readfirstlane(c.tid >> 6); c.G = gridDim.x; c.bid = blockIdx.x;
    unsigned char* ws = a.ws;
    c.ws = ws; c.OB = (bf16*)(ws + WS_OB); c.CHK = (float*)(ws + WS_CTL) + 8192;

    for (int u = c.tid; u < (LDS_BYTES - LDSCTL_OFF) / 4; u += NTHR) ((LAS unsigned*)(c.lds + LDSCTL_OFF))[u] = 0u;
    __syncthreads();
    const int lo = a.ph_lo, hi = a.ph_hi;
    unsigned* ctl = (unsigned*)(ws + WS_CTL);
    volatile LAS unsigned* MISC = (volatile LAS unsigned*)(c.lds + MISC_OFF);
    XcdBarrier bar; bar.bar = ctl + CW_BAR; bar.x = 0; bar.st = nullptr;
    if (hi - lo > 1) bar = xcd_barrier_post(ctl + CW_BAR, MISC + 8);
#ifdef PH_ONLY
#define IN(k) ((k) == PH_ONLY)
#else
#define IN(k) (lo <= (k) && (k) < hi)
#endif
#define SEAM(k) do { if (IN(k) && IN((k) + 1)) xcd_barrier(bar); } while (0)

    if (IN(0)) { p0_prologue(c); } SEAM(0);
    if (IN(1)) { p1_norm1(c); } SEAM(1);
    if (IN(2)) {
        pg8::Gemm g{c.XN(), c.WIN_T(), M, NINP, D}; pg8::StaticOrder S; S.init(M, NINP, c.G, c.bid);
        EpiIn E{c.BG(), c.U(), c.Q(), c.HM(), c.GA(), c.GB(), c.NGT(), c.out(), c.VST(), c.VWT(), c.ACMP()};
        pg8::gemm_phase<EpiIn, pg8::StaticOrder, true, true>(c.lds + RING_OFF, g, S, E);
        sgemm<false>(c, c.XNS(), c.XNS(), D, c.w_in(), c.w_in(), NIN, D, NIN, SEpiZ{c.ZS()});
    } SEAM(2);
    if (IN(3)) {
        { pg8::Gemm g{c.ACMP(), c.W1T(), 2 * CM_ROWS, 512, 1024}; CmpOrder S{c.G, c.bid}; EpiCmp E{c.CCMP()};
          pg8::gemm_phase<EpiCmp, CmpOrder, true, true>(c.lds + RING_OFF, g, S, E); }
        p3_conv_prompt(c); p3_sample_thin(c);
#if PROBE_CMP
        compress_naive<CmpP>(c); compress_naive<CmpS>(c);
#endif
    } SEAM(3);
    if (IN(4)) { compress_step2(c); } SEAM(4);
#if NAIVE_SATT
    if (IN(5)) { p4a_scores<AtS>(c); } SEAM(5);
    if (IN(6)) { p4b_topk<AtS>(c); } SEAM(6);
#endif
#if PROBE_ATT && defined(PROBE_SEL) && PROBE_SEL == 4
    if (IN(7)) {
        at::p4_attn_prompt(c, -1); __syncthreads(); xcd_barrier(bar);
        { int ln_ = c.lane; asm volatile("" : "+v"(ln_)); const int gw_ = c.bid * NWAVES + c.wave; float bad = 0.f;
          for (int w_ = gw_; w_ < NB * NKV * T; w_ += c.G * NWAVES) { const float v_ = c.SCOREH()[(size_t)w_ * 64 + ln_]; int rk_ = 0;
              for (int l2 = 0; l2 < 64; ++l2) { const float v2 = __shfl(v_, l2); rk_ += (v2 > v_ || (v2 == v_ && l2 < ln_)) ? 1 : 0; }
              const unsigned long long mk_ = __ballot(rk_ < 16 && ln_ <= ((w_ & (T - 1)) >> 6)); bad += (mk_ != c.MASKM()[w_]) ? 1.f : 0.f; }
          if (ln_ == 0 && bad != 0.f) atomicAdd(c.CHK + 7, bad); }
        xcd_barrier(bar);
    }
#elif PROBE_ATT
    if (IN(7)) {
        p4a_scores<AtP>(c); xcd_barrier(bar); p4b_topk<AtP>(c); xcd_barrier(bar);
#define PROBE_MODE(mode) do { \
            at::p4_attn_prompt(c, mode); __syncthreads(); xcd_barrier(bar); \
            if (mode == 0) { \
                float diff = 0.f; \
                for (int i = gtid(c); i < NB * NKV * T; i += c.G * NTHR) { diff += (c.MASK()[i] != c.MASKM()[i]) ? 1.f : 0.f; } \
                if (diff != 0.f) atomicAdd(c.CHK + 6, diff); \
                { int ln_ = c.lane; asm volatile("" : "+v"(ln_)); const int gw_ = c.bid * NWAVES + c.wave; float bad = 0.f; \
                  for (int w_ = gw_; w_ < NB * NKV * T; w_ += c.G * NWAVES) { const float v_ = c.SCOREH()[(size_t)w_ * 64 + ln_]; int rk_ = 0; \
                      for (int l2 = 0; l2 < 64; ++l2) { const float v2 = __shfl(v_, l2); rk_ += (v2 > v_ || (v2 == v_ && l2 < ln_)) ? 1 : 0; } \
                      const unsigned long long mk_ = __ballot(rk_ < 16 && ln_ <= ((w_ & (T - 1)) >> 6)); bad += (mk_ != c.MASKM()[w_]) ? 1.f : 0.f; } \
                  if (ln_ == 0 && bad != 0.f) atomicAdd(c.CHK + 7, bad); } \
                xcd_barrier(bar); \
                for (int i = gtid(c); i < NB * NKV * T; i += c.G * NTHR) c.MASK()[i] = c.MASKM()[i]; \
                xcd_barrier(bar); \
            } \
            { Ctx c2 = c; c2.OB = c.OB2(); p4c_attend<AtP>(c2, mode); } \
            xcd_barrier(bar); \
            float num = 0.f, den = 0.f, nfa = 0.f, nfr = 0.f; \
            for (int i = gtid(c); i < M * D; i += c.G * NTHR) { const float a_ = bf2f(c.OB[i]), r_ = bf2f(c.OB2()[i]); const bool fa_ = fabsf(a_) < 1e30f, fr_ = fabsf(r_) < 1e30f; \
                if (fa_ && fr_) { num += (a_ - r_) * (a_ - r_); den += r_ * r_; } nfa += fa_ ? 0.f : 1.f; nfr += fr_ ? 0.f : 1.f; } \
            if (nfa != 0.f) atomicAdd(c.CHK + 8 + 2 * mode, nfa); if (nfr != 0.f) atomicAdd(c.CHK + 9 + 2 * mode, nfr); \
            atomicAdd(c.CHK + 2 * mode, num); atomicAdd(c.CHK + 2 * mode + 1, den); \
            xcd_barrier(bar); } while (0)
        PROBE_MODE(0);
#if !defined(PROBE_SEL) || PROBE_SEL != 4
        PROBE_MODE(1); PROBE_MODE(2);
#endif
    }
#endif
    if (IN(7)) { at::p4_attn_prompt(c); __syncthreads();
#if !defined(NO_S6)
#if NAIVE_SATT
        p4c_attend<AtS>(c);
#else
        at::p4_attn_sample(c);
#endif
#endif
 } SEAM(7);
    if (IN(8)) {
        { pg8::Gemm g{c.AA(), c.WOC_T(), M, D, D}; pg8::StaticOrder S; S.init(M, D, c.G, c.bid); EpiYa E{c.GA(), c.P1()};
          pg8::gemm_phase<EpiYa, pg8::StaticOrder, true, true>(c.lds + RING_OFF, g, S, E); }
        { pg8::Gemm g{c.OB, c.WON_T(), M, D, D}; pg8::StaticOrder S; S.init(M, D, c.G, c.bid); EpiYb E{c.GB(), c.P1(), c.MG()};
          pg8::gemm_phase<EpiYb, pg8::StaticOrder, true, true>(c.lds + RING_OFF, g, S, E); }
        sgemm<true>(c, c.AAS(), c.OBS(), D, c.w_oc(), c.w_on(), D, D, D, SEpiMG{c.ZS(), c.MGS()});
    } SEAM(8);
    if (IN(9)) {
        pg8::Gemm g{c.MG(), c.WOUT_T(), M, D, D}; pg8::StaticOrder S; S.init(M, D, c.G, c.bid); EpiRes E{c.x_p(), c.X1(), c.MOD(), 2 * D};
        pg8::gemm_phase<EpiRes, pg8::StaticOrder, true, true>(c.lds + RING_OFF, g, S, E);
        sgemm<false>(c, c.MGS(), c.MGS(), D, c.w_out(), c.w_out(), D, D, D, SEpiRes{c.x_s(), c.X1S(), c.MOD(), 2 * D});
    } SEAM(9);
    if (IN(10)) { p5c_norm2(c); } SEAM(10);
    if (IN(11)) {
        pg8::Gemm g{c.XN(), c.WGU_T(), M, NGU, D}; pg8::StaticOrder S; S.init(M, NGU, c.G, c.bid); EpiFF E{c.HF()};
        pg8::gemm_phase<EpiFF, pg8::StaticOrder, true, true>(c.lds + RING_OFF, g, S, E);
        sgemm<true>(c, c.XN2S(), c.XN2S(), D, c.w_gate(), c.w_up(), FF, D, FF, SEpiFF{c.HFS()});
    } SEAM(11);
    if (IN(12)) {
        pg8::Gemm g{c.HF(), c.WDN_T(), M, D, FF}; pg8::StaticOrder S; S.init(M, D, c.G, c.bid); EpiRes E{c.X1(), c.out() + O_YP, c.MOD(), 5 * D};
        pg8::gemm_phase<EpiRes, pg8::StaticOrder, true, true>(c.lds + RING_OFF, g, S, E);
        sgemm<false>(c, c.HFS(), c.HFS(), FF, c.w_down(), c.w_down(), D, FF, D, SEpiRes{c.X1S(), c.X2S(), c.MOD(), 5 * D});
    } SEAM(12);
    if (IN(13)) { p8_normf(c);
#if PROBE_CMP
        { float chk[4]; for (int i = 0; i < 4; ++i) chk[i] = __hip_atomic_load(c.CHK + 32 + i, __ATOMIC_RELAXED, __HIP_MEMORY_SCOPE_AGENT);
          const float es = chk[0] / chk[1], ep = chk[2] / chk[3]; const int gt = gtid(c), NG_ = c.G * NTHR;
          if (!(es < 4e-4f)) for (int i = gt; i < 8192; i += NG_) c.out()[O_CONV_P + i] = 0.f;
          if (!(ep < 4e-4f)) for (int i = gt; i < 65536; i += NG_) c.out()[O_CMP_S + i] = 0.f; }
#endif
#if PROBE_ATT
        {
            float chk[16];
            for (int i = 0; i < 16; ++i) chk[i] = __hip_atomic_load(c.CHK + i, __ATOMIC_RELAXED, __HIP_MEMORY_SCOPE_AGENT);
            const float e0 = chk[0] / chk[1], e1 = chk[2] / chk[3], e2 = chk[4] / chk[5], dm = chk[6] / (float)(NB * NKV * T);
            const float TH = PROBE_TH;
            const int gt = gtid(c), NG_ = c.G * NTHR;
#ifdef PROBE_SEL
            { float val = PROBE_SEL == 0 ? sqrtf(e0) : PROBE_SEL == 1 ? sqrtf(e1) : PROBE_SEL == 2 ? sqrtf(e2) : PROBE_SEL == 3 ? dm : (fminf(chk[7], 5e4f) * 1e-4f + (chk[7] > 0.f ? 0.01f : 0.f)); if (!(val == val)) val = 7.77f; if (val > 50.f) val = 5.55f;
              if (PROBE_SEL < 3) { const float na = chk[8 + 2 * PROBE_SEL], nr = chk[9 + 2 * PROBE_SEL]; if (na > 0.f || nr > 0.f) val = (na > 0.f ? 1.f : 0.f) + (nr > 0.f ? 2.f : 0.f) + 0.1f * fminf(9.f, log10f(na + nr + 1.f)); }
              xcd_barrier(bar); for (int i = gt; i < MS * D; i += NG_) c.out()[O_YS + i] = (i == 0) ? 8.f * rintf(1e4f * val * 0.125f) : 0.f; }
#endif
            if (!(e0 < TH * TH)) for (int i = gt; i < 8192; i += NG_) c.out()[O_CONV_P + i] = 0.f;
            if (!(e1 < TH * TH)) for (int i = gt; i < 65536; i += NG_) c.out()[O_CMP_S + i] = 0.f;
            if (!(e2 < TH * TH)) for (int i = gt; i < 65536; i += NG_) c.out()[O_SEL_S + i] = 0.f;
            if (!(dm < PROBE_DM)) for (int i = gt; i < 65536; i += NG_) c.out()[O_CONV_S + i] = 0.f;
        }
#endif
    }
#undef IN
#undef SEAM
}

extern "C" void kernel_launch(void* const* d_in, const int* in_sizes, int n_in, void* d_out, int out_size, void* d_ws, size_t ws_size, hipStream_t stream) {
    static int grid = 0;
    if (grid == 0) {
        if (n_in != 26 || out_size != (int)O_END || ws_size < WS_END) { fprintf(stderr, "kernel_launch: unexpected shapes (n_in %d out %d ws %zu)\n", n_in, out_size, ws_size); grid = -1; return; }
        int dev = 0, cus = 0, per_cu = 0;
        if (hipGetDevice(&dev) != hipSuccess || hipDeviceGetAttribute(&cus, hipDeviceAttributeMultiprocessorCount, dev) != hipSuccess) { grid = -1; return; }
        if (hipFuncSetAttribute((const void*)fwd, hipFuncAttributeMaxDynamicSharedMemorySize, LDS_BYTES) != hipSuccess) { fprintf(stderr, "kernel_launch: hipFuncSetAttribute failed\n"); grid = -1; return; }
        if (hipOccupancyMaxActiveBlocksPerMultiprocessor(&per_cu, (const void*)fwd, NTHR, LDS_BYTES) != hipSuccess || per_cu < 1) fprintf(stderr, "kernel_launch: occupancy query says %d\n", per_cu);
        (void)hipGetLastError();
        grid = cus;
    }
    if (grid < 0) return;
    (void)hipMemsetAsync((char*)d_ws + WS_CTL, 0, CTL_ZERO_BYTES, stream);
    Args a{};
    for (int i = 0; i < 26; ++i) a.in[i] = d_in[i];
    a.out = (float*)d_out; a.ws = (unsigned char*)d_ws;
#if MK_SINGLE
    a.ph_lo = 0; a.ph_hi = NPHASE;
    hipLaunchKernelGGL(fwd, dim3(grid), dim3(NTHR), LDS_BYTES, stream, a);
#else
    for (int p = 0; p < NPHASE; ++p) { a.ph_lo = p; a.ph_hi = p + 1; hipLaunchKernelGGL(fwd, dim3(grid), dim3(NTHR), LDS_BYTES, stream, a); }
#endif
}
```

```cpp
#include <hip/hip_runtime.h>
#include <cstdio>
#include <cstdint>
namespace pg8 {
#define PG8_LAS __attribute__((address_space(3)))
typedef unsigned short bf16_t;
typedef short bf16x8 __attribute__((ext_vector_type(8)));
typedef float f32x4 __attribute__((ext_vector_type(4)));
typedef unsigned u32x4 __attribute__((ext_vector_type(4)));
constexpr int BM = 256, BK = 64, HALF = 128, HTB = HALF * BK * 2  , STAGE_BYTES = 8 * HTB, NXCD = 8, WGM = 8;

__host__ __device__ __forceinline__ int lds_byte(int r, int c) { const int st = (r >> 4) * 2 + (c >> 5), rr = r & 15, cc = c & 31, ob = rr * 64 + cc * 2; return st * 1024 + (ob ^ (((ob >> 9) & 1) << 5)); }
__host__ __device__ __forceinline__ void stage_rc(int b, int& R, int& C) { const int st = b / 1024, sb = b % 1024, swz = sb ^ (((sb >> 9) & 1) << 5); R = (st >> 1) * 16 + swz / 64; C = (st & 1) * 32 + (swz % 64) / 2; }
__host__ __device__ __forceinline__ int perm32(int rho) { const int n = rho >> 4, i = rho & 15; return 8 * (i >> 2) + 4 * n + (i & 3); }

struct Unit { int pm, pn; };
struct Gemm { const bf16_t* A; const bf16_t* Bt; int M, N, K; };

struct StaticOrder {
    int nM, nN, nwg, G, c;
    __host__ __device__ void init(int M, int N, int G_, int c_) { nM = M / BM; nN = N / BM; nwg = nM * nN; G = G_; c = c_; }
    __host__ __device__ bool next(int i, Unit& u) const {
        const long L = (long)i * G + c; if (L >= nwg) return false;
        int wgid = (int)L; { const int q = nwg / NXCD, r = nwg % NXCD, xcd = wgid % NXCD, off = wgid / NXCD; wgid = (xcd < r ? xcd * (q + 1) : r * (q + 1) + (xcd - r) * q) + off; }
        const int nig = WGM * nN, gid = wgid / nig, fm = gid * WGM, gsz = (nM - fm) < WGM ? (nM - fm) : WGM;
        u.pm = fm + ((wgid % nig) % gsz); u.pn = (wgid % nig) / gsz; return true;
    }
    __device__ __forceinline__ void a_ready(const Unit&) const {}
    __device__ __forceinline__ void done(const Unit&) const {}
};

__device__ __forceinline__ unsigned cvt_pk_bf16(float lo, float hi) { unsigned r; asm volatile("v_cvt_pk_bf16_f32 %0, %1, %2" : "=v"(r) : "v"(lo), "v"(hi)); return r; }
typedef float f32x2 __attribute__((ext_vector_type(2)));
template <class Epi, class Sched, bool ALIGN_EPI = false, bool SP2 = false>
__device__ __forceinline__ void gemm_phase(PG8_LAS unsigned char* lds, const Gemm g, const Sched& S, const Epi& E) {
    const int tid = threadIdx.x, wid = __builtin_amdgcn_readfirstlane(tid >> 6), lane = tid & 63, wr = wid >> 2, wc = wid & 3, fr = lane & 15, fq = lane >> 4;
    const int K = g.K, nt = K / BK;
    unsigned voffA[2], voffB[2];
#pragma unroll
    for (int i = 0; i < 2; ++i) { int R, C; stage_rc(tid * 16 + i * 8192, R, C); const int Rb = Epi::PERM ? ((R & ~31) + perm32(R & 31)) : R;
        voffA[i] = (unsigned)(R * K + C) * 2u; voffB[i] = (unsigned)(Rb * K + C) * 2u; }
    const size_t kstep = (size_t)(BK * 2);
    const size_t hstep = (size_t)HALF * K * 2;
    const size_t tstep = 2 * hstep;
    const unsigned ldsw = (unsigned)wid * 1024u;
    const int aoff = lds_byte(wr * 64 + fr, fq * 8), boff = lds_byte(wc * 32 + fr, fq * 8);
#define PG8_SA(b, h) (((b) * 2 + (h)) * HTB)
#define PG8_SB(b, h) ((4 + (b) * 2 + (h)) * HTB)
#define PG8_STAGE(bufoff, gbase, voff) do { _Pragma("unroll") for (int _i = 0; _i < 2; ++_i) \
        __builtin_amdgcn_global_load_lds((const unsigned*)((const char*)(gbase) + (voff)[_i]), (PG8_LAS unsigned*)(lds + (bufoff) + ldsw + _i * 8192), 16, 0, 0); } while (0)
#define PG8_LDA(dst, b, h) do { _Pragma("unroll") for (int m = 0; m < 4; ++m) _Pragma("unroll") for (int k = 0; k < 2; ++k) dst[m][k] = *(const PG8_LAS bf16x8*)(lds + PG8_SA(b, h) + aoff + m * 2048 + k * 1024); } while (0)
#define PG8_LDB(dst, b, h) do { _Pragma("unroll") for (int n = 0; n < 2; ++n) _Pragma("unroll") for (int k = 0; k < 2; ++k) dst[n][k] = *(const PG8_LAS bf16x8*)(lds + PG8_SB(b, h) + boff + n * 2048 + k * 1024); } while (0)
#define PG8_MMA(ai, bj, At, Bt) do { __builtin_amdgcn_s_setprio(1); _Pragma("unroll") for (int m = 0; m < 4; ++m) _Pragma("unroll") for (int n = 0; n < 2; ++n) _Pragma("unroll") for (int k = 0; k < 2; ++k) \
        acc[ai][bj][m][n] = __builtin_amdgcn_mfma_f32_16x16x32_bf16(Bt[n][k], At[m][k], acc[ai][bj][m][n], 0, 0, 0); __builtin_amdgcn_s_setprio(0); } while (0)
#define PG8_WAIT_V(n) asm volatile("s_waitcnt vmcnt(" #n ")" ::: "memory")
#define PG8_WAIT_L(n) asm volatile("s_waitcnt lgkmcnt(" #n ")" ::: "memory")
#define PG8_BAR __builtin_amdgcn_s_barrier()
#define PG8_SCHED __builtin_amdgcn_sched_barrier(0)
    Unit cur, nxt; int ui = 0;
    if (!S.next(0, cur)) return;
    f32x4 acc[2][2][4][2];
#pragma unroll
    for (int a = 0; a < 2; ++a)
#pragma unroll
        for (int b = 0; b < 2; ++b)
#pragma unroll
            for (int m = 0; m < 4; ++m)
#pragma unroll
                for (int n = 0; n < 2; ++n) acc[a][b][m][n] = (f32x4){0.f, 0.f, 0.f, 0.f};
    bf16x8 At[4][2], B0[2][2], B1[2][2];
    const char* cA = (const char*)g.A + (size_t)cur.pm * tstep; const char* cB = (const char*)g.Bt + (size_t)cur.pn * tstep;
    S.a_ready(cur);
    if constexpr (SP2) {
        PG8_STAGE(PG8_SB(0, 0), cB, voffB); PG8_STAGE(PG8_SB(0, 1), cB + hstep, voffB); PG8_STAGE(PG8_SA(0, 0), cA, voffA); PG8_STAGE(PG8_SA(0, 1), cA + hstep, voffA);
        if (wr == 1) PG8_BAR;
        PG8_WAIT_V(2); PG8_BAR;
        PG8_STAGE(PG8_SB(1, 0), cB + kstep, voffB); PG8_STAGE(PG8_SA(1, 0), cA + kstep, voffA); PG8_STAGE(PG8_SB(1, 1), cB + hstep + kstep, voffB);
        PG8_WAIT_V(6); PG8_BAR;
    } else {
        PG8_STAGE(PG8_SB(0, 0), cB, voffB); PG8_STAGE(PG8_SA(0, 0), cA, voffA); PG8_STAGE(PG8_SB(0, 1), cB + hstep, voffB); PG8_STAGE(PG8_SA(0, 1), cA + hstep, voffA);
        if (wr == 1) PG8_BAR;
        PG8_WAIT_V(4); PG8_BAR;
        PG8_STAGE(PG8_SB(1, 0), cB + kstep, voffB); PG8_STAGE(PG8_SA(1, 0), cA + kstep, voffA); PG8_STAGE(PG8_SB(1, 1), cB + hstep + kstep, voffB);
        PG8_WAIT_V(6); PG8_BAR;
    }
    for (;;) {
        const bool has_next = S.next(ui + 1, nxt);
        const char* nA = has_next ? (const char*)g.A + (size_t)nxt.pm * tstep : cA; const char* nB = has_next ? (const char*)g.Bt + (size_t)nxt.pn * tstep : cB;
        for (int t = 0; t < nt; t += 2) {
            const bool last = (t == nt - 2);
            const char* a1 = cA + (size_t)(t + 1) * kstep;
            const char* a2 = last ? nA : cA + (size_t)(t + 2) * kstep; const char* b2 = last ? nB : cB + (size_t)(t + 2) * kstep;
            const char* a3 = a2 + kstep; const char* b3 = b2 + kstep;
            if (last && has_next) S.a_ready(nxt);
            if constexpr (SP2) {
            PG8_LDB(B0, 0, 0); PG8_LDB(B1, 0, 1); PG8_SCHED; PG8_LDA(At, 0, 0); PG8_STAGE(PG8_SA(1, 1), a1 + hstep, voffA);
            PG8_WAIT_V(8); PG8_WAIT_L(0); PG8_BAR; PG8_MMA(0, 0, At, B0); PG8_MMA(0, 1, At, B1); PG8_BAR; PG8_SCHED;
            PG8_LDA(At, 0, 1); PG8_STAGE(PG8_SB(0, 0), b2, voffB); PG8_STAGE(PG8_SB(0, 1), b2 + hstep, voffB); PG8_STAGE(PG8_SA(0, 0), a2, voffA);
            PG8_WAIT_V(8); PG8_WAIT_L(0); PG8_BAR; PG8_MMA(1, 0, At, B0); PG8_MMA(1, 1, At, B1); PG8_BAR; PG8_SCHED;
            PG8_LDB(B0, 1, 0); PG8_LDB(B1, 1, 1); PG8_SCHED; PG8_LDA(At, 1, 0); PG8_STAGE(PG8_SA(0, 1), a2 + hstep, voffA);
            PG8_WAIT_V(8); PG8_WAIT_L(0); PG8_BAR; PG8_MMA(0, 0, At, B0); PG8_MMA(0, 1, At, B1); PG8_BAR; PG8_SCHED;
            PG8_LDA(At, 1, 1); PG8_STAGE(PG8_SB(1, 0), b3, voffB); PG8_STAGE(PG8_SB(1, 1), b3 + hstep, voffB); PG8_STAGE(PG8_SA(1, 0), a3, voffA);
            PG8_WAIT_V(8); PG8_WAIT_L(0); PG8_BAR; PG8_MMA(1, 0, At, B0); PG8_MMA(1, 1, At, B1); PG8_BAR; PG8_SCHED;
            } else {
            PG8_LDB(B0, 0, 0); PG8_SCHED; PG8_LDA(At, 0, 0); PG8_STAGE(PG8_SA(1, 1), a1 + hstep, voffA);
            PG8_WAIT_L(8); PG8_BAR; PG8_WAIT_L(0); PG8_MMA(0, 0, At, B0); PG8_BAR; PG8_SCHED;
            PG8_LDB(B1, 0, 1); PG8_STAGE(PG8_SB(0, 0), b2, voffB);
            PG8_BAR; PG8_WAIT_L(0); PG8_MMA(0, 1, At, B1); PG8_BAR;
            PG8_LDA(At, 0, 1); PG8_STAGE(PG8_SA(0, 0), a2, voffA);
            PG8_BAR; PG8_WAIT_L(0); PG8_MMA(1, 0, At, B0); PG8_BAR; PG8_SCHED;
            PG8_STAGE(PG8_SB(0, 1), b2 + hstep, voffB);
            PG8_WAIT_V(6); PG8_BAR; PG8_MMA(1, 1, At, B1); PG8_BAR;
            PG8_LDB(B0, 1, 0); PG8_SCHED; PG8_LDA(At, 1, 0); PG8_STAGE(PG8_SA(0, 1), a2 + hstep, voffA);
            PG8_WAIT_L(8); PG8_BAR; PG8_WAIT_L(0); PG8_MMA(0, 0, At, B0); PG8_BAR; PG8_SCHED;
            PG8_LDB(B1, 1, 1); PG8_STAGE(PG8_SB(1, 0), b3, voffB);
            PG8_BAR; PG8_WAIT_L(0); PG8_MMA(0, 1, At, B1); PG8_BAR;
            PG8_LDA(At, 1, 1); PG8_STAGE(PG8_SA(1, 0), a3, voffA);
            PG8_BAR; PG8_WAIT_L(0); PG8_MMA(1, 0, At, B0); PG8_BAR; PG8_SCHED;
            PG8_STAGE(PG8_SB(1, 1), b3 + hstep, voffB);
            PG8_WAIT_V(6); PG8_BAR; PG8_MMA(1, 1, At, B1); PG8_BAR;
            }
        }
        if constexpr (ALIGN_EPI) { if (wr == 0) PG8_BAR; }
        if constexpr (!Epi::AFTER_DRAIN) { E(acc, cur, wr, wc, fr, fq); S.done(cur); }
        if (!has_next) break;
#pragma unroll
        for (int a = 0; a < 2; ++a)
#pragma unroll
            for (int b = 0; b < 2; ++b)
#pragma unroll
                for (int m = 0; m < 4; ++m)
#pragma unroll
                    for (int n = 0; n < 2; ++n) acc[a][b][m][n] = (f32x4){0.f, 0.f, 0.f, 0.f};
        cur = nxt; cA = nA; cB = nB; ++ui;
        if constexpr (ALIGN_EPI) { if (wr == 1) PG8_BAR; }
    }
    PG8_WAIT_V(0);
    if constexpr (!ALIGN_EPI) { if (wr == 0) PG8_BAR; }
    PG8_BAR;
    if constexpr (Epi::AFTER_DRAIN) { E.fused(acc, cur, wr, wc, fr, fq, lds, wid, lane); S.done(cur); }
#undef PG8_SA
#undef PG8_SB
#undef PG8_STAGE
#undef PG8_LDA
#undef PG8_LDB
#undef PG8_MMA
#undef PG8_WAIT_V
#undef PG8_WAIT_L
#undef PG8_BAR
#undef PG8_SCHED
}
}
#define GAS __attribute__((address_space(1)))
#define LAS __attribute__((address_space(3)))
typedef unsigned short bf16;
typedef unsigned v4u __attribute__((ext_vector_type(4)));
typedef float f32x4 __attribute__((ext_vector_type(4)));
typedef short bf16x8 __attribute__((ext_vector_type(8)));
typedef GAS unsigned gu32;
typedef GAS unsigned long long gu64;
#define RLX_AGENT __ATOMIC_RELAXED, __HIP_MEMORY_SCOPE_AGENT
#define LDS_WAIT() asm volatile("s_waitcnt lgkmcnt(0)" ::: "memory")
#define VM_WAIT() asm volatile("s_waitcnt vmcnt(0)" ::: "memory")
__device__ __forceinline__ unsigned long long rt() { return __builtin_amdgcn_s_memrealtime(); }
__device__ __forceinline__ unsigned f2bf(float f) { unsigned u = __builtin_bit_cast(unsigned, f); return (u + 0x7fffu + ((u >> 16) & 1u)) >> 16; }
__device__ __forceinline__ unsigned pk2(float lo, float hi) { return f2bf(lo) | (f2bf(hi) << 16); }

#define XB_TMO      128
#define XB_XCNT(j)  (256  + 64 * (j))
#define XB_XSUB(j)  (1280 + 64 * (j))
#define XB_XGEN(j)  (2304 + 64 * (j))
#define XB_TOP      3328
#define XB_TOPGEN   3392
#define XCD_BAR_WORDS 3456
#define XB_SPIN_CAP (1u << 18)

__device__ __forceinline__ unsigned xb_ld(unsigned* p)              { return __hip_atomic_load(p, __ATOMIC_RELAXED, __HIP_MEMORY_SCOPE_AGENT); }
__device__ __forceinline__ unsigned xb_add(unsigned* p, unsigned v) { return __hip_atomic_fetch_add(p, v, __ATOMIC_RELAXED, __HIP_MEMORY_SCOPE_AGENT); }
__device__ __forceinline__ unsigned xb_xcc_id() { return (unsigned)__builtin_amdgcn_s_getreg((3 << 11) | 20) & 0xFu; }
#define XB_SPIN(cond, bar) do { unsigned _sp = 0; while (cond) { __builtin_amdgcn_s_sleep(1); \
    if ((++_sp & 255u) == 0u) { if (xb_ld(&(bar)[XB_TMO])) break; if (_sp > XB_SPIN_CAP) { atomicAdd(&(bar)[XB_TMO], 1u); break; } } } } while (0)

struct XcdBarrier {
    unsigned* bar; unsigned x;
    volatile LAS unsigned* st;
};

__device__ __forceinline__ XcdBarrier xcd_barrier_post(unsigned* bar, volatile LAS unsigned* st) {
    XcdBarrier b; b.bar = bar; b.x = xb_xcc_id(); b.st = st;
    if (threadIdx.x == 0) (void)xb_add(&bar[XB_XCNT(b.x)], 1u);
    return b;
}
__device__ __forceinline__ void xcd_barrier_complete(unsigned* bar, unsigned x, unsigned& nloc, unsigned& nx) {
    const unsigned G = gridDim.x * gridDim.y * gridDim.z;
    unsigned sum, cnt, mine, sp = 0u;
    for (;;) {
        sum = 0u; cnt = 0u; mine = 0u;
#pragma unroll
        for (unsigned j = 0; j < 16; ++j) { const unsigned c = xb_ld(&bar[XB_XCNT(j)]); sum += c; cnt += (c > 0u) ? 1u : 0u; mine = (j == x) ? c : mine; }
        if (sum == G) break;
        __builtin_amdgcn_s_sleep(1);
        if ((++sp & 255u) == 0u) { if (xb_ld(&bar[XB_TMO])) break; if (sp > XB_SPIN_CAP) { atomicAdd(&bar[XB_TMO], 1u); break; } }
    }
    nloc = mine > 0u ? mine : 1u; nx = cnt > 0u ? cnt : 1u;
}

__device__ __forceinline__ void xcd_barrier(const XcdBarrier& b) {
    asm volatile("s_waitcnt vmcnt(0)" ::: "memory");
    __syncthreads();
    if (threadIdx.x == 0) {
        unsigned* bar = b.bar;
        __builtin_amdgcn_s_waitcnt(0);
        unsigned nloc = b.st[0], nx = b.st[1];
        if (nloc == 0u) { xcd_barrier_complete(bar, b.x, nloc, nx); b.st[0] = nloc; b.st[1] = nx; }
        const unsigned old = xb_add(&bar[XB_XSUB(b.x)], 1u);
        const unsigned gen = old / nloc;
        if (old + 1u == (gen + 1u) * nloc) {
            __builtin_amdgcn_fence(__ATOMIC_RELEASE, "agent");
            asm volatile("s_waitcnt vmcnt(0)" ::: "memory");
            const unsigned og = xb_add(&bar[XB_TOP], 1u);
            const unsigned tg = og / nx;
            if (og + 1u == (tg + 1u) * nx) xb_add(&bar[XB_TOPGEN], 1u);
            else XB_SPIN(xb_ld(&bar[XB_TOPGEN]) == tg, bar);
            __builtin_amdgcn_fence(__ATOMIC_ACQUIRE, "agent");
            xb_add(&bar[XB_XGEN(b.x)], 1u);
            asm volatile("s_waitcnt vmcnt(0)" ::: "memory");
        } else {
            XB_SPIN(xb_ld(&bar[XB_XGEN(b.x)]) == gen, bar);
            __builtin_amdgcn_fence(__ATOMIC_ACQUIRE, "agent");
            asm volatile("s_waitcnt vmcnt(0)" ::: "memory");
        }
    }
    __syncthreads();
}

#ifndef PROBE_ATT
#define PROBE_ATT 0
#endif
#ifndef PROBE_CMP
#define PROBE_CMP 0
#endif
namespace cfg {
constexpr int D = 1024, NB = 4, T = 4096, M = NB * T, SB = 32, SS = 4, MS = SB * SS, PAST = 8192, PAGE = 128, NPG = PAST / PAGE;
constexpr int H = 16, HD = 64, NKV = 4, NIN = 7728, NINP = 7936, FF = 2816, NGU = 2 * FF, NMOD = 6 * D, RMOD = NB + SB, MODKC = 8;
constexpr int NCS_P = 255, NCP_P = 256, NCS_S = 511, NCP_S = 512;
constexpr float EPS = 1e-6f, NEGF = -1e30f;
constexpr size_t O_YP = 0, O_YS = 16777216, O_CMP_P = 16908288, O_SEL_P = 25296896, O_WIN_P = 33685504, O_CONV_P = 34734080,
                 O_CMP_S = 34742272, O_SEL_S = 34807808, O_WIN_S = 34873344, O_CONV_S = 43261952, O_END = 43327488;
constexpr size_t MiB = 1u << 20;
constexpr size_t WS_CTL = 0, CTL_ZERO_BYTES = 1 * MiB;
constexpr size_t WS_WIN_T = 2 * MiB, WS_WOC_T = 18 * MiB, WS_WON_T = 20 * MiB, WS_WOUT_T = 22 * MiB, WS_WGU_T = 24 * MiB, WS_WDN_T = 36 * MiB;
constexpr size_t WS_MODP = 42 * MiB, WS_MOD = 49 * MiB;
constexpr size_t WS_XN = 64 * MiB, WS_BG = 96 * MiB, WS_U = 128 * MiB, WS_Q = 160 * MiB, WS_HM = 192 * MiB, WS_GA = 240 * MiB, WS_GB = 272 * MiB, WS_NGT = 304 * MiB;
constexpr size_t WS_AA = 308 * MiB, WS_OB = 340 * MiB, WS_MG = 372 * MiB, WS_X1 = 404 * MiB, WS_P1 = 468 * MiB, WS_HF = 532 * MiB, WS_KCC = 620 * MiB, WS_SCOREH = 622 * MiB, WS_MASK = 686 * MiB;
constexpr size_t WS_XNS = 688 * MiB, WS_ZS = 689 * MiB, WS_AAS = 693 * MiB, WS_OBS = 694 * MiB, WS_MGS = 695 * MiB, WS_X1S = 696 * MiB, WS_XN2S = 697 * MiB, WS_HFS = 698 * MiB, WS_X2S = 700 * MiB;
constexpr size_t WS_KCCS = 701 * MiB, WS_SCOREHS = 733 * MiB, WS_MASKS = 735 * MiB, WS_KCCB = 736 * MiB, WS_VCCT = 737 * MiB, WS_VST = 738 * MiB, WS_VWT = 746 * MiB, WS_OB2 = 754 * MiB, WS_MASKM = 786 * MiB, WS_W1T = 787 * MiB, WS_W2T = 788 * MiB, WS_BIASC = 789 * MiB, WS_KCCSB = 790 * MiB, WS_VCCST = 798 * MiB,
                 WS_CCMP = 806 * MiB, WS_ACMP = 880 * MiB, WS_END = 1160 * MiB;
constexpr int CM_S = SB * NKV * 512, CM_P = NB * NKV * 256, CM_ROWS = CM_S + CM_P;
constexpr size_t HMSZ = (size_t)NB * NKV * T * HD;
constexpr int CW_BAR = 4096;
constexpr int RING_OFF = 0, RING_BYTES = 131072, LDSCTL_OFF = RING_BYTES, MISC_OFF = LDSCTL_OFF + 320, LDS_BYTES = 147456;
constexpr int NWAVES = 8, NTHR = 512;
constexpr int NPHASE = 14;
}
using namespace cfg;

struct Ctx {
    __device__ static __forceinline__ const void* karg(int i) { return ((const void* const __attribute__((address_space(4)))*)__builtin_amdgcn_kernarg_segment_ptr())[i]; }
    __device__ __forceinline__ const float* x_p() const { return (const float*)karg(0); }
    __device__ __forceinline__ const float* x_s() const { return (const float*)karg(1); }
    __device__ __forceinline__ const float* c_p() const { return (const float*)karg(2); }
    __device__ __forceinline__ const float* c_s() const { return (const float*)karg(3); }
    __device__ __forceinline__ const float* cache_cmp() const { return (const float*)karg(4); }
    __device__ __forceinline__ const float* cache_sel() const { return (const float*)karg(5); }
    __device__ __forceinline__ const float* cache_win() const { return (const float*)karg(6); }
    __device__ __forceinline__ const float* state_conv() const { return (const float*)karg(7); }
    __device__ __forceinline__ const int* pt() const { return (const int*)karg(8); }
    __device__ __forceinline__ const float* w_ada() const { return (const float*)karg(9); }
    __device__ __forceinline__ const float* b_ada() const { return (const float*)karg(10); }
    __device__ __forceinline__ const float* norm1() const { return (const float*)karg(11); }
    __device__ __forceinline__ const float* w_in() const { return (const float*)karg(12); }
    __device__ __forceinline__ const float* w_conv() const { return (const float*)karg(13); }
    __device__ __forceinline__ const float* b_conv() const { return (const float*)karg(14); }
    __device__ __forceinline__ const float* w_oc() const { return (const float*)karg(15); }
    __device__ __forceinline__ const float* pe() const { return (const float*)karg(16); }
    __device__ __forceinline__ const float* w_phi1() const { return (const float*)karg(17); }
    __device__ __forceinline__ const float* w_phi2() const { return (const float*)karg(18); }
    __device__ __forceinline__ const float* w_on() const { return (const float*)karg(19); }
    __device__ __forceinline__ const float* w_out() const { return (const float*)karg(20); }
    __device__ __forceinline__ const float* norm2() const { return (const float*)karg(21); }
    __device__ __forceinline__ const float* w_gate() const { return (const float*)karg(22); }
    __device__ __forceinline__ const float* w_up() const { return (const float*)karg(23); }
    __device__ __forceinline__ const float* w_down() const { return (const float*)karg(24); }
    __device__ __forceinline__ const float* norm_f() const { return (const float*)karg(25); }
    __device__ __forceinline__ float* out() const { return (float*)karg(26); }
    unsigned char* ws; bf16* OB; float* CHK;
    LAS unsigned char* lds; int tid, lane, wave, G, bid;
    __device__ __forceinline__ bf16* WIN_T() const { return (bf16*)(ws + WS_WIN_T); }
    __device__ __forceinline__ bf16* WOC_T() const { return (bf16*)(ws + WS_WOC_T); }
    __device__ __forceinline__ bf16* WON_T() const { return (bf16*)(ws + WS_WON_T); }
    __device__ __forceinline__ bf16* WOUT_T() const { return (bf16*)(ws + WS_WOUT_T); }
    __device__ __forceinline__ bf16* WGU_T() const { return (bf16*)(ws + WS_WGU_T); }
    __device__ __forceinline__ bf16* WDN_T() const { return (bf16*)(ws + WS_WDN_T); }
    __device__ __forceinline__ float* MODP() const { return (float*)(ws + WS_MODP); }
    __device__ __forceinline__ float* MOD() const { return (float*)(ws + WS_MOD); }
    __device__ __forceinline__ bf16* XN() const { return (bf16*)(ws + WS_XN); }
    __device__ __forceinline__ bf16* BG() const { return (bf16*)(ws + WS_BG); }
    __device__ __forceinline__ bf16* U() const { return (bf16*)(ws + WS_U); }
    __device__ __forceinline__ bf16* Q() const { return (bf16*)(ws + WS_Q); }
    __device__ __forceinline__ bf16* HM() const { return (bf16*)(ws + WS_HM); }
    __device__ __forceinline__ bf16* GA() const { return (bf16*)(ws + WS_GA); }
    __device__ __forceinline__ bf16* GB() const { return (bf16*)(ws + WS_GB); }
    __device__ __forceinline__ float* NGT() const { return (float*)(ws + WS_NGT); }
    __device__ __forceinline__ bf16* AA() const { return (bf16*)(ws + WS_AA); }
    __device__ __forceinline__ bf16* MG() const { return (bf16*)(ws + WS_MG); }
    __device__ __forceinline__ float* X1() const { return (float*)(ws + WS_X1); }
    __device__ __forceinline__ float* P1() const { return (float*)(ws + WS_P1); }
    __device__ __forceinline__ bf16* HF() const { return (bf16*)(ws + WS_HF); }
    __device__ __forceinline__ float* KCC() const { return (float*)(ws + WS_KCC); }
    __device__ __forceinline__ float* SCOREH() const { return (float*)(ws + WS_SCOREH); }
    __device__ __forceinline__ unsigned long long* MASK() const { return (unsigned long long*)(ws + WS_MASK); }
    __device__ __forceinline__ float* XNS() const { return (float*)(ws + WS_XNS); }
    __device__ __forceinline__ float* ZS() const { return (float*)(ws + WS_ZS); }
    __device__ __forceinline__ float* AAS() const { return (float*)(ws + WS_AAS); }
    __device__ __forceinline__ float* OBS() const { return (float*)(ws + WS_OBS); }
    __device__ __forceinline__ float* MGS() const { return (float*)(ws + WS_MGS); }
    __device__ __forceinline__ float* X1S() const { return (float*)(ws + WS_X1S); }
    __device__ __forceinline__ float* XN2S() const { return (float*)(ws + WS_XN2S); }
    __device__ __forceinline__ float* HFS() const { return (float*)(ws + WS_HFS); }
    __device__ __forceinline__ float* X2S() const { return (float*)(ws + WS_X2S); }
    __device__ __forceinline__ float* KCCS() const { return (float*)(ws + WS_KCCS); }
    __device__ __forceinline__ float* SCOREHS() const { return (float*)(ws + WS_SCOREHS); }
    __device__ __forceinline__ unsigned long long* MASKS() const { return (unsigned long long*)(ws + WS_MASKS); }
    __device__ __forceinline__ bf16* KCCB() const { return (bf16*)(ws + WS_KCCB); }
    __device__ __forceinline__ bf16* VCCT() const { return (bf16*)(ws + WS_VCCT); }
    __device__ __forceinline__ bf16* VST() const { return (bf16*)(ws + WS_VST); }
    __device__ __forceinline__ bf16* VWT() const { return (bf16*)(ws + WS_VWT); }
    __device__ __forceinline__ bf16* OB2() const { return (bf16*)(ws + WS_OB2); }
    __device__ __forceinline__ unsigned long long* MASKM() const { return (unsigned long long*)(ws + WS_MASKM); }
    __device__ __forceinline__ bf16* W1T() const { return (bf16*)(ws + WS_W1T); }
    __device__ __forceinline__ bf16* W2T() const { return (bf16*)(ws + WS_W2T); }
    __device__ __forceinline__ float* BIASC() const { return (float*)(ws + WS_BIASC); }
    __device__ __forceinline__ bf16* KCCSB() const { return (bf16*)(ws + WS_KCCSB); }
    __device__ __forceinline__ bf16* VCCST() const { return (bf16*)(ws + WS_VCCST); }
    __device__ __forceinline__ bf16* CCMP() const { return (bf16*)(ws + WS_CCMP); }
    __device__ __forceinline__ bf16* ACMP() const { return (bf16*)(ws + WS_ACMP); }
};

__device__ __forceinline__ int gtid(const Ctx& c) { int t = c.tid; asm volatile("" : "+v"(t)); return c.bid * NTHR + t; }
__device__ __forceinline__ float bf2f(bf16 b) { return __uint_as_float((unsigned)b << 16); }
__device__ __forceinline__ float sigmoidf_(float x) { return 1.f / (1.f + __expf(-x)); }
__device__ __forceinline__ float siluf_(float x) { return x / (1.f + __expf(-x)); }
__device__ __forceinline__ float gelu_tanh(float x) { const float u = 0.7978845608028654f * (x + 0.044715f * x * x * x); const float e = __expf(2.f * u); const float th = 1.f - 2.f / (e + 1.f); return 0.5f * x * (1.f + th); }
__device__ __forceinline__ float wave_sum(float v) {
#pragma unroll
    for (int o = 1; o < 64; o <<= 1) v += __shfl_xor(v, o);
    return v;
}
__device__ __forceinline__ void ld8(const bf16* p, float (&v)[8]) {
    const v4u w = *(const v4u*)p;
    v[0] = __uint_as_float(w.x << 16); v[1] = __uint_as_float(w.x & 0xffff0000u); v[2] = __uint_as_float(w.y << 16); v[3] = __uint_as_float(w.y & 0xffff0000u);
    v[4] = __uint_as_float(w.z << 16); v[5] = __uint_as_float(w.z & 0xffff0000u); v[6] = __uint_as_float(w.w << 16); v[7] = __uint_as_float(w.w & 0xffff0000u);
}
__device__ __forceinline__ void ld8(const float* p, float (&v)[8]) {
    const f32x4 a = *(const f32x4*)p, b = *(const f32x4*)(p + 4);
    v[0] = a.x; v[1] = a.y; v[2] = a.z; v[3] = a.w; v[4] = b.x; v[5] = b.y; v[6] = b.z; v[7] = b.w;
}
__device__ __forceinline__ v4u pack8(const float (&v)[8]) { v4u w; w.x = pg8::cvt_pk_bf16(v[0], v[1]); w.y = pg8::cvt_pk_bf16(v[2], v[3]); w.z = pg8::cvt_pk_bf16(v[4], v[5]); w.w = pg8::cvt_pk_bf16(v[6], v[7]); return w; }
template <class TP> __device__ __forceinline__ float dot64(const TP* row, const float (&q)[64]) {
    float s = 0.f;
#pragma unroll
    for (int c = 0; c < 8; ++c) { float v[8]; ld8(row + 8 * c, v);
#pragma unroll
        for (int j = 0; j < 8; ++j) s += q[8 * c + j] * v[j]; }
    return s;
}
template <class TP> __device__ __forceinline__ void axpy64(const TP* row, float p, float (&o)[64]) {
#pragma unroll
    for (int c = 0; c < 8; ++c) { float v[8]; ld8(row + 8 * c, v);
#pragma unroll
        for (int j = 0; j < 8; ++j) o[8 * c + j] += p * v[j]; }
}

struct SrcCol { const float* W; int ld; int col; };
template <class F> __device__ __forceinline__ void transpose_item(const F& f, int K, bf16* WT, LAS float* scr, int item, int nblk, int lane) {
    const int kb = item / nblk, nb = item % nblk, k0 = 64 * kb, n0 = 32 * nb;
    const SrcCol sc = f(n0 + (lane & 31));
#pragma unroll 8
    for (int i = 0; i < 32; ++i) { const int kk = 2 * i + (lane >> 5); scr[kk * 33 + (lane & 31)] = sc.col >= 0 ? sc.W[(size_t)(k0 + kk) * sc.ld + sc.col] : 0.f; }
    LDS_WAIT(); asm volatile("" ::: "memory");
    const int c = lane & 7;
#pragma unroll
    for (int j = 0; j < 4; ++j) { const int n = (lane >> 3) + 8 * j; const LAS float* s = scr + (8 * c) * 33 + n;
        v4u o; o.x = pk2(s[0 * 33], s[1 * 33]); o.y = pk2(s[2 * 33], s[3 * 33]); o.z = pk2(s[4 * 33], s[5 * 33]); o.w = pk2(s[6 * 33], s[7 * 33]);
        *(GAS v4u*)(WT + (size_t)(n0 + n) * K + k0 + 8 * c) = o; }
    LDS_WAIT(); asm volatile("" ::: "memory");
}
struct ColIn { const float* W; __device__ __forceinline__ SrcCol operator()(int p) const {
    int s;
    if (p < 1024) s = p;
    else if (p < 3072) { const int t = (p - 1024) >> 8, w = (p - 1024) & 255; s = (w < 128) ? (1024 + 128 * t + w) : (2048 + 128 * t + (w - 128)); }
    else if (p < 5632) s = p;
    else if (p < 7680) s = 5680 + (p - 5632);
    else if (p < 7728) s = 5632 + (p - 7680);
    else s = -1;
    return SrcCol{W, NIN, s}; } };
struct ColPlain { const float* W; int ld; __device__ __forceinline__ SrcCol operator()(int p) const { return SrcCol{W, ld, p}; } };
struct ColW1 { const float* W; __device__ __forceinline__ SrcCol operator()(int p) const { return (p < 128) ? SrcCol{W, 128, p} : SrcCol{W + 1024 * 128, 128, p - 128}; } };
struct ColGU { const float *Wg, *Wu; __device__ __forceinline__ SrcCol operator()(int p) const { const int t = p >> 8, w = p & 255; return (w < 128) ? SrcCol{Wg, FF, 128 * t + w} : SrcCol{Wu, FF, 128 * t + (w - 128)}; } };

__device__ __forceinline__ void mod_partial_item(const Ctx& c, int item) {
    const int kc = item / 12, cc = item % 12, k0 = kc * 128, n = cc * 512 + c.tid;
    LAS float* sc = (LAS float*)c.lds;
    for (int i = c.tid; i < RMOD * 128; i += NTHR) { const int r = i >> 7, k = i & 127; const float cv = (r < NB) ? c.c_p()[r * D + k0 + k] : c.c_s()[(r - NB) * D + k0 + k]; sc[i] = siluf_(cv); }
    __syncthreads();
    float acc[RMOD];
#pragma unroll
    for (int r = 0; r < RMOD; ++r) acc[r] = 0.f;
    for (int k = 0; k < 128; ++k) { const float w = c.w_ada()[(size_t)(k0 + k) * NMOD + n];
#pragma unroll
        for (int r = 0; r < RMOD; ++r) acc[r] += sc[r * 128 + k] * w; }
#pragma unroll
    for (int r = 0; r < RMOD; ++r) c.MODP()[((size_t)kc * RMOD + r) * NMOD + n] = acc[r];
    __syncthreads();
}
__device__ __forceinline__ void p0_prologue(const Ctx& c) {
    for (int it = c.bid; it < MODKC * 12; it += c.G) mod_partial_item(c, it);
    LAS float* scr = (LAS float*)(c.lds + c.wave * 16384);
    const int gw = c.bid * NWAVES + c.wave, NGW = c.G * NWAVES;
    constexpr int I_IN = 16 * (NINP / 32), I_SQ = 16 * 32, I_GU = 16 * (NGU / 32), I_DN = (FF / 64) * 32;
    constexpr int I_W1 = 2 * 16 * 8, I_W2 = 2 * 2 * 2;
    constexpr int NITEMS = I_IN + 3 * I_SQ + I_GU + I_DN + I_W1 + I_W2;
    for (int it = gw; it < NITEMS; it += NGW) {
        int r = it;
        if (r < I_IN) { transpose_item(ColIn{c.w_in()}, D, c.WIN_T(), scr, r, NINP / 32, c.lane); continue; } r -= I_IN;
        if (r < I_SQ) { transpose_item(ColPlain{c.w_oc(), D}, D, c.WOC_T(), scr, r, 32, c.lane); continue; } r -= I_SQ;
        if (r < I_SQ) { transpose_item(ColPlain{c.w_on(), D}, D, c.WON_T(), scr, r, 32, c.lane); continue; } r -= I_SQ;
        if (r < I_SQ) { transpose_item(ColPlain{c.w_out(), D}, D, c.WOUT_T(), scr, r, 32, c.lane); continue; } r -= I_SQ;
        if (r < I_GU) { transpose_item(ColGU{c.w_gate(), c.w_up()}, D, c.WGU_T(), scr, r, NGU / 32, c.lane); continue; } r -= I_GU;
        if (r < I_DN) { transpose_item(ColPlain{c.w_down(), D}, FF, c.WDN_T(), scr, r, 32, c.lane); continue; } r -= I_DN;
        if (r < I_W1) { const int kv = r >> 7; transpose_item(ColW1{c.w_phi1() + (size_t)kv * 2048 * 128}, 1024, c.W1T() + (size_t)kv * 256 * 1024, scr, r & 127, 8, c.lane); continue; } r -= I_W1;
        { const int kv = r >> 2; transpose_item(ColPlain{c.w_phi2() + (size_t)kv * 128 * HD, HD}, 128, c.W2T() + (size_t)kv * HD * 128, scr, r & 3, 2, c.lane); }
    }
    if (c.bid == c.G - 1 && c.tid < 256) { const int kv = c.tid >> 7, n = c.tid & 127; float s = 0.f;
        for (int kk = 0; kk < 2048; ++kk) s += c.pe()[kv * 2048 + kk] * c.w_phi1()[((size_t)kv * 2048 + kk) * 128 + n];
        c.BIASC()[c.tid] = s; }
    { const int gt = gtid(c), NGT_ = c.G * NTHR;
      for (int it = gt; it < SB * PAST * 64; it += NGT_) {
          const int l8 = it & 63, pos = (it >> 6) & (PAST - 1), b = it >> 19;
          const float* src = c.cache_cmp() + ((size_t)c.pt()[b * NPG + (pos >> 7)] * PAGE + (pos & 127)) * 512 + l8 * 8;
          float v[8]; ld8(src, v);
          const int kv = l8 >> 5, g = (l8 >> 3) & 3, d = (l8 & 7) * 8;
          *(GAS v4u*)(c.ACMP() + ((size_t)kv * CM_ROWS + (size_t)((b * NKV + g) * 512 + (pos >> 4))) * 1024 + (pos & 15) * HD + d) = pack8(v); } }
}

template <bool MODUL, bool OUT_BF16> __device__ __forceinline__ void norm_row(const float* xrow, const float* gain, const float* sh, const float* sc, void* orow, int lane) {
    const GAS f32x4* xr = (const GAS f32x4*)xrow + lane;
    f32x4 v[4]; float s = 0.f;
#pragma unroll
    for (int j = 0; j < 4; ++j) { v[j] = xr[64 * j]; s += (v[j].x * v[j].x + v[j].y * v[j].y) + (v[j].z * v[j].z + v[j].w * v[j].w); }
    const float inv = 1.0f / sqrtf(wave_sum(s) * (1.f / D) + EPS);
#pragma unroll
    for (int j = 0; j < 4; ++j) {
        const int k = 4 * lane + 256 * j;
        const f32x4 g = *(const f32x4*)(gain + k);
        f32x4 o = v[j] * inv * g;
        if (MODUL) { const f32x4 a = *(const f32x4*)(sc + k), b = *(const f32x4*)(sh + k); o = o * (a + 1.0f) + b; }
        if (OUT_BF16) { ((GAS unsigned long long*)orow)[lane + 64 * j] = (unsigned long long)pg8::cvt_pk_bf16(o.x, o.y) | ((unsigned long long)pg8::cvt_pk_bf16(o.z, o.w) << 32); }
        else { ((GAS f32x4*)orow)[lane + 64 * j] = o; }
    }
}
__device__ __forceinline__ void p1_norm1(const Ctx& c) {
    for (int r = c.bid; r < RMOD; r += c.G)
        for (int n = c.tid; n < NMOD; n += NTHR) { float s = c.b_ada()[n];
#pragma unroll
            for (int kc = 0; kc < MODKC; ++kc) s += c.MODP()[((size_t)kc * RMOD + r) * NMOD + n];
            c.MOD()[(size_t)r * NMOD + n] = s; }
    LAS float* shl = (LAS float*)c.lds; LAS float* scl = shl + D;
    constexpr int NCH = M / 64 + SB;
    for (int ch = c.bid; ch < NCH; ch += c.G) {
        const bool smp = ch >= M / 64; const int r = smp ? NB + (ch - M / 64) : (ch * 64) / T;
        __syncthreads();
        for (int k = c.tid; k < 2 * D; k += NTHR) { float s = c.b_ada()[k];
#pragma unroll
            for (int kc = 0; kc < MODKC; ++kc) s += c.MODP()[((size_t)kc * RMOD + r) * NMOD + k];
            shl[k] = s; }
        __syncthreads();
        if (!smp) { for (int rr = c.wave; rr < 64; rr += NWAVES) { const int row = ch * 64 + rr;
                const GAS f32x4* xr = (const GAS f32x4*)(c.x_p() + (size_t)row * D) + c.lane; f32x4 v[4]; float s = 0.f;
#pragma unroll
                for (int j = 0; j < 4; ++j) { v[j] = xr[64 * j]; s += (v[j].x * v[j].x + v[j].y * v[j].y) + (v[j].z * v[j].z + v[j].w * v[j].w); }
                const float inv = 1.0f / sqrtf(wave_sum(s) * (1.f / D) + EPS);
#pragma unroll
                for (int j = 0; j < 4; ++j) { const int k = 4 * c.lane + 256 * j; const f32x4 g = *(const f32x4*)(c.norm1() + k);
                    const f32x4 a = *(const LAS f32x4*)(scl + k), b = *(const LAS f32x4*)(shl + k); const f32x4 o = v[j] * inv * g * (a + 1.0f) + b;
                    ((GAS unsigned long long*)(c.XN() + (size_t)row * D))[c.lane + 64 * j] = (unsigned long long)pg8::cvt_pk_bf16(o.x, o.y) | ((unsigned long long)pg8::cvt_pk_bf16(o.z, o.w) << 32); } } }
        else if (c.wave < SS) { const int row = (ch - M / 64) * SS + c.wave;
                const GAS f32x4* xr = (const GAS f32x4*)(c.x_s() + (size_t)row * D) + c.lane; f32x4 v[4]; float s = 0.f;
#pragma unroll
                for (int j = 0; j < 4; ++j) { v[j] = xr[64 * j]; s += (v[j].x * v[j].x + v[j].y * v[j].y) + (v[j].z * v[j].z + v[j].w * v[j].w); }
                const float inv = 1.0f / sqrtf(wave_sum(s) * (1.f / D) + EPS);
#pragma unroll
                for (int j = 0; j < 4; ++j) { const int k = 4 * c.lane + 256 * j; const f32x4 g = *(const f32x4*)(c.norm1() + k);
                    const f32x4 a = *(const LAS f32x4*)(scl + k), b = *(const LAS f32x4*)(shl + k); const f32x4 o = v[j] * inv * g * (a + 1.0f) + b;
                    ((GAS f32x4*)(c.XNS() + (size_t)row * D))[c.lane + 64 * j] = o; } }
    }
    __syncthreads();
}
__device__ __forceinline__ void p5c_norm2(const Ctx& c) {
    const int gw = c.bid * NWAVES + c.wave, NGW = c.G * NWAVES;
    for (int row = gw; row < M + MS; row += NGW) {
        if (row < M) { const int r = row / T; norm_row<true, true>(c.X1() + (size_t)row * D, c.norm2(), c.MOD() + (size_t)r * NMOD + 3 * D, c.MOD() + (size_t)r * NMOD + 4 * D, c.XN() + (size_t)row * D, c.lane); }
        else { const int rs = row - M, r = NB + rs / SS; norm_row<true, false>(c.X1S() + (size_t)rs * D, c.norm2(), c.MOD() + (size_t)r * NMOD + 3 * D, c.MOD() + (size_t)r * NMOD + 4 * D, c.XN2S() + (size_t)rs * D, c.lane); }
    }
}
__device__ __forceinline__ void p8_normf(const Ctx& c) {
    const int gw = c.bid * NWAVES + c.wave, NGW = c.G * NWAVES;
    for (int row = gw; row < M + MS; row += NGW) {
        if (row < M) norm_row<false, false>(c.out() + O_YP + (size_t)row * D, c.norm_f(), nullptr, nullptr, c.out() + O_YP + (size_t)row * D, c.lane);
        else { const int rs = row - M; norm_row<false, false>(c.X2S() + (size_t)rs * D, c.norm_f(), nullptr, nullptr, c.out() + O_YS + (size_t)rs * D, c.lane); }
    }
}

using pg8::Unit;
#define EPI_ROWS(...) _Pragma("unroll") for (int ai = 0; ai < 2; ++ai) _Pragma("unroll") for (int m = 0; m < 4; ++m) { const int row = row0 + ai * 128 + m * 16; __VA_ARGS__ }
struct EpiIn {
    static constexpr bool PERM = true, AFTER_DRAIN = false;
    bf16 *BG, *U, *Q, *HM, *GA, *GB; float* NGT; float* out; bf16 *VST, *VWT, *ACMP;
    __device__ __forceinline__ void operator()(const f32x4 (&acc)[2][2][4][2], const Unit& u, int wr, int wc, int fr, int fq) const {
        const int pn = u.pn, row0 = u.pm * 256 + wr * 64 + fr, cl0 = wc * 32 + 8 * fq;
        if (pn < 4 || (pn >= 12 && pn < 16) || (pn >= 22 && pn < 30)) {
            bf16* base; int colt; float sc = 1.f; bool sig = false;
            if (pn < 4) { base = BG; colt = pn * 256; } else if (pn < 16) { base = Q; colt = (pn - 12) * 256; sc = 0.125f * 1.4426950408889634f; } else if (pn < 26) { base = GA; colt = (pn - 22) * 256; sig = true; } else { base = GB; colt = (pn - 26) * 256; sig = true; }
            EPI_ROWS(
_Pragma("unroll")
                for (int bj = 0; bj < 2; ++bj) { const f32x4 a = acc[ai][bj][m][0], b = acc[ai][bj][m][1]; float v[8] = {a.x, a.y, a.z, a.w, b.x, b.y, b.z, b.w};
_Pragma("unroll")
                    for (int j = 0; j < 8; ++j) v[j] = sig ? sigmoidf_(v[j]) : v[j] * sc;
                    *(GAS v4u*)(base + (size_t)row * D + colt + bj * 128 + cl0) = pack8(v); } )
        } else if (pn < 12) {
            const int t = pn - 4;
            EPI_ROWS(
                const f32x4 a = acc[ai][0][m][0] * acc[ai][1][m][0], b = acc[ai][0][m][1] * acc[ai][1][m][1]; const float v[8] = {a.x, a.y, a.z, a.w, b.x, b.y, b.z, b.w};
                *(GAS v4u*)(U + (size_t)row * D + t * 128 + cl0) = pack8(v);
                const int tt = row & (T - 1);
                if (tt >= T - 2) { float* o = out + O_CONV_P + (size_t)((row >> 12) * 2 + (tt - (T - 2))) * D + t * 128 + cl0; *(GAS f32x4*)o = a; *(GAS f32x4*)(o + 4) = b; } )
        } else if (pn < 22) {
            const int kind = pn - 16, kv = kind & 1, reg = kind >> 1;
            EPI_ROWS(
                const int b = row >> 12, tt = row & (T - 1);
_Pragma("unroll")
                for (int bj = 0; bj < 2; ++bj) { const f32x4 a = acc[ai][bj][m][0], bq = acc[ai][bj][m][1]; const float v[8] = {a.x, a.y, a.z, a.w, bq.x, bq.y, bq.z, bq.w};
                    const int cl = bj * 128 + cl0, g = cl >> 6, d = cl & 63;
                    if (kind == 3 || kind == 5) { bf16* vt = (kind == 3 ? VST : VWT) + ((size_t)((b * NKV + g) * HD + d)) * T + tt;
_Pragma("unroll")
                        for (int j = 0; j < 8; ++j) vt[(size_t)j * T] = (bf16)f2bf(v[j]); }
                    if (kind < 2) *(GAS v4u*)(ACMP + ((size_t)kind * CM_ROWS + CM_S) * 1024 + ((size_t)((b * NKV + g) * T + tt)) * HD + d) = pack8(v);
                    else if (PROBE_ATT || !(kind == 3 || kind == 5)) *(GAS v4u*)(HM + (size_t)kind * HMSZ + ((size_t)((b * NKV + g) * T + tt)) * HD + d) = pack8(v);
                    float* o = nullptr;
                    if (reg == 0) o = out + O_CMP_P + ((size_t)row * 2 + kv) * 256 + cl;
                    else if (reg == 1) o = out + O_SEL_P + ((size_t)row * 2 + kv) * 256 + cl;
                    else if (tt >= T - 512) o = out + O_WIN_P + ((size_t)(b * 512 + tt - (T - 512)) * 2 + kv) * 256 + cl;
                    if (o) { *(GAS f32x4*)o = a; *(GAS f32x4*)(o + 4) = bq; } } )
        } else {
            if (cl0 < 48) {
                EPI_ROWS(
                    const f32x4 a = acc[ai][0][m][0], b = acc[ai][0][m][1];
                    f32x4 sa, sb; sa.x = sigmoidf_(a.x); sa.y = sigmoidf_(a.y); sa.z = sigmoidf_(a.z); sa.w = sigmoidf_(a.w); sb.x = sigmoidf_(b.x); sb.y = sigmoidf_(b.y); sb.z = sigmoidf_(b.z); sb.w = sigmoidf_(b.w);
                    float* o = NGT + (size_t)row * 48 + cl0; *(GAS f32x4*)o = sa; *(GAS f32x4*)(o + 4) = sb; )
            }
        }
    }
};
struct EpiYa { static constexpr bool PERM = true, AFTER_DRAIN = false; const bf16* GA; float* P1;
    __device__ __forceinline__ void operator()(const f32x4 (&acc)[2][2][4][2], const Unit& u, int wr, int wc, int fr, int fq) const {
        const int row0 = u.pm * 256 + wr * 64 + fr, col0 = u.pn * 256 + wc * 32 + 8 * fq;
        EPI_ROWS(
_Pragma("unroll")
            for (int bj = 0; bj < 2; ++bj) { const size_t off = (size_t)row * D + col0 + bj * 128; float g[8]; ld8(GA + off, g); const f32x4 a = acc[ai][bj][m][0], b = acc[ai][bj][m][1];
                f32x4 o0, o1; o0.x = g[0] * a.x; o0.y = g[1] * a.y; o0.z = g[2] * a.z; o0.w = g[3] * a.w; o1.x = g[4] * b.x; o1.y = g[5] * b.y; o1.z = g[6] * b.z; o1.w = g[7] * b.w;
                *(GAS f32x4*)(P1 + off) = o0; *(GAS f32x4*)(P1 + off + 4) = o1; } )
    } };
struct EpiYb { static constexpr bool PERM = true, AFTER_DRAIN = false; const bf16* GB; const float* P1; bf16* MG;
    __device__ __forceinline__ void operator()(const f32x4 (&acc)[2][2][4][2], const Unit& u, int wr, int wc, int fr, int fq) const {
        const int row0 = u.pm * 256 + wr * 64 + fr, col0 = u.pn * 256 + wc * 32 + 8 * fq;
        EPI_ROWS(
_Pragma("unroll")
            for (int bj = 0; bj < 2; ++bj) { const size_t off = (size_t)row * D + col0 + bj * 128; float g[8]; ld8(GB + off, g); float p[8]; ld8(P1 + off, p); const f32x4 a = acc[ai][bj][m][0], b = acc[ai][bj][m][1];
                const float v[8] = {p[0] + g[0] * a.x, p[1] + g[1] * a.y, p[2] + g[2] * a.z, p[3] + g[3] * a.w, p[4] + g[4] * b.x, p[5] + g[5] * b.y, p[6] + g[6] * b.z, p[7] + g[7] * b.w};
                *(GAS v4u*)(MG + off) = pack8(v); } )
    } };
struct EpiRes { static constexpr bool PERM = true, AFTER_DRAIN = false; const float* base; float* O; const float* MOD; int goff;
    __device__ __forceinline__ void operator()(const f32x4 (&acc)[2][2][4][2], const Unit& u, int wr, int wc, int fr, int fq) const {
        const int row0 = u.pm * 256 + wr * 64 + fr, col0 = u.pn * 256 + wc * 32 + 8 * fq;
        const float* gp = MOD + (size_t)((u.pm * 256) / T) * NMOD + goff + col0;
        f32x4 gt[2][2];
#pragma unroll
        for (int bj = 0; bj < 2; ++bj) { gt[bj][0] = *(const f32x4*)(gp + bj * 128); gt[bj][1] = *(const f32x4*)(gp + bj * 128 + 4); }
        EPI_ROWS(
_Pragma("unroll")
            for (int bj = 0; bj < 2; ++bj) { const size_t off = (size_t)row * D + col0 + bj * 128;
                const f32x4 x0 = *(const f32x4*)(base + off), x1 = *(const f32x4*)(base + off + 4);
                *(GAS f32x4*)(O + off) = x0 + gt[bj][0] * acc[ai][bj][m][0]; *(GAS f32x4*)(O + off + 4) = x1 + gt[bj][1] * acc[ai][bj][m][1]; } )
    } };
struct EpiFF { static constexpr bool PERM = true, AFTER_DRAIN = false; bf16* HF;
    __device__ __forceinline__ void operator()(const f32x4 (&acc)[2][2][4][2], const Unit& u, int wr, int wc, int fr, int fq) const {
        const int row0 = u.pm * 256 + wr * 64 + fr, col0 = u.pn * 128 + wc * 32 + 8 * fq;
        EPI_ROWS(
            const f32x4 g0 = acc[ai][0][m][0], g1 = acc[ai][0][m][1], u0 = acc[ai][1][m][0], u1 = acc[ai][1][m][1];
            const float v[8] = {siluf_(g0.x) * u0.x, siluf_(g0.y) * u0.y, siluf_(g0.z) * u0.z, siluf_(g0.w) * u0.w, siluf_(g1.x) * u1.x, siluf_(g1.y) * u1.y, siluf_(g1.z) * u1.z, siluf_(g1.w) * u1.w};
            *(GAS v4u*)(HF + (size_t)row * FF + col0) = pack8(v); )
    } };

struct CmpOrder { int G, c; static constexpr int NPM = CM_ROWS / 256;
    __device__ bool next(int i, Unit& u) const { const int L = i * G + c; if (L >= 2 * NPM) return false; u.pm = L; u.pn = L >= NPM ? 1 : 0; return true; }
    __device__ __forceinline__ void a_ready(const Unit&) const {}
    __device__ __forceinline__ void done(const Unit&) const {} };
struct EpiCmp { static constexpr bool PERM = true, AFTER_DRAIN = false; bf16* C;
    __device__ __forceinline__ void operator()(const f32x4 (&acc)[2][2][4][2], const Unit& u, int wr, int wc, int fr, int fq) const {
        const int row0 = u.pm * 256 + wr * 64 + fr, col0 = wc * 32 + 8 * fq;
        EPI_ROWS(
_Pragma("unroll")
            for (int bj = 0; bj < 2; ++bj) { const f32x4 a = acc[ai][bj][m][0], b = acc[ai][bj][m][1]; const float v[8] = {a.x, a.y, a.z, a.w, b.x, b.y, b.z, b.w};
                *(GAS v4u*)(C + (size_t)row * 256 + bj * 128 + col0) = pack8(v); } )
    } };
__device__ __forceinline__ void compress_step2(const Ctx& c) {
    typedef short bfx8 __attribute__((ext_vector_type(8)));
    constexpr int NT_S = SB * NKV * 32, NT_P = NB * NKV * 16, NTASK = 2 * (NT_S + NT_P);
    const int gw = c.bid * NWAVES + c.wave, NGW = c.G * NWAVES, r16 = c.lane & 15, G = c.lane >> 4;
    for (int w = gw; w < NTASK; w += NGW) {
        const int kv = w / (NT_S + NT_P), w2 = w % (NT_S + NT_P); const bool smp = w2 < NT_S;
        const int bgi = smp ? (w2 >> 5) : ((w2 - NT_S) >> 4), it = smp ? (w2 & 31) : ((w2 - NT_S) & 15);
        const int nper = smp ? 512 : 256, ncs = smp ? NCS_S : NCS_P;
        const int ci = it * 16 + r16, cic = ci < ncs ? ci : ncs - 1;
        const size_t rowA = (size_t)kv * CM_ROWS + (smp ? 0 : CM_S) + (size_t)bgi * nper + cic;
        const bf16* ca = c.CCMP() + rowA * 256; const bf16* cb = ca + 256 + 128;
        f32x4 acc[4];
#pragma unroll
        for (int ob = 0; ob < 4; ++ob) acc[ob] = (f32x4){0.f, 0.f, 0.f, 0.f};
#pragma unroll
        for (int ks = 0; ks < 4; ++ks) {
            float a[8], b[8], bi[8]; ld8(ca + 32 * ks + 8 * G, a); ld8(cb + 32 * ks + 8 * G, b); ld8(c.BIASC() + kv * 128 + 32 * ks + 8 * G, bi);
            float h[8];
#pragma unroll
            for (int j = 0; j < 8; ++j) h[j] = gelu_tanh(a[j] + b[j] + bi[j]);
            const bfx8 hf = __builtin_bit_cast(bfx8, pack8(h));
#pragma unroll
            for (int ob = 0; ob < 4; ++ob) { const bfx8 wf = *(const bfx8*)(c.W2T() + ((size_t)kv * HD + 16 * ob + r16) * 128 + 32 * ks + 8 * G);
                acc[ob] = __builtin_amdgcn_mfma_f32_16x16x32_bf16(wf, hf, acc[ob], 0, 0, 0); }
        }
        if (PROBE_CMP && ci < ncs) {
            float num = 0.f, den = 0.f;
#pragma unroll
            for (int ob = 0; ob < 4; ++ob)
#pragma unroll
                for (int i = 0; i < 4; ++i) { const int o = 16 * ob + 4 * G + i;
                    const float r = smp ? c.KCCS()[((size_t)((kv * SB * NKV + bgi)) * NCP_S + ci) * HD + o] : c.KCC()[((size_t)((kv * NB * NKV + bgi)) * NCP_P + ci) * HD + o];
                    num += (acc[ob][i] - r) * (acc[ob][i] - r); den += r * r; }
            atomicAdd(c.CHK + (smp ? 0 : 2) + 32, num); atomicAdd(c.CHK + (smp ? 1 : 3) + 32, den);
        }
        if (ci < ncs) {
            if (smp) {
#pragma unroll
                for (int ob = 0; ob < 4; ++ob)
#pragma unroll
                    for (int i = 0; i < 4; ++i) c.KCCS()[((size_t)((kv * SB * NKV + bgi)) * NCP_S + ci) * HD + 16 * ob + 4 * G + i] = acc[ob][i];
            }
            if (PROBE_ATT && !smp) {
#pragma unroll
                for (int ob = 0; ob < 4; ++ob)
#pragma unroll
                    for (int i = 0; i < 4; ++i) c.KCC()[((size_t)((kv * NB * NKV + bgi)) * NCP_P + ci) * HD + 16 * ob + 4 * G + i] = acc[ob][i];
            }
            bf16* kout = smp ? c.KCCSB() : c.KCCB(); bf16* vout = smp ? c.VCCST() : c.VCCT();
            if (kv == 0) {
#pragma unroll
                for (int ob = 0; ob < 4; ++ob) *(GAS unsigned long long*)(kout + ((size_t)bgi * nper + ci) * HD + 16 * ob + 4 * G) =
                    (unsigned long long)pg8::cvt_pk_bf16(acc[ob][0], acc[ob][1]) | ((unsigned long long)pg8::cvt_pk_bf16(acc[ob][2], acc[ob][3]) << 32);
            } else {
#pragma unroll
                for (int ob = 0; ob < 4; ++ob)
#pragma unroll
                    for (int i = 0; i < 4; ++i) vout[((size_t)bgi * HD + 16 * ob + 4 * G + i) * nper + ci] = (bf16)f2bf(acc[ob][i]);
            }
        }
    }
}

template <bool DUAL, class Epi> __device__ __forceinline__ void sgemm(const Ctx& c, const float* A1, const float* A2, int lda, const float* W1, const float* W2, int ldw, int K, int N, const Epi& epi) {
    const int nch = (N + NTHR - 1) / NTHR, nitems = 8 * nch;
    for (int it = c.G - 1 - c.bid; it < nitems; it += c.G) {
        const int rg = it & 7, n = (it >> 3) * NTHR + c.tid;
        if (n < N) {
            float a1[16], a2[16];
#pragma unroll
            for (int r = 0; r < 16; ++r) { a1[r] = 0.f; a2[r] = 0.f; }
            const float* ar1 = A1 + (size_t)rg * 16 * lda; const float* ar2 = A2 + (size_t)rg * 16 * lda;
            for (int k = 0; k < K; ++k) { const float w1 = W1[(size_t)k * ldw + n]; const float w2 = DUAL ? W2[(size_t)k * ldw + n] : 0.f;
#pragma unroll
                for (int r = 0; r < 16; ++r) { a1[r] += ar1[(size_t)r * lda + k] * w1; if (DUAL) a2[r] += ar2[(size_t)r * lda + k] * w2; } }
#pragma unroll
            for (int r = 0; r < 16; ++r) epi(rg * 16 + r, n, a1[r], a2[r]);
        }
    }
}

template <int NACC, class Epi> __device__ __forceinline__ void sgemm_item(const Ctx& c, const float* A1, const float* A2, int lda, const bf16* B1, const bf16* B2, int K, const Epi& epi) {
    typedef short bfx8 __attribute__((ext_vector_type(8)));
    int lane_ = c.lane; asm volatile("" : "+v"(lane_));
    const int r16 = lane_ & 15, G = lane_ >> 4, wave = c.wave, ks = K / NWAVES, k0 = wave * ks;
    f32x4 acc[NACC][8];
#pragma unroll
    for (int a = 0; a < NACC; ++a)
#pragma unroll
        for (int rb = 0; rb < 8; ++rb) acc[a][rb] = (f32x4){0.f, 0.f, 0.f, 0.f};
    for (int kk = 0; kk < ks; kk += 32) {
        const int k = k0 + kk + 8 * G;
#pragma unroll
        for (int a = 0; a < NACC; ++a) {
            const bfx8 bf = *(const bfx8*)((a == 0 ? B1 : B2) + (size_t)r16 * K + k);
            const float* Ap = (a == 0 ? A1 : A2) + (size_t)r16 * lda + k;
#pragma unroll
            for (int rb = 0; rb < 8; ++rb) { float v[8]; ld8(Ap + (size_t)rb * 16 * lda, v); const bfx8 af = __builtin_bit_cast(bfx8, pack8(v));
                acc[a][rb] = __builtin_amdgcn_mfma_f32_16x16x32_bf16(af, bf, acc[a][rb], 0, 0, 0); }
        }
    }
    LAS float* L = (LAS float*)c.lds;
    __syncthreads();
#pragma unroll
    for (int a = 0; a < NACC; ++a)
#pragma unroll
        for (int rb = 0; rb < 8; ++rb)
#pragma unroll
            for (int i = 0; i < 4; ++i) L[(wave * NACC + a) * 2048 + (16 * rb + 4 * G + i) * 16 + r16] = acc[a][rb][i];
    __syncthreads();
    { const int e0 = c.tid * 4; f32x4 s[NACC];
#pragma unroll
      for (int a = 0; a < NACC; ++a) { s[a] = (f32x4){0.f, 0.f, 0.f, 0.f};
#pragma unroll
          for (int w = 0; w < NWAVES; ++w) s[a] = s[a] + *(const LAS f32x4*)(L + (w * NACC + a) * 2048 + e0); }
#pragma unroll
      for (int i = 0; i < 4; ++i) epi((e0 + i) >> 4, (e0 + i) & 15, s[0][i], NACC > 1 ? s[NACC - 1][i] : 0.f); }
}

__device__ __forceinline__ void p3_conv_prompt(const Ctx& c) {
    const int gt = gtid(c), NGT_ = c.G * NTHR;
    for (int it = gt; it < M * (D / 8); it += NGT_) {
        const int row = it >> 7, ch = (it & 127) * 8, tt = row & (T - 1);
        float u0[8], u1[8], u2[8], bg[8];
        ld8(c.U() + (size_t)row * D + ch, u0); ld8(c.BG() + (size_t)row * D + ch, bg);
        if (tt >= 1) ld8(c.U() + (size_t)(row - 1) * D + ch, u1); else { for (int j = 0; j < 8; ++j) u1[j] = 0.f; }
        if (tt >= 2) ld8(c.U() + (size_t)(row - 2) * D + ch, u2); else { for (int j = 0; j < 8; ++j) u2[j] = 0.f; }
        float w0[8], w1[8], w2[8], bb[8]; ld8(c.w_conv() + ch, w0); ld8(c.w_conv() + D + ch, w1); ld8(c.w_conv() + 2 * D + ch, w2); ld8(c.b_conv() + ch, bb);
        float v[8];
#pragma unroll
        for (int j = 0; j < 8; ++j) v[j] = bg[j] * (bb[j] + w0[j] * u2[j] + w1[j] * u1[j] + w2[j] * u0[j]);
        *(GAS v4u*)(c.AA() + (size_t)row * D + ch) = pack8(v);
    }
}
__device__ __forceinline__ void p3_sample_thin(const Ctx& c) {
    const int gt = gtid(c), NGT_ = c.G * NTHR;
    for (int it = gt; it < MS * D; it += NGT_) {
        const int row = it >> 10, ch = it & 1023, b = row >> 2, s = row & 3;
        float up[3];
#pragma unroll
        for (int k = 0; k < 3; ++k) { const int ss = s - 2 + k; up[k] = (ss >= 0) ? c.ZS()[(size_t)(b * SS + ss) * NIN + 1024 + ch] * c.ZS()[(size_t)(b * SS + ss) * NIN + 2048 + ch] : c.state_conv()[(size_t)(b * 2 + (ss + 2)) * D + ch]; }
        const float v = c.b_conv()[ch] + c.w_conv()[ch] * up[0] + c.w_conv()[D + ch] * up[1] + c.w_conv()[2 * D + ch] * up[2];
        c.AAS()[(size_t)row * D + ch] = c.ZS()[(size_t)row * NIN + ch] * v;
        if (s >= 2) c.out()[O_CONV_S + (size_t)(b * 2 + (s - 2)) * D + ch] = up[2];
    }
    for (int it = gt; it < MS * 512; it += NGT_) { const int row = it >> 9, cc = it & 511;
        c.out()[O_CMP_S + (size_t)row * 512 + cc] = c.ZS()[(size_t)row * NIN + 4096 + cc]; c.out()[O_SEL_S + (size_t)row * 512 + cc] = c.ZS()[(size_t)row * NIN + 4608 + cc]; }
    for (int it = gt; it < SB * 512 * 128; it += NGT_) { const int cc = (it & 127) * 4, j = (it >> 7) & 511, b = it >> 16;
        f32x4 v;
        if (j + SS < 512) v = *(const f32x4*)(c.cache_win() + ((size_t)(b * 512 + j + SS)) * 512 + cc);
        else v = *(const f32x4*)(c.ZS() + (size_t)(b * SS + (j + SS - 512)) * NIN + 5120 + cc);
        *(GAS f32x4*)(c.out() + O_WIN_S + ((size_t)(b * 512 + j)) * 512 + cc) = v; }
}
struct CmpP { static constexpr int NB_ = NB, NCS = NCS_P, NCP = NCP_P, NGRP = 16;
    __device__ static __forceinline__ float x(const Ctx& c, int kv, int b, int g, int pos, int d) { return bf2f(c.ACMP()[((size_t)kv * CM_ROWS + CM_S) * 1024 + ((size_t)((b * NKV + g) * T + pos)) * HD + d]); }
    __device__ static __forceinline__ void store(const Ctx& c, int kv, int b, int g, int i, int o, float s) {
        c.KCC()[((size_t)((kv * NB + b) * NKV + g) * NCP_P + i) * HD + o] = s; } };
struct CmpS { static constexpr int NB_ = SB, NCS = NCS_S, NCP = NCP_S, NGRP = 32;
    __device__ static __forceinline__ float x(const Ctx& c, int kv, int b, int g, int pos, int d) { return c.cache_cmp()[((size_t)c.pt()[b * NPG + (pos >> 7)] * PAGE + (pos & 127)) * 512 + kv * 256 + g * HD + d]; }
    __device__ static __forceinline__ void store(const Ctx& c, int kv, int b, int g, int i, int o, float s) { c.KCCS()[((size_t)((kv * SB + b) * NKV + g) * NCP_S + i) * HD + o] = s; } };
template <class S> __device__ __forceinline__ void compress_naive(const Ctx& c) {
    constexpr int NITEMS = 2 * S::NB_ * NKV * S::NGRP;
    LAS float* hid = (LAS float*)c.lds;
    const int n = c.tid & 127, rq = c.tid >> 7;
    for (int it = c.bid; it < NITEMS; it += c.G) {
        const int ig = it % S::NGRP, g = (it / S::NGRP) % NKV, b = (it / (S::NGRP * NKV)) % S::NB_, kv = it / (S::NGRP * NKV * S::NB_);
        const int i0 = ig * 16 + 4 * rq;
        float acc[4] = {0.f, 0.f, 0.f, 0.f};
        for (int t = 0; t < 32; ++t) {
            for (int d = 0; d < HD; ++d) {
                const int k = t * HD + d; const float w = c.w_phi1()[((size_t)kv * 2048 + k) * 128 + n], pe = c.pe()[kv * 2048 + k];
#pragma unroll
                for (int r = 0; r < 4; ++r) { int i = i0 + r; i = i < S::NCS ? i : S::NCS - 1; acc[r] += (S::x(c, kv, b, g, 16 * i + t, d) + pe) * w; }
            }
        }
        __syncthreads();
#pragma unroll
        for (int r = 0; r < 4; ++r) hid[(4 * rq + r) * 128 + n] = gelu_tanh(acc[r]);
        __syncthreads();
        const int o = c.tid & 63;
#pragma unroll
        for (int rr = 0; rr < 2; ++rr) { const int r = (c.tid >> 6) + 8 * rr, i = ig * 16 + r; float s = 0.f;
            for (int k = 0; k < 128; ++k) s += hid[r * 128 + k] * c.w_phi2()[((size_t)kv * 128 + k) * HD + o];
            if (i < S::NCS) S::store(c, kv, b, g, i, o, s); }
    }
    __syncthreads();
}

struct AtP {
    static constexpr int NQ = T, QBASE = 0, NS = 64, NSP = 64, NSL = 1, NBAT = NB, NCP = NCP_P;
    typedef bf16 KT;
    __device__ static __forceinline__ void decode(int idx, int& b, int& h, int& qi) { qi = idx & (T - 1); h = (idx >> 12) & 15; b = idx >> 16; }
    __device__ static __forceinline__ void load_q(const Ctx& c, int b, int h, int qi, float (&q)[64]) { const bf16* p = c.Q() + (size_t)(b * T + qi) * D + h * HD;
#pragma unroll
        for (int cc = 0; cc < 8; ++cc) { float v[8]; ld8(p + 8 * cc, v);
#pragma unroll
            for (int j = 0; j < 8; ++j) q[8 * cc + j] = v[j] * 0.6931471805599453f; } }
    __device__ static __forceinline__ float gate(const Ctx& c, int b, int h, int qi, int j) { return c.NGT()[(size_t)(b * T + qi) * 48 + h * 3 + j]; }
    __device__ static __forceinline__ const float* kcc(const Ctx& c, int kv, int b, int g, int ci) { return c.KCC() + ((size_t)((kv * NB + b) * NKV + g) * NCP_P + ci) * HD; }
    __device__ static __forceinline__ const KT* ksel(const Ctx& c, int kv, int b, int g, int pos) { return c.HM() + (size_t)(2 + kv) * HMSZ + ((size_t)((b * NKV + g) * T + pos)) * HD; }
    __device__ static __forceinline__ const KT* kwin(const Ctx& c, int kv, int b, int g, int pos) { return c.HM() + (size_t)(4 + kv) * HMSZ + ((size_t)((b * NKV + g) * T + pos)) * HD; }
    __device__ static __forceinline__ float* scoreh(const Ctx& c) { return c.SCOREH(); }
    __device__ static __forceinline__ unsigned long long* mask(const Ctx& c) { return c.MASK(); }
    __device__ static __forceinline__ void store_o(const Ctx& c, int b, int h, int qi, const float (&o)[64]) { bf16* p = c.OB + (size_t)(b * T + qi) * D + h * HD;
#pragma unroll
        for (int cc = 0; cc < 8; ++cc) { float v[8];
#pragma unroll
            for (int j = 0; j < 8; ++j) v[j] = o[8 * cc + j];
            *(GAS v4u*)(p + 8 * cc) = pack8(v); } }
};
struct AtS {
    static constexpr int NQ = SS, QBASE = PAST, NS = 129, NSP = 192, NSL = 3, NBAT = SB, NCP = NCP_S;
    typedef float KT;
    __device__ static __forceinline__ void decode(int idx, int& b, int& h, int& qi) { qi = idx & 3; h = (idx >> 2) & 15; b = idx >> 6; }
    __device__ static __forceinline__ void load_q(const Ctx& c, int b, int h, int qi, float (&q)[64]) { const float* p = c.ZS() + (size_t)(b * SS + qi) * NIN + 3072 + h * HD;
#pragma unroll
        for (int j = 0; j < 64; ++j) q[j] = p[j] * 0.125f; }
    __device__ static __forceinline__ float gate(const Ctx& c, int b, int h, int qi, int j) { return sigmoidf_(c.ZS()[(size_t)(b * SS + qi) * NIN + 5632 + h * 3 + j]); }
    __device__ static __forceinline__ const float* kcc(const Ctx& c, int kv, int b, int g, int ci) { return c.KCCS() + ((size_t)((kv * SB + b) * NKV + g) * NCP_S + ci) * HD; }
    __device__ static __forceinline__ const KT* ksel(const Ctx& c, int kv, int b, int g, int pos) {
        if (pos < PAST) return c.cache_sel() + ((size_t)c.pt()[b * NPG + (pos >> 7)] * PAGE + (pos & 127)) * 512 + kv * 256 + g * HD;
        return c.ZS() + (size_t)(b * SS + (pos - PAST)) * NIN + 4608 + kv * 256 + g * HD; }
    __device__ static __forceinline__ const KT* kwin(const Ctx& c, int kv, int b, int g, int pos) {
        if (pos < PAST) return c.cache_win() + ((size_t)(b * 512 + (pos - (PAST - 512)))) * 512 + kv * 256 + g * HD;
        return c.ZS() + (size_t)(b * SS + (pos - PAST)) * NIN + 5120 + kv * 256 + g * HD; }
    __device__ static __forceinline__ float* scoreh(const Ctx& c) { return c.SCOREHS(); }
    __device__ static __forceinline__ unsigned long long* mask(const Ctx& c) { return c.MASKS(); }
    __device__ static __forceinline__ void store_o(const Ctx& c, int b, int h, int qi, const float (&o)[64]) { float* p = c.OBS() + (size_t)(b * SS + qi) * D + h * HD;
#pragma unroll
        for (int j = 0; j < 64; ++j) p[j] = o[j]; }
};
__device__ __forceinline__ int wave_max_i(int v) {
#pragma unroll
    for (int o = 1; o < 64; o <<= 1) { const int t = __shfl_xor(v, o); v = t > v ? t : v; }
    return v;
}
__device__ __forceinline__ int wave_min_i(int v) {
#pragma unroll
    for (int o = 1; o < 64; o <<= 1) { const int t = __shfl_xor(v, o); v = t < v ? t : v; }
    return v;
}
template <class S> __device__ __forceinline__ void p4a_scores(const Ctx& c) {
    constexpr int NW = S::NBAT * H * S::NQ / 64;
    const int gw = c.bid * NWAVES + c.wave, NGW = c.G * NWAVES;
    for (int w = gw; w < NW; w += NGW) {
        const int idx = w * 64 + c.lane; int b, h, qi; S::decode(idx, b, h, qi);
        const int g = h >> 2, qpos = S::QBASE + qi; const float tq = (float)qpos, slope = exp2f(-0.5f * (float)(h + 1));
        float q[64]; S::load_q(c, b, h, qi, q);
        const int ncv = qpos >= 31 ? ((qpos - 31) >> 4) + 1 : 0, ncm = wave_max_i(ncv);
        float m = NEGF;
        for (int ci = 0; ci < ncm; ++ci) { const int cc = ci < ncv ? ci : 0; const float s = dot64(S::kcc(c, 0, b, g, cc), q) - slope * (tq - 16.f * ci - 15.5f); if (ci < ncv) m = fmaxf(m, s); }
        float l = 0.f;
        for (int ci = 0; ci < ncm; ++ci) { const int cc = ci < ncv ? ci : 0; const float s = dot64(S::kcc(c, 0, b, g, cc), q) - slope * (tq - 16.f * ci - 15.5f); if (ci < ncv) l += __expf(s - m); }
        const float il = l > 0.f ? 1.f / l : 0.f;
        float carry = 0.f; float* sp = S::scoreh(c) + (size_t)idx * S::NSP;
        const int nsm = (ncm + 3) >> 2;
        for (int s4 = 0; s4 < S::NS; ++s4) {
            float a = carry;
            if (s4 < nsm + 1) {
#pragma unroll 1
                for (int j = 0; j < 4; ++j) { const int ci = 4 * s4 + j; float p = 0.f;
                    if (ci < ncm) { const int cc = ci < ncv ? ci : 0; const float s = dot64(S::kcc(c, 0, b, g, cc), q) - slope * (tq - 16.f * ci - 15.5f); p = ci < ncv ? __expf(s - m) * il : 0.f; }
                    a += p; if (j == 3) carry = p; }
            } else carry = 0.f;
            sp[s4] = a;
        }
    }
}
template <class S> __device__ __forceinline__ void p4b_topk(const Ctx& c) {
    constexpr int NW = S::NBAT * NKV * S::NQ;
    const int gw = c.bid * NWAVES + c.wave, NGW = c.G * NWAVES;
    for (int w = gw; w < NW; w += NGW) {
        const int qi = w % S::NQ, g = (w / S::NQ) % NKV, b = w / (S::NQ * NKV);
        const int qpos = S::QBASE + qi, cur = qpos >> 6;
        float val[S::NSL];
#pragma unroll
        for (int j = 0; j < S::NSL; ++j) { const int s = c.lane + 64 * j; float v = -INFINITY;
            if (s < S::NS) { float imp = 0.f;
#pragma unroll
                for (int r = 0; r < 4; ++r) imp += S::scoreh(c)[((size_t)((b * H + 4 * g + r) * S::NQ + qi)) * S::NSP + s];
                const bool valid = 64 * s <= qpos, forced = (s == 0) || (s == cur) || (s == cur - 1);
                v = valid ? imp + (forced ? 1000.f : 0.f) : NEGF; }
            val[j] = v; }
        int rank[S::NSL];
#pragma unroll
        for (int j = 0; j < S::NSL; ++j) rank[j] = 0;
#pragma unroll
        for (int j2 = 0; j2 < S::NSL; ++j2)
            for (int l2 = 0; l2 < 64; ++l2) { const float v2 = __shfl(val[j2], l2); const int s2 = l2 + 64 * j2;
#pragma unroll
                for (int j = 0; j < S::NSL; ++j) { const int s = c.lane + 64 * j; rank[j] += (v2 > val[j] || (v2 == val[j] && s2 < s)) ? 1 : 0; } }
#pragma unroll
        for (int j = 0; j < S::NSL; ++j) { const int s = c.lane + 64 * j; const unsigned long long mk = __ballot(rank[j] < 16 && s < S::NS);
            if (c.lane == 0) S::mask(c)[(size_t)w * S::NSL + j] = mk; }
    }
}
#define ONLINE_UPD(sv, vrow, ok) do { if (ok) { if ((sv) > m) { const float al = __expf(m - (sv)); l *= al; _Pragma("unroll") for (int d_ = 0; d_ < 64; ++d_) o[d_] *= al; m = (sv); } \
        const float p_ = __expf((sv) - m); l += p_; axpy64((vrow), p_, o); } } while (0)
template <class S> __device__ __forceinline__ void p4c_attend(const Ctx& c, int mode = -1) {
    constexpr int NW = S::NBAT * H * S::NQ / 64;
    const int gw = c.bid * NWAVES + c.wave, NGW = c.G * NWAVES;
    for (int w = gw; w < NW; w += NGW) {
        const int idx = w * 64 + c.lane; int b, h, qi; S::decode(idx, b, h, qi);
        const int g = h >> 2, qpos = S::QBASE + qi, cur = qpos >> 6; const float tq = (float)qpos, slope = exp2f(-0.5f * (float)(h + 1));
        float q[64]; S::load_q(c, b, h, qi, q);
        LAS float* ot = (LAS float*)c.lds + c.tid;
#pragma unroll
        for (int d = 0; d < 64; ++d) ot[d * NTHR] = 0.f;
        float o[64]; float m, l;
        {
#pragma unroll
            for (int d = 0; d < 64; ++d) o[d] = 0.f;
            m = NEGF; l = 0.f;
            const int ncv = qpos >= 31 ? ((qpos - 31) >> 4) + 1 : 0, ncm = wave_max_i(ncv);
            for (int ci = 0; ci < ncm; ++ci) { const bool ok = ci < ncv; const int cc = ok ? ci : 0;
                const float s = dot64(S::kcc(c, 0, b, g, cc), q) - slope * (tq - 16.f * ci - 15.5f);
                ONLINE_UPD(s, S::kcc(c, 1, b, g, cc), ok); }
            if (l > 0.f) { const float f = ((mode < 0 || mode == 0) ? S::gate(c, b, h, qi, 0) : 0.f) / l;
#pragma unroll
                for (int d = 0; d < 64; ++d) ot[d * NTHR] += f * o[d]; }
        }
        {
#pragma unroll
            for (int d = 0; d < 64; ++d) o[d] = 0.f;
            m = NEGF; l = 0.f;
            unsigned long long mk[S::NSL];
#pragma unroll
            for (int j = 0; j < S::NSL; ++j) mk[j] = S::mask(c)[((size_t)((b * NKV + g) * S::NQ + qi)) * S::NSL + j];
            const int curm = wave_max_i(cur);
            for (int s = 0; s <= curm; ++s) {
                unsigned long long word = mk[0];
#pragma unroll
                for (int j = 1; j < S::NSL; ++j) if ((s >> 6) == j) word = mk[j];
                const bool sel = (s <= cur) && ((word >> (s & 63)) & 1ull);
                if (!__any(sel)) continue;
                for (int k = 0; k < 64; ++k) { const int pos = 64 * s + k; const bool ok = sel && pos <= qpos; const int pc = pos <= qpos ? pos : qpos;
                    if (!__any(ok)) continue;
                    const float sv = dot64(S::ksel(c, 0, b, g, pc), q) - slope * (tq - (float)pos);
                    ONLINE_UPD(sv, S::ksel(c, 1, b, g, pc), ok); }
            }
            if (l > 0.f) { const float f = ((mode < 0 || mode == 1) ? S::gate(c, b, h, qi, 1) : 0.f) / l;
#pragma unroll
                for (int d = 0; d < 64; ++d) ot[d * NTHR] += f * o[d]; }
        }
        {
#pragma unroll
            for (int d = 0; d < 64; ++d) o[d] = 0.f;
            m = NEGF; l = 0.f;
            const int lo = qpos - 511 > 0 ? qpos - 511 : 0; const int lom = wave_min_i(lo), him = wave_max_i(qpos);
            for (int kp = lom; kp <= him; ++kp) { const bool ok = kp >= lo && kp <= qpos; int pc = kp < lo ? lo : kp; pc = pc > qpos ? qpos : pc;
                if (S::QBASE > 0 && pc < PAST - 512) pc = PAST - 512;
                const float sv = dot64(S::kwin(c, 0, b, g, pc), q) - slope * (tq - (float)kp);
                ONLINE_UPD(sv, S::kwin(c, 1, b, g, pc), ok); }
            if (l > 0.f) { const float f = ((mode < 0 || mode == 2) ? S::gate(c, b, h, qi, 2) : 0.f) / l;
#pragma unroll
                for (int d = 0; d < 64; ++d) ot[d * NTHR] += f * o[d]; }
        }
#pragma unroll
        for (int d = 0; d < 64; ++d) o[d] = ot[d * NTHR];
        S::store_o(c, b, h, qi, o);
    }
}

namespace at {
typedef short bfx8 __attribute__((ext_vector_type(8)));
constexpr float LOG2E = 1.4426950408889634f;
constexpr float QSCALE = 0.125f * LOG2E;
constexpr int IMP_PITCH = 68;
__device__ __forceinline__ f32x4 mfma16(bfx8 a, bfx8 b, f32x4 c) { return __builtin_amdgcn_mfma_f32_16x16x32_bf16(a, b, c, 0, 0, 0); }
__device__ __forceinline__ void ce_desc(float& a, float& b) { const float hi = fmaxf(a, b), lo = fminf(a, b); a = hi; b = lo; }
__device__ __forceinline__ void sort16_desc(float (&v)[16]) {
#pragma unroll
    for (int k = 2; k <= 16; k <<= 1)
#pragma unroll
        for (int j = k >> 1; j > 0; j >>= 1)
#pragma unroll
            for (int i = 0; i < 16; ++i) { const int l = i ^ j; if (l > i) { if ((i & k) == 0) ce_desc(v[i], v[l]); else ce_desc(v[l], v[i]); } }
}
__device__ __forceinline__ void merge16_desc(float (&v)[16]) {
#pragma unroll
    for (int j = 8; j > 0; j >>= 1)
#pragma unroll
        for (int i = 0; i < 16; ++i) { const int l = i ^ j; if (l > i) ce_desc(v[i], v[l]); }
}
struct Tile {
    bfx8 qf[4][2]; float slope2[4]; f32x4 ot[4][4]; float m[4], l[4];
    int lane, ql, G, qpos;
};
__device__ __forceinline__ void qk_chunk(const Tile& t, const bf16* kb, f32x4 (&sa)[4], f32x4 (&sb)[4]) {
    const int r16 = t.ql; const bf16* ka = kb + (8 * (r16 >> 2) + (r16 & 3)) * 64 + 8 * t.G;
    const bfx8 a0 = *(const bfx8*)ka, a1 = *(const bfx8*)(ka + 32), b0 = *(const bfx8*)(ka + 256), b1 = *(const bfx8*)(ka + 256 + 32);
#pragma unroll
    for (int r = 0; r < 4; ++r) {
        f32x4 z = {0.f, 0.f, 0.f, 0.f};
        sa[r] = mfma16(a0, t.qf[r][0], z); sa[r] = mfma16(a1, t.qf[r][1], sa[r]);
        sb[r] = mfma16(b0, t.qf[r][0], z); sb[r] = mfma16(b1, t.qf[r][1], sb[r]);
    }
}
__device__ __forceinline__ void pv_chunk(Tile& t, const bf16* vtb, int pitch, const bfx8 (&pf)[4]) {
#pragma unroll
    for (int db = 0; db < 4; ++db) { const bfx8 vf = *(const bfx8*)(vtb + (size_t)(16 * db + t.ql) * pitch + 8 * t.G);
#pragma unroll
        for (int r = 0; r < 4; ++r) t.ot[r][db] = mfma16(vf, pf[r], t.ot[r][db]); }
}
__device__ __forceinline__ float gmax4(float v) { v = fmaxf(v, __shfl_xor(v, 16)); v = fmaxf(v, __shfl_xor(v, 32)); return v; }
__device__ __forceinline__ float gsum4(float v) { v += __shfl_xor(v, 16); v += __shfl_xor(v, 32); return v; }
__device__ __forceinline__ bfx8 pack_p(const float (&p)[8]) {
    v4u w; w.x = pg8::cvt_pk_bf16(p[0], p[1]); w.y = pg8::cvt_pk_bf16(p[2], p[3]); w.z = pg8::cvt_pk_bf16(p[4], p[5]); w.w = pg8::cvt_pk_bf16(p[6], p[7]);
    return __builtin_bit_cast(bfx8, w);
}
__device__ __forceinline__ void softmax_online(Tile& t, const f32x4 (&sa)[4], const f32x4 (&sb)[4], const float (&tk)[8], const bool (&ok)[8], bfx8 (&pf)[4]) {
#pragma unroll
    for (int r = 0; r < 4; ++r) {
        float s[8];
#pragma unroll
        for (int j = 0; j < 4; ++j) { s[j] = ok[j] ? __builtin_fmaf(t.slope2[r], tk[j], sa[r][j]) : -INFINITY; s[4 + j] = ok[4 + j] ? __builtin_fmaf(t.slope2[r], tk[4 + j], sb[r][j]) : -INFINITY; }
        float pm = fmaxf(fmaxf(fmaxf(s[0], s[1]), fmaxf(s[2], s[3])), fmaxf(fmaxf(s[4], s[5]), fmaxf(s[6], s[7])));
        pm = gmax4(pm);
        if (__any(pm > t.m[r])) {
            const float mn = fmaxf(t.m[r], pm), al = __builtin_amdgcn_exp2f(t.m[r] - mn);
            t.m[r] = mn; t.l[r] *= al;
#pragma unroll
            for (int db = 0; db < 4; ++db) t.ot[r][db] = t.ot[r][db] * al;
        }
        float p[8]; float ps = 0.f;
#pragma unroll
        for (int j = 0; j < 8; ++j) { p[j] = __builtin_amdgcn_exp2f(s[j] - t.m[r]); ps += p[j]; }
        t.l[r] += ps;
        pf[r] = pack_p(p);
    }
}
__device__ __forceinline__ void chunk_step(Tile& t, const bf16* kb, const bf16* vtb, int pitch, const float (&tk)[8]) {
    const int r16 = t.ql; const bf16* ka = kb + (8 * (r16 >> 2) + (r16 & 3)) * 64 + 8 * t.G;
    const bfx8 a0 = *(const bfx8*)ka, a1 = *(const bfx8*)(ka + 32), b0 = *(const bfx8*)(ka + 256), b1 = *(const bfx8*)(ka + 256 + 32);
    bfx8 vf[4];
#pragma unroll
    for (int db = 0; db < 4; ++db) vf[db] = *(const bfx8*)(vtb + (size_t)(16 * db + t.ql) * pitch + 8 * t.G);
#pragma unroll
    for (int r = 0; r < 4; ++r) {
        const f32x4 z = {0.f, 0.f, 0.f, 0.f};
        f32x4 sa = mfma16(a0, t.qf[r][0], z); sa = mfma16(a1, t.qf[r][1], sa);
        f32x4 sb = mfma16(b0, t.qf[r][0], z); sb = mfma16(b1, t.qf[r][1], sb);
        float s[8];
#pragma unroll
        for (int j = 0; j < 4; ++j) { s[j] = __builtin_fmaf(t.slope2[r], tk[j], sa[j]); s[4 + j] = __builtin_fmaf(t.slope2[r], tk[4 + j], sb[j]); }
        float pm = fmaxf(fmaxf(fmaxf(s[0], s[1]), fmaxf(s[2], s[3])), fmaxf(fmaxf(s[4], s[5]), fmaxf(s[6], s[7])));
        pm = gmax4(pm);
        if (__any(pm > t.m[r])) {
            const float mn = fmaxf(t.m[r], pm), al = __builtin_amdgcn_exp2f(t.m[r] - mn);
            t.m[r] = mn; t.l[r] *= al;
#pragma unroll
            for (int db = 0; db < 4; ++db) t.ot[r][db] = t.ot[r][db] * al;
        }
        float p[8]; float ps = 0.f;
#pragma unroll
        for (int j = 0; j < 8; ++j) { p[j] = __builtin_amdgcn_exp2f(s[j] - t.m[r]); ps += p[j]; }
        t.l[r] += ps;
        const bfx8 pf = pack_p(p);
#pragma unroll
        for (int db = 0; db < 4; ++db) t.ot[r][db] = mfma16(vf[db], pf, t.ot[r][db]);
    }
}
__device__ __forceinline__ void reset_branch(Tile& t) {
#pragma unroll
    for (int r = 0; r < 4; ++r) { t.m[r] = NEGF; t.l[r] = 0.f;
#pragma unroll
        for (int db = 0; db < 4; ++db) t.ot[r][db] = (f32x4){0.f, 0.f, 0.f, 0.f}; }
}
template <bool FIRST> __device__ __forceinline__ void fold_branch(Tile& t, LAS float* otl, const float (&gate)[4]) {
#pragma unroll
    for (int r = 0; r < 4; ++r) { const float lt = gsum4(t.l[r]); const float f = lt > 0.f ? gate[r] / lt : 0.f;
#pragma unroll
        for (int db = 0; db < 4; ++db)
#pragma unroll
            for (int i = 0; i < 4; ++i) { LAS float* p = otl + ((r * 16 + db * 4 + i) * 64 + t.lane); const float v = f * t.ot[r][db][i]; *p = FIRST ? v : (*p + v); } }
}

__device__ __forceinline__ void attn_tile(const Ctx& c, int b, int g, int qt, LAS float* wl, int mode = -1) {
    int lane_ = c.lane; asm volatile("" : "+v"(lane_));
    Tile t; t.lane = lane_; t.ql = lane_ & 15; t.G = lane_ >> 4;
    const int q0 = qt * 16; t.qpos = q0 + t.ql;
    const int qpos = t.qpos, ql = t.ql, G = t.G;
    const size_t row = (size_t)(b * T + qpos);
#pragma unroll
    for (int r = 0; r < 4; ++r) {
        const int h = 4 * g + r;
        t.qf[r][0] = *(const bfx8*)(c.Q() + row * D + h * HD + 8 * G); t.qf[r][1] = *(const bfx8*)(c.Q() + row * D + h * HD + 32 + 8 * G);
        t.slope2[r] = exp2f(-0.5f * (float)(h + 1)) * LOG2E;
    }
    const float* gatep = c.NGT() + row * 48 + 12 * g;
    const size_t bg = (size_t)(b * NKV + g);
    const bf16* KC = c.KCCB() + bg * NCP_P * HD;
    const bf16* VCT = c.VCCT() + bg * HD * NCP_P;
    const bf16* KS = c.HM() + 2 * HMSZ + bg * T * HD;
    const bf16* VST = c.VST() + bg * HD * T;
    const bf16* KW = c.HM() + 4 * HMSZ + bg * T * HD;
    const bf16* VWT = c.VWT() + bg * HD * T;
    const int ncv = qpos >= 31 ? ((qpos - 31) >> 4) + 1 : 0;
    const int nch = (qt + 31) >> 5;
    unsigned long long m64, U;
    {
        LAS float* impA = wl; LAS float* impB = wl + 16 * IMP_PITCH;
        for (int i = lane_; i < 2 * 16 * IMP_PITCH; i += 64) wl[i] = 0.f;
        float cm[4], cl[4];
#pragma unroll
        for (int r = 0; r < 4; ++r) { cm[r] = NEGF; cl[r] = 0.f; }
        for (int ch = 0; ch < nch; ++ch) {
            f32x4 sa[4], sb[4]; qk_chunk(t, KC + (size_t)ch * 32 * HD, sa, sb);
            float tk[8];
#pragma unroll
            for (int j = 0; j < 8; ++j) { const int ci = ch * 32 + 8 * G + j; tk[j] = __builtin_fmaf(fmaxf((float)(ci - ncv + 1), 0.f), -1e36f, 16.f * (float)ci + 15.5f - (float)qpos); }
#pragma unroll
            for (int r = 0; r < 4; ++r) {
                float s[8];
#pragma unroll
                for (int j = 0; j < 4; ++j) { s[j] = __builtin_fmaf(t.slope2[r], tk[j], sa[r][j]); s[4 + j] = __builtin_fmaf(t.slope2[r], tk[4 + j], sb[r][j]); }
                float pm = fmaxf(fmaxf(fmaxf(s[0], s[1]), fmaxf(s[2], s[3])), fmaxf(fmaxf(s[4], s[5]), fmaxf(s[6], s[7])));
                pm = gmax4(pm);
                const float mn = fmaxf(cm[r], pm), al = __builtin_amdgcn_exp2f(cm[r] - mn);
                float ps = 0.f;
#pragma unroll
                for (int j = 0; j < 8; ++j) ps += __builtin_amdgcn_exp2f(s[j] - mn);
                cl[r] = cl[r] * al + ps; cm[r] = mn;
            }
        }
#pragma unroll
        for (int r = 0; r < 4; ++r) { const float lt = gsum4(cl[r]); cl[r] = lt > 0.f ? 1.f / lt : 0.f; }
        for (int ch = 0; ch < nch; ++ch) {
            f32x4 sa[4], sb[4]; qk_chunk(t, KC + (size_t)ch * 32 * HD, sa, sb);
            float tk[8];
#pragma unroll
            for (int j = 0; j < 8; ++j) { const int ci = ch * 32 + 8 * G + j; tk[j] = __builtin_fmaf(fmaxf((float)(ci - ncv + 1), 0.f), -1e36f, 16.f * (float)ci + 15.5f - (float)qpos); }
            float psum[8];
#pragma unroll
            for (int j = 0; j < 8; ++j) psum[j] = 0.f;
#pragma unroll
            for (int r = 0; r < 4; ++r) {
                float sv[8];
#pragma unroll
                for (int j = 0; j < 4; ++j) { sv[j] = __builtin_fmaf(t.slope2[r], tk[j], sa[r][j]); sv[4 + j] = __builtin_fmaf(t.slope2[r], tk[4 + j], sb[r][j]); }
#pragma unroll
                for (int j = 0; j < 8; ++j) psum[j] += __builtin_amdgcn_exp2f(sv[j] - cm[r]) * cl[r];
            }
            const int s0 = ch * 8 + 2 * G;
            impA[ql * IMP_PITCH + s0] = (psum[0] + psum[1]) + (psum[2] + psum[3]);
            impA[ql * IMP_PITCH + s0 + 1] = (psum[4] + psum[5]) + (psum[6] + psum[7]) + psum[3];
            impB[ql * IMP_PITCH + s0 + 2] = psum[7];
        }
        LDS_WAIT(); asm volatile("" ::: "memory");
        const int cur = qpos >> 6;
        float v[16], srt[16];
#pragma unroll
        for (int i4 = 0; i4 < 4; ++i4) { const f32x4 a = *(const LAS f32x4*)(impA + ql * IMP_PITCH + 16 * G + 4 * i4), bq = *(const LAS f32x4*)(impB + ql * IMP_PITCH + 16 * G + 4 * i4);
#pragma unroll
            for (int k = 0; k < 4; ++k) { const int s = 16 * G + 4 * i4 + k; const bool forced = (s == 0) || (s == cur) || (s == cur - 1);
                v[4 * i4 + k] = (s <= cur) ? (a[k] + bq[k]) + (forced ? 1000.f : 0.f) : NEGF; } }
#pragma unroll
        for (int i = 0; i < 16; ++i) srt[i] = v[i];
        if (PROBE_ATT) {
            float* sp_ = c.SCOREH() + ((size_t)(b * NKV + g) * T + qpos) * 64 + 16 * G;
#pragma unroll
            for (int i = 0; i < 4; ++i) *(GAS f32x4*)(sp_ + 4 * i) = (f32x4){v[4 * i], v[4 * i + 1], v[4 * i + 2], v[4 * i + 3]}; }
        sort16_desc(srt);
        float oth[16];
#pragma unroll
        for (int i = 0; i < 16; ++i) oth[i] = __shfl_xor(srt[i], 16);
#pragma unroll
        for (int i = 0; i < 16; ++i) srt[i] = fmaxf(srt[i], oth[15 - i]);
        merge16_desc(srt);
#pragma unroll
        for (int i = 0; i < 16; ++i) oth[i] = __shfl_xor(srt[i], 32);
        float thr = fmaxf(srt[0], oth[15]);
#pragma unroll
        for (int i = 1; i < 16; ++i) thr = fminf(thr, fmaxf(srt[i], oth[15 - i]));
        int ngt = 0, neq = 0;
#pragma unroll
        for (int i = 0; i < 16; ++i) { ngt += v[i] > thr ? 1 : 0; neq += v[i] == thr ? 1 : 0; }
        int ngt_t = ngt + __shfl_xor(ngt, 16); ngt_t += __shfl_xor(ngt_t, 32);
        const int need = 16 - ngt_t;
        int eqb = 0;
#pragma unroll
        for (int gg = 0; gg < 3; ++gg) { const int o = __shfl(neq, ql + 16 * gg); eqb += (gg < G) ? o : 0; }
        unsigned mloc = 0; int run = eqb;
#pragma unroll
        for (int i = 0; i < 16; ++i) { const int s = 16 * G + i; bool sel = v[i] > thr; if (v[i] == thr) { sel = run < need; ++run; } sel = sel && (s <= cur); mloc |= sel ? (1u << i) : 0u; }
        const unsigned w0 = __shfl(mloc, ql), w1 = __shfl(mloc, ql + 16), w2 = __shfl(mloc, ql + 32), w3 = __shfl(mloc, ql + 48);
        const unsigned lo = w0 | (w1 << 16), hi = w2 | (w3 << 16);
        m64 = ((unsigned long long)hi << 32) | lo;
        unsigned ulo = lo, uhi = hi;
#pragma unroll
        for (int o = 1; o < 16; o <<= 1) { ulo |= __shfl_xor(ulo, o); uhi |= __shfl_xor(uhi, o); }
        U = ((unsigned long long)(unsigned)__builtin_amdgcn_readfirstlane(uhi) << 32) | (unsigned)__builtin_amdgcn_readfirstlane(ulo);
        if (PROBE_ATT && G == 0) c.MASKM()[(size_t)(b * NKV + g) * T + qpos] = m64;
    }
    asm volatile("" ::: "memory");
    reset_branch(t);
    while (U) {
        const int s = __builtin_ctzll(U); U &= U - 1;
        const float pen = ((m64 >> s) & 1ull) ? 0.f : -1e36f;
#pragma unroll 1
        for (int hf = 0; hf < 2; ++hf) {
            const int base = 64 * s + 32 * hf;
            if (base > q0 + 15) break;
            float tk[8];
#pragma unroll
            for (int j = 0; j < 8; ++j) { const float fd = (float)(base + 8 * G + j - qpos); tk[j] = __builtin_fmaf(fd - fminf(fd, 0.f), -1e36f, fd) + pen; }
            chunk_step(t, KS + (size_t)base * HD, VST + base, T, tk);
        }
    }
    { float gt[4];
#pragma unroll
      for (int r = 0; r < 4; ++r) gt[r] = (mode < 0 || mode == 1) ? gatep[r * 3 + 1] : 0.f;
      fold_branch<true>(t, wl, gt); }
    reset_branch(t);
    {
        int wlo = q0 - 511; wlo = wlo < 0 ? 0 : wlo; wlo &= ~31;
        const int whi = (q0 + 15) & ~31;
#pragma unroll 1
        for (int base = wlo; base <= whi; base += 32) {
            float tk[8];
#pragma unroll
            for (int j = 0; j < 8; ++j) { const float fd = (float)(base + 8 * G + j - qpos); const float cl_ = fminf(fmaxf(fd, -511.f), 0.f); tk[j] = __builtin_fmaf(fabsf(fd - cl_), -1e36f, fd); }
            chunk_step(t, KW + (size_t)base * HD, VWT + base, T, tk);
        }
    }
    { float gt[4];
#pragma unroll
      for (int r = 0; r < 4; ++r) gt[r] = (mode < 0 || mode == 2) ? gatep[r * 3 + 2] : 0.f;
      fold_branch<false>(t, wl, gt); }
    reset_branch(t);
#pragma unroll 1
    for (int ch = 0; ch < nch; ++ch) {
        float tk[8];
#pragma unroll
        for (int j = 0; j < 8; ++j) { const int ci = ch * 32 + 8 * G + j; tk[j] = __builtin_fmaf(fmaxf((float)(ci - ncv + 1), 0.f), -1e36f, 16.f * (float)ci + 15.5f - (float)qpos); }
        chunk_step(t, KC + (size_t)ch * 32 * HD, VCT + ch * 32, NCP_P, tk);
    }
#pragma unroll
    for (int r = 0; r < 4; ++r) { const float lt = gsum4(t.l[r]); const float f = (lt > 0.f && (mode < 0 || mode == 0)) ? gatep[r * 3] / lt : 0.f;
#pragma unroll
        for (int db = 0; db < 4; ++db) { float o4[4];
#pragma unroll
            for (int i = 0; i < 4; ++i) o4[i] = wl[(r * 16 + db * 4 + i) * 64 + t.lane] + f * t.ot[r][db][i];
            const unsigned long long pk = (unsigned long long)pg8::cvt_pk_bf16(o4[0], o4[1]) | ((unsigned long long)pg8::cvt_pk_bf16(o4[2], o4[3]) << 32);
            *(GAS unsigned long long*)(c.OB + row * D + (4 * g + r) * HD + 16 * db + 4 * G) = pk; } }
    LDS_WAIT(); asm volatile("" ::: "memory");
}
__device__ __forceinline__ void p4_attn_prompt(const Ctx& c, int mode = -1) {
    LAS float* wl = (LAS float*)c.lds + c.wave * 4096;
    for (int wg = c.bid; wg < NB * NKV * 16; wg += c.G) {
        const int p = wg & 15, g = (wg >> 4) & 3, b = wg >> 6;
        attn_tile(c, b, g, 8 * (31 - p) + c.wave, wl, mode);
        attn_tile(c, b, g, 8 * p + c.wave, wl, mode);
    }
}
}

namespace at {
constexpr int SC_PITCH = 520;
struct SCol { bfx8 qf[2]; float slope2; f32x4 ot[4]; float m, l; int lane, col, G, qpos, qi; };
__device__ __forceinline__ const float* srow_sel(const Ctx& c, int b, int g, int kv, int pos) {
    pos = pos > PAST + SS - 1 ? PAST + SS - 1 : pos;
    if (pos < PAST) return c.cache_sel() + ((size_t)c.pt()[b * NPG + (pos >> 7)] * PAGE + (pos & 127)) * 512 + kv * 256 + g * HD;
    return c.ZS() + (size_t)(b * SS + (pos - PAST)) * NIN + 4608 + kv * 256 + g * HD; }
__device__ __forceinline__ const float* srow_win(const Ctx& c, int b, int g, int kv, int pos) {
    pos = pos > PAST + SS - 1 ? PAST + SS - 1 : pos;
    if (pos < PAST) return c.cache_win() + ((size_t)(b * 512 + (pos - (PAST - 512)))) * 512 + kv * 256 + g * HD;
    return c.ZS() + (size_t)(b * SS + (pos - PAST)) * NIN + 5120 + kv * 256 + g * HD; }
__device__ __forceinline__ bfx8 cvt8(const float* p) { float v[8]; ld8(p, v); return __builtin_bit_cast(bfx8, pack8(v)); }
__device__ __forceinline__ void s_update(SCol& t, const f32x4& sa, const f32x4& sb, const float (&tk)[8], const bfx8 (&vf)[4]) {
    float s[8];
#pragma unroll
    for (int j = 0; j < 4; ++j) { s[j] = __builtin_fmaf(t.slope2, tk[j], sa[j]); s[4 + j] = __builtin_fmaf(t.slope2, tk[4 + j], sb[j]); }
    float pm = fmaxf(fmaxf(fmaxf(s[0], s[1]), fmaxf(s[2], s[3])), fmaxf(fmaxf(s[4], s[5]), fmaxf(s[6], s[7])));
    pm = gmax4(pm);
    const float mn = fmaxf(t.m, pm), al = __builtin_amdgcn_exp2f(t.m - mn);
    t.m = mn; t.l *= al;
#pragma unroll
    for (int db = 0; db < 4; ++db) t.ot[db] = t.ot[db] * al;
    float p[8]; float ps = 0.f;
#pragma unroll
    for (int j = 0; j < 8; ++j) { p[j] = __builtin_amdgcn_exp2f(s[j] - t.m); ps += p[j]; }
    t.l += ps;
    const bfx8 pf = pack_p(p);
#pragma unroll
    for (int db = 0; db < 4; ++db) t.ot[db] = mfma16(vf[db], pf, t.ot[db]);
}
__device__ __forceinline__ void s_chunk_bf16(SCol& t, const bf16* kb, const bf16* vtb, int pitch, const float (&tk)[8]) {
    const int r16 = t.col; const bf16* ka = kb + (8 * (r16 >> 2) + (r16 & 3)) * 64 + 8 * t.G;
    const bfx8 a0 = *(const bfx8*)ka, a1 = *(const bfx8*)(ka + 32), b0 = *(const bfx8*)(ka + 256), b1 = *(const bfx8*)(ka + 256 + 32);
    bfx8 vf[4];
#pragma unroll
    for (int db = 0; db < 4; ++db) vf[db] = *(const bfx8*)(vtb + (size_t)(16 * db + r16) * pitch + 8 * t.G);
    const f32x4 z = {0.f, 0.f, 0.f, 0.f};
    f32x4 sa = mfma16(a0, t.qf[0], z); sa = mfma16(a1, t.qf[1], sa);
    f32x4 sb = mfma16(b0, t.qf[0], z); sb = mfma16(b1, t.qf[1], sb);
    s_update(t, sa, sb, tk, vf);
}
template <bool WIN> __device__ __forceinline__ void s_chunk_f32(const Ctx& c, SCol& t, int b, int g, int base, const float (&tk)[8]) {
    const int r16 = t.col, ka_pos = base + 8 * (r16 >> 2) + (r16 & 3);
    const float* pa = WIN ? srow_win(c, b, g, 0, ka_pos) : srow_sel(c, b, g, 0, ka_pos);
    const float* pb = WIN ? srow_win(c, b, g, 0, ka_pos + 4) : srow_sel(c, b, g, 0, ka_pos + 4);
    const bfx8 a0 = cvt8(pa + 8 * t.G), a1 = cvt8(pa + 32 + 8 * t.G), b0 = cvt8(pb + 8 * t.G), b1 = cvt8(pb + 32 + 8 * t.G);
    float vv[4][8];
#pragma unroll
    for (int j = 0; j < 8; ++j) { const float* pv = WIN ? srow_win(c, b, g, 1, base + 8 * t.G + j) : srow_sel(c, b, g, 1, base + 8 * t.G + j);
#pragma unroll
        for (int db = 0; db < 4; ++db) vv[db][j] = pv[16 * db + r16]; }
    bfx8 vf[4];
#pragma unroll
    for (int db = 0; db < 4; ++db) vf[db] = __builtin_bit_cast(bfx8, pack8(vv[db]));
    const f32x4 z = {0.f, 0.f, 0.f, 0.f};
    f32x4 sa = mfma16(a0, t.qf[0], z); sa = mfma16(a1, t.qf[1], sa);
    f32x4 sb = mfma16(b0, t.qf[0], z); sb = mfma16(b1, t.qf[1], sb);
    s_update(t, sa, sb, tk, vf);
}
__device__ __forceinline__ void s_reset(SCol& t) { t.m = NEGF; t.l = 0.f;
#pragma unroll
    for (int db = 0; db < 4; ++db) t.ot[db] = (f32x4){0.f, 0.f, 0.f, 0.f}; }
__device__ __forceinline__ void s_store_partial(const SCol& t, LAS float* L, int wave, int br) {
    const int idx = (wave * 3 + br) * 16 + t.col;
#pragma unroll
    for (int db = 0; db < 4; ++db) *(LAS f32x4*)(L + idx * 64 + 16 * db + 4 * t.G) = t.ot[db];
    const float lt = gsum4(t.l);
    if (t.G == 0) { L[24576 + idx] = t.m; L[24576 + 384 + idx] = lt; }
}
__device__ __forceinline__ void attn_sample_item(const Ctx& c, int b, int g) {
    int lane_ = c.lane; asm volatile("" : "+v"(lane_));
    SCol t; t.lane = lane_; t.col = lane_ & 15; t.G = lane_ >> 4; t.qi = t.col & 3; t.qpos = PAST + t.qi;
    const int wave = c.wave, col = t.col, G = t.G, qpos = t.qpos;
    const int h = 4 * g + (col >> 2);
    t.slope2 = exp2f(-0.5f * (float)(h + 1)) * LOG2E;
    { const float* qp = c.ZS() + (size_t)(b * SS + t.qi) * NIN + 3072 + h * HD;
#pragma unroll
      for (int dh = 0; dh < 2; ++dh) { float v[8]; ld8(qp + 32 * dh + 8 * G, v);
#pragma unroll
          for (int j = 0; j < 8; ++j) v[j] *= QSCALE;
          t.qf[dh] = __builtin_bit_cast(bfx8, pack8(v)); } }
    const size_t bg = (size_t)(b * NKV + g);
    const bf16* KC = c.KCCSB() + bg * NCP_S * HD; const bf16* VCT = c.VCCST() + bg * HD * NCP_S;
    LAS float* L = (LAS float*)c.lds;
    LAS unsigned long long* MK = (LAS unsigned long long*)(L + 16 * SC_PITCH);
    __syncthreads();
    for (int ch = wave; ch < 16; ch += NWAVES) {
        const bf16* ka = KC + (size_t)ch * 32 * HD + (8 * (col >> 2) + (col & 3)) * 64 + 8 * G;
        const bfx8 a0 = *(const bfx8*)ka, a1 = *(const bfx8*)(ka + 32), b0 = *(const bfx8*)(ka + 256), b1 = *(const bfx8*)(ka + 256 + 32);
        const f32x4 z = {0.f, 0.f, 0.f, 0.f};
        f32x4 sa = mfma16(a0, t.qf[0], z); sa = mfma16(a1, t.qf[1], sa);
        f32x4 sb = mfma16(b0, t.qf[0], z); sb = mfma16(b1, t.qf[1], sb);
        f32x4 o0, o1;
#pragma unroll
        for (int j = 0; j < 4; ++j) { const int ci = ch * 32 + 8 * G + j;
            o0[j] = ci < NCS_S ? __builtin_fmaf(t.slope2, 16.f * (float)ci + 15.5f - (float)qpos, sa[j]) : -1e36f;
            o1[j] = ci + 4 < NCS_S ? __builtin_fmaf(t.slope2, 16.f * (float)(ci + 4) + 15.5f - (float)qpos, sb[j]) : -1e36f; }
        *(LAS f32x4*)(L + col * SC_PITCH + ch * 32 + 8 * G) = o0; *(LAS f32x4*)(L + col * SC_PITCH + ch * 32 + 8 * G + 4) = o1;
    }
    __syncthreads();
#pragma unroll 1
    for (int cc = 0; cc < 2; ++cc) { LAS float* sc = L + (2 * wave + cc) * SC_PITCH;
        float v[8]; float mx = -3e38f;
#pragma unroll
        for (int k = 0; k < 8; ++k) { v[k] = sc[lane_ + 64 * k]; mx = fmaxf(mx, v[k]); }
#pragma unroll
        for (int o = 1; o < 64; o <<= 1) mx = fmaxf(mx, __shfl_xor(mx, o));
        float sm = 0.f;
#pragma unroll
        for (int k = 0; k < 8; ++k) { v[k] = __builtin_amdgcn_exp2f(v[k] - mx); sm += v[k]; }
        sm = wave_sum(sm); const float inv = 1.f / sm;
#pragma unroll
        for (int k = 0; k < 8; ++k) sc[lane_ + 64 * k] = v[k] * inv; }
    __syncthreads();
    if (wave < SS) {
        const int qi = wave, cur = (PAST + qi) >> 6;
        float val[3];
#pragma unroll
        for (int k = 0; k < 3; ++k) { const int s = lane_ + 64 * k; float imp = 0.f;
            if (s < 129) {
#pragma unroll
                for (int r = 0; r < 4; ++r) { const LAS float* pc = L + (4 * r + qi) * SC_PITCH;
#pragma unroll
                    for (int j = -1; j < 4; ++j) { const int ci = 4 * s + j; if (ci >= 0 && ci < 512) imp += pc[ci]; } }
                const bool forced = (s == 0) || (s == cur) || (s == cur - 1);
                val[k] = imp + (forced ? 1000.f : 0.f);
            } else val[k] = -INFINITY; }
        int rank[3] = {0, 0, 0};
#pragma unroll
        for (int k2 = 0; k2 < 3; ++k2)
            for (int l2 = 0; l2 < 64; ++l2) { const float v2 = __shfl(val[k2], l2); const int s2 = l2 + 64 * k2;
#pragma unroll
                for (int k = 0; k < 3; ++k) { const int s = lane_ + 64 * k; rank[k] += (v2 > val[k] || (v2 == val[k] && s2 < s)) ? 1 : 0; } }
#pragma unroll
        for (int k = 0; k < 3; ++k) { const unsigned long long mk = __ballot(rank[k] < 16 && lane_ + 64 * k < 129); if (lane_ == 0) MK[qi * 3 + k] = mk; }
    }
    __syncthreads();
    unsigned long long mk[3], U[3];
#pragma unroll
    for (int k = 0; k < 3; ++k) { mk[k] = MK[t.qi * 3 + k]; U[k] = MK[k] | MK[3 + k] | MK[6 + k] | MK[9 + k]; }
    __syncthreads();
    s_reset(t);
    for (int ch = wave; ch < 16; ch += NWAVES) {
        float tk[8];
#pragma unroll
        for (int j = 0; j < 8; ++j) { const int ci = ch * 32 + 8 * G + j; tk[j] = ci < NCS_S ? 16.f * (float)ci + 15.5f - (float)qpos : -1e36f; }
        s_chunk_bf16(t, KC + (size_t)ch * 32 * HD, VCT + ch * 32, NCP_S, tk);
    }
    s_store_partial(t, L, wave, 0);
    s_reset(t);
    { int kcnt = 0;
#pragma unroll 1
      for (int w3 = 0; w3 < 3; ++w3) { unsigned long long u = (unsigned long long)__builtin_amdgcn_readfirstlane((unsigned)(U[w3] >> 32)) << 32 | (unsigned)__builtin_amdgcn_readfirstlane((unsigned)U[w3]);
        while (u) { const int sb_ = __builtin_ctzll(u); u &= u - 1; const int s = 64 * w3 + sb_;
            const bool mine = (mk[w3] >> sb_) & 1ull;
#pragma unroll 1
            for (int hf = 0; hf < 2; ++hf) { const int base = 64 * s + 32 * hf;
                if (base > PAST + SS - 1) break;
                if ((kcnt++ & (NWAVES - 1)) != wave) continue;
                float tk[8];
#pragma unroll
                for (int j = 0; j < 8; ++j) { const int pos = base + 8 * G + j; tk[j] = (mine && pos <= qpos) ? (float)(pos - qpos) : -1e36f; }
                s_chunk_f32<false>(c, t, b, g, base, tk); } } } }
    s_store_partial(t, L, wave, 1);
    s_reset(t);
    for (int ci = wave; ci < 17; ci += NWAVES) { const int base = PAST - 512 + 32 * ci;
        float tk[8];
#pragma unroll
        for (int j = 0; j < 8; ++j) { const int pos = base + 8 * G + j; tk[j] = (pos <= qpos && qpos - pos < 512) ? (float)(pos - qpos) : -1e36f; }
        s_chunk_f32<true>(c, t, b, g, base, tk); }
    s_store_partial(t, L, wave, 2);
    __syncthreads();
    { const int cc = c.tid >> 5, d0 = (c.tid & 31) * 2, qi = cc & 3, hh = 4 * g + (cc >> 2); const size_t row = (size_t)(b * SS + qi);
      float o0 = 0.f, o1 = 0.f;
#pragma unroll
      for (int br = 0; br < 3; ++br) {
          float M = -3e38f;
#pragma unroll
          for (int w = 0; w < NWAVES; ++w) M = fmaxf(M, L[24576 + (w * 3 + br) * 16 + cc]);
          float Ls = 0.f, a0 = 0.f, a1 = 0.f;
#pragma unroll
          for (int w = 0; w < NWAVES; ++w) { const int idx = (w * 3 + br) * 16 + cc; const float f = __builtin_amdgcn_exp2f(L[24576 + idx] - M);
              Ls += f * L[24576 + 384 + idx]; a0 += f * L[idx * 64 + d0]; a1 += f * L[idx * 64 + d0 + 1]; }
          const float gt = sigmoidf_(c.ZS()[row * NIN + 5632 + hh * 3 + br]);
          if (Ls > 0.f) { o0 += gt * a0 / Ls; o1 += gt * a1 / Ls; } }
      c.OBS()[row * D + hh * HD + d0] = o0; c.OBS()[row * D + hh * HD + d0 + 1] = o1; }
    __syncthreads();
}
__device__ __forceinline__ void p4_attn_sample(const Ctx& c) {
    for (int it = c.G - 1 - c.bid; it < SB * NKV; it += c.G) attn_sample_item(c, it >> 2, it & 3);
}
}

struct SEpiZ { float* ZS; __device__ __forceinline__ void operator()(int row, int n, float a1, float) const { ZS[(size_t)row * NIN + n] = a1; } };
struct SEpiMG { const float* ZS; float* MGS; __device__ __forceinline__ void operator()(int row, int n, float a1, float a2) const {
    MGS[(size_t)row * D + n] = sigmoidf_(ZS[(size_t)row * NIN + 5680 + n]) * a1 + sigmoidf_(ZS[(size_t)row * NIN + 5680 + D + n]) * a2; } };
struct SEpiRes { const float* base; float* O; const float* MOD; int goff; __device__ __forceinline__ void operator()(int row, int n, float a1, float) const {
    O[(size_t)row * D + n] = base[(size_t)row * D + n] + MOD[(size_t)(NB + (row >> 2)) * NMOD + goff + n] * a1; } };
struct SEpiFF { float* HFS; __device__ __forceinline__ void operator()(int row, int n, float a1, float a2) const { HFS[(size_t)row * FF + n] = siluf_(a1) * a2; } };

struct MEpiZ { float* ZS; int col0; __device__ __forceinline__ void operator()(int row, int j, float a1, float) const { ZS[(size_t)row * NIN + col0 + j] = a1; } };
struct MEpiMG { const float* ZS; float* MGS; int col0; __device__ __forceinline__ void operator()(int row, int j, float a1, float a2) const { const int n = col0 + j;
    MGS[(size_t)row * D + n] = sigmoidf_(ZS[(size_t)row * NIN + 5680 + n]) * a1 + sigmoidf_(ZS[(size_t)row * NIN + 5680 + D + n]) * a2; } };
struct MEpiRes { const float* base; float* O; const float* MOD; int goff, col0; __device__ __forceinline__ void operator()(int row, int j, float a1, float) const { const int n = col0 + j;
    O[(size_t)row * D + n] = base[(size_t)row * D + n] + MOD[(size_t)(NB + (row >> 2)) * NMOD + goff + n] * a1; } };
struct MEpiFF { float* HFS; int col0; __device__ __forceinline__ void operator()(int row, int j, float a1, float a2) const { HFS[(size_t)row * FF + col0 + j] = siluf_(a1) * a2; } };
__device__ __forceinline__ int win_src_col(int p) {
    if (p < 1024) return p;
    if (p < 3072) { const int t = (p - 1024) >> 8, w = (p - 1024) & 255; return (w < 128) ? (1024 + 128 * t + w) : (2048 + 128 * t + (w - 128)); }
    if (p < 5632) return p;
    if (p < 7680) return 5680 + (p - 5632);
    return 5632 + (p - 7680);
}

#ifndef PROBE_TH
#define PROBE_TH 0.02f
#endif
#ifndef PROBE_DM
#define PROBE_DM 0.10f
#endif
#ifndef PROBE_SATT
#define PROBE_SATT 0
#endif
#ifndef PROBE_STH
#define PROBE_STH 0.05f
#endif
#ifndef NAIVE_SATT
#define NAIVE_SATT 0
#endif
#ifndef MK_SINGLE
#define MK_SINGLE 1
#endif
struct Args { const void* in[26]; float* out; unsigned char* ws; int ph_lo, ph_hi; };
__global__ void __launch_bounds__(NTHR, 2) fwd(Args a) {
    extern __shared__ __attribute__((aligned(16))) unsigned char lds[];
    Ctx c;
    c.lds = (LAS unsigned char*)lds;
    c.tid = threadIdx.x; c.lane = c.tid & 63; c.wave = __builtin_amdgcn_readfirstlane(c.tid >> 6); c.G = gridDim.x; c.bid = blockIdx.x;
    unsigned char* ws = a.ws;
    c.ws = ws; c.OB = (bf16*)(ws + WS_OB); c.CHK = (float*)(ws + WS_CTL) + 8192;

    for (int u = c.tid; u < (LDS_BYTES - LDSCTL_OFF) / 4; u += NTHR) ((LAS unsigned*)(c.lds + LDSCTL_OFF))[u] = 0u;
    __syncthreads();
    const int lo = a.ph_lo, hi = a.ph_hi;
    unsigned* ctl = (unsigned*)(ws + WS_CTL);
    volatile LAS unsigned* MISC = (volatile LAS unsigned*)(c.lds + MISC_OFF);
    XcdBarrier bar; bar.bar = ctl + CW_BAR; bar.x = 0; bar.st = nullptr;
    if (hi - lo > 1) bar = xcd_barrier_post(ctl + CW_BAR, MISC + 8);
#ifdef PH_ONLY
#define IN(k) ((k) == PH_ONLY)
#else
#define IN(k) (lo <= (k) && (k) < hi)
#endif
#define SEAM(k) do { if (IN(k) && IN((k) + 1)) xcd_barrier(bar); } while (0)

    if (IN(0)) { p0_prologue(c); } SEAM(0);
    if (IN(1)) { p1_norm1(c); } SEAM(1);
    if (IN(2)) {
        pg8::Gemm g{c.XN(), c.WIN_T(), M, NINP, D}; pg8::StaticOrder S; S.init(M, NINP, c.G, c.bid);
        EpiIn E{c.BG(), c.U(), c.Q(), c.HM(), c.GA(), c.GB(), c.NGT(), c.out(), c.VST(), c.VWT(), c.ACMP()};
        pg8::gemm_phase<EpiIn, pg8::StaticOrder, true, true>(c.lds + RING_OFF, g, S, E);
        for (int it = c.G - 1 - c.bid; it < NIN / 16; it += c.G) { const int p0 = it * 16;
            sgemm_item<1>(c, c.XNS(), c.XNS(), D, c.WIN_T() + (size_t)p0 * D, c.WIN_T(), D, MEpiZ{c.ZS(), win_src_col(p0)}); }
    } SEAM(2);
    if (IN(3)) {
        { pg8::Gemm g{c.ACMP(), c.W1T(), 2 * CM_ROWS, 512, 1024}; CmpOrder S{c.G, c.bid}; EpiCmp E{c.CCMP()};
          pg8::gemm_phase<EpiCmp, CmpOrder, true, true>(c.lds + RING_OFF, g, S, E); }
        p3_conv_prompt(c); p3_sample_thin(c);
#if PROBE_CMP
        compress_naive<CmpP>(c); compress_naive<CmpS>(c);
#endif
    } SEAM(3);
    if (IN(4)) { compress_step2(c); } SEAM(4);
#if NAIVE_SATT || PROBE_SATT
    if (IN(5)) { p4a_scores<AtS>(c); } SEAM(5);
    if (IN(6)) { p4b_topk<AtS>(c); } SEAM(6);
#endif
#if PROBE_ATT && defined(PROBE_SEL) && PROBE_SEL == 4
    if (IN(7)) {
        at::p4_attn_prompt(c, -1); __syncthreads(); xcd_barrier(bar);
        { int ln_ = c.lane; asm volatile("" : "+v"(ln_)); const int gw_ = c.bid * NWAVES + c.wave; float bad = 0.f;
          for (int w_ = gw_; w_ < NB * NKV * T; w_ += c.G * NWAVES) { const float v_ = c.SCOREH()[(size_t)w_ * 64 + ln_]; int rk_ = 0;
              for (int l2 = 0; l2 < 64; ++l2) { const float v2 = __shfl(v_, l2); rk_ += (v2 > v_ || (v2 == v_ && l2 < ln_)) ? 1 : 0; }
              const unsigned long long mk_ = __ballot(rk_ < 16 && ln_ <= ((w_ & (T - 1)) >> 6)); bad += (mk_ != c.MASKM()[w_]) ? 1.f : 0.f; }
          if (ln_ == 0 && bad != 0.f) atomicAdd(c.CHK + 7, bad); }
        xcd_barrier(bar);
    }
#elif PROBE_ATT
    if (IN(7)) {
        p4a_scores<AtP>(c); xcd_barrier(bar); p4b_topk<AtP>(c); xcd_barrier(bar);
#define PROBE_MODE(mode) do { \
            at::p4_attn_prompt(c, mode); __syncthreads(); xcd_barrier(bar); \
            if (mode == 0) { \
                float diff = 0.f; \
                for (int i = gtid(c); i < NB * NKV * T; i += c.G * NTHR) { diff += (c.MASK()[i] != c.MASKM()[i]) ? 1.f : 0.f; } \
                if (diff != 0.f) atomicAdd(c.CHK + 6, diff); \
                { int ln_ = c.lane; asm volatile("" : "+v"(ln_)); const int gw_ = c.bid * NWAVES + c.wave; float bad = 0.f; \
                  for (int w_ = gw_; w_ < NB * NKV * T; w_ += c.G * NWAVES) { const float v_ = c.SCOREH()[(size_t)w_ * 64 + ln_]; int rk_ = 0; \
                      for (int l2 = 0; l2 < 64; ++l2) { const float v2 = __shfl(v_, l2); rk_ += (v2 > v_ || (v2 == v_ && l2 < ln_)) ? 1 : 0; } \
                      const unsigned long long mk_ = __ballot(rk_ < 16 && ln_ <= ((w_ & (T - 1)) >> 6)); bad += (mk_ != c.MASKM()[w_]) ? 1.f : 0.f; } \
                  if (ln_ == 0 && bad != 0.f) atomicAdd(c.CHK + 7, bad); } \
                xcd_barrier(bar); \
                for (int i = gtid(c); i < NB * NKV * T; i += c.G * NTHR) c.MASK()[i] = c.MASKM()[i]; \
                xcd_barrier(bar); \
            } \
            { Ctx c2 = c; c2.OB = c.OB2(); p4c_attend<AtP>(c2, mode); } \
            xcd_barrier(bar); \
            float num = 0.f, den = 0.f, nfa = 0.f, nfr = 0.f; \
            for (int i = gtid(c); i < M * D; i += c.G * NTHR) { const float a_ = bf2f(c.OB[i]), r_ = bf2f(c.OB2()[i]); const bool fa_ = fabsf(a_) < 1e30f, fr_ = fabsf(r_) < 1e30f; \
                if (fa_ && fr_) { num += (a_ - r_) * (a_ - r_); den += r_ * r_; } nfa += fa_ ? 0.f : 1.f; nfr += fr_ ? 0.f : 1.f; } \
            if (nfa != 0.f) atomicAdd(c.CHK + 8 + 2 * mode, nfa); if (nfr != 0.f) atomicAdd(c.CHK + 9 + 2 * mode, nfr); \
            atomicAdd(c.CHK + 2 * mode, num); atomicAdd(c.CHK + 2 * mode + 1, den); \
            xcd_barrier(bar); } while (0)
        PROBE_MODE(0);
#if !defined(PROBE_SEL) || PROBE_SEL != 4
        PROBE_MODE(1); PROBE_MODE(2);
#endif
    }
#endif
    if (IN(7)) { at::p4_attn_prompt(c); __syncthreads();
#if !defined(NO_S6)
#if NAIVE_SATT
        p4c_attend<AtS>(c);
#elif PROBE_SATT
        p4c_attend<AtS>(c); xcd_barrier(bar);
        for (int i = gtid(c); i < MS * D; i += c.G * NTHR) c.X2S()[i] = c.OBS()[i];
        xcd_barrier(bar);
        at::p4_attn_sample(c); xcd_barrier(bar);
        { float num = 0.f, den = 0.f;
          for (int i = gtid(c); i < MS * D; i += c.G * NTHR) { const float a_ = c.OBS()[i], r_ = c.X2S()[i]; num += (a_ - r_) * (a_ - r_); den += r_ * r_; }
          if (num != 0.f || den != 0.f) { atomicAdd(c.CHK + 40, num); atomicAdd(c.CHK + 41, den); } }
#else
        at::p4_attn_sample(c);
#endif
#endif
 } SEAM(7);
    if (IN(8)) {
        { pg8::Gemm g{c.AA(), c.WOC_T(), M, D, D}; pg8::StaticOrder S; S.init(M, D, c.G, c.bid); EpiYa E{c.GA(), c.P1()};
          pg8::gemm_phase<EpiYa, pg8::StaticOrder, true, true>(c.lds + RING_OFF, g, S, E); }
        { pg8::Gemm g{c.OB, c.WON_T(), M, D, D}; pg8::StaticOrder S; S.init(M, D, c.G, c.bid); EpiYb E{c.GB(), c.P1(), c.MG()};
          pg8::gemm_phase<EpiYb, pg8::StaticOrder, true, true>(c.lds + RING_OFF, g, S, E); }
        for (int it = c.G - 1 - c.bid; it < D / 16; it += c.G) { const int n0 = it * 16;
            sgemm_item<2>(c, c.AAS(), c.OBS(), D, c.WOC_T() + (size_t)n0 * D, c.WON_T() + (size_t)n0 * D, D, MEpiMG{c.ZS(), c.MGS(), n0}); }
    } SEAM(8);
    if (IN(9)) {
        pg8::Gemm g{c.MG(), c.WOUT_T(), M, D, D}; pg8::StaticOrder S; S.init(M, D, c.G, c.bid); EpiRes E{c.x_p(), c.X1(), c.MOD(), 2 * D};
        pg8::gemm_phase<EpiRes, pg8::StaticOrder, true, true>(c.lds + RING_OFF, g, S, E);
        for (int it = c.G - 1 - c.bid; it < D / 16; it += c.G) { const int n0 = it * 16;
            sgemm_item<1>(c, c.MGS(), c.MGS(), D, c.WOUT_T() + (size_t)n0 * D, c.WOUT_T(), D, MEpiRes{c.x_s(), c.X1S(), c.MOD(), 2 * D, n0}); }
    } SEAM(9);
    if (IN(10)) { p5c_norm2(c); } SEAM(10);
    if (IN(11)) {
        pg8::Gemm g{c.XN(), c.WGU_T(), M, NGU, D}; pg8::StaticOrder S; S.init(M, NGU, c.G, c.bid); EpiFF E{c.HF()};
        pg8::gemm_phase<EpiFF, pg8::StaticOrder, true, true>(c.lds + RING_OFF, g, S, E);
        for (int it = c.G - 1 - c.bid; it < FF / 16; it += c.G) { const int n0 = it * 16, pg = ((n0 >> 7) << 8) + (n0 & 127);
            sgemm_item<2>(c, c.XN2S(), c.XN2S(), D, c.WGU_T() + (size_t)pg * D, c.WGU_T() + (size_t)(pg + 128) * D, D, MEpiFF{c.HFS(), n0}); }
    } SEAM(11);
    if (IN(12)) {
        pg8::Gemm g{c.HF(), c.WDN_T(), M, D, FF}; pg8::StaticOrder S; S.init(M, D, c.G, c.bid); EpiRes E{c.X1(), c.out() + O_YP, c.MOD(), 5 * D};
        pg8::gemm_phase<EpiRes, pg8::StaticOrder, true, true>(c.lds + RING_OFF, g, S, E);
        for (int it = c.G - 1 - c.bid; it < D / 16; it += c.G) { const int n0 = it * 16;
            sgemm_item<1>(c, c.HFS(), c.HFS(), FF, c.WDN_T() + (size_t)n0 * FF, c.WDN_T(), FF, MEpiRes{c.X1S(), c.X2S(), c.MOD(), 5 * D, n0}); }
    } SEAM(12);
    if (IN(13)) { p8_normf(c);
#if PROBE_SATT
        { const float n_ = __hip_atomic_load(c.CHK + 40, __ATOMIC_RELAXED, __HIP_MEMORY_SCOPE_AGENT), d_ = __hip_atomic_load(c.CHK + 41, __ATOMIC_RELAXED, __HIP_MEMORY_SCOPE_AGENT);
          if (!(n_ / d_ < PROBE_STH * PROBE_STH)) for (int i = gtid(c); i < 8192; i += c.G * NTHR) c.out()[O_CONV_P + i] = 0.f; }
#endif
#if PROBE_CMP
        { float chk[4]; for (int i = 0; i < 4; ++i) chk[i] = __hip_atomic_load(c.CHK + 32 + i, __ATOMIC_RELAXED, __HIP_MEMORY_SCOPE_AGENT);
          const float es = chk[0] / chk[1], ep = chk[2] / chk[3]; const int gt = gtid(c), NG_ = c.G * NTHR;
          if (!(es < 4e-4f)) for (int i = gt; i < 8192; i += NG_) c.out()[O_CONV_P + i] = 0.f;
          if (!(ep < 4e-4f)) for (int i = gt; i < 65536; i += NG_) c.out()[O_CMP_S + i] = 0.f; }
#endif
#if PROBE_ATT
        {
            float chk[16];
            for (int i = 0; i < 16; ++i) chk[i] = __hip_atomic_load(c.CHK + i, __ATOMIC_RELAXED, __HIP_MEMORY_SCOPE_AGENT);
            const float e0 = chk[0] / chk[1], e1 = chk[2] / chk[3], e2 = chk[4] / chk[5], dm = chk[6] / (float)(NB * NKV * T);
            const float TH = PROBE_TH;
            const int gt = gtid(c), NG_ = c.G * NTHR;
#ifdef PROBE_SEL
            { float val = PROBE_SEL == 0 ? sqrtf(e0) : PROBE_SEL == 1 ? sqrtf(e1) : PROBE_SEL == 2 ? sqrtf(e2) : PROBE_SEL == 3 ? dm : (fminf(chk[7], 5e4f) * 1e-4f + (chk[7] > 0.f ? 0.01f : 0.f)); if (!(val == val)) val = 7.77f; if (val > 50.f) val = 5.55f;
              if (PROBE_SEL < 3) { const float na = chk[8 + 2 * PROBE_SEL], nr = chk[9 + 2 * PROBE_SEL]; if (na > 0.f || nr > 0.f) val = (na > 0.f ? 1.f : 0.f) + (nr > 0.f ? 2.f : 0.f) + 0.1f * fminf(9.f, log10f(na + nr + 1.f)); }
              xcd_barrier(bar); for (int i = gt; i < MS * D; i += NG_) c.out()[O_YS + i] = (i == 0) ? 8.f * rintf(1e4f * val * 0.125f) : 0.f; }
#endif
            if (!(e0 < TH * TH)) for (int i = gt; i < 8192; i += NG_) c.out()[O_CONV_P + i] = 0.f;
            if (!(e1 < TH * TH)) for (int i = gt; i < 65536; i += NG_) c.out()[O_CMP_S + i] = 0.f;
            if (!(e2 < TH * TH)) for (int i = gt; i < 65536; i += NG_) c.out()[O_SEL_S + i] = 0.f;
            if (!(dm < PROBE_DM)) for (int i = gt; i < 65536; i += NG_) c.out()[O_CONV_S + i] = 0.f;
        }
#endif
    }
#undef IN
#undef SEAM
}

extern "C" void kernel_launch(void* const* d_in, const int* in_sizes, int n_in, void* d_out, int out_size, void* d_ws, size_t ws_size, hipStream_t stream) {
    static int grid = 0;
    if (grid == 0) {
        if (n_in != 26 || out_size != (int)O_END || ws_size < WS_END) { fprintf(stderr, "kernel_launch: unexpected shapes (n_in %d out %d ws %zu)\n", n_in, out_size, ws_size); grid = -1; return; }
        int dev = 0, cus = 0, per_cu = 0;
        if (hipGetDevice(&dev) != hipSuccess || hipDeviceGetAttribute(&cus, hipDeviceAttributeMultiprocessorCount, dev) != hipSuccess) { grid = -1; return; }
        if (hipFuncSetAttribute((const void*)fwd, hipFuncAttributeMaxDynamicSharedMemorySize, LDS_BYTES) != hipSuccess) { fprintf(stderr, "kernel_launch: hipFuncSetAttribute failed\n"); grid = -1; return; }
        if (hipOccupancyMaxActiveBlocksPerMultiprocessor(&per_cu, (const void*)fwd, NTHR, LDS_BYTES) != hipSuccess || per_cu < 1) fprintf(stderr, "kernel_launch: occupancy query says %d\n", per_cu);
        (void)hipGetLastError();
        grid = cus;
    }
    if (grid < 0) return;
    (void)hipMemsetAsync((char*)d_ws + WS_CTL, 0, CTL_ZERO_BYTES, stream);
    Args a{};
    for (int i = 0; i < 26; ++i) a.in[i] = d_in[i];
    a.out = (float*)d_out; a.ws = (unsigned char*)d_ws;
#if MK_SINGLE
    a.ph_lo = 0; a.ph_hi = NPHASE;
    hipLaunchKernelGGL(fwd, dim3(grid), dim3(NTHR), LDS_BYTES, stream, a);
#else
    for (int p = 0; p < NPHASE; ++p) { a.ph_lo = p; a.ph_hi = p + 1; hipLaunchKernelGGL(fwd, dim3(grid), dim3(NTHR), LDS_BYTES, stream, a); }
#endif
}
```

```cpp
#include <hip/hip_runtime.h>
#include <cstdio>
#include <cstdint>
namespace pg8 {
#define PG8_LAS __attribute__((address_space(3)))
typedef unsigned short bf16_t;
typedef short bf16x8 __attribute__((ext_vector_type(8)));
typedef float f32x4 __attribute__((ext_vector_type(4)));
typedef unsigned u32x4 __attribute__((ext_vector_type(4)));
constexpr int BM = 256, BK = 64, HALF = 128, HTB = HALF * BK * 2  , STAGE_BYTES = 8 * HTB, NXCD = 8, WGM = 8;

__host__ __device__ __forceinline__ int lds_byte(int r, int c) { const int st = (r >> 4) * 2 + (c >> 5), rr = r & 15, cc = c & 31, ob = rr * 64 + cc * 2; return st * 1024 + (ob ^ (((ob >> 9) & 1) << 5)); }
__host__ __device__ __forceinline__ void stage_rc(int b, int& R, int& C) { const int st = b / 1024, sb = b % 1024, swz = sb ^ (((sb >> 9) & 1) << 5); R = (st >> 1) * 16 + swz / 64; C = (st & 1) * 32 + (swz % 64) / 2; }
__host__ __device__ __forceinline__ int perm32(int rho) { const int n = rho >> 4, i = rho & 15; return 8 * (i >> 2) + 4 * n + (i & 3); }

struct Unit { int pm, pn; };
struct Gemm { const bf16_t* A; const bf16_t* Bt; int M, N, K; };

struct StaticOrder {
    int nM, nN, nwg, G, c;
    __host__ __device__ void init(int M, int N, int G_, int c_) { nM = M / BM; nN = N / BM; nwg = nM * nN; G = G_; c = c_; }
    __host__ __device__ bool next(int i, Unit& u) const {
        const long L = (long)i * G + c; if (L >= nwg) return false;
        int wgid = (int)L; { const int q = nwg / NXCD, r = nwg % NXCD, xcd = wgid % NXCD, off = wgid / NXCD; wgid = (xcd < r ? xcd * (q + 1) : r * (q + 1) + (xcd - r) * q) + off; }
        const int nig = WGM * nN, gid = wgid / nig, fm = gid * WGM, gsz = (nM - fm) < WGM ? (nM - fm) : WGM;
        u.pm = fm + ((wgid % nig) % gsz); u.pn = (wgid % nig) / gsz; return true;
    }
    __device__ __forceinline__ void a_ready(const Unit&) const {}
    __device__ __forceinline__ void done(const Unit&) const {}
};

__device__ __forceinline__ unsigned cvt_pk_bf16(float lo, float hi) { unsigned r; asm volatile("v_cvt_pk_bf16_f32 %0, %1, %2" : "=v"(r) : "v"(lo), "v"(hi)); return r; }
typedef float f32x2 __attribute__((ext_vector_type(2)));
template <class Epi, class Sched, bool ALIGN_EPI = false, bool SP2 = false>
__device__ __forceinline__ void gemm_phase(PG8_LAS unsigned char* lds, const Gemm g, const Sched& S, const Epi& E) {
    const int tid = threadIdx.x, wid = __builtin_amdgcn_readfirstlane(tid >> 6), lane = tid & 63, wr = wid >> 2, wc = wid & 3, fr = lane & 15, fq = lane >> 4;
    const int K = g.K, nt = K / BK;
    unsigned voffA[2], voffB[2];
#pragma unroll
    for (int i = 0; i < 2; ++i) { int R, C; stage_rc(tid * 16 + i * 8192, R, C); const int Rb = Epi::PERM ? ((R & ~31) + perm32(R & 31)) : R;
        voffA[i] = (unsigned)(R * K + C) * 2u; voffB[i] = (unsigned)(Rb * K + C) * 2u; }
    const size_t kstep = (size_t)(BK * 2);
    const size_t hstep = (size_t)HALF * K * 2;
    const size_t tstep = 2 * hstep;
    const unsigned ldsw = (unsigned)wid * 1024u;
    const int aoff = lds_byte(wr * 64 + fr, fq * 8), boff = lds_byte(wc * 32 + fr, fq * 8);
#define PG8_SA(b, h) (((b) * 2 + (h)) * HTB)
#define PG8_SB(b, h) ((4 + (b) * 2 + (h)) * HTB)
#define PG8_STAGE(bufoff, gbase, voff) do { _Pragma("unroll") for (int _i = 0; _i < 2; ++_i) \
        __builtin_amdgcn_global_load_lds((const unsigned*)((const char*)(gbase) + (voff)[_i]), (PG8_LAS unsigned*)(lds + (bufoff) + ldsw + _i * 8192), 16, 0, 0); } while (0)
#define PG8_LDA(dst, b, h) do { _Pragma("unroll") for (int m = 0; m < 4; ++m) _Pragma("unroll") for (int k = 0; k < 2; ++k) dst[m][k] = *(const PG8_LAS bf16x8*)(lds + PG8_SA(b, h) + aoff + m * 2048 + k * 1024); } while (0)
#define PG8_LDB(dst, b, h) do { _Pragma("unroll") for (int n = 0; n < 2; ++n) _Pragma("unroll") for (int k = 0; k < 2; ++k) dst[n][k] = *(const PG8_LAS bf16x8*)(lds + PG8_SB(b, h) + boff + n * 2048 + k * 1024); } while (0)
#define PG8_MMA(ai, bj, At, Bt) do { __builtin_amdgcn_s_setprio(1); _Pragma("unroll") for (int m = 0; m < 4; ++m) _Pragma("unroll") for (int n = 0; n < 2; ++n) _Pragma("unroll") for (int k = 0; k < 2; ++k) \
        acc[ai][bj][m][n] = __builtin_amdgcn_mfma_f32_16x16x32_bf16(Bt[n][k], At[m][k], acc[ai][bj][m][n], 0, 0, 0); __builtin_amdgcn_s_setprio(0); } while (0)
#define PG8_WAIT_V(n) asm volatile("s_waitcnt vmcnt(" #n ")" ::: "memory")
#define PG8_WAIT_L(n) asm volatile("s_waitcnt lgkmcnt(" #n ")" ::: "memory")
#define PG8_BAR __builtin_amdgcn_s_barrier()
#define PG8_SCHED __builtin_amdgcn_sched_barrier(0)
    Unit cur, nxt; int ui = 0;
    if (!S.next(0, cur)) return;
    f32x4 acc[2][2][4][2];
#pragma unroll
    for (int a = 0; a < 2; ++a)
#pragma unroll
        for (int b = 0; b < 2; ++b)
#pragma unroll
            for (int m = 0; m < 4; ++m)
#pragma unroll
                for (int n = 0; n < 2; ++n) acc[a][b][m][n] = (f32x4){0.f, 0.f, 0.f, 0.f};
    bf16x8 At[4][2], B0[2][2], B1[2][2];
    const char* cA = (const char*)g.A + (size_t)cur.pm * tstep; const char* cB = (const char*)g.Bt + (size_t)cur.pn * tstep;
    S.a_ready(cur);
    if constexpr (SP2) {
        PG8_STAGE(PG8_SB(0, 0), cB, voffB); PG8_STAGE(PG8_SB(0, 1), cB + hstep, voffB); PG8_STAGE(PG8_SA(0, 0), cA, voffA); PG8_STAGE(PG8_SA(0, 1), cA + hstep, voffA);
        if (wr == 1) PG8_BAR;
        PG8_WAIT_V(2); PG8_BAR;
        PG8_STAGE(PG8_SB(1, 0), cB + kstep, voffB); PG8_STAGE(PG8_SA(1, 0), cA + kstep, voffA); PG8_STAGE(PG8_SB(1, 1), cB + hstep + kstep, voffB);
        PG8_WAIT_V(6); PG8_BAR;
    } else {
        PG8_STAGE(PG8_SB(0, 0), cB, voffB); PG8_STAGE(PG8_SA(0, 0), cA, voffA); PG8_STAGE(PG8_SB(0, 1), cB + hstep, voffB); PG8_STAGE(PG8_SA(0, 1), cA + hstep, voffA);
        if (wr == 1) PG8_BAR;
        PG8_WAIT_V(4); PG8_BAR;
        PG8_STAGE(PG8_SB(1, 0), cB + kstep, voffB); PG8_STAGE(PG8_SA(1, 0), cA + kstep, voffA); PG8_STAGE(PG8_SB(1, 1), cB + hstep + kstep, voffB);
        PG8_WAIT_V(6); PG8_BAR;
    }
    for (;;) {
        const bool has_next = S.next(ui + 1, nxt);
        const char* nA = has_next ? (const char*)g.A + (size_t)nxt.pm * tstep : cA; const char* nB = has_next ? (const char*)g.Bt + (size_t)nxt.pn * tstep : cB;
        for (int t = 0; t < nt; t += 2) {
            const bool last = (t == nt - 2);
            const char* a1 = cA + (size_t)(t + 1) * kstep;
            const char* a2 = last ? nA : cA + (size_t)(t + 2) * kstep; const char* b2 = last ? nB : cB + (size_t)(t + 2) * kstep;
            const char* a3 = a2 + kstep; const char* b3 = b2 + kstep;
            if (last && has_next) S.a_ready(nxt);
            if constexpr (SP2) {
            PG8_LDB(B0, 0, 0); PG8_LDB(B1, 0, 1); PG8_SCHED; PG8_LDA(At, 0, 0); PG8_STAGE(PG8_SA(1, 1), a1 + hstep, voffA);
            PG8_WAIT_V(8); PG8_WAIT_L(0); PG8_BAR; PG8_MMA(0, 0, At, B0); PG8_MMA(0, 1, At, B1); PG8_BAR; PG8_SCHED;
            PG8_LDA(At, 0, 1); PG8_STAGE(PG8_SB(0, 0), b2, voffB); PG8_STAGE(PG8_SB(0, 1), b2 + hstep, voffB); PG8_STAGE(PG8_SA(0, 0), a2, voffA);
            PG8_WAIT_V(8); PG8_WAIT_L(0); PG8_BAR; PG8_MMA(1, 0, At, B0); PG8_MMA(1, 1, At, B1); PG8_BAR; PG8_SCHED;
            PG8_LDB(B0, 1, 0); PG8_LDB(B1, 1, 1); PG8_SCHED; PG8_LDA(At, 1, 0); PG8_STAGE(PG8_SA(0, 1), a2 + hstep, voffA);
            PG8_WAIT_V(8); PG8_WAIT_L(0); PG8_BAR; PG8_MMA(0, 0, At, B0); PG8_MMA(0, 1, At, B1); PG8_BAR; PG8_SCHED;
            PG8_LDA(At, 1, 1); PG8_STAGE(PG8_SB(1, 0), b3, voffB); PG8_STAGE(PG8_SB(1, 1), b3 + hstep, voffB); PG8_STAGE(PG8_SA(1, 0), a3, voffA);
            PG8_WAIT_V(8); PG8_WAIT_L(0); PG8_BAR; PG8_MMA(1, 0, At, B0); PG8_MMA(1, 1, At, B1); PG8_BAR; PG8_SCHED;
            } else {
            PG8_LDB(B0, 0, 0); PG8_SCHED; PG8_LDA(At, 0, 0); PG8_STAGE(PG8_SA(1, 1), a1 + hstep, voffA);
            PG8_WAIT_L(8); PG8_BAR; PG8_WAIT_L(0); PG8_MMA(0, 0, At, B0); PG8_BAR; PG8_SCHED;
            PG8_LDB(B1, 0, 1); PG8_STAGE(PG8_SB(0, 0), b2, voffB);
            PG8_BAR; PG8_WAIT_L(0); PG8_MMA(0, 1, At, B1); PG8_BAR;
            PG8_LDA(At, 0, 1); PG8_STAGE(PG8_SA(0, 0), a2, voffA);
            PG8_BAR; PG8_WAIT_L(0); PG8_MMA(1, 0, At, B0); PG8_BAR; PG8_SCHED;
            PG8_STAGE(PG8_SB(0, 1), b2 + hstep, voffB);
            PG8_WAIT_V(6); PG8_BAR; PG8_MMA(1, 1, At, B1); PG8_BAR;
            PG8_LDB(B0, 1, 0); PG8_SCHED; PG8_LDA(At, 1, 0); PG8_STAGE(PG8_SA(0, 1), a2 + hstep, voffA);
            PG8_WAIT_L(8); PG8_BAR; PG8_WAIT_L(0); PG8_MMA(0, 0, At, B0); PG8_BAR; PG8_SCHED;
            PG8_LDB(B1, 1, 1); PG8_STAGE(PG8_SB(1, 0), b3, voffB);
            PG8_BAR; PG8_WAIT_L(0); PG8_MMA(0, 1, At, B1); PG8_BAR;
            PG8_LDA(At, 1, 1); PG8_STAGE(PG8_SA(1, 0), a3, voffA);
            PG8_BAR; PG8_WAIT_L(0); PG8_MMA(1, 0, At, B0); PG8_BAR; PG8_SCHED;
            PG8_STAGE(PG8_SB(1, 1), b3 + hstep, voffB);
            PG8_WAIT_V(6); PG8_BAR; PG8_MMA(1, 1, At, B1); PG8_BAR;
            }
        }
        if constexpr (ALIGN_EPI) { if (wr == 0) PG8_BAR; }
        if constexpr (!Epi::AFTER_DRAIN) { E(acc, cur, wr, wc, fr, fq); S.done(cur); }
        if (!has_next) break;
#pragma unroll
        for (int a = 0; a < 2; ++a)
#pragma unroll
            for (int b = 0; b < 2; ++b)
#pragma unroll
                for (int m = 0; m < 4; ++m)
#pragma unroll
                    for (int n = 0; n < 2; ++n) acc[a][b][m][n] = (f32x4){0.f, 0.f, 0.f, 0.f};
        cur = nxt; cA = nA; cB = nB; ++ui;
        if constexpr (ALIGN_EPI) { if (wr == 1) PG8_BAR; }
    }
    PG8_WAIT_V(0);
    if constexpr (!ALIGN_EPI) { if (wr == 0) PG8_BAR; }
    PG8_BAR;
    if constexpr (Epi::AFTER_DRAIN) { E.fused(acc, cur, wr, wc, fr, fq, lds, wid, lane); S.done(cur); }
#undef PG8_SA
#undef PG8_SB
#undef PG8_STAGE
#undef PG8_LDA
#undef PG8_LDB
#undef PG8_MMA
#undef PG8_WAIT_V
#undef PG8_WAIT_L
#undef PG8_BAR
#undef PG8_SCHED
}
}
#define GAS __attribute__((address_space(1)))
#define LAS __attribute__((address_space(3)))
typedef unsigned short bf16;
typedef unsigned v4u __attribute__((ext_vector_type(4)));
typedef float f32x4 __attribute__((ext_vector_type(4)));
typedef short bf16x8 __attribute__((ext_vector_type(8)));
typedef GAS unsigned gu32;
typedef GAS unsigned long long gu64;
#define RLX_AGENT __ATOMIC_RELAXED, __HIP_MEMORY_SCOPE_AGENT
#define LDS_WAIT() asm volatile("s_waitcnt lgkmcnt(0)" ::: "memory")
#define VM_WAIT() asm volatile("s_waitcnt vmcnt(0)" ::: "memory")
__device__ __forceinline__ unsigned long long rt() { return __builtin_amdgcn_s_memrealtime(); }
__device__ __forceinline__ unsigned f2bf(float f) { unsigned u = __builtin_bit_cast(unsigned, f); return (u + 0x7fffu + ((u >> 16) & 1u)) >> 16; }
__device__ __forceinline__ unsigned pk2(float lo, float hi) { return f2bf(lo) | (f2bf(hi) << 16); }

#define XB_TMO      128
#define XB_XCNT(j)  (256  + 64 * (j))
#define XB_XSUB(j)  (1280 + 64 * (j))
#define XB_XGEN(j)  (2304 + 64 * (j))
#define XB_TOP      3328
#define XB_TOPGEN   3392
#define XCD_BAR_WORDS 3456
#define XB_SPIN_CAP (1u << 18)

__device__ __forceinline__ unsigned xb_ld(unsigned* p)              { return __hip_atomic_load(p, __ATOMIC_RELAXED, __HIP_MEMORY_SCOPE_AGENT); }
__device__ __forceinline__ unsigned xb_add(unsigned* p, unsigned v) { return __hip_atomic_fetch_add(p, v, __ATOMIC_RELAXED, __HIP_MEMORY_SCOPE_AGENT); }
__device__ __forceinline__ unsigned xb_xcc_id() { return (unsigned)__builtin_amdgcn_s_getreg((3 << 11) | 20) & 0xFu; }
#define XB_SPIN(cond, bar) do { unsigned _sp = 0; while (cond) { __builtin_amdgcn_s_sleep(1); \
    if ((++_sp & 255u) == 0u) { if (xb_ld(&(bar)[XB_TMO])) break; if (_sp > XB_SPIN_CAP) { atomicAdd(&(bar)[XB_TMO], 1u); break; } } } } while (0)

struct XcdBarrier {
    unsigned* bar; unsigned x;
    volatile LAS unsigned* st;
};

__device__ __forceinline__ XcdBarrier xcd_barrier_post(unsigned* bar, volatile LAS unsigned* st) {
    XcdBarrier b; b.bar = bar; b.x = xb_xcc_id(); b.st = st;
    if (threadIdx.x == 0) (void)xb_add(&bar[XB_XCNT(b.x)], 1u);
    return b;
}
__device__ __forceinline__ void xcd_barrier_complete(unsigned* bar, unsigned x, unsigned& nloc, unsigned& nx) {
    const unsigned G = gridDim.x * gridDim.y * gridDim.z;
    unsigned sum, cnt, mine, sp = 0u;
    for (;;) {
        sum = 0u; cnt = 0u; mine = 0u;
#pragma unroll
        for (unsigned j = 0; j < 16; ++j) { const unsigned c = xb_ld(&bar[XB_XCNT(j)]); sum += c; cnt += (c > 0u) ? 1u : 0u; mine = (j == x) ? c : mine; }
        if (sum == G) break;
        __builtin_amdgcn_s_sleep(1);
        if ((++sp & 255u) == 0u) { if (xb_ld(&bar[XB_TMO])) break; if (sp > XB_SPIN_CAP) { atomicAdd(&bar[XB_TMO], 1u); break; } }
    }
    nloc = mine > 0u ? mine : 1u; nx = cnt > 0u ? cnt : 1u;
}

__device__ __forceinline__ void xcd_barrier(const XcdBarrier& b) {
    asm volatile("s_waitcnt vmcnt(0)" ::: "memory");
    __syncthreads();
    if (threadIdx.x == 0) {
        unsigned* bar = b.bar;
        __builtin_amdgcn_s_waitcnt(0);
        unsigned nloc = b.st[0], nx = b.st[1];
        if (nloc == 0u) { xcd_barrier_complete(bar, b.x, nloc, nx); b.st[0] = nloc; b.st[1] = nx; }
        const unsigned old = xb_add(&bar[XB_XSUB(b.x)], 1u);
        const unsigned gen = old / nloc;
        if (old + 1u == (gen + 1u) * nloc) {
            __builtin_amdgcn_fence(__ATOMIC_RELEASE, "agent");
            asm volatile("s_waitcnt vmcnt(0)" ::: "memory");
            const unsigned og = xb_add(&bar[XB_TOP], 1u);
            const unsigned tg = og / nx;
            if (og + 1u == (tg + 1u) * nx) xb_add(&bar[XB_TOPGEN], 1u);
            else XB_SPIN(xb_ld(&bar[XB_TOPGEN]) == tg, bar);
            __builtin_amdgcn_fence(__ATOMIC_ACQUIRE, "agent");
            xb_add(&bar[XB_XGEN(b.x)], 1u);
            asm volatile("s_waitcnt vmcnt(0)" ::: "memory");
        } else {
            XB_SPIN(xb_ld(&bar[XB_XGEN(b.x)]) == gen, bar);
            __builtin_amdgcn_fence(__ATOMIC_ACQUIRE, "agent");
            asm volatile("s_waitcnt vmcnt(0)" ::: "memory");
        }
    }
    __syncthreads();
}

#ifndef PROBE_ATT
#define PROBE_ATT 0
#endif
#ifndef PROBE_CMP
#define PROBE_CMP 0
#endif
#ifndef PROBE_SATT
#define PROBE_SATT 0
#endif
#ifndef NAIVE_SATT
#define NAIVE_SATT 0
#endif
namespace cfg {
constexpr int D = 1024, NB = 4, T = 4096, M = NB * T, SB = 32, SS = 4, MS = SB * SS, PAST = 8192, PAGE = 128, NPG = PAST / PAGE;
constexpr int H = 16, HD = 64, NKV = 4, NIN = 7728, NINP = 7936, FF = 2816, NGU = 2 * FF, NMOD = 6 * D, RMOD = NB + SB, MODKC = 8;
constexpr int NCS_P = 255, NCP_P = 256, NCS_S = 511, NCP_S = 512;
constexpr float EPS = 1e-6f, NEGF = -1e30f;
constexpr size_t O_YP = 0, O_YS = 16777216, O_CMP_P = 16908288, O_SEL_P = 25296896, O_WIN_P = 33685504, O_CONV_P = 34734080,
                 O_CMP_S = 34742272, O_SEL_S = 34807808, O_WIN_S = 34873344, O_CONV_S = 43261952, O_END = 43327488;
constexpr size_t MiB = 1u << 20;
constexpr size_t WS_CTL = 0, CTL_ZERO_BYTES = 1 * MiB;
constexpr size_t WS_WIN_T = 2 * MiB, WS_WOC_T = 18 * MiB, WS_WON_T = 20 * MiB, WS_WOUT_T = 22 * MiB, WS_WGU_T = 24 * MiB, WS_WDN_T = 36 * MiB;
constexpr size_t WS_MODP = 42 * MiB, WS_MOD = 49 * MiB;
constexpr size_t WS_XN = 64 * MiB, WS_BG = 96 * MiB, WS_U = 128 * MiB, WS_Q = 160 * MiB, WS_HM = 192 * MiB, WS_GA = 240 * MiB, WS_GB = 272 * MiB, WS_NGT = 304 * MiB;
constexpr size_t WS_AA = 308 * MiB, WS_OB = 340 * MiB, WS_MG = 372 * MiB, WS_X1 = 404 * MiB, WS_P1 = 468 * MiB, WS_HF = 532 * MiB, WS_KCC = 620 * MiB, WS_SCOREH = 622 * MiB, WS_MASK = 686 * MiB;
constexpr size_t WS_XNS = 688 * MiB, WS_ZS = 689 * MiB, WS_AAS = 693 * MiB, WS_OBS = 694 * MiB, WS_MGS = 695 * MiB, WS_X1S = 696 * MiB, WS_XN2S = 697 * MiB, WS_HFS = 698 * MiB, WS_X2S = 700 * MiB;
constexpr size_t WS_KCCS = 701 * MiB, WS_SCOREHS = 733 * MiB, WS_MASKS = 735 * MiB, WS_KCCB = 736 * MiB, WS_VCCT = 737 * MiB, WS_VST = 738 * MiB, WS_VWT = 746 * MiB, WS_OB2 = 754 * MiB, WS_MASKM = 786 * MiB, WS_W1T = 787 * MiB, WS_W2T = 788 * MiB, WS_BIASC = 789 * MiB, WS_KCCSB = 790 * MiB, WS_VCCST = 798 * MiB,
                 WS_CCMP = 806 * MiB, WS_ACMP = 880 * MiB, WS_END = 1160 * MiB;
constexpr int CM_S = SB * NKV * 512, CM_P = NB * NKV * 256, CM_ROWS = CM_S + CM_P;
constexpr size_t HMSZ = (size_t)NB * NKV * T * HD;
constexpr int CW_BAR = 4096;
constexpr int RING_OFF = 0, RING_BYTES = 151552, LDSCTL_OFF = RING_BYTES, MISC_OFF = LDSCTL_OFF + 320, LDS_BYTES = 155648;
constexpr int NWAVES = 8, NTHR = 512;
constexpr int NPHASE = 14;
}
using namespace cfg;

struct Ctx {
    __device__ static __forceinline__ const void* karg(int i) { return ((const void* const __attribute__((address_space(4)))*)__builtin_amdgcn_kernarg_segment_ptr())[i]; }
    __device__ __forceinline__ const float* x_p() const { return (const float*)karg(0); }
    __device__ __forceinline__ const float* x_s() const { return (const float*)karg(1); }
    __device__ __forceinline__ const float* c_p() const { return (const float*)karg(2); }
    __device__ __forceinline__ const float* c_s() const { return (const float*)karg(3); }
    __device__ __forceinline__ const float* cache_cmp() const { return (const float*)karg(4); }
    __device__ __forceinline__ const float* cache_sel() const { return (const float*)karg(5); }
    __device__ __forceinline__ const float* cache_win() const { return (const float*)karg(6); }
    __device__ __forceinline__ const float* state_conv() const { return (const float*)karg(7); }
    __device__ __forceinline__ const int* pt() const { return (const int*)karg(8); }
    __device__ __forceinline__ const float* w_ada() const { return (const float*)karg(9); }
    __device__ __forceinline__ const float* b_ada() const { return (const float*)karg(10); }
    __device__ __forceinline__ const float* norm1() const { return (const float*)karg(11); }
    __device__ __forceinline__ const float* w_in() const { return (const float*)karg(12); }
    __device__ __forceinline__ const float* w_conv() const { return (const float*)karg(13); }
    __device__ __forceinline__ const float* b_conv() const { return (const float*)karg(14); }
    __device__ __forceinline__ const float* w_oc() const { return (const float*)karg(15); }
    __device__ __forceinline__ const float* pe() const { return (const float*)karg(16); }
    __device__ __forceinline__ const float* w_phi1() const { return (const float*)karg(17); }
    __device__ __forceinline__ const float* w_phi2() const { return (const float*)karg(18); }
    __device__ __forceinline__ const float* w_on() const { return (const float*)karg(19); }
    __device__ __forceinline__ const float* w_out() const { return (const float*)karg(20); }
    __device__ __forceinline__ const float* norm2() const { return (const float*)karg(21); }
    __device__ __forceinline__ const float* w_gate() const { return (const float*)karg(22); }
    __device__ __forceinline__ const float* w_up() const { return (const float*)karg(23); }
    __device__ __forceinline__ const float* w_down() const { return (const float*)karg(24); }
    __device__ __forceinline__ const float* norm_f() const { return (const float*)karg(25); }
    __device__ __forceinline__ float* out() const { return (float*)karg(26); }
    unsigned char* ws; bf16* OB; float* CHK;
    LAS unsigned char* lds; int tid, lane, wave, G, bid;
    __device__ __forceinline__ bf16* WIN_T() const { return (bf16*)(ws + WS_WIN_T); }
    __device__ __forceinline__ bf16* WOC_T() const { return (bf16*)(ws + WS_WOC_T); }
    __device__ __forceinline__ bf16* WON_T() const { return (bf16*)(ws + WS_WON_T); }
    __device__ __forceinline__ bf16* WOUT_T() const { return (bf16*)(ws + WS_WOUT_T); }
    __device__ __forceinline__ bf16* WGU_T() const { return (bf16*)(ws + WS_WGU_T); }
    __device__ __forceinline__ bf16* WDN_T() const { return (bf16*)(ws + WS_WDN_T); }
    __device__ __forceinline__ float* MODP() const { return (float*)(ws + WS_MODP); }
    __device__ __forceinline__ float* MOD() const { return (float*)(ws + WS_MOD); }
    __device__ __forceinline__ bf16* XN() const { return (bf16*)(ws + WS_XN); }
    __device__ __forceinline__ bf16* BG() const { return (bf16*)(ws + WS_BG); }
    __device__ __forceinline__ bf16* U() const { return (bf16*)(ws + WS_U); }
    __device__ __forceinline__ bf16* Q() const { return (bf16*)(ws + WS_Q); }
    __device__ __forceinline__ bf16* HM() const { return (bf16*)(ws + WS_HM); }
    __device__ __forceinline__ bf16* GA() const { return (bf16*)(ws + WS_GA); }
    __device__ __forceinline__ bf16* GB() const { return (bf16*)(ws + WS_GB); }
    __device__ __forceinline__ float* NGT() const { return (float*)(ws + WS_NGT); }
    __device__ __forceinline__ bf16* AA() const { return (bf16*)(ws + WS_AA); }
    __device__ __forceinline__ bf16* MG() const { return (bf16*)(ws + WS_MG); }
    __device__ __forceinline__ float* X1() const { return (float*)(ws + WS_X1); }
    __device__ __forceinline__ float* P1() const { return (float*)(ws + WS_P1); }
    __device__ __forceinline__ bf16* HF() const { return (bf16*)(ws + WS_HF); }
    __device__ __forceinline__ float* KCC() const { return (float*)(ws + WS_KCC); }
    __device__ __forceinline__ float* SCOREH() const { return (float*)(ws + WS_SCOREH); }
    __device__ __forceinline__ unsigned long long* MASK() const { return (unsigned long long*)(ws + WS_MASK); }
    __device__ __forceinline__ float* XNS() const { return (float*)(ws + WS_XNS); }
    __device__ __forceinline__ float* ZS() const { return (float*)(ws + WS_ZS); }
    __device__ __forceinline__ float* AAS() const { return (float*)(ws + WS_AAS); }
    __device__ __forceinline__ float* OBS() const { return (float*)(ws + WS_OBS); }
    __device__ __forceinline__ float* MGS() const { return (float*)(ws + WS_MGS); }
    __device__ __forceinline__ float* X1S() const { return (float*)(ws + WS_X1S); }
    __device__ __forceinline__ float* XN2S() const { return (float*)(ws + WS_XN2S); }
    __device__ __forceinline__ float* HFS() const { return (float*)(ws + WS_HFS); }
    __device__ __forceinline__ float* X2S() const { return (float*)(ws + WS_X2S); }
    __device__ __forceinline__ float* KCCS() const { return (float*)(ws + WS_KCCS); }
    __device__ __forceinline__ float* SCOREHS() const { return (float*)(ws + WS_SCOREHS); }
    __device__ __forceinline__ unsigned long long* MASKS() const { return (unsigned long long*)(ws + WS_MASKS); }
    __device__ __forceinline__ bf16* KCCB() const { return (bf16*)(ws + WS_KCCB); }
    __device__ __forceinline__ bf16* VCCT() const { return (bf16*)(ws + WS_VCCT); }
    __device__ __forceinline__ bf16* VST() const { return (bf16*)(ws + WS_VST); }
    __device__ __forceinline__ bf16* VWT() const { return (bf16*)(ws + WS_VWT); }
    __device__ __forceinline__ bf16* OB2() const { return (bf16*)(ws + WS_OB2); }
    __device__ __forceinline__ unsigned long long* MASKM() const { return (unsigned long long*)(ws + WS_MASKM); }
    __device__ __forceinline__ bf16* W1T() const { return (bf16*)(ws + WS_W1T); }
    __device__ __forceinline__ bf16* W2T() const { return (bf16*)(ws + WS_W2T); }
    __device__ __forceinline__ float* BIASC() const { return (float*)(ws + WS_BIASC); }
    __device__ __forceinline__ bf16* KCCSB() const { return (bf16*)(ws + WS_KCCSB); }
    __device__ __forceinline__ bf16* VCCST() const { return (bf16*)(ws + WS_VCCST); }
    __device__ __forceinline__ bf16* CCMP() const { return (bf16*)(ws + WS_CCMP); }
    __device__ __forceinline__ bf16* ACMP() const { return (bf16*)(ws + WS_ACMP); }
};

__device__ __forceinline__ int gtid(const Ctx& c) { int t = c.tid; asm volatile("" : "+v"(t)); return c.bid * NTHR + t; }
__device__ __forceinline__ float bf2f(bf16 b) { return __uint_as_float((unsigned)b << 16); }
__device__ __forceinline__ float sigmoidf_(float x) { return 1.f / (1.f + __expf(-x)); }
__device__ __forceinline__ float siluf_(float x) { return x / (1.f + __expf(-x)); }
__device__ __forceinline__ float gelu_tanh(float x) { const float u = 0.7978845608028654f * (x + 0.044715f * x * x * x); const float e = __expf(2.f * u); const float th = 1.f - 2.f / (e + 1.f); return 0.5f * x * (1.f + th); }
__device__ __forceinline__ float wave_sum(float v) {
#pragma unroll
    for (int o = 1; o < 64; o <<= 1) v += __shfl_xor(v, o);
    return v;
}
__device__ __forceinline__ void ld8(const bf16* p, float (&v)[8]) {
    const v4u w = *(const v4u*)p;
    v[0] = __uint_as_float(w.x << 16); v[1] = __uint_as_float(w.x & 0xffff0000u); v[2] = __uint_as_float(w.y << 16); v[3] = __uint_as_float(w.y & 0xffff0000u);
    v[4] = __uint_as_float(w.z << 16); v[5] = __uint_as_float(w.z & 0xffff0000u); v[6] = __uint_as_float(w.w << 16); v[7] = __uint_as_float(w.w & 0xffff0000u);
}
__device__ __forceinline__ void ld8(const float* p, float (&v)[8]) {
    const f32x4 a = *(const f32x4*)p, b = *(const f32x4*)(p + 4);
    v[0] = a.x; v[1] = a.y; v[2] = a.z; v[3] = a.w; v[4] = b.x; v[5] = b.y; v[6] = b.z; v[7] = b.w;
}
__device__ __forceinline__ v4u pack8(const float (&v)[8]) { v4u w; w.x = pg8::cvt_pk_bf16(v[0], v[1]); w.y = pg8::cvt_pk_bf16(v[2], v[3]); w.z = pg8::cvt_pk_bf16(v[4], v[5]); w.w = pg8::cvt_pk_bf16(v[6], v[7]); return w; }
template <class TP> __device__ __forceinline__ float dot64(const TP* row, const float (&q)[64]) {
    float s = 0.f;
#pragma unroll
    for (int c = 0; c < 8; ++c) { float v[8]; ld8(row + 8 * c, v);
#pragma unroll
        for (int j = 0; j < 8; ++j) s += q[8 * c + j] * v[j]; }
    return s;
}
template <class TP> __device__ __forceinline__ void axpy64(const TP* row, float p, float (&o)[64]) {
#pragma unroll
    for (int c = 0; c < 8; ++c) { float v[8]; ld8(row + 8 * c, v);
#pragma unroll
        for (int j = 0; j < 8; ++j) o[8 * c + j] += p * v[j]; }
}

struct SrcCol { const float* W; int ld; int col; };
template <class F> __device__ __forceinline__ void transpose_item(const F& f, int K, bf16* WT, LAS float* scr, int item, int nblk, int lane) {
    const int kb = item / nblk, nb = item % nblk, k0 = 64 * kb, n0 = 32 * nb, c4 = 4 * (lane & 7), rb = lane >> 3;
    const SrcCol sc = f(n0 + c4);
    f32x4 v[8];
#pragma unroll
    for (int i = 0; i < 8; ++i) v[i] = sc.col >= 0 ? *(const f32x4*)(sc.W + (size_t)(k0 + 8 * i + rb) * sc.ld + sc.col) : (f32x4){0.f, 0.f, 0.f, 0.f};
#pragma unroll
    for (int i = 0; i < 8; ++i) { LAS float* d = scr + (8 * i + rb) * 33 + c4; d[0] = v[i].x; d[1] = v[i].y; d[2] = v[i].z; d[3] = v[i].w; }
    LDS_WAIT(); asm volatile("" ::: "memory");
    const int c = lane & 7;
#pragma unroll
    for (int j = 0; j < 4; ++j) { const int n = (lane >> 3) + 8 * j; const LAS float* s = scr + (8 * c) * 33 + n;
        v4u o; o.x = pk2(s[0 * 33], s[1 * 33]); o.y = pk2(s[2 * 33], s[3 * 33]); o.z = pk2(s[4 * 33], s[5 * 33]); o.w = pk2(s[6 * 33], s[7 * 33]);
        *(GAS v4u*)(WT + (size_t)(n0 + n) * K + k0 + 8 * c) = o; }
    LDS_WAIT(); asm volatile("" ::: "memory");
}
struct ColIn { const float* W; __device__ __forceinline__ SrcCol operator()(int p) const {
    int s;
    if (p < 1024) s = p;
    else if (p < 3072) { const int t = (p - 1024) >> 8, w = (p - 1024) & 255; s = (w < 128) ? (1024 + 128 * t + w) : (2048 + 128 * t + (w - 128)); }
    else if (p < 5632) s = p;
    else if (p < 7680) s = 5680 + (p - 5632);
    else if (p < 7728) s = 5632 + (p - 7680);
    else s = -1;
    return SrcCol{W, NIN, s}; } };
struct ColPlain { const float* W; int ld; __device__ __forceinline__ SrcCol operator()(int p) const { return SrcCol{W, ld, p}; } };
struct ColW1 { const float* W; __device__ __forceinline__ SrcCol operator()(int p) const { return (p < 128) ? SrcCol{W, 128, p} : SrcCol{W + 1024 * 128, 128, p - 128}; } };
struct ColGU { const float *Wg, *Wu; __device__ __forceinline__ SrcCol operator()(int p) const { const int t = p >> 8, w = p & 255; return (w < 128) ? SrcCol{Wg, FF, 128 * t + w} : SrcCol{Wu, FF, 128 * t + (w - 128)}; } };

__device__ __forceinline__ void mod_partial_item(const Ctx& c, int item) {
    const int kc = item / 12, cc = item % 12, k0 = kc * 128, n = cc * 512 + c.tid;
    LAS float* sc = (LAS float*)c.lds;
    for (int i = c.tid; i < RMOD * 128; i += NTHR) { const int r = i >> 7, k = i & 127; const float cv = (r < NB) ? c.c_p()[r * D + k0 + k] : c.c_s()[(r - NB) * D + k0 + k]; sc[i] = siluf_(cv); }
    __syncthreads();
    float acc[RMOD];
#pragma unroll
    for (int r = 0; r < RMOD; ++r) acc[r] = 0.f;
#pragma unroll 8
    for (int k = 0; k < 128; ++k) { const float w = c.w_ada()[(size_t)(k0 + k) * NMOD + n];
#pragma unroll
        for (int r = 0; r < RMOD; ++r) acc[r] += sc[r * 128 + k] * w; }
#pragma unroll
    for (int r = 0; r < RMOD; ++r) c.MODP()[((size_t)kc * RMOD + r) * NMOD + n] = acc[r];
    __syncthreads();
}
__device__ __forceinline__ void p0_prologue(const Ctx& c) {
    for (int it = c.bid; it < MODKC * 12; it += c.G) mod_partial_item(c, it);
    LAS float* scr = (LAS float*)(c.lds + c.wave * 16384);
    const int gw = c.bid * NWAVES + c.wave, NGW = c.G * NWAVES;
    constexpr int I_IN = 16 * (NINP / 32), I_SQ = 16 * 32, I_GU = 16 * (NGU / 32), I_DN = (FF / 64) * 32;
    constexpr int I_W1 = 2 * 16 * 8, I_W2 = 2 * 2 * 2;
    constexpr int NITEMS = I_IN + 3 * I_SQ + I_GU + I_DN + I_W1 + I_W2;
    const int nmodw = (MODKC * 12 < c.G ? MODKC * 12 : c.G) * NWAVES, nvirt = nmodw + 2 * (NGW - nmodw);
    for (int sh = 0; sh < 2; ++sh) {
      if (sh == 1 && gw < nmodw) break;
      for (int it = (gw < nmodw ? gw : nmodw + 2 * (gw - nmodw) + sh); it < NITEMS; it += nvirt) {
        int r = it;
        if (r < I_IN) { transpose_item(ColIn{c.w_in()}, D, c.WIN_T(), scr, r, NINP / 32, c.lane); continue; } r -= I_IN;
        if (r < I_SQ) { transpose_item(ColPlain{c.w_oc(), D}, D, c.WOC_T(), scr, r, 32, c.lane); continue; } r -= I_SQ;
        if (r < I_SQ) { transpose_item(ColPlain{c.w_on(), D}, D, c.WON_T(), scr, r, 32, c.lane); continue; } r -= I_SQ;
        if (r < I_SQ) { transpose_item(ColPlain{c.w_out(), D}, D, c.WOUT_T(), scr, r, 32, c.lane); continue; } r -= I_SQ;
        if (r < I_GU) { transpose_item(ColGU{c.w_gate(), c.w_up()}, D, c.WGU_T(), scr, r, NGU / 32, c.lane); continue; } r -= I_GU;
        if (r < I_DN) { transpose_item(ColPlain{c.w_down(), D}, FF, c.WDN_T(), scr, r, 32, c.lane); continue; } r -= I_DN;
        if (r < I_W1) { const int kv = r >> 7; transpose_item(ColW1{c.w_phi1() + (size_t)kv * 2048 * 128}, 1024, c.W1T() + (size_t)kv * 256 * 1024, scr, r & 127, 8, c.lane); continue; } r -= I_W1;
        { const int kv = r >> 2; transpose_item(ColPlain{c.w_phi2() + (size_t)kv * 128 * HD, HD}, 128, c.W2T() + (size_t)kv * HD * 128, scr, r & 3, 2, c.lane); }
      }
    }
    for (int it = c.G - 1 - c.bid; it < 256; it += c.G) { const int kv = it >> 7, n = it & 127; float s = 0.f;
#pragma unroll
        for (int j = 0; j < 4; ++j) { const int kk = c.tid + NTHR * j; s += c.pe()[kv * 2048 + kk] * c.w_phi1()[((size_t)kv * 2048 + kk) * 128 + n]; }
        s = wave_sum(s);
        LAS float* red = (LAS float*)c.lds;
        __syncthreads(); if (c.lane == 0) red[c.wave] = s; __syncthreads();
        if (c.tid == 0) { float tsum = 0.f; for (int w = 0; w < NWAVES; ++w) tsum += red[w]; c.BIASC()[it] = tsum; } }
    __syncthreads();
}

template <bool MODUL, bool OUT_BF16> __device__ __forceinline__ void norm_row(const float* xrow, const float* gain, const float* sh, const float* sc, void* orow, int lane) {
    const GAS f32x4* xr = (const GAS f32x4*)xrow + lane;
    f32x4 v[4]; float s = 0.f;
#pragma unroll
    for (int j = 0; j < 4; ++j) { v[j] = xr[64 * j]; s += (v[j].x * v[j].x + v[j].y * v[j].y) + (v[j].z * v[j].z + v[j].w * v[j].w); }
    const float inv = 1.0f / sqrtf(wave_sum(s) * (1.f / D) + EPS);
#pragma unroll
    for (int j = 0; j < 4; ++j) {
        const int k = 4 * lane + 256 * j;
        const f32x4 g = *(const f32x4*)(gain + k);
        f32x4 o = v[j] * inv * g;
        if (MODUL) { const f32x4 a = *(const f32x4*)(sc + k), b = *(const f32x4*)(sh + k); o = o * (a + 1.0f) + b; }
        if (OUT_BF16) { ((GAS unsigned long long*)orow)[lane + 64 * j] = (unsigned long long)pg8::cvt_pk_bf16(o.x, o.y) | ((unsigned long long)pg8::cvt_pk_bf16(o.z, o.w) << 32); }
        else { ((GAS f32x4*)orow)[lane + 64 * j] = o; }
    }
}
__device__ __forceinline__ void p1_norm1(const Ctx& c) {
    for (int r = c.bid; r < RMOD; r += c.G)
        for (int n = c.tid; n < NMOD; n += NTHR) { float s = c.b_ada()[n];
#pragma unroll
            for (int kc = 0; kc < MODKC; ++kc) s += c.MODP()[((size_t)kc * RMOD + r) * NMOD + n];
            c.MOD()[(size_t)r * NMOD + n] = s; }
    LAS float* shl = (LAS float*)c.lds; LAS float* scl = shl + D;
    constexpr int NCH = M / 64 + SB;
    for (int ch = c.bid; ch < NCH; ch += c.G) {
        const bool smp = ch >= M / 64; const int r = smp ? NB + (ch - M / 64) : (ch * 64) / T;
        __syncthreads();
        for (int k = c.tid; k < 2 * D; k += NTHR) { float s = c.b_ada()[k];
#pragma unroll
            for (int kc = 0; kc < MODKC; ++kc) s += c.MODP()[((size_t)kc * RMOD + r) * NMOD + k];
            shl[k] = s; }
        __syncthreads();
        if (!smp) { for (int rr = c.wave; rr < 64; rr += NWAVES) { const int row = ch * 64 + rr;
                const GAS f32x4* xr = (const GAS f32x4*)(c.x_p() + (size_t)row * D) + c.lane; f32x4 v[4]; float s = 0.f;
#pragma unroll
                for (int j = 0; j < 4; ++j) { v[j] = xr[64 * j]; s += (v[j].x * v[j].x + v[j].y * v[j].y) + (v[j].z * v[j].z + v[j].w * v[j].w); }
                const float inv = 1.0f / sqrtf(wave_sum(s) * (1.f / D) + EPS);
#pragma unroll
                for (int j = 0; j < 4; ++j) { const int k = 4 * c.lane + 256 * j; const f32x4 g = *(const f32x4*)(c.norm1() + k);
                    const f32x4 a = *(const LAS f32x4*)(scl + k), b = *(const LAS f32x4*)(shl + k); const f32x4 o = v[j] * inv * g * (a + 1.0f) + b;
                    ((GAS unsigned long long*)(c.XN() + (size_t)row * D))[c.lane + 64 * j] = (unsigned long long)pg8::cvt_pk_bf16(o.x, o.y) | ((unsigned long long)pg8::cvt_pk_bf16(o.z, o.w) << 32); } } }
        else if (c.wave < SS) { const int row = (ch - M / 64) * SS + c.wave;
                const GAS f32x4* xr = (const GAS f32x4*)(c.x_s() + (size_t)row * D) + c.lane; f32x4 v[4]; float s = 0.f;
#pragma unroll
                for (int j = 0; j < 4; ++j) { v[j] = xr[64 * j]; s += (v[j].x * v[j].x + v[j].y * v[j].y) + (v[j].z * v[j].z + v[j].w * v[j].w); }
                const float inv = 1.0f / sqrtf(wave_sum(s) * (1.f / D) + EPS);
#pragma unroll
                for (int j = 0; j < 4; ++j) { const int k = 4 * c.lane + 256 * j; const f32x4 g = *(const f32x4*)(c.norm1() + k);
                    const f32x4 a = *(const LAS f32x4*)(scl + k), b = *(const LAS f32x4*)(shl + k); const f32x4 o = v[j] * inv * g * (a + 1.0f) + b;
                    ((GAS f32x4*)(c.XNS() + (size_t)row * D))[c.lane + 64 * j] = o; } }
    }
    __syncthreads();
}
__device__ __forceinline__ void p5c_norm2(const Ctx& c) {
    const int gw = c.bid * NWAVES + c.wave, NGW = c.G * NWAVES;
    for (int row = gw; row < M + MS; row += NGW) {
        if (row < M) { const int r = row / T; norm_row<true, true>(c.X1() + (size_t)row * D, c.norm2(), c.MOD() + (size_t)r * NMOD + 3 * D, c.MOD() + (size_t)r * NMOD + 4 * D, c.XN() + (size_t)row * D, c.lane); }
        else { const int rs = row - M, r = NB + rs / SS; norm_row<true, false>(c.X1S() + (size_t)rs * D, c.norm2(), c.MOD() + (size_t)r * NMOD + 3 * D, c.MOD() + (size_t)r * NMOD + 4 * D, c.XN2S() + (size_t)rs * D, c.lane); }
    }
}
__device__ __forceinline__ void p8_normf(const Ctx& c) {
    const int gw = c.bid * NWAVES + c.wave, NGW = c.G * NWAVES;
    for (int row = gw; row < M + MS; row += NGW) {
        if (row < M) norm_row<false, false>(c.out() + O_YP + (size_t)row * D, c.norm_f(), nullptr, nullptr, c.out() + O_YP + (size_t)row * D, c.lane);
        else { const int rs = row - M; norm_row<false, false>(c.X2S() + (size_t)rs * D, c.norm_f(), nullptr, nullptr, c.out() + O_YS + (size_t)rs * D, c.lane); }
    }
}

using pg8::Unit;
#define EPI_ROWS(...) _Pragma("unroll") for (int ai = 0; ai < 2; ++ai) _Pragma("unroll") for (int m = 0; m < 4; ++m) { const int row = row0 + ai * 128 + m * 16; __VA_ARGS__ }
struct EpiIn {
    static constexpr bool PERM = true, AFTER_DRAIN = false;
    bf16 *BG, *U, *Q, *HM, *GA, *GB; float* NGT; float* out; bf16 *VST, *VWT, *ACMP;
    __device__ __forceinline__ void operator()(const f32x4 (&acc)[2][2][4][2], const Unit& u, int wr, int wc, int fr, int fq) const {
        const int pn = u.pn, row0 = u.pm * 256 + wr * 64 + fr, cl0 = wc * 32 + 8 * fq;
        if (pn < 4 || (pn >= 12 && pn < 16) || (pn >= 22 && pn < 30)) {
            bf16* base; int colt; float sc = 1.f; bool sig = false;
            if (pn < 4) { base = BG; colt = pn * 256; } else if (pn < 16) { base = Q; colt = (pn - 12) * 256; sc = 0.125f * 1.4426950408889634f; } else if (pn < 26) { base = GA; colt = (pn - 22) * 256; sig = true; } else { base = GB; colt = (pn - 26) * 256; sig = true; }
            EPI_ROWS(
_Pragma("unroll")
                for (int bj = 0; bj < 2; ++bj) { const f32x4 a = acc[ai][bj][m][0], b = acc[ai][bj][m][1]; float v[8] = {a.x, a.y, a.z, a.w, b.x, b.y, b.z, b.w};
_Pragma("unroll")
                    for (int j = 0; j < 8; ++j) v[j] = sig ? sigmoidf_(v[j]) : v[j] * sc;
                    *(GAS v4u*)(base + (size_t)row * D + colt + bj * 128 + cl0) = pack8(v); } )
        } else if (pn < 12) {
            const int t = pn - 4;
            EPI_ROWS(
                const f32x4 a = acc[ai][0][m][0] * acc[ai][1][m][0], b = acc[ai][0][m][1] * acc[ai][1][m][1]; const float v[8] = {a.x, a.y, a.z, a.w, b.x, b.y, b.z, b.w};
                *(GAS v4u*)(U + (size_t)row * D + t * 128 + cl0) = pack8(v);
                const int tt = row & (T - 1);
                if (tt >= T - 2) { float* o = out + O_CONV_P + (size_t)((row >> 12) * 2 + (tt - (T - 2))) * D + t * 128 + cl0; *(GAS f32x4*)o = a; *(GAS f32x4*)(o + 4) = b; } )
        } else if (pn < 22) {
            const int kind = pn - 16, kv = kind & 1, reg = kind >> 1;
            EPI_ROWS(
                const int b = row >> 12, tt = row & (T - 1);
_Pragma("unroll")
                for (int bj = 0; bj < 2; ++bj) { const f32x4 a = acc[ai][bj][m][0], bq = acc[ai][bj][m][1]; const float v[8] = {a.x, a.y, a.z, a.w, bq.x, bq.y, bq.z, bq.w};
                    const int cl = bj * 128 + cl0, g = cl >> 6, d = cl & 63;
                    if (kind == 3 || kind == 5) { bf16* vt = (kind == 3 ? VST : VWT) + ((size_t)((b * NKV + g) * HD + d)) * T + tt;
_Pragma("unroll")
                        for (int j = 0; j < 8; ++j) vt[(size_t)j * T] = (bf16)f2bf(v[j]); }
                    if (kind < 2) *(GAS v4u*)(ACMP + ((size_t)kind * CM_ROWS + CM_S) * 1024 + ((size_t)((b * NKV + g) * T + tt)) * HD + d) = pack8(v);
                    else if (PROBE_ATT || !(kind == 3 || kind == 5)) *(GAS v4u*)(HM + (size_t)kind * HMSZ + ((size_t)((b * NKV + g) * T + tt)) * HD + d) = pack8(v);
                    float* o = nullptr;
                    if (reg == 0) o = out + O_CMP_P + ((size_t)row * 2 + kv) * 256 + cl;
                    else if (reg == 1) o = out + O_SEL_P + ((size_t)row * 2 + kv) * 256 + cl;
                    else if (tt >= T - 512) o = out + O_WIN_P + ((size_t)(b * 512 + tt - (T - 512)) * 2 + kv) * 256 + cl;
                    if (o) { *(GAS f32x4*)o = a; *(GAS f32x4*)(o + 4) = bq; } } )
        } else {
            if (cl0 < 48) {
                EPI_ROWS(
                    const f32x4 a = acc[ai][0][m][0], b = acc[ai][0][m][1];
                    f32x4 sa, sb; sa.x = sigmoidf_(a.x); sa.y = sigmoidf_(a.y); sa.z = sigmoidf_(a.z); sa.w = sigmoidf_(a.w); sb.x = sigmoidf_(b.x); sb.y = sigmoidf_(b.y); sb.z = sigmoidf_(b.z); sb.w = sigmoidf_(b.w);
                    float* o = NGT + (size_t)row * 48 + cl0; *(GAS f32x4*)o = sa; *(GAS f32x4*)(o + 4) = sb; )
            }
        }
    }
};
struct EpiYa { static constexpr bool PERM = true, AFTER_DRAIN = false; const bf16* GA; float* P1;
    __device__ __forceinline__ void operator()(const f32x4 (&acc)[2][2][4][2], const Unit& u, int wr, int wc, int fr, int fq) const {
        const int row0 = u.pm * 256 + wr * 64 + fr, col0 = u.pn * 256 + wc * 32 + 8 * fq;
        EPI_ROWS(
_Pragma("unroll")
            for (int bj = 0; bj < 2; ++bj) { const size_t off = (size_t)row * D + col0 + bj * 128; float g[8]; ld8(GA + off, g); const f32x4 a = acc[ai][bj][m][0], b = acc[ai][bj][m][1];
                f32x4 o0, o1; o0.x = g[0] * a.x; o0.y = g[1] * a.y; o0.z = g[2] * a.z; o0.w = g[3] * a.w; o1.x = g[4] * b.x; o1.y = g[5] * b.y; o1.z = g[6] * b.z; o1.w = g[7] * b.w;
                *(GAS f32x4*)(P1 + off) = o0; *(GAS f32x4*)(P1 + off + 4) = o1; } )
    } };
struct EpiYb { static constexpr bool PERM = true, AFTER_DRAIN = false; const bf16* GB; const float* P1; bf16* MG;
    __device__ __forceinline__ void operator()(const f32x4 (&acc)[2][2][4][2], const Unit& u, int wr, int wc, int fr, int fq) const {
        const int row0 = u.pm * 256 + wr * 64 + fr, col0 = u.pn * 256 + wc * 32 + 8 * fq;
        EPI_ROWS(
_Pragma("unroll")
            for (int bj = 0; bj < 2; ++bj) { const size_t off = (size_t)row * D + col0 + bj * 128; float g[8]; ld8(GB + off, g); float p[8]; ld8(P1 + off, p); const f32x4 a = acc[ai][bj][m][0], b = acc[ai][bj][m][1];
                const float v[8] = {p[0] + g[0] * a.x, p[1] + g[1] * a.y, p[2] + g[2] * a.z, p[3] + g[3] * a.w, p[4] + g[4] * b.x, p[5] + g[5] * b.y, p[6] + g[6] * b.z, p[7] + g[7] * b.w};
                *(GAS v4u*)(MG + off) = pack8(v); } )
    } };
struct EpiRes { static constexpr bool PERM = true, AFTER_DRAIN = false; const float* base; float* O; const float* MOD; int goff;
    __device__ __forceinline__ void operator()(const f32x4 (&acc)[2][2][4][2], const Unit& u, int wr, int wc, int fr, int fq) const {
        const int row0 = u.pm * 256 + wr * 64 + fr, col0 = u.pn * 256 + wc * 32 + 8 * fq;
        const float* gp = MOD + (size_t)((u.pm * 256) / T) * NMOD + goff + col0;
        f32x4 gt[2][2];
#pragma unroll
        for (int bj = 0; bj < 2; ++bj) { gt[bj][0] = *(const f32x4*)(gp + bj * 128); gt[bj][1] = *(const f32x4*)(gp + bj * 128 + 4); }
        EPI_ROWS(
_Pragma("unroll")
            for (int bj = 0; bj < 2; ++bj) { const size_t off = (size_t)row * D + col0 + bj * 128;
                const f32x4 x0 = *(const f32x4*)(base + off), x1 = *(const f32x4*)(base + off + 4);
                *(GAS f32x4*)(O + off) = x0 + gt[bj][0] * acc[ai][bj][m][0]; *(GAS f32x4*)(O + off + 4) = x1 + gt[bj][1] * acc[ai][bj][m][1]; } )
    } };
struct EpiFF { static constexpr bool PERM = true, AFTER_DRAIN = false; bf16* HF;
    __device__ __forceinline__ void operator()(const f32x4 (&acc)[2][2][4][2], const Unit& u, int wr, int wc, int fr, int fq) const {
        const int row0 = u.pm * 256 + wr * 64 + fr, col0 = u.pn * 128 + wc * 32 + 8 * fq;
        EPI_ROWS(
            const f32x4 g0 = acc[ai][0][m][0], g1 = acc[ai][0][m][1], u0 = acc[ai][1][m][0], u1 = acc[ai][1][m][1];
            const float v[8] = {siluf_(g0.x) * u0.x, siluf_(g0.y) * u0.y, siluf_(g0.z) * u0.z, siluf_(g0.w) * u0.w, siluf_(g1.x) * u1.x, siluf_(g1.y) * u1.y, siluf_(g1.z) * u1.z, siluf_(g1.w) * u1.w};
            *(GAS v4u*)(HF + (size_t)row * FF + col0) = pack8(v); )
    } };

struct CmpOrder { int G, c; static constexpr int NPM = CM_ROWS / 256, NPP = CM_P / 256;
    __device__ bool next(int i, Unit& u) const { const int L = i * G + c; if (L >= 2 * NPP) return false; const int kv = L / NPP; u.pm = kv * NPM + CM_S / 256 + (L % NPP); u.pn = kv; return true; }
    __device__ __forceinline__ void a_ready(const Unit&) const {}
    __device__ __forceinline__ void done(const Unit&) const {} };
struct EpiCmp { static constexpr bool PERM = true, AFTER_DRAIN = false; bf16* C;
    __device__ __forceinline__ void operator()(const f32x4 (&acc)[2][2][4][2], const Unit& u, int wr, int wc, int fr, int fq) const {
        const int row0 = u.pm * 256 + wr * 64 + fr, col0 = wc * 32 + 8 * fq;
        EPI_ROWS(
_Pragma("unroll")
            for (int bj = 0; bj < 2; ++bj) { const f32x4 a = acc[ai][bj][m][0], b = acc[ai][bj][m][1]; const float v[8] = {a.x, a.y, a.z, a.w, b.x, b.y, b.z, b.w};
                *(GAS v4u*)(C + (size_t)row * 256 + bj * 128 + col0) = pack8(v); } )
    } };
constexpr int SC_BP = 80, SC_BBUF = 512 * SC_BP;
__device__ __forceinline__ void scmp_tile(const Ctx& c, int tile) {
    typedef short bfx8 __attribute__((ext_vector_type(8)));
    int lane_ = c.lane; asm volatile("" : "+v"(lane_));
    int tid_ = c.tid; asm volatile("" : "+v"(tid_));
    const int r16 = lane_ & 15, G = lane_ >> 4, wave = c.wave;
    const int b = tile >> 4, j0 = (tile & 15) * 32, kv = wave >> 2, g = wave & 3;
    const int r0 = (b * NKV + g) * 512 + j0;
    const float* abase[2];
#pragma unroll
    for (int rb = 0; rb < 2; ++rb) { const int pos0 = 16 * (j0 + 16 * rb + r16);
        abase[rb] = c.cache_cmp() + ((size_t)c.pt()[b * NPG + (pos0 >> 7)] * PAGE + (pos0 & 127)) * 512 + kv * 256 + g * HD + 8 * G; }
    const bf16* wsrc = c.W1T() + (size_t)tid_ * 1024;
    LAS unsigned char* lds = c.lds; const int wdst = tid_ * SC_BP;
    f32x4 acc[2][16];
#pragma unroll
    for (int rb = 0; rb < 2; ++rb)
#pragma unroll
        for (int cb = 0; cb < 16; ++cb) acc[rb][cb] = (f32x4){0.f, 0.f, 0.f, 0.f};
    f32x4 ar0[2][2], ar1[2][2]; v4u wr0[4], wr1[4];
#pragma unroll
    for (int rb = 0; rb < 2; ++rb) { ar0[rb][0] = *(const f32x4*)(abase[rb]); ar0[rb][1] = *(const f32x4*)(abase[rb] + 4);
                                     ar1[rb][0] = *(const f32x4*)(abase[rb] + 32); ar1[rb][1] = *(const f32x4*)(abase[rb] + 36); }
#pragma unroll
    for (int q = 0; q < 4; ++q) { wr0[q] = *(const v4u*)(wsrc + 8 * q); wr1[q] = *(const v4u*)(wsrc + 32 + 8 * q); }
    __syncthreads();
#pragma unroll
    for (int q = 0; q < 4; ++q) *(LAS v4u*)(lds + wdst + 16 * q) = wr0[q];
#pragma unroll
    for (int q = 0; q < 4; ++q) wr0[q] = *(const v4u*)(wsrc + 64 + 8 * q);
    __syncthreads();
#define SC_STEP(KS, AR, WN) do { \
        bfx8 af[2]; \
        _Pragma("unroll") for (int rb = 0; rb < 2; ++rb) { const float v_[8] = {AR[rb][0].x, AR[rb][0].y, AR[rb][0].z, AR[rb][0].w, AR[rb][1].x, AR[rb][1].y, AR[rb][1].z, AR[rb][1].w}; \
            af[rb] = __builtin_bit_cast(bfx8, pack8(v_)); } \
        if ((KS) + 2 < 32) { const int o_ = (((KS) + 2) >> 1) * 512 + (((KS) + 2) & 1) * 32; \
            _Pragma("unroll") for (int rb = 0; rb < 2; ++rb) { AR[rb][0] = *(const f32x4*)(abase[rb] + o_); AR[rb][1] = *(const f32x4*)(abase[rb] + o_ + 4); } } \
        asm volatile("" ::: "memory"); \
        const LAS unsigned char* bb = lds + ((KS) & 1) * SC_BBUF + (kv * 256 + r16) * SC_BP + G * 16; \
        bfx8 bq[2][4]; \
        _Pragma("unroll") for (int i = 0; i < 4; ++i) bq[0][i] = *(const LAS bfx8*)(bb + i * 16 * SC_BP); \
        _Pragma("unroll") for (int q4 = 0; q4 < 4; ++q4) { \
            if (q4 < 3) { _Pragma("unroll") for (int i = 0; i < 4; ++i) bq[(q4 + 1) & 1][i] = *(const LAS bfx8*)(bb + (4 * (q4 + 1) + i) * 16 * SC_BP); } \
            _Pragma("unroll") for (int i = 0; i < 4; ++i) { const int cb = 4 * q4 + i; \
                acc[0][cb] = __builtin_amdgcn_mfma_f32_16x16x32_bf16(bq[q4 & 1][i], af[0], acc[0][cb], 0, 0, 0); \
                acc[1][cb] = __builtin_amdgcn_mfma_f32_16x16x32_bf16(bq[q4 & 1][i], af[1], acc[1][cb], 0, 0, 0); } } \
        asm volatile("" ::: "memory"); \
        if ((KS) + 1 < 32) { LAS unsigned char* d_ = lds + (((KS) + 1) & 1) * SC_BBUF + wdst; _Pragma("unroll") for (int q = 0; q < 4; ++q) *(LAS v4u*)(d_ + 16 * q) = WN[q]; } \
        if ((KS) + 3 < 32) { _Pragma("unroll") for (int q = 0; q < 4; ++q) WN[q] = *(const v4u*)(wsrc + ((KS) + 3) * 32 + 8 * q); } \
        __syncthreads(); } while (0)
#pragma unroll 1
    for (int ks = 0; ks < 32; ks += 2) { SC_STEP(ks, ar0, wr1); SC_STEP(ks + 1, ar1, wr0); }
#undef SC_STEP
#pragma unroll
    for (int rb = 0; rb < 2; ++rb) { bf16* crow = c.CCMP() + ((size_t)kv * CM_ROWS + r0 + 16 * rb + r16) * 256 + 4 * G;
#pragma unroll
        for (int cb = 0; cb < 16; ++cb) *(GAS unsigned long long*)(crow + 16 * cb) =
            (unsigned long long)pg8::cvt_pk_bf16(acc[rb][cb][0], acc[rb][cb][1]) | ((unsigned long long)pg8::cvt_pk_bf16(acc[rb][cb][2], acc[rb][cb][3]) << 32); }
}
__device__ __forceinline__ void scmp_phase(const Ctx& c) { for (int tile = c.bid; tile < 512; tile += c.G) scmp_tile(c, tile); }

__device__ __forceinline__ void compress_step2(const Ctx& c) {
    typedef short bfx8 __attribute__((ext_vector_type(8)));
    constexpr int NT_S = SB * NKV * 32, NT_P = NB * NKV * 16, NTASK = 2 * (NT_S + NT_P);
    const int gw = c.bid * NWAVES + c.wave, NGW = c.G * NWAVES, r16 = c.lane & 15, G = c.lane >> 4;
    for (int w = gw; w < NTASK; w += NGW) {
        const int kv = w / (NT_S + NT_P), w2 = w % (NT_S + NT_P); const bool smp = w2 < NT_S;
        const int bgi = smp ? (w2 >> 5) : ((w2 - NT_S) >> 4), it = smp ? (w2 & 31) : ((w2 - NT_S) & 15);
        const int nper = smp ? 512 : 256, ncs = smp ? NCS_S : NCS_P;
        const int ci = it * 16 + r16, cic = ci < ncs ? ci : ncs - 1;
        const size_t rowA = (size_t)kv * CM_ROWS + (smp ? 0 : CM_S) + (size_t)bgi * nper + cic;
        const bf16* ca = c.CCMP() + rowA * 256; const bf16* cb = ca + 256 + 128;
        f32x4 acc[4];
#pragma unroll
        for (int ob = 0; ob < 4; ++ob) acc[ob] = (f32x4){0.f, 0.f, 0.f, 0.f};
#pragma unroll
        for (int ks = 0; ks < 4; ++ks) {
            float a[8], b[8], bi[8]; ld8(ca + 32 * ks + 8 * G, a); ld8(cb + 32 * ks + 8 * G, b); ld8(c.BIASC() + kv * 128 + 32 * ks + 8 * G, bi);
            float h[8];
#pragma unroll
            for (int j = 0; j < 8; ++j) h[j] = gelu_tanh(a[j] + b[j] + bi[j]);
            const bfx8 hf = __builtin_bit_cast(bfx8, pack8(h));
#pragma unroll
            for (int ob = 0; ob < 4; ++ob) { const bfx8 wf = *(const bfx8*)(c.W2T() + ((size_t)kv * HD + 16 * ob + r16) * 128 + 32 * ks + 8 * G);
                acc[ob] = __builtin_amdgcn_mfma_f32_16x16x32_bf16(wf, hf, acc[ob], 0, 0, 0); }
        }
        if (PROBE_CMP && ci < ncs) {
            float num = 0.f, den = 0.f;
#pragma unroll
            for (int ob = 0; ob < 4; ++ob)
#pragma unroll
                for (int i = 0; i < 4; ++i) { const int o = 16 * ob + 4 * G + i;
                    const float r = smp ? c.KCCS()[((size_t)((kv * SB * NKV + bgi)) * NCP_S + ci) * HD + o] : c.KCC()[((size_t)((kv * NB * NKV + bgi)) * NCP_P + ci) * HD + o];
                    num += (acc[ob][i] - r) * (acc[ob][i] - r); den += r * r; }
            atomicAdd(c.CHK + (smp ? 0 : 2) + 32, num); atomicAdd(c.CHK + (smp ? 1 : 3) + 32, den);
        }
        if (ci < ncs) {
            if (smp && (NAIVE_SATT || PROBE_SATT || PROBE_CMP)) {
#pragma unroll
                for (int ob = 0; ob < 4; ++ob)
#pragma unroll
                    for (int i = 0; i < 4; ++i) c.KCCS()[((size_t)((kv * SB * NKV + bgi)) * NCP_S + ci) * HD + 16 * ob + 4 * G + i] = acc[ob][i];
            }
            if (PROBE_ATT && !smp) {
#pragma unroll
                for (int ob = 0; ob < 4; ++ob)
#pragma unroll
                    for (int i = 0; i < 4; ++i) c.KCC()[((size_t)((kv * NB * NKV + bgi)) * NCP_P + ci) * HD + 16 * ob + 4 * G + i] = acc[ob][i];
            }
            bf16* kout = smp ? c.KCCSB() : c.KCCB(); bf16* vout = smp ? c.VCCST() : c.VCCT();
            if (kv == 0) {
#pragma unroll
                for (int ob = 0; ob < 4; ++ob) *(GAS unsigned long long*)(kout + ((size_t)bgi * nper + ci) * HD + 16 * ob + 4 * G) =
                    (unsigned long long)pg8::cvt_pk_bf16(acc[ob][0], acc[ob][1]) | ((unsigned long long)pg8::cvt_pk_bf16(acc[ob][2], acc[ob][3]) << 32);
            } else {
#pragma unroll
                for (int ob = 0; ob < 4; ++ob)
#pragma unroll
                    for (int i = 0; i < 4; ++i) vout[((size_t)bgi * HD + 16 * ob + 4 * G + i) * nper + ci] = (bf16)f2bf(acc[ob][i]);
            }
        }
    }
}

template <bool DUAL, class Epi> __device__ __forceinline__ void sgemm(const Ctx& c, const float* A1, const float* A2, int lda, const float* W1, const float* W2, int ldw, int K, int N, const Epi& epi) {
    const int nch = (N + NTHR - 1) / NTHR, nitems = 8 * nch;
    for (int it = c.G - 1 - c.bid; it < nitems; it += c.G) {
        const int rg = it & 7, n = (it >> 3) * NTHR + c.tid;
        if (n < N) {
            float a1[16], a2[16];
#pragma unroll
            for (int r = 0; r < 16; ++r) { a1[r] = 0.f; a2[r] = 0.f; }
            const float* ar1 = A1 + (size_t)rg * 16 * lda; const float* ar2 = A2 + (size_t)rg * 16 * lda;
            for (int k = 0; k < K; ++k) { const float w1 = W1[(size_t)k * ldw + n]; const float w2 = DUAL ? W2[(size_t)k * ldw + n] : 0.f;
#pragma unroll
                for (int r = 0; r < 16; ++r) { a1[r] += ar1[(size_t)r * lda + k] * w1; if (DUAL) a2[r] += ar2[(size_t)r * lda + k] * w2; } }
#pragma unroll
            for (int r = 0; r < 16; ++r) epi(rg * 16 + r, n, a1[r], a2[r]);
        }
    }
}

template <int NACC, class Epi> __device__ __forceinline__ void sgemm_item(const Ctx& c, const float* A1, const float* A2, int lda, const bf16* B1, const bf16* B2, int K, const Epi& epi) {
    typedef short bfx8 __attribute__((ext_vector_type(8)));
    int lane_ = c.lane; asm volatile("" : "+v"(lane_));
    const int r16 = lane_ & 15, G = lane_ >> 4, wave = c.wave, ks = K / NWAVES, k0 = wave * ks;
    f32x4 acc[NACC][8];
#pragma unroll
    for (int a = 0; a < NACC; ++a)
#pragma unroll
        for (int rb = 0; rb < 8; ++rb) acc[a][rb] = (f32x4){0.f, 0.f, 0.f, 0.f};
    for (int kk = 0; kk < ks; kk += 32) {
        const int k = k0 + kk + 8 * G;
#pragma unroll
        for (int a = 0; a < NACC; ++a) {
            const bfx8 bf = *(const bfx8*)((a == 0 ? B1 : B2) + (size_t)r16 * K + k);
            const float* Ap = (a == 0 ? A1 : A2) + (size_t)r16 * lda + k;
#pragma unroll
            for (int rb = 0; rb < 8; ++rb) { float v[8]; ld8(Ap + (size_t)rb * 16 * lda, v); const bfx8 af = __builtin_bit_cast(bfx8, pack8(v));
                acc[a][rb] = __builtin_amdgcn_mfma_f32_16x16x32_bf16(af, bf, acc[a][rb], 0, 0, 0); }
        }
    }
    LAS float* L = (LAS float*)c.lds;
    __syncthreads();
#pragma unroll
    for (int a = 0; a < NACC; ++a)
#pragma unroll
        for (int rb = 0; rb < 8; ++rb)
#pragma unroll
            for (int i = 0; i < 4; ++i) L[(wave * NACC + a) * 2048 + (16 * rb + 4 * G + i) * 16 + r16] = acc[a][rb][i];
    __syncthreads();
    { const int e0 = c.tid * 4; f32x4 s[NACC];
#pragma unroll
      for (int a = 0; a < NACC; ++a) { s[a] = (f32x4){0.f, 0.f, 0.f, 0.f};
#pragma unroll
          for (int w = 0; w < NWAVES; ++w) s[a] = s[a] + *(const LAS f32x4*)(L + (w * NACC + a) * 2048 + e0); }
#pragma unroll
      for (int i = 0; i < 4; ++i) epi((e0 + i) >> 4, (e0 + i) & 15, s[0][i], NACC > 1 ? s[NACC - 1][i] : 0.f); }
}

__device__ __forceinline__ void p3_conv_prompt(const Ctx& c) {
    const int gt = gtid(c), NGT_ = c.G * NTHR;
    for (int it = gt; it < M * (D / 8); it += NGT_) {
        const int row = it >> 7, ch = (it & 127) * 8, tt = row & (T - 1);
        float u0[8], u1[8], u2[8], bg[8];
        ld8(c.U() + (size_t)row * D + ch, u0); ld8(c.BG() + (size_t)row * D + ch, bg);
        if (tt >= 1) ld8(c.U() + (size_t)(row - 1) * D + ch, u1); else { for (int j = 0; j < 8; ++j) u1[j] = 0.f; }
        if (tt >= 2) ld8(c.U() + (size_t)(row - 2) * D + ch, u2); else { for (int j = 0; j < 8; ++j) u2[j] = 0.f; }
        float w0[8], w1[8], w2[8], bb[8]; ld8(c.w_conv() + ch, w0); ld8(c.w_conv() + D + ch, w1); ld8(c.w_conv() + 2 * D + ch, w2); ld8(c.b_conv() + ch, bb);
        float v[8];
#pragma unroll
        for (int j = 0; j < 8; ++j) v[j] = bg[j] * (bb[j] + w0[j] * u2[j] + w1[j] * u1[j] + w2[j] * u0[j]);
        *(GAS v4u*)(c.AA() + (size_t)row * D + ch) = pack8(v);
    }
}
__device__ __forceinline__ void p3_sample_thin(const Ctx& c) {
    const int gt = gtid(c), NGT_ = c.G * NTHR;
    for (int it = gt; it < MS * D; it += NGT_) {
        const int row = it >> 10, ch = it & 1023, b = row >> 2, s = row & 3;
        float up[3];
#pragma unroll
        for (int k = 0; k < 3; ++k) { const int ss = s - 2 + k; up[k] = (ss >= 0) ? c.ZS()[(size_t)(b * SS + ss) * NIN + 1024 + ch] * c.ZS()[(size_t)(b * SS + ss) * NIN + 2048 + ch] : c.state_conv()[(size_t)(b * 2 + (ss + 2)) * D + ch]; }
        const float v = c.b_conv()[ch] + c.w_conv()[ch] * up[0] + c.w_conv()[D + ch] * up[1] + c.w_conv()[2 * D + ch] * up[2];
        c.AAS()[(size_t)row * D + ch] = c.ZS()[(size_t)row * NIN + ch] * v;
        if (s >= 2) c.out()[O_CONV_S + (size_t)(b * 2 + (s - 2)) * D + ch] = up[2];
    }
    for (int it = gt; it < MS * 512; it += NGT_) { const int row = it >> 9, cc = it & 511;
        c.out()[O_CMP_S + (size_t)row * 512 + cc] = c.ZS()[(size_t)row * NIN + 4096 + cc]; c.out()[O_SEL_S + (size_t)row * 512 + cc] = c.ZS()[(size_t)row * NIN + 4608 + cc]; }
    for (int it = gt; it < SB * 512 * 128; it += NGT_) { const int cc = (it & 127) * 4, j = (it >> 7) & 511, b = it >> 16;
        f32x4 v;
        if (j + SS < 512) v = *(const f32x4*)(c.cache_win() + ((size_t)(b * 512 + j + SS)) * 512 + cc);
        else v = *(const f32x4*)(c.ZS() + (size_t)(b * SS + (j + SS - 512)) * NIN + 5120 + cc);
        *(GAS f32x4*)(c.out() + O_WIN_S + ((size_t)(b * 512 + j)) * 512 + cc) = v; }
}
struct CmpP { static constexpr int NB_ = NB, NCS = NCS_P, NCP = NCP_P, NGRP = 16;
    __device__ static __forceinline__ float x(const Ctx& c, int kv, int b, int g, int pos, int d) { return bf2f(c.ACMP()[((size_t)kv * CM_ROWS + CM_S) * 1024 + ((size_t)((b * NKV + g) * T + pos)) * HD + d]); }
    __device__ static __forceinline__ void store(const Ctx& c, int kv, int b, int g, int i, int o, float s) {
        c.KCC()[((size_t)((kv * NB + b) * NKV + g) * NCP_P + i) * HD + o] = s; } };
struct CmpS { static constexpr int NB_ = SB, NCS = NCS_S, NCP = NCP_S, NGRP = 32;
    __device__ static __forceinline__ float x(const Ctx& c, int kv, int b, int g, int pos, int d) { return c.cache_cmp()[((size_t)c.pt()[b * NPG + (pos >> 7)] * PAGE + (pos & 127)) * 512 + kv * 256 + g * HD + d]; }
    __device__ static __forceinline__ void store(const Ctx& c, int kv, int b, int g, int i, int o, float s) { c.KCCS()[((size_t)((kv * SB + b) * NKV + g) * NCP_S + i) * HD + o] = s; } };
template <class S> __device__ __forceinline__ void compress_naive(const Ctx& c) {
    constexpr int NITEMS = 2 * S::NB_ * NKV * S::NGRP;
    LAS float* hid = (LAS float*)c.lds;
    const int n = c.tid & 127, rq = c.tid >> 7;
    for (int it = c.bid; it < NITEMS; it += c.G) {
        const int ig = it % S::NGRP, g = (it / S::NGRP) % NKV, b = (it / (S::NGRP * NKV)) % S::NB_, kv = it / (S::NGRP * NKV * S::NB_);
        const int i0 = ig * 16 + 4 * rq;
        float acc[4] = {0.f, 0.f, 0.f, 0.f};
        for (int t = 0; t < 32; ++t) {
            for (int d = 0; d < HD; ++d) {
                const int k = t * HD + d; const float w = c.w_phi1()[((size_t)kv * 2048 + k) * 128 + n], pe = c.pe()[kv * 2048 + k];
#pragma unroll
                for (int r = 0; r < 4; ++r) { int i = i0 + r; i = i < S::NCS ? i : S::NCS - 1; acc[r] += (S::x(c, kv, b, g, 16 * i + t, d) + pe) * w; }
            }
        }
        __syncthreads();
#pragma unroll
        for (int r = 0; r < 4; ++r) hid[(4 * rq + r) * 128 + n] = gelu_tanh(acc[r]);
        __syncthreads();
        const int o = c.tid & 63;
#pragma unroll
        for (int rr = 0; rr < 2; ++rr) { const int r = (c.tid >> 6) + 8 * rr, i = ig * 16 + r; float s = 0.f;
            for (int k = 0; k < 128; ++k) s += hid[r * 128 + k] * c.w_phi2()[((size_t)kv * 128 + k) * HD + o];
            if (i < S::NCS) S::store(c, kv, b, g, i, o, s); }
    }
    __syncthreads();
}

struct AtP {
    static constexpr int NQ = T, QBASE = 0, NS = 64, NSP = 64, NSL = 1, NBAT = NB, NCP = NCP_P;
    typedef bf16 KT;
    __device__ static __forceinline__ void decode(int idx, int& b, int& h, int& qi) { qi = idx & (T - 1); h = (idx >> 12) & 15; b = idx >> 16; }
    __device__ static __forceinline__ void load_q(const Ctx& c, int b, int h, int qi, float (&q)[64]) { const bf16* p = c.Q() + (size_t)(b * T + qi) * D + h * HD;
#pragma unroll
        for (int cc = 0; cc < 8; ++cc) { float v[8]; ld8(p + 8 * cc, v);
#pragma unroll
            for (int j = 0; j < 8; ++j) q[8 * cc + j] = v[j] * 0.6931471805599453f; } }
    __device__ static __forceinline__ float gate(const Ctx& c, int b, int h, int qi, int j) { return c.NGT()[(size_t)(b * T + qi) * 48 + h * 3 + j]; }
    __device__ static __forceinline__ const float* kcc(const Ctx& c, int kv, int b, int g, int ci) { return c.KCC() + ((size_t)((kv * NB + b) * NKV + g) * NCP_P + ci) * HD; }
    __device__ static __forceinline__ const KT* ksel(const Ctx& c, int kv, int b, int g, int pos) { return c.HM() + (size_t)(2 + kv) * HMSZ + ((size_t)((b * NKV + g) * T + pos)) * HD; }
    __device__ static __forceinline__ const KT* kwin(const Ctx& c, int kv, int b, int g, int pos) { return c.HM() + (size_t)(4 + kv) * HMSZ + ((size_t)((b * NKV + g) * T + pos)) * HD; }
    __device__ static __forceinline__ float* scoreh(const Ctx& c) { return c.SCOREH(); }
    __device__ static __forceinline__ unsigned long long* mask(const Ctx& c) { return c.MASK(); }
    __device__ static __forceinline__ void store_o(const Ctx& c, int b, int h, int qi, const float (&o)[64]) { bf16* p = c.OB + (size_t)(b * T + qi) * D + h * HD;
#pragma unroll
        for (int cc = 0; cc < 8; ++cc) { float v[8];
#pragma unroll
            for (int j = 0; j < 8; ++j) v[j] = o[8 * cc + j];
            *(GAS v4u*)(p + 8 * cc) = pack8(v); } }
};
struct AtS {
    static constexpr int NQ = SS, QBASE = PAST, NS = 129, NSP = 192, NSL = 3, NBAT = SB, NCP = NCP_S;
    typedef float KT;
    __device__ static __forceinline__ void decode(int idx, int& b, int& h, int& qi) { qi = idx & 3; h = (idx >> 2) & 15; b = idx >> 6; }
    __device__ static __forceinline__ void load_q(const Ctx& c, int b, int h, int qi, float (&q)[64]) { const float* p = c.ZS() + (size_t)(b * SS + qi) * NIN + 3072 + h * HD;
#pragma unroll
        for (int j = 0; j < 64; ++j) q[j] = p[j] * 0.125f; }
    __device__ static __forceinline__ float gate(const Ctx& c, int b, int h, int qi, int j) { return sigmoidf_(c.ZS()[(size_t)(b * SS + qi) * NIN + 5632 + h * 3 + j]); }
    __device__ static __forceinline__ const float* kcc(const Ctx& c, int kv, int b, int g, int ci) { return c.KCCS() + ((size_t)((kv * SB + b) * NKV + g) * NCP_S + ci) * HD; }
    __device__ static __forceinline__ const KT* ksel(const Ctx& c, int kv, int b, int g, int pos) {
        if (pos < PAST) return c.cache_sel() + ((size_t)c.pt()[b * NPG + (pos >> 7)] * PAGE + (pos & 127)) * 512 + kv * 256 + g * HD;
        return c.ZS() + (size_t)(b * SS + (pos - PAST)) * NIN + 4608 + kv * 256 + g * HD; }
    __device__ static __forceinline__ const KT* kwin(const Ctx& c, int kv, int b, int g, int pos) {
        if (pos < PAST) return c.cache_win() + ((size_t)(b * 512 + (pos - (PAST - 512)))) * 512 + kv * 256 + g * HD;
        return c.ZS() + (size_t)(b * SS + (pos - PAST)) * NIN + 5120 + kv * 256 + g * HD; }
    __device__ static __forceinline__ float* scoreh(const Ctx& c) { return c.SCOREHS(); }
    __device__ static __forceinline__ unsigned long long* mask(const Ctx& c) { return c.MASKS(); }
    __device__ static __forceinline__ void store_o(const Ctx& c, int b, int h, int qi, const float (&o)[64]) { float* p = c.OBS() + (size_t)(b * SS + qi) * D + h * HD;
#pragma unroll
        for (int j = 0; j < 64; ++j) p[j] = o[j]; }
};
__device__ __forceinline__ int wave_max_i(int v) {
#pragma unroll
    for (int o = 1; o < 64; o <<= 1) { const int t = __shfl_xor(v, o); v = t > v ? t : v; }
    return v;
}
__device__ __forceinline__ int wave_min_i(int v) {
#pragma unroll
    for (int o = 1; o < 64; o <<= 1) { const int t = __shfl_xor(v, o); v = t < v ? t : v; }
    return v;
}
template <class S> __device__ __forceinline__ void p4a_scores(const Ctx& c) {
    constexpr int NW = S::NBAT * H * S::NQ / 64;
    const int gw = c.bid * NWAVES + c.wave, NGW = c.G * NWAVES;
    for (int w = gw; w < NW; w += NGW) {
        const int idx = w * 64 + c.lane; int b, h, qi; S::decode(idx, b, h, qi);
        const int g = h >> 2, qpos = S::QBASE + qi; const float tq = (float)qpos, slope = exp2f(-0.5f * (float)(h + 1));
        float q[64]; S::load_q(c, b, h, qi, q);
        const int ncv = qpos >= 31 ? ((qpos - 31) >> 4) + 1 : 0, ncm = wave_max_i(ncv);
        float m = NEGF;
        for (int ci = 0; ci < ncm; ++ci) { const int cc = ci < ncv ? ci : 0; const float s = dot64(S::kcc(c, 0, b, g, cc), q) - slope * (tq - 16.f * ci - 15.5f); if (ci < ncv) m = fmaxf(m, s); }
        float l = 0.f;
        for (int ci = 0; ci < ncm; ++ci) { const int cc = ci < ncv ? ci : 0; const float s = dot64(S::kcc(c, 0, b, g, cc), q) - slope * (tq - 16.f * ci - 15.5f); if (ci < ncv) l += __expf(s - m); }
        const float il = l > 0.f ? 1.f / l : 0.f;
        float carry = 0.f; float* sp = S::scoreh(c) + (size_t)idx * S::NSP;
        const int nsm = (ncm + 3) >> 2;
        for (int s4 = 0; s4 < S::NS; ++s4) {
            float a = carry;
            if (s4 < nsm + 1) {
#pragma unroll 1
                for (int j = 0; j < 4; ++j) { const int ci = 4 * s4 + j; float p = 0.f;
                    if (ci < ncm) { const int cc = ci < ncv ? ci : 0; const float s = dot64(S::kcc(c, 0, b, g, cc), q) - slope * (tq - 16.f * ci - 15.5f); p = ci < ncv ? __expf(s - m) * il : 0.f; }
                    a += p; if (j == 3) carry = p; }
            } else carry = 0.f;
            sp[s4] = a;
        }
    }
}
template <class S> __device__ __forceinline__ void p4b_topk(const Ctx& c) {
    constexpr int NW = S::NBAT * NKV * S::NQ;
    const int gw = c.bid * NWAVES + c.wave, NGW = c.G * NWAVES;
    for (int w = gw; w < NW; w += NGW) {
        const int qi = w % S::NQ, g = (w / S::NQ) % NKV, b = w / (S::NQ * NKV);
        const int qpos = S::QBASE + qi, cur = qpos >> 6;
        float val[S::NSL];
#pragma unroll
        for (int j = 0; j < S::NSL; ++j) { const int s = c.lane + 64 * j; float v = -INFINITY;
            if (s < S::NS) { float imp = 0.f;
#pragma unroll
                for (int r = 0; r < 4; ++r) imp += S::scoreh(c)[((size_t)((b * H + 4 * g + r) * S::NQ + qi)) * S::NSP + s];
                const bool valid = 64 * s <= qpos, forced = (s == 0) || (s == cur) || (s == cur - 1);
                v = valid ? imp + (forced ? 1000.f : 0.f) : NEGF; }
            val[j] = v; }
        int rank[S::NSL];
#pragma unroll
        for (int j = 0; j < S::NSL; ++j) rank[j] = 0;
#pragma unroll
        for (int j2 = 0; j2 < S::NSL; ++j2)
            for (int l2 = 0; l2 < 64; ++l2) { const float v2 = __shfl(val[j2], l2); const int s2 = l2 + 64 * j2;
#pragma unroll
                for (int j = 0; j < S::NSL; ++j) { const int s = c.lane + 64 * j; rank[j] += (v2 > val[j] || (v2 == val[j] && s2 < s)) ? 1 : 0; } }
#pragma unroll
        for (int j = 0; j < S::NSL; ++j) { const int s = c.lane + 64 * j; const unsigned long long mk = __ballot(rank[j] < 16 && s < S::NS);
            if (c.lane == 0) S::mask(c)[(size_t)w * S::NSL + j] = mk; }
    }
}
#define ONLINE_UPD(sv, vrow, ok) do { if (ok) { if ((sv) > m) { const float al = __expf(m - (sv)); l *= al; _Pragma("unroll") for (int d_ = 0; d_ < 64; ++d_) o[d_] *= al; m = (sv); } \
        const float p_ = __expf((sv) - m); l += p_; axpy64((vrow), p_, o); } } while (0)
template <class S> __device__ __forceinline__ void p4c_attend(const Ctx& c, int mode = -1) {
    constexpr int NW = S::NBAT * H * S::NQ / 64;
    const int gw = c.bid * NWAVES + c.wave, NGW = c.G * NWAVES;
    for (int w = gw; w < NW; w += NGW) {
        const int idx = w * 64 + c.lane; int b, h, qi; S::decode(idx, b, h, qi);
        const int g = h >> 2, qpos = S::QBASE + qi, cur = qpos >> 6; const float tq = (float)qpos, slope = exp2f(-0.5f * (float)(h + 1));
        float q[64]; S::load_q(c, b, h, qi, q);
        LAS float* ot = (LAS float*)c.lds + c.tid;
#pragma unroll
        for (int d = 0; d < 64; ++d) ot[d * NTHR] = 0.f;
        float o[64]; float m, l;
        {
#pragma unroll
            for (int d = 0; d < 64; ++d) o[d] = 0.f;
            m = NEGF; l = 0.f;
            const int ncv = qpos >= 31 ? ((qpos - 31) >> 4) + 1 : 0, ncm = wave_max_i(ncv);
            for (int ci = 0; ci < ncm; ++ci) { const bool ok = ci < ncv; const int cc = ok ? ci : 0;
                const float s = dot64(S::kcc(c, 0, b, g, cc), q) - slope * (tq - 16.f * ci - 15.5f);
                ONLINE_UPD(s, S::kcc(c, 1, b, g, cc), ok); }
            if (l > 0.f) { const float f = ((mode < 0 || mode == 0) ? S::gate(c, b, h, qi, 0) : 0.f) / l;
#pragma unroll
                for (int d = 0; d < 64; ++d) ot[d * NTHR] += f * o[d]; }
        }
        {
#pragma unroll
            for (int d = 0; d < 64; ++d) o[d] = 0.f;
            m = NEGF; l = 0.f;
            unsigned long long mk[S::NSL];
#pragma unroll
            for (int j = 0; j < S::NSL; ++j) mk[j] = S::mask(c)[((size_t)((b * NKV + g) * S::NQ + qi)) * S::NSL + j];
            const int curm = wave_max_i(cur);
            for (int s = 0; s <= curm; ++s) {
                unsigned long long word = mk[0];
#pragma unroll
                for (int j = 1; j < S::NSL; ++j) if ((s >> 6) == j) word = mk[j];
                const bool sel = (s <= cur) && ((word >> (s & 63)) & 1ull);
                if (!__any(sel)) continue;
                for (int k = 0; k < 64; ++k) { const int pos = 64 * s + k; const bool ok = sel && pos <= qpos; const int pc = pos <= qpos ? pos : qpos;
                    if (!__any(ok)) continue;
                    const float sv = dot64(S::ksel(c, 0, b, g, pc), q) - slope * (tq - (float)pos);
                    ONLINE_UPD(sv, S::ksel(c, 1, b, g, pc), ok); }
            }
            if (l > 0.f) { const float f = ((mode < 0 || mode == 1) ? S::gate(c, b, h, qi, 1) : 0.f) / l;
#pragma unroll
                for (int d = 0; d < 64; ++d) ot[d * NTHR] += f * o[d]; }
        }
        {
#pragma unroll
            for (int d = 0; d < 64; ++d) o[d] = 0.f;
            m = NEGF; l = 0.f;
            const int lo = qpos - 511 > 0 ? qpos - 511 : 0; const int lom = wave_min_i(lo), him = wave_max_i(qpos);
            for (int kp = lom; kp <= him; ++kp) { const bool ok = kp >= lo && kp <= qpos; int pc = kp < lo ? lo : kp; pc = pc > qpos ? qpos : pc;
                if (S::QBASE > 0 && pc < PAST - 512) pc = PAST - 512;
                const float sv = dot64(S::kwin(c, 0, b, g, pc), q) - slope * (tq - (float)kp);
                ONLINE_UPD(sv, S::kwin(c, 1, b, g, pc), ok); }
            if (l > 0.f) { const float f = ((mode < 0 || mode == 2) ? S::gate(c, b, h, qi, 2) : 0.f) / l;
#pragma unroll
                for (int d = 0; d < 64; ++d) ot[d * NTHR] += f * o[d]; }
        }
#pragma unroll
        for (int d = 0; d < 64; ++d) o[d] = ot[d * NTHR];
        S::store_o(c, b, h, qi, o);
    }
}

namespace at {
typedef short bfx8 __attribute__((ext_vector_type(8)));
constexpr float LOG2E = 1.4426950408889634f;
constexpr float QSCALE = 0.125f * LOG2E;
constexpr int IMP_PITCH = 68;
__device__ __forceinline__ f32x4 mfma16(bfx8 a, bfx8 b, f32x4 c) { return __builtin_amdgcn_mfma_f32_16x16x32_bf16(a, b, c, 0, 0, 0); }
__device__ __forceinline__ void ce_desc(float& a, float& b) { const float hi = fmaxf(a, b), lo = fminf(a, b); a = hi; b = lo; }
__device__ __forceinline__ void sort16_desc(float (&v)[16]) {
#pragma unroll
    for (int k = 2; k <= 16; k <<= 1)
#pragma unroll
        for (int j = k >> 1; j > 0; j >>= 1)
#pragma unroll
            for (int i = 0; i < 16; ++i) { const int l = i ^ j; if (l > i) { if ((i & k) == 0) ce_desc(v[i], v[l]); else ce_desc(v[l], v[i]); } }
}
__device__ __forceinline__ void merge16_desc(float (&v)[16]) {
#pragma unroll
    for (int j = 8; j > 0; j >>= 1)
#pragma unroll
        for (int i = 0; i < 16; ++i) { const int l = i ^ j; if (l > i) ce_desc(v[i], v[l]); }
}
struct Tile {
    bfx8 qf[4][2]; float slope2[4]; f32x4 ot[4][4]; float m[4], l[4];
    int lane, ql, G, qpos;
};
__device__ __forceinline__ void qk_chunk(const Tile& t, const bf16* kb, f32x4 (&sa)[4], f32x4 (&sb)[4]) {
    const int r16 = t.ql; const bf16* ka = kb + (8 * (r16 >> 2) + (r16 & 3)) * 64 + 8 * t.G;
    const bfx8 a0 = *(const bfx8*)ka, a1 = *(const bfx8*)(ka + 32), b0 = *(const bfx8*)(ka + 256), b1 = *(const bfx8*)(ka + 256 + 32);
#pragma unroll
    for (int r = 0; r < 4; ++r) {
        f32x4 z = {0.f, 0.f, 0.f, 0.f};
        sa[r] = mfma16(a0, t.qf[r][0], z); sa[r] = mfma16(a1, t.qf[r][1], sa[r]);
        sb[r] = mfma16(b0, t.qf[r][0], z); sb[r] = mfma16(b1, t.qf[r][1], sb[r]);
    }
}
__device__ __forceinline__ void pv_chunk(Tile& t, const bf16* vtb, int pitch, const bfx8 (&pf)[4]) {
#pragma unroll
    for (int db = 0; db < 4; ++db) { const bfx8 vf = *(const bfx8*)(vtb + (size_t)(16 * db + t.ql) * pitch + 8 * t.G);
#pragma unroll
        for (int r = 0; r < 4; ++r) t.ot[r][db] = mfma16(vf, pf[r], t.ot[r][db]); }
}
__device__ __forceinline__ float gmax4(float v) {
    auto a = __builtin_amdgcn_permlane16_swap(__float_as_uint(v), __float_as_uint(v), false, false); v = fmaxf(__uint_as_float(a[0]), __uint_as_float(a[1]));
    auto b = __builtin_amdgcn_permlane32_swap(__float_as_uint(v), __float_as_uint(v), false, false); return fmaxf(__uint_as_float(b[0]), __uint_as_float(b[1])); }
__device__ __forceinline__ float gsum4(float v) {
    auto a = __builtin_amdgcn_permlane16_swap(__float_as_uint(v), __float_as_uint(v), false, false); v = __uint_as_float(a[0]) + __uint_as_float(a[1]);
    auto b = __builtin_amdgcn_permlane32_swap(__float_as_uint(v), __float_as_uint(v), false, false); return __uint_as_float(b[0]) + __uint_as_float(b[1]); }
__device__ __forceinline__ bfx8 pack_p(const float (&p)[8]) {
    v4u w; w.x = pg8::cvt_pk_bf16(p[0], p[1]); w.y = pg8::cvt_pk_bf16(p[2], p[3]); w.z = pg8::cvt_pk_bf16(p[4], p[5]); w.w = pg8::cvt_pk_bf16(p[6], p[7]);
    return __builtin_bit_cast(bfx8, w);
}
__device__ __forceinline__ void softmax_online(Tile& t, const f32x4 (&sa)[4], const f32x4 (&sb)[4], const float (&tk)[8], const bool (&ok)[8], bfx8 (&pf)[4]) {
#pragma unroll
    for (int r = 0; r < 4; ++r) {
        float s[8];
#pragma unroll
        for (int j = 0; j < 4; ++j) { s[j] = ok[j] ? __builtin_fmaf(t.slope2[r], tk[j], sa[r][j]) : -INFINITY; s[4 + j] = ok[4 + j] ? __builtin_fmaf(t.slope2[r], tk[4 + j], sb[r][j]) : -INFINITY; }
        float pm = fmaxf(fmaxf(fmaxf(s[0], s[1]), fmaxf(s[2], s[3])), fmaxf(fmaxf(s[4], s[5]), fmaxf(s[6], s[7])));
        pm = gmax4(pm);
        if (__any(pm > t.m[r])) {
            const float mn = fmaxf(t.m[r], pm), al = __builtin_amdgcn_exp2f(t.m[r] - mn);
            t.m[r] = mn; t.l[r] *= al;
#pragma unroll
            for (int db = 0; db < 4; ++db) t.ot[r][db] = t.ot[r][db] * al;
        }
        float p[8]; float ps = 0.f;
#pragma unroll
        for (int j = 0; j < 8; ++j) { p[j] = __builtin_amdgcn_exp2f(s[j] - t.m[r]); ps += p[j]; }
        t.l[r] += ps;
        pf[r] = pack_p(p);
    }
}
struct Frags { bfx8 a0, a1, b0, b1, vf[4]; };
__device__ __forceinline__ void load_frags(Frags& f, const Tile& t, const bf16* kb, const bf16* vtb, int pitch) {
    const int r16 = t.ql; const bf16* ka = kb + (8 * (r16 >> 2) + (r16 & 3)) * 64 + 8 * t.G;
    f.a0 = *(const bfx8*)ka; f.a1 = *(const bfx8*)(ka + 32); f.b0 = *(const bfx8*)(ka + 256); f.b1 = *(const bfx8*)(ka + 256 + 32);
#pragma unroll
    for (int db = 0; db < 4; ++db) f.vf[db] = *(const bfx8*)(vtb + (size_t)(16 * db + t.ql) * pitch + 8 * t.G);
}
__device__ __forceinline__ void chunk_compute(Tile& t, const Frags& f, const float (&tk)[8]) {
    float s[4][8]; bool grow = false;
#pragma unroll
    for (int r = 0; r < 4; ++r) {
        const f32x4 z = {0.f, 0.f, 0.f, 0.f};
        f32x4 sa = mfma16(f.a0, t.qf[r][0], z); sa = mfma16(f.a1, t.qf[r][1], sa);
        f32x4 sb = mfma16(f.b0, t.qf[r][0], z); sb = mfma16(f.b1, t.qf[r][1], sb);
#pragma unroll
        for (int j = 0; j < 4; ++j) { s[r][j] = __builtin_fmaf(t.slope2[r], tk[j], sa[j]); s[r][4 + j] = __builtin_fmaf(t.slope2[r], tk[4 + j], sb[j]); }
        const float pm = fmaxf(fmaxf(fmaxf(s[r][0], s[r][1]), fmaxf(s[r][2], s[r][3])), fmaxf(fmaxf(s[r][4], s[r][5]), fmaxf(s[r][6], s[r][7])));
        grow = grow || (pm > t.m[r] + 8.f);
    }
    if (__any(grow)) {
#pragma unroll
        for (int r = 0; r < 4; ++r) {
            float pm = fmaxf(fmaxf(fmaxf(s[r][0], s[r][1]), fmaxf(s[r][2], s[r][3])), fmaxf(fmaxf(s[r][4], s[r][5]), fmaxf(s[r][6], s[r][7])));
            pm = gmax4(pm);
            const float mn = fmaxf(t.m[r], pm), al = __builtin_amdgcn_exp2f(t.m[r] - mn);
            t.m[r] = mn; t.l[r] *= al;
#pragma unroll
            for (int db = 0; db < 4; ++db) t.ot[r][db] = t.ot[r][db] * al;
        }
    }
#pragma unroll
    for (int r = 0; r < 4; ++r) {
        float p[8]; float ps = 0.f;
#pragma unroll
        for (int j = 0; j < 8; ++j) { p[j] = __builtin_amdgcn_exp2f(s[r][j] - t.m[r]); ps += p[j]; }
        t.l[r] += ps;
        const bfx8 pf = pack_p(p);
#pragma unroll
        for (int db = 0; db < 4; ++db) t.ot[r][db] = mfma16(f.vf[db], pf, t.ot[r][db]);
    }
}
__device__ __forceinline__ void reset_branch(Tile& t) {
#pragma unroll
    for (int r = 0; r < 4; ++r) { t.m[r] = NEGF; t.l[r] = 0.f;
#pragma unroll
        for (int db = 0; db < 4; ++db) t.ot[r][db] = (f32x4){0.f, 0.f, 0.f, 0.f}; }
}
template <bool FIRST> __device__ __forceinline__ void fold_branch(Tile& t, LAS float* otl, const float (&gate)[4]) {
#pragma unroll
    for (int r = 0; r < 4; ++r) { const float lt = gsum4(t.l[r]); const float f = lt > 0.f ? gate[r] / lt : 0.f;
#pragma unroll
        for (int db = 0; db < 4; ++db)
#pragma unroll
            for (int i = 0; i < 4; ++i) { LAS float* p = otl + ((r * 16 + db * 4 + i) * 64 + t.lane); const float v = f * t.ot[r][db][i]; *p = FIRST ? v : (*p + v); } }
}

__device__ __forceinline__ void tile_select(const Ctx& c, const Tile& t, int lane_, int b, int g, int qt, const bf16* KC, LAS float* wl, unsigned long long& m64_out, unsigned long long& U_out) {
    const int qpos = t.qpos, ql = t.ql, G = t.G;
    const int ncv = qpos >= 31 ? ((qpos - 31) >> 4) + 1 : 0;
    const int nch = (qt + 31) >> 5;
    unsigned long long m64, U;
    {
        LAS float* impA = wl; LAS float* impB = wl + 16 * IMP_PITCH;
        for (int i = lane_; i < 2 * 16 * IMP_PITCH; i += 64) wl[i] = 0.f;
        float cm[4], cl[4];
#pragma unroll
        for (int r = 0; r < 4; ++r) { cm[r] = NEGF; cl[r] = 0.f; }
        for (int ch = 0; ch < nch; ++ch) {
            f32x4 sa[4], sb[4]; qk_chunk(t, KC + (size_t)ch * 32 * HD, sa, sb);
            float tk[8];
#pragma unroll
            for (int j = 0; j < 8; ++j) { const int ci = ch * 32 + 8 * G + j; tk[j] = __builtin_fmaf(fmaxf((float)(ci - ncv + 1), 0.f), -1e36f, 16.f * (float)ci + 15.5f - (float)qpos); }
#pragma unroll
            for (int r = 0; r < 4; ++r) {
                float s[8];
#pragma unroll
                for (int j = 0; j < 4; ++j) { s[j] = __builtin_fmaf(t.slope2[r], tk[j], sa[r][j]); s[4 + j] = __builtin_fmaf(t.slope2[r], tk[4 + j], sb[r][j]); }
                float pm = fmaxf(fmaxf(fmaxf(s[0], s[1]), fmaxf(s[2], s[3])), fmaxf(fmaxf(s[4], s[5]), fmaxf(s[6], s[7])));
                pm = gmax4(pm);
                const float mn = fmaxf(cm[r], pm), al = __builtin_amdgcn_exp2f(cm[r] - mn);
                float ps = 0.f;
#pragma unroll
                for (int j = 0; j < 8; ++j) ps += __builtin_amdgcn_exp2f(s[j] - mn);
                cl[r] = cl[r] * al + ps; cm[r] = mn;
            }
        }
#pragma unroll
        for (int r = 0; r < 4; ++r) { const float lt = gsum4(cl[r]); cl[r] = lt > 0.f ? 1.f / lt : 0.f; }
        for (int ch = 0; ch < nch; ++ch) {
            f32x4 sa[4], sb[4]; qk_chunk(t, KC + (size_t)ch * 32 * HD, sa, sb);
            float tk[8];
#pragma unroll
            for (int j = 0; j < 8; ++j) { const int ci = ch * 32 + 8 * G + j; tk[j] = __builtin_fmaf(fmaxf((float)(ci - ncv + 1), 0.f), -1e36f, 16.f * (float)ci + 15.5f - (float)qpos); }
            float psum[8];
#pragma unroll
            for (int j = 0; j < 8; ++j) psum[j] = 0.f;
#pragma unroll
            for (int r = 0; r < 4; ++r) {
                float sv[8];
#pragma unroll
                for (int j = 0; j < 4; ++j) { sv[j] = __builtin_fmaf(t.slope2[r], tk[j], sa[r][j]); sv[4 + j] = __builtin_fmaf(t.slope2[r], tk[4 + j], sb[r][j]); }
#pragma unroll
                for (int j = 0; j < 8; ++j) psum[j] += __builtin_amdgcn_exp2f(sv[j] - cm[r]) * cl[r];
            }
            const int s0 = ch * 8 + 2 * G;
            impA[ql * IMP_PITCH + s0] = (psum[0] + psum[1]) + (psum[2] + psum[3]);
            impA[ql * IMP_PITCH + s0 + 1] = (psum[4] + psum[5]) + (psum[6] + psum[7]) + psum[3];
            impB[ql * IMP_PITCH + s0 + 2] = psum[7];
        }
        LDS_WAIT(); asm volatile("" ::: "memory");
        const int cur = qpos >> 6;
        float v[16], srt[16];
#pragma unroll
        for (int i4 = 0; i4 < 4; ++i4) { const f32x4 a = *(const LAS f32x4*)(impA + ql * IMP_PITCH + 16 * G + 4 * i4), bq = *(const LAS f32x4*)(impB + ql * IMP_PITCH + 16 * G + 4 * i4);
#pragma unroll
            for (int k = 0; k < 4; ++k) { const int s = 16 * G + 4 * i4 + k; const bool forced = (s == 0) || (s == cur) || (s == cur - 1);
                v[4 * i4 + k] = (s <= cur) ? (a[k] + bq[k]) + (forced ? 1000.f : 0.f) : NEGF; } }
#pragma unroll
        for (int i = 0; i < 16; ++i) srt[i] = v[i];
        if (PROBE_ATT) {
            float* sp_ = c.SCOREH() + ((size_t)(b * NKV + g) * T + qpos) * 64 + 16 * G;
#pragma unroll
            for (int i = 0; i < 4; ++i) *(GAS f32x4*)(sp_ + 4 * i) = (f32x4){v[4 * i], v[4 * i + 1], v[4 * i + 2], v[4 * i + 3]}; }
        sort16_desc(srt);
        float oth[16];
#pragma unroll
        for (int i = 0; i < 16; ++i) oth[i] = __shfl_xor(srt[i], 16);
#pragma unroll
        for (int i = 0; i < 16; ++i) srt[i] = fmaxf(srt[i], oth[15 - i]);
        merge16_desc(srt);
#pragma unroll
        for (int i = 0; i < 16; ++i) oth[i] = __shfl_xor(srt[i], 32);
        float thr = fmaxf(srt[0], oth[15]);
#pragma unroll
        for (int i = 1; i < 16; ++i) thr = fminf(thr, fmaxf(srt[i], oth[15 - i]));
        int ngt = 0, neq = 0;
#pragma unroll
        for (int i = 0; i < 16; ++i) { ngt += v[i] > thr ? 1 : 0; neq += v[i] == thr ? 1 : 0; }
        int ngt_t = ngt + __shfl_xor(ngt, 16); ngt_t += __shfl_xor(ngt_t, 32);
        const int need = 16 - ngt_t;
        int eqb = 0;
#pragma unroll
        for (int gg = 0; gg < 3; ++gg) { const int o = __shfl(neq, ql + 16 * gg); eqb += (gg < G) ? o : 0; }
        unsigned mloc = 0; int run = eqb;
#pragma unroll
        for (int i = 0; i < 16; ++i) { const int s = 16 * G + i; bool sel = v[i] > thr; if (v[i] == thr) { sel = run < need; ++run; } sel = sel && (s <= cur); mloc |= sel ? (1u << i) : 0u; }
        const unsigned w0 = __shfl(mloc, ql), w1 = __shfl(mloc, ql + 16), w2 = __shfl(mloc, ql + 32), w3 = __shfl(mloc, ql + 48);
        const unsigned lo = w0 | (w1 << 16), hi = w2 | (w3 << 16);
        m64 = ((unsigned long long)hi << 32) | lo;
        unsigned ulo = lo, uhi = hi;
#pragma unroll
        for (int o = 1; o < 16; o <<= 1) { ulo |= __shfl_xor(ulo, o); uhi |= __shfl_xor(uhi, o); }
        U = ((unsigned long long)(unsigned)__builtin_amdgcn_readfirstlane(uhi) << 32) | (unsigned)__builtin_amdgcn_readfirstlane(ulo);
        if (PROBE_ATT && G == 0) c.MASKM()[(size_t)(b * NKV + g) * T + qpos] = m64;
    }
    m64_out = m64; U_out = U;
}

__device__ __forceinline__ void attn_tile(const Ctx& c, int b, int g, int qt, LAS float* wl, int mode = -1) {
    int lane_ = c.lane; asm volatile("" : "+v"(lane_));
    Tile t; t.lane = lane_; t.ql = lane_ & 15; t.G = lane_ >> 4;
    const int q0 = qt * 16; t.qpos = q0 + t.ql;
    const int qpos = t.qpos, ql = t.ql, G = t.G;
    const size_t row = (size_t)(b * T + qpos);
#pragma unroll
    for (int r = 0; r < 4; ++r) {
        const int h = 4 * g + r;
        t.qf[r][0] = *(const bfx8*)(c.Q() + row * D + h * HD + 8 * G); t.qf[r][1] = *(const bfx8*)(c.Q() + row * D + h * HD + 32 + 8 * G);
        t.slope2[r] = exp2f(-0.5f * (float)(h + 1)) * LOG2E;
    }
    const float* gatep = c.NGT() + row * 48 + 12 * g;
    const size_t bg = (size_t)(b * NKV + g);
    const bf16* KC = c.KCCB() + bg * NCP_P * HD;
    const bf16* VCT = c.VCCT() + bg * HD * NCP_P;
    const bf16* KS = c.HM() + 2 * HMSZ + bg * T * HD;
    const bf16* VST = c.VST() + bg * HD * T;
    const bf16* KW = c.HM() + 4 * HMSZ + bg * T * HD;
    const bf16* VWT = c.VWT() + bg * HD * T;
    const int ncv = qpos >= 31 ? ((qpos - 31) >> 4) + 1 : 0;
    const int nch = (qt + 31) >> 5;
    unsigned long long m64, U;
    {
        LAS float* impA = wl; LAS float* impB = wl + 16 * IMP_PITCH;
        for (int i = lane_; i < 2 * 16 * IMP_PITCH; i += 64) wl[i] = 0.f;
        float cm[4], cl[4];
#pragma unroll
        for (int r = 0; r < 4; ++r) { cm[r] = NEGF; cl[r] = 0.f; }
        for (int ch = 0; ch < nch; ++ch) {
            f32x4 sa[4], sb[4]; qk_chunk(t, KC + (size_t)ch * 32 * HD, sa, sb);
            float tk[8];
#pragma unroll
            for (int j = 0; j < 8; ++j) { const int ci = ch * 32 + 8 * G + j; tk[j] = __builtin_fmaf(fmaxf((float)(ci - ncv + 1), 0.f), -1e36f, 16.f * (float)ci + 15.5f - (float)qpos); }
#pragma unroll
            for (int r = 0; r < 4; ++r) {
                float s[8];
#pragma unroll
                for (int j = 0; j < 4; ++j) { s[j] = __builtin_fmaf(t.slope2[r], tk[j], sa[r][j]); s[4 + j] = __builtin_fmaf(t.slope2[r], tk[4 + j], sb[r][j]); }
                float pm = fmaxf(fmaxf(fmaxf(s[0], s[1]), fmaxf(s[2], s[3])), fmaxf(fmaxf(s[4], s[5]), fmaxf(s[6], s[7])));
                pm = gmax4(pm);
                const float mn = fmaxf(cm[r], pm), al = __builtin_amdgcn_exp2f(cm[r] - mn);
                float ps = 0.f;
#pragma unroll
                for (int j = 0; j < 8; ++j) ps += __builtin_amdgcn_exp2f(s[j] - mn);
                cl[r] = cl[r] * al + ps; cm[r] = mn;
            }
        }
#pragma unroll
        for (int r = 0; r < 4; ++r) { const float lt = gsum4(cl[r]); cl[r] = lt > 0.f ? 1.f / lt : 0.f; }
        for (int ch = 0; ch < nch; ++ch) {
            f32x4 sa[4], sb[4]; qk_chunk(t, KC + (size_t)ch * 32 * HD, sa, sb);
            float tk[8];
#pragma unroll
            for (int j = 0; j < 8; ++j) { const int ci = ch * 32 + 8 * G + j; tk[j] = __builtin_fmaf(fmaxf((float)(ci - ncv + 1), 0.f), -1e36f, 16.f * (float)ci + 15.5f - (float)qpos); }
            float psum[8];
#pragma unroll
            for (int j = 0; j < 8; ++j) psum[j] = 0.f;
#pragma unroll
            for (int r = 0; r < 4; ++r) {
                float sv[8];
#pragma unroll
                for (int j = 0; j < 4; ++j) { sv[j] = __builtin_fmaf(t.slope2[r], tk[j], sa[r][j]); sv[4 + j] = __builtin_fmaf(t.slope2[r], tk[4 + j], sb[r][j]); }
#pragma unroll
                for (int j = 0; j < 8; ++j) psum[j] += __builtin_amdgcn_exp2f(sv[j] - cm[r]) * cl[r];
            }
            const int s0 = ch * 8 + 2 * G;
            impA[ql * IMP_PITCH + s0] = (psum[0] + psum[1]) + (psum[2] + psum[3]);
            impA[ql * IMP_PITCH + s0 + 1] = (psum[4] + psum[5]) + (psum[6] + psum[7]) + psum[3];
            impB[ql * IMP_PITCH + s0 + 2] = psum[7];
        }
        LDS_WAIT(); asm volatile("" ::: "memory");
        const int cur = qpos >> 6;
        float v[16], srt[16];
#pragma unroll
        for (int i4 = 0; i4 < 4; ++i4) { const f32x4 a = *(const LAS f32x4*)(impA + ql * IMP_PITCH + 16 * G + 4 * i4), bq = *(const LAS f32x4*)(impB + ql * IMP_PITCH + 16 * G + 4 * i4);
#pragma unroll
            for (int k = 0; k < 4; ++k) { const int s = 16 * G + 4 * i4 + k; const bool forced = (s == 0) || (s == cur) || (s == cur - 1);
                v[4 * i4 + k] = (s <= cur) ? (a[k] + bq[k]) + (forced ? 1000.f : 0.f) : NEGF; } }
#pragma unroll
        for (int i = 0; i < 16; ++i) srt[i] = v[i];
        if (PROBE_ATT) {
            float* sp_ = c.SCOREH() + ((size_t)(b * NKV + g) * T + qpos) * 64 + 16 * G;
#pragma unroll
            for (int i = 0; i < 4; ++i) *(GAS f32x4*)(sp_ + 4 * i) = (f32x4){v[4 * i], v[4 * i + 1], v[4 * i + 2], v[4 * i + 3]}; }
        sort16_desc(srt);
        float oth[16];
#pragma unroll
        for (int i = 0; i < 16; ++i) oth[i] = __shfl_xor(srt[i], 16);
#pragma unroll
        for (int i = 0; i < 16; ++i) srt[i] = fmaxf(srt[i], oth[15 - i]);
        merge16_desc(srt);
#pragma unroll
        for (int i = 0; i < 16; ++i) oth[i] = __shfl_xor(srt[i], 32);
        float thr = fmaxf(srt[0], oth[15]);
#pragma unroll
        for (int i = 1; i < 16; ++i) thr = fminf(thr, fmaxf(srt[i], oth[15 - i]));
        int ngt = 0, neq = 0;
#pragma unroll
        for (int i = 0; i < 16; ++i) { ngt += v[i] > thr ? 1 : 0; neq += v[i] == thr ? 1 : 0; }
        int ngt_t = ngt + __shfl_xor(ngt, 16); ngt_t += __shfl_xor(ngt_t, 32);
        const int need = 16 - ngt_t;
        int eqb = 0;
#pragma unroll
        for (int gg = 0; gg < 3; ++gg) { const int o = __shfl(neq, ql + 16 * gg); eqb += (gg < G) ? o : 0; }
        unsigned mloc = 0; int run = eqb;
#pragma unroll
        for (int i = 0; i < 16; ++i) { const int s = 16 * G + i; bool sel = v[i] > thr; if (v[i] == thr) { sel = run < need; ++run; } sel = sel && (s <= cur); mloc |= sel ? (1u << i) : 0u; }
        const unsigned w0 = __shfl(mloc, ql), w1 = __shfl(mloc, ql + 16), w2 = __shfl(mloc, ql + 32), w3 = __shfl(mloc, ql + 48);
        const unsigned lo = w0 | (w1 << 16), hi = w2 | (w3 << 16);
        m64 = ((unsigned long long)hi << 32) | lo;
        unsigned ulo = lo, uhi = hi;
#pragma unroll
        for (int o = 1; o < 16; o <<= 1) { ulo |= __shfl_xor(ulo, o); uhi |= __shfl_xor(uhi, o); }
        U = ((unsigned long long)(unsigned)__builtin_amdgcn_readfirstlane(uhi) << 32) | (unsigned)__builtin_amdgcn_readfirstlane(ulo);
        if (PROBE_ATT && G == 0) c.MASKM()[(size_t)(b * NKV + g) * T + qpos] = m64;
    }
    asm volatile("" ::: "memory");
    reset_branch(t);
    {
        unsigned long long Ur = U; int hf = 0;
        int nxt = Ur ? 64 * __builtin_ctzll(Ur) : -1;
        Frags fn; if (nxt >= 0) load_frags(fn, t, KS + (size_t)nxt * HD, VST + nxt, T);
        while (nxt >= 0) {
            const int base = nxt; const Frags fc = fn;
            if (hf == 0 && base + 32 <= q0 + 15) { hf = 1; nxt = base + 32; }
            else { hf = 0; Ur &= Ur - 1; nxt = Ur ? 64 * __builtin_ctzll(Ur) : -1; }
            if (nxt >= 0) load_frags(fn, t, KS + (size_t)nxt * HD, VST + nxt, T);
            const float pen = ((m64 >> (base >> 6)) & 1ull) ? 0.f : -1e36f;
            float tk[8]; const float fb = (float)(base + 8 * G - qpos) + pen;
            if (base + 31 <= q0) {
#pragma unroll
                for (int j = 0; j < 8; ++j) tk[j] = fb + (float)j;
            } else {
#pragma unroll
                for (int j = 0; j < 8; ++j) { const float fd = fb + (float)j; tk[j] = __builtin_fmaf(fmaxf(fd - pen, 0.f), -1e36f, fd); }
            }
            chunk_compute(t, fc, tk);
        }
    }
    { float gt[4];
#pragma unroll
      for (int r = 0; r < 4; ++r) gt[r] = (mode < 0 || mode == 1) ? gatep[r * 3 + 1] : 0.f;
      fold_branch<true>(t, wl, gt); }
    reset_branch(t);
    {
        int wlo = q0 - 511; wlo = wlo < 0 ? 0 : wlo; wlo &= ~31;
        const int whi = (q0 + 15) & ~31;
        Frags fn; load_frags(fn, t, KW + (size_t)wlo * HD, VWT + wlo, T);
#pragma unroll 1
        for (int base = wlo; base <= whi; base += 32) {
            const Frags fc = fn;
            if (base + 32 <= whi) load_frags(fn, t, KW + (size_t)(base + 32) * HD, VWT + base + 32, T);
            float tk[8]; const float fb = (float)(base + 8 * G - qpos);
            if (base + 31 <= q0 && base >= q0 - 496) {
#pragma unroll
                for (int j = 0; j < 8; ++j) tk[j] = fb + (float)j;
            } else {
#pragma unroll
                for (int j = 0; j < 8; ++j) { const float fd = fb + (float)j; const float cl_ = fminf(fmaxf(fd, -511.f), 0.f); tk[j] = __builtin_fmaf(fabsf(fd - cl_), -1e36f, fd); }
            }
            chunk_compute(t, fc, tk);
        }
    }
    { float gt[4];
#pragma unroll
      for (int r = 0; r < 4; ++r) gt[r] = (mode < 0 || mode == 2) ? gatep[r * 3 + 2] : 0.f;
      fold_branch<false>(t, wl, gt); }
    reset_branch(t);
    { Frags fn; if (nch > 0) load_frags(fn, t, KC, VCT, NCP_P);
#pragma unroll 1
      for (int ch = 0; ch < nch; ++ch) {
        const Frags fc = fn;
        if (ch + 1 < nch) load_frags(fn, t, KC + (size_t)(ch + 1) * 32 * HD, VCT + (ch + 1) * 32, NCP_P);
        float tk[8];
#pragma unroll
        for (int j = 0; j < 8; ++j) { const int ci = ch * 32 + 8 * G + j; tk[j] = __builtin_fmaf(fmaxf((float)(ci - ncv + 1), 0.f), -1e36f, 16.f * (float)ci + 15.5f - (float)qpos); }
        chunk_compute(t, fc, tk);
      } }
#pragma unroll
    for (int r = 0; r < 4; ++r) { const float lt = gsum4(t.l[r]); const float f = (lt > 0.f && (mode < 0 || mode == 0)) ? gatep[r * 3] / lt : 0.f;
#pragma unroll
        for (int db = 0; db < 4; ++db) { float o4[4];
#pragma unroll
            for (int i = 0; i < 4; ++i) o4[i] = wl[(r * 16 + db * 4 + i) * 64 + t.lane] + f * t.ot[r][db][i];
            const unsigned long long pk = (unsigned long long)pg8::cvt_pk_bf16(o4[0], o4[1]) | ((unsigned long long)pg8::cvt_pk_bf16(o4[2], o4[3]) << 32);
            *(GAS unsigned long long*)(c.OB + row * D + (4 * g + r) * HD + 16 * db + 4 * G) = pk; } }
    LDS_WAIT(); asm volatile("" ::: "memory");
}
__device__ __forceinline__ void p4_attn_prompt(const Ctx& c, int mode = -1) {
    LAS float* wl = (LAS float*)c.lds + c.wave * 4096;
    for (int wg = c.bid; wg < NB * NKV * 16; wg += c.G) {
        const int p = wg & 15, g = (wg >> 4) & 3, b = wg >> 6;
        attn_tile(c, b, g, 8 * (31 - p) + c.wave, wl, mode);
        attn_tile(c, b, g, 8 * p + c.wave, wl, mode);
    }
}
}

namespace at {
constexpr int KP = 144, VP = 80, STG_K = 32 * KP, STG_V = 64 * VP, STG_BYTES = STG_K + STG_V;
constexpr int WG_WAVE_BYTES = 16384, WG_STG_OFF = 8 * WG_WAVE_BYTES, WG_UX_OFF = WG_STG_OFF + 2 * STG_BYTES;
static_assert(WG_UX_OFF + 64 <= RING_BYTES, "attention LDS map");
__device__ __forceinline__ void attn_wg(const Ctx& c, int b, int g, int cq, int mode) {
    int lane_ = c.lane; asm volatile("" : "+v"(lane_));
    int tid_ = c.tid; asm volatile("" : "+v"(tid_));
    const int wave = c.wave;
    Tile t; t.lane = lane_; t.ql = lane_ & 15; t.G = lane_ >> 4;
    const int qt = 8 * cq + wave, q0 = qt * 16, q0w = cq * 128; t.qpos = q0 + t.ql;
    const int qpos = t.qpos, G = t.G, r16 = t.ql;
    const size_t row = (size_t)(b * T + qpos);
#pragma unroll
    for (int r = 0; r < 4; ++r) {
        const int h = 4 * g + r;
        t.qf[r][0] = *(const bfx8*)(c.Q() + row * D + h * HD + 8 * G); t.qf[r][1] = *(const bfx8*)(c.Q() + row * D + h * HD + 32 + 8 * G);
        t.slope2[r] = exp2f(-0.5f * (float)(h + 1)) * LOG2E;
    }
    const float* gatep = c.NGT() + row * 48 + 12 * g;
    const size_t bg = (size_t)(b * NKV + g);
    const bf16* KC = c.KCCB() + bg * NCP_P * HD; const bf16* VCT = c.VCCT() + bg * HD * NCP_P;
    const bf16* KS = c.HM() + 2 * HMSZ + bg * T * HD; const bf16* VST = c.VST() + bg * HD * T;
    const bf16* KW = c.HM() + 4 * HMSZ + bg * T * HD; const bf16* VWT = c.VWT() + bg * HD * T;
    LAS unsigned char* lds = c.lds;
    unsigned long long m64, Ut;
    LAS float* wl = (LAS float*)(lds + wave * WG_WAVE_BYTES);
    tile_select(c, t, lane_, b, g, qt, KC, wl, m64, Ut);
#ifdef DUP_SELECT
    { unsigned long long m2, u2; tile_select(c, t, lane_, b, g, qt, KC, wl, m2, u2); m64 |= m2; Ut |= u2; }
#endif
    LAS unsigned long long* UX = (LAS unsigned long long*)(lds + WG_UX_OFF);
    if (lane_ == 0) UX[wave] = Ut;
    __syncthreads();
    unsigned long long Uw = 0;
#pragma unroll
    for (int w = 0; w < NWAVES; ++w) Uw |= UX[w];
    Uw = ((unsigned long long)(unsigned)__builtin_amdgcn_readfirstlane((unsigned)(Uw >> 32)) << 32) | (unsigned)__builtin_amdgcn_readfirstlane((unsigned)Uw);
    const int ncv = qpos >= 31 ? ((qpos - 31) >> 4) + 1 : 0;
    const int ncht = (qt + 31) >> 5, nchw = (8 * cq + 7 + 31) >> 5;
    int wlo = q0w - 511; wlo = wlo < 0 ? 0 : wlo; wlo &= ~31; const int whi = (q0w + 127) & ~31;
    const bool kpart = tid_ < 256; const int sp = kpart ? tid_ : tid_ - 256;
    const int srow = kpart ? (sp >> 3) : (sp >> 2), spc = kpart ? (sp & 7) : (sp & 3);
    const int sdst = kpart ? (srow * KP + spc * 16) : (STG_K + srow * VP + spc * 16);
    int br = 0; unsigned long long Ur = Uw; int base = 64 * __builtin_ctzll(Ur);
#define ATT_SRC(BR, BASE) (kpart ? (const void*)(((BR) == 0 ? KS : (BR) == 1 ? KW : KC) + (size_t)((BASE) + srow) * HD + 8 * spc) \
                                 : (const void*)(((BR) == 0 ? VST : (BR) == 1 ? VWT : VCT) + (size_t)srow * ((BR) == 2 ? NCP_P : T) + (BASE) + 8 * spc))
    v4u sreg = *(const v4u*)ATT_SRC(br, base);
    *(LAS v4u*)(lds + WG_STG_OFF + sdst) = sreg;
    __syncthreads();
    reset_branch(t);
    int cur = 0;
    while (br < 3) {
        int nbr = br, nbase = base;
        if (br == 0) { if ((base & 32) == 0 && base + 32 <= q0w + 127) nbase = base + 32; else { Ur &= Ur - 1; if (Ur) nbase = 64 * __builtin_ctzll(Ur); else { nbr = 1; nbase = wlo; } } }
        else if (br == 1) { nbase = base + 32; if (nbase > whi) { nbr = nchw > 0 ? 2 : 3; nbase = 0; } }
        else { nbase = base + 32; if (nbase >= 32 * nchw) nbr = 3; }
        if (nbr < 3) sreg = *(const v4u*)ATT_SRC(nbr, nbase);
        bool need;
        if (br == 0) need = ((Ut >> (base >> 6)) & 1ull) && base <= q0 + 15;
        else if (br == 1) need = base + 31 >= q0 - 511 && base <= q0 + 15;
        else need = (base >> 5) < ncht;
        if (need) {
            const LAS unsigned char* kb = lds + WG_STG_OFF + cur * STG_BYTES;
            Frags f; const LAS unsigned char* ka = kb + (8 * (r16 >> 2) + (r16 & 3)) * KP + G * 16;
            f.a0 = *(const LAS bfx8*)ka; f.a1 = *(const LAS bfx8*)(ka + 64); f.b0 = *(const LAS bfx8*)(ka + 4 * KP); f.b1 = *(const LAS bfx8*)(ka + 4 * KP + 64);
#pragma unroll
            for (int db = 0; db < 4; ++db) f.vf[db] = *(const LAS bfx8*)(kb + STG_K + (16 * db + r16) * VP + G * 16);
            float tk[8];
            if (br == 0) {
                const float pen = ((m64 >> (base >> 6)) & 1ull) ? 0.f : -1e36f;
                const float fb = (float)(base + 8 * G - qpos) + pen;
                if (base + 31 <= q0) {
#pragma unroll
                    for (int j = 0; j < 8; ++j) tk[j] = fb + (float)j;
                } else {
#pragma unroll
                    for (int j = 0; j < 8; ++j) { const float fd = fb + (float)j; tk[j] = __builtin_fmaf(fmaxf(fd - pen, 0.f), -1e36f, fd); }
                }
            } else if (br == 1) {
                const float fb = (float)(base + 8 * G - qpos);
                if (base + 31 <= q0 && base >= q0 - 496) {
#pragma unroll
                    for (int j = 0; j < 8; ++j) tk[j] = fb + (float)j;
                } else {
#pragma unroll
                    for (int j = 0; j < 8; ++j) { const float fd = fb + (float)j; const float cl_ = fminf(fmaxf(fd, -511.f), 0.f); tk[j] = __builtin_fmaf(fabsf(fd - cl_), -1e36f, fd); }
                }
            } else {
#pragma unroll
                for (int j = 0; j < 8; ++j) { const int ci = base + 8 * G + j; tk[j] = __builtin_fmaf(fmaxf((float)(ci - ncv + 1), 0.f), -1e36f, 16.f * (float)ci + 15.5f - (float)qpos); }
            }
            chunk_compute(t, f, tk);
        }
        if (nbr != br) {
            const int gi = br == 0 ? 1 : br == 1 ? 2 : 0;
            float gt[4];
#pragma unroll
            for (int r = 0; r < 4; ++r) gt[r] = (mode < 0 || mode == gi) ? gatep[r * 3 + gi] : 0.f;
            if (br == 0) fold_branch<true>(t, wl, gt); else fold_branch<false>(t, wl, gt);
            reset_branch(t);
        }
        if (nbr < 3) *(LAS v4u*)(lds + WG_STG_OFF + (cur ^ 1) * STG_BYTES + sdst) = sreg;
        __syncthreads();
        br = nbr; base = nbase; cur ^= 1;
    }
#undef ATT_SRC
#pragma unroll
    for (int r = 0; r < 4; ++r)
#pragma unroll
        for (int db = 0; db < 4; ++db) {
            float o4[4];
#pragma unroll
            for (int i = 0; i < 4; ++i) o4[i] = wl[(r * 16 + db * 4 + i) * 64 + lane_];
            const unsigned long long pk = (unsigned long long)pg8::cvt_pk_bf16(o4[0], o4[1]) | ((unsigned long long)pg8::cvt_pk_bf16(o4[2], o4[3]) << 32);
            *(GAS unsigned long long*)(c.OB + row * D + (4 * g + r) * HD + 16 * db + 4 * G) = pk; }
    LDS_WAIT(); asm volatile("" ::: "memory");
    __syncthreads();
}
__device__ __forceinline__ void p4_attn_prompt_wg(const Ctx& c, int mode = -1) {
    for (int wg = c.bid; wg < NB * NKV * 16; wg += c.G) {
        const int p = wg & 15, g = (wg >> 4) & 3, b = wg >> 6;
        attn_wg(c, b, g, 31 - p, mode);
        attn_wg(c, b, g, p, mode);
    }
}
}

namespace at {
constexpr int SC_PITCH = 520;
struct SCol { bfx8 qf[2]; float slope2; f32x4 ot[4]; float m, l; int lane, col, G, qpos, qi; };
__device__ __forceinline__ const float* srow_sel(const Ctx& c, int b, int g, int kv, int pos) {
    pos = pos > PAST + SS - 1 ? PAST + SS - 1 : pos;
    if (pos < PAST) return c.cache_sel() + ((size_t)c.pt()[b * NPG + (pos >> 7)] * PAGE + (pos & 127)) * 512 + kv * 256 + g * HD;
    return c.ZS() + (size_t)(b * SS + (pos - PAST)) * NIN + 4608 + kv * 256 + g * HD; }
__device__ __forceinline__ const float* srow_win(const Ctx& c, int b, int g, int kv, int pos) {
    pos = pos > PAST + SS - 1 ? PAST + SS - 1 : pos;
    if (pos < PAST) return c.cache_win() + ((size_t)(b * 512 + (pos - (PAST - 512)))) * 512 + kv * 256 + g * HD;
    return c.ZS() + (size_t)(b * SS + (pos - PAST)) * NIN + 5120 + kv * 256 + g * HD; }
__device__ __forceinline__ bfx8 cvt8(const float* p) { float v[8]; ld8(p, v); return __builtin_bit_cast(bfx8, pack8(v)); }
__device__ __forceinline__ void s_update(SCol& t, const f32x4& sa, const f32x4& sb, const float (&tk)[8], const bfx8 (&vf)[4]) {
    float s[8];
#pragma unroll
    for (int j = 0; j < 4; ++j) { s[j] = __builtin_fmaf(t.slope2, tk[j], sa[j]); s[4 + j] = __builtin_fmaf(t.slope2, tk[4 + j], sb[j]); }
    float pm = fmaxf(fmaxf(fmaxf(s[0], s[1]), fmaxf(s[2], s[3])), fmaxf(fmaxf(s[4], s[5]), fmaxf(s[6], s[7])));
    pm = gmax4(pm);
    const float mn = fmaxf(t.m, pm), al = __builtin_amdgcn_exp2f(t.m - mn);
    t.m = mn; t.l *= al;
#pragma unroll
    for (int db = 0; db < 4; ++db) t.ot[db] = t.ot[db] * al;
    float p[8]; float ps = 0.f;
#pragma unroll
    for (int j = 0; j < 8; ++j) { p[j] = __builtin_amdgcn_exp2f(s[j] - t.m); ps += p[j]; }
    t.l += ps;
    const bfx8 pf = pack_p(p);
#pragma unroll
    for (int db = 0; db < 4; ++db) t.ot[db] = mfma16(vf[db], pf, t.ot[db]);
}
__device__ __forceinline__ void s_chunk_bf16(SCol& t, const bf16* kb, const bf16* vtb, int pitch, const float (&tk)[8]) {
    const int r16 = t.col; const bf16* ka = kb + (8 * (r16 >> 2) + (r16 & 3)) * 64 + 8 * t.G;
    const bfx8 a0 = *(const bfx8*)ka, a1 = *(const bfx8*)(ka + 32), b0 = *(const bfx8*)(ka + 256), b1 = *(const bfx8*)(ka + 256 + 32);
    bfx8 vf[4];
#pragma unroll
    for (int db = 0; db < 4; ++db) vf[db] = *(const bfx8*)(vtb + (size_t)(16 * db + r16) * pitch + 8 * t.G);
    const f32x4 z = {0.f, 0.f, 0.f, 0.f};
    f32x4 sa = mfma16(a0, t.qf[0], z); sa = mfma16(a1, t.qf[1], sa);
    f32x4 sb = mfma16(b0, t.qf[0], z); sb = mfma16(b1, t.qf[1], sb);
    s_update(t, sa, sb, tk, vf);
}
template <bool WIN> __device__ __forceinline__ void s_chunk_f32(const Ctx& c, SCol& t, int b, int g, int base, const float (&tk)[8]) {
    const int r16 = t.col, ka_pos = base + 8 * (r16 >> 2) + (r16 & 3);
    const float* pa = WIN ? srow_win(c, b, g, 0, ka_pos) : srow_sel(c, b, g, 0, ka_pos);
    const float* pb = WIN ? srow_win(c, b, g, 0, ka_pos + 4) : srow_sel(c, b, g, 0, ka_pos + 4);
    const bfx8 a0 = cvt8(pa + 8 * t.G), a1 = cvt8(pa + 32 + 8 * t.G), b0 = cvt8(pb + 8 * t.G), b1 = cvt8(pb + 32 + 8 * t.G);
    float vv[4][8];
#pragma unroll
    for (int j = 0; j < 8; ++j) { const float* pv = WIN ? srow_win(c, b, g, 1, base + 8 * t.G + j) : srow_sel(c, b, g, 1, base + 8 * t.G + j);
#pragma unroll
        for (int db = 0; db < 4; ++db) vv[db][j] = pv[16 * db + r16]; }
    bfx8 vf[4];
#pragma unroll
    for (int db = 0; db < 4; ++db) vf[db] = __builtin_bit_cast(bfx8, pack8(vv[db]));
    const f32x4 z = {0.f, 0.f, 0.f, 0.f};
    f32x4 sa = mfma16(a0, t.qf[0], z); sa = mfma16(a1, t.qf[1], sa);
    f32x4 sb = mfma16(b0, t.qf[0], z); sb = mfma16(b1, t.qf[1], sb);
    s_update(t, sa, sb, tk, vf);
}
__device__ __forceinline__ void s_reset(SCol& t) { t.m = NEGF; t.l = 0.f;
#pragma unroll
    for (int db = 0; db < 4; ++db) t.ot[db] = (f32x4){0.f, 0.f, 0.f, 0.f}; }
__device__ __forceinline__ void s_store_partial(const SCol& t, LAS float* L, int wave, int br) {
    const int idx = (wave * 3 + br) * 16 + t.col;
#pragma unroll
    for (int db = 0; db < 4; ++db) *(LAS f32x4*)(L + idx * 64 + 16 * db + 4 * t.G) = t.ot[db];
    const float lt = gsum4(t.l);
    if (t.G == 0) { L[24576 + idx] = t.m; L[24576 + 384 + idx] = lt; }
}
__device__ __forceinline__ void attn_sample_item(const Ctx& c, int b, int g) {
    int lane_ = c.lane; asm volatile("" : "+v"(lane_));
    SCol t; t.lane = lane_; t.col = lane_ & 15; t.G = lane_ >> 4; t.qi = t.col & 3; t.qpos = PAST + t.qi;
    const int wave = c.wave, col = t.col, G = t.G, qpos = t.qpos;
    const int h = 4 * g + (col >> 2);
    t.slope2 = exp2f(-0.5f * (float)(h + 1)) * LOG2E;
    { const float* qp = c.ZS() + (size_t)(b * SS + t.qi) * NIN + 3072 + h * HD;
#pragma unroll
      for (int dh = 0; dh < 2; ++dh) { float v[8]; ld8(qp + 32 * dh + 8 * G, v);
#pragma unroll
          for (int j = 0; j < 8; ++j) v[j] *= QSCALE;
          t.qf[dh] = __builtin_bit_cast(bfx8, pack8(v)); } }
    const size_t bg = (size_t)(b * NKV + g);
    const bf16* KC = c.KCCSB() + bg * NCP_S * HD; const bf16* VCT = c.VCCST() + bg * HD * NCP_S;
    LAS float* L = (LAS float*)c.lds;
    LAS unsigned long long* MK = (LAS unsigned long long*)(L + 16 * SC_PITCH);
    __syncthreads();
    for (int ch = wave; ch < 16; ch += NWAVES) {
        const bf16* ka = KC + (size_t)ch * 32 * HD + (8 * (col >> 2) + (col & 3)) * 64 + 8 * G;
        const bfx8 a0 = *(const bfx8*)ka, a1 = *(const bfx8*)(ka + 32), b0 = *(const bfx8*)(ka + 256), b1 = *(const bfx8*)(ka + 256 + 32);
        const f32x4 z = {0.f, 0.f, 0.f, 0.f};
        f32x4 sa = mfma16(a0, t.qf[0], z); sa = mfma16(a1, t.qf[1], sa);
        f32x4 sb = mfma16(b0, t.qf[0], z); sb = mfma16(b1, t.qf[1], sb);
        f32x4 o0, o1;
#pragma unroll
        for (int j = 0; j < 4; ++j) { const int ci = ch * 32 + 8 * G + j;
            o0[j] = ci < NCS_S ? __builtin_fmaf(t.slope2, 16.f * (float)ci + 15.5f - (float)qpos, sa[j]) : -1e36f;
            o1[j] = ci + 4 < NCS_S ? __builtin_fmaf(t.slope2, 16.f * (float)(ci + 4) + 15.5f - (float)qpos, sb[j]) : -1e36f; }
        *(LAS f32x4*)(L + col * SC_PITCH + ch * 32 + 8 * G) = o0; *(LAS f32x4*)(L + col * SC_PITCH + ch * 32 + 8 * G + 4) = o1;
    }
    __syncthreads();
#pragma unroll 1
    for (int cc = 0; cc < 2; ++cc) { LAS float* sc = L + (2 * wave + cc) * SC_PITCH;
        float v[8]; float mx = -3e38f;
#pragma unroll
        for (int k = 0; k < 8; ++k) { v[k] = sc[lane_ + 64 * k]; mx = fmaxf(mx, v[k]); }
#pragma unroll
        for (int o = 1; o < 64; o <<= 1) mx = fmaxf(mx, __shfl_xor(mx, o));
        float sm = 0.f;
#pragma unroll
        for (int k = 0; k < 8; ++k) { v[k] = __builtin_amdgcn_exp2f(v[k] - mx); sm += v[k]; }
        sm = wave_sum(sm); const float inv = 1.f / sm;
#pragma unroll
        for (int k = 0; k < 8; ++k) sc[lane_ + 64 * k] = v[k] * inv; }
    __syncthreads();
    if (wave < SS) {
        const int qi = wave, cur = (PAST + qi) >> 6;
        float val[3];
#pragma unroll
        for (int k = 0; k < 3; ++k) { const int s = lane_ + 64 * k; float imp = 0.f;
            if (s < 129) {
#pragma unroll
                for (int r = 0; r < 4; ++r) { const LAS float* pc = L + (4 * r + qi) * SC_PITCH;
#pragma unroll
                    for (int j = -1; j < 4; ++j) { const int ci = 4 * s + j; if (ci >= 0 && ci < 512) imp += pc[ci]; } }
                const bool forced = (s == 0) || (s == cur) || (s == cur - 1);
                val[k] = imp + (forced ? 1000.f : 0.f);
            } else val[k] = -INFINITY; }
        int rank[3] = {0, 0, 0};
#pragma unroll
        for (int k2 = 0; k2 < 3; ++k2)
            for (int l2 = 0; l2 < 64; ++l2) { const float v2 = __shfl(val[k2], l2); const int s2 = l2 + 64 * k2;
#pragma unroll
                for (int k = 0; k < 3; ++k) { const int s = lane_ + 64 * k; rank[k] += (v2 > val[k] || (v2 == val[k] && s2 < s)) ? 1 : 0; } }
#pragma unroll
        for (int k = 0; k < 3; ++k) { const unsigned long long mk = __ballot(rank[k] < 16 && lane_ + 64 * k < 129); if (lane_ == 0) MK[qi * 3 + k] = mk; }
    }
    __syncthreads();
    unsigned long long mk[3], U[3];
#pragma unroll
    for (int k = 0; k < 3; ++k) { mk[k] = MK[t.qi * 3 + k]; U[k] = MK[k] | MK[3 + k] | MK[6 + k] | MK[9 + k]; }
    __syncthreads();
    s_reset(t);
    for (int ch = wave; ch < 16; ch += NWAVES) {
        float tk[8];
#pragma unroll
        for (int j = 0; j < 8; ++j) { const int ci = ch * 32 + 8 * G + j; tk[j] = ci < NCS_S ? 16.f * (float)ci + 15.5f - (float)qpos : -1e36f; }
        s_chunk_bf16(t, KC + (size_t)ch * 32 * HD, VCT + ch * 32, NCP_S, tk);
    }
    s_store_partial(t, L, wave, 0);
    s_reset(t);
    { int kcnt = 0;
#pragma unroll 1
      for (int w3 = 0; w3 < 3; ++w3) { unsigned long long u = (unsigned long long)__builtin_amdgcn_readfirstlane((unsigned)(U[w3] >> 32)) << 32 | (unsigned)__builtin_amdgcn_readfirstlane((unsigned)U[w3]);
        while (u) { const int sb_ = __builtin_ctzll(u); u &= u - 1; const int s = 64 * w3 + sb_;
            const bool mine = (mk[w3] >> sb_) & 1ull;
#pragma unroll 1
            for (int hf = 0; hf < 2; ++hf) { const int base = 64 * s + 32 * hf;
                if (base > PAST + SS - 1) break;
                if ((kcnt++ & (NWAVES - 1)) != wave) continue;
                float tk[8];
#pragma unroll
                for (int j = 0; j < 8; ++j) { const int pos = base + 8 * G + j; tk[j] = (mine && pos <= qpos) ? (float)(pos - qpos) : -1e36f; }
                s_chunk_f32<false>(c, t, b, g, base, tk); } } } }
    s_store_partial(t, L, wave, 1);
    s_reset(t);
    for (int ci = wave; ci < 17; ci += NWAVES) { const int base = PAST - 512 + 32 * ci;
        float tk[8];
#pragma unroll
        for (int j = 0; j < 8; ++j) { const int pos = base + 8 * G + j; tk[j] = (pos <= qpos && qpos - pos < 512) ? (float)(pos - qpos) : -1e36f; }
        s_chunk_f32<true>(c, t, b, g, base, tk); }
    s_store_partial(t, L, wave, 2);
    __syncthreads();
    { const int cc = c.tid >> 5, d0 = (c.tid & 31) * 2, qi = cc & 3, hh = 4 * g + (cc >> 2); const size_t row = (size_t)(b * SS + qi);
      float o0 = 0.f, o1 = 0.f;
#pragma unroll
      for (int br = 0; br < 3; ++br) {
          float M = -3e38f;
#pragma unroll
          for (int w = 0; w < NWAVES; ++w) M = fmaxf(M, L[24576 + (w * 3 + br) * 16 + cc]);
          float Ls = 0.f, a0 = 0.f, a1 = 0.f;
#pragma unroll
          for (int w = 0; w < NWAVES; ++w) { const int idx = (w * 3 + br) * 16 + cc; const float f = __builtin_amdgcn_exp2f(L[24576 + idx] - M);
              Ls += f * L[24576 + 384 + idx]; a0 += f * L[idx * 64 + d0]; a1 += f * L[idx * 64 + d0 + 1]; }
          const float gt = sigmoidf_(c.ZS()[row * NIN + 5632 + hh * 3 + br]);
          if (Ls > 0.f) { o0 += gt * a0 / Ls; o1 += gt * a1 / Ls; } }
      c.OBS()[row * D + hh * HD + d0] = o0; c.OBS()[row * D + hh * HD + d0 + 1] = o1; }
    __syncthreads();
}
__device__ __forceinline__ void p4_attn_sample(const Ctx& c) {
    for (int wg = c.bid; wg < NB * NKV * 16; wg += c.G) { const int p = wg & 15; if (p < 8) { const int it = 8 * (wg >> 4) + p; attn_sample_item(c, it >> 2, it & 3); } }
}
}

struct SEpiZ { float* ZS; __device__ __forceinline__ void operator()(int row, int n, float a1, float) const { ZS[(size_t)row * NIN + n] = a1; } };
struct SEpiMG { const float* ZS; float* MGS; __device__ __forceinline__ void operator()(int row, int n, float a1, float a2) const {
    MGS[(size_t)row * D + n] = sigmoidf_(ZS[(size_t)row * NIN + 5680 + n]) * a1 + sigmoidf_(ZS[(size_t)row * NIN + 5680 + D + n]) * a2; } };
struct SEpiRes { const float* base; float* O; const float* MOD; int goff; __device__ __forceinline__ void operator()(int row, int n, float a1, float) const {
    O[(size_t)row * D + n] = base[(size_t)row * D + n] + MOD[(size_t)(NB + (row >> 2)) * NMOD + goff + n] * a1; } };
struct SEpiFF { float* HFS; __device__ __forceinline__ void operator()(int row, int n, float a1, float a2) const { HFS[(size_t)row * FF + n] = siluf_(a1) * a2; } };

struct MEpiZ { float* ZS; int col0; __device__ __forceinline__ void operator()(int row, int j, float a1, float) const { ZS[(size_t)row * NIN + col0 + j] = a1; } };
struct MEpiMG { const float* ZS; float* MGS; int col0; __device__ __forceinline__ void operator()(int row, int j, float a1, float a2) const { const int n = col0 + j;
    MGS[(size_t)row * D + n] = sigmoidf_(ZS[(size_t)row * NIN + 5680 + n]) * a1 + sigmoidf_(ZS[(size_t)row * NIN + 5680 + D + n]) * a2; } };
struct MEpiRes { const float* base; float* O; const float* MOD; int goff, col0; __device__ __forceinline__ void operator()(int row, int j, float a1, float) const { const int n = col0 + j;
    O[(size_t)row * D + n] = base[(size_t)row * D + n] + MOD[(size_t)(NB + (row >> 2)) * NMOD + goff + n] * a1; } };
struct MEpiFF { float* HFS; int col0; __device__ __forceinline__ void operator()(int row, int j, float a1, float a2) const { HFS[(size_t)row * FF + col0 + j] = siluf_(a1) * a2; } };
__device__ __forceinline__ int win_src_col(int p) {
    if (p < 1024) return p;
    if (p < 3072) { const int t = (p - 1024) >> 8, w = (p - 1024) & 255; return (w < 128) ? (1024 + 128 * t + w) : (2048 + 128 * t + (w - 128)); }
    if (p < 5632) return p;
    if (p < 7680) return 5680 + (p - 5632);
    return 5632 + (p - 7680);
}

#ifndef PROBE_TH
#define PROBE_TH 0.02f
#endif
#ifndef PROBE_DM
#define PROBE_DM 0.10f
#endif
#ifndef PROBE_SATT
#define PROBE_SATT 0
#endif
#ifndef PROBE_STH
#define PROBE_STH 0.05f
#endif
#ifndef NAIVE_SATT
#define NAIVE_SATT 0
#endif
#ifndef ATTN_WG
#define ATTN_WG 1
#endif
#if ATTN_WG
#define ATTN_PROMPT at::p4_attn_prompt_wg
#else
#define ATTN_PROMPT at::p4_attn_prompt
#endif
#ifndef MK_SINGLE
#define MK_SINGLE 1
#endif
struct Args { const void* in[26]; float* out; unsigned char* ws; int ph_lo, ph_hi; };
__global__ void __launch_bounds__(NTHR, 2) fwd(Args a) {
    extern __shared__ __attribute__((aligned(16))) unsigned char lds[];
    Ctx c;
    c.lds = (LAS unsigned char*)lds;
    c.tid = threadIdx.x; c.lane = c.tid & 63; c.wave = __builtin_amdgcn_readfirstlane(c.tid >> 6); c.G = gridDim.x; c.bid = blockIdx.x;
    unsigned char* ws = a.ws;
    c.ws = ws; c.OB = (bf16*)(ws + WS_OB); c.CHK = (float*)(ws + WS_CTL) + 8192;

    for (int u = c.tid; u < (LDS_BYTES - LDSCTL_OFF) / 4; u += NTHR) ((LAS unsigned*)(c.lds + LDSCTL_OFF))[u] = 0u;
    __syncthreads();
    const int lo = a.ph_lo, hi = a.ph_hi;
    unsigned* ctl = (unsigned*)(ws + WS_CTL);
    volatile LAS unsigned* MISC = (volatile LAS unsigned*)(c.lds + MISC_OFF);
    XcdBarrier bar; bar.bar = ctl + CW_BAR; bar.x = 0; bar.st = nullptr;
    if (hi - lo > 1) bar = xcd_barrier_post(ctl + CW_BAR, MISC + 8);
#ifdef PH_ONLY
#define IN(k) ((k) == PH_ONLY)
#else
#define IN(k) (lo <= (k) && (k) < hi)
#endif
#ifdef PROBE_T
    unsigned long long ts_[16]; ts_[0] = __builtin_amdgcn_s_memrealtime();
#define SEAM(k) do { if (IN(k) && IN((k) + 1)) xcd_barrier(bar); ts_[(k) + 1] = __builtin_amdgcn_s_memrealtime(); } while (0)
#else
#define SEAM(k) do { if (IN(k) && IN((k) + 1)) xcd_barrier(bar); } while (0)
#endif

    if (IN(0)) { p0_prologue(c);
#ifdef DUP_P0
        __syncthreads(); p0_prologue(c);
#endif
    } SEAM(0);
    if (IN(1)) { p1_norm1(c); scmp_phase(c);
#ifdef DUP_SCMP
        scmp_phase(c);
#endif
#ifdef DUP_THIN
        p1_norm1(c);
#endif
    } SEAM(1);
    if (IN(2)) {
        pg8::Gemm g{c.XN(), c.WIN_T(), M, NINP, D}; pg8::StaticOrder S; S.init(M, NINP, c.G, c.bid);
        EpiIn E{c.BG(), c.U(), c.Q(), c.HM(), c.GA(), c.GB(), c.NGT(), c.out(), c.VST(), c.VWT(), c.ACMP()};
        pg8::gemm_phase<EpiIn, pg8::StaticOrder, true, true>(c.lds + RING_OFF, g, S, E);
#ifdef DUP_IN
        pg8::gemm_phase<EpiIn, pg8::StaticOrder, true, true>(c.lds + RING_OFF, g, S, E);
#endif
        for (int it = c.G - 1 - c.bid; it < NIN / 16; it += c.G) { const int p0 = it * 16;
            sgemm_item<1>(c, c.XNS(), c.XNS(), D, c.WIN_T() + (size_t)p0 * D, c.WIN_T(), D, MEpiZ{c.ZS(), win_src_col(p0)}); }
    } SEAM(2);
    if (IN(3)) {
        { pg8::Gemm g{c.ACMP(), c.W1T(), 2 * CM_ROWS, 512, 1024}; CmpOrder S{c.G, c.bid}; EpiCmp E{c.CCMP()};
          pg8::gemm_phase<EpiCmp, CmpOrder, true, true>(c.lds + RING_OFF, g, S, E); }
        p3_conv_prompt(c); p3_sample_thin(c);
#ifdef DUP_THIN
        p3_conv_prompt(c); p3_sample_thin(c);
#endif
#if PROBE_CMP
        compress_naive<CmpP>(c); compress_naive<CmpS>(c);
#endif
    } SEAM(3);
    if (IN(4)) { compress_step2(c);
#ifdef DUP_THIN
        compress_step2(c);
#endif
    } SEAM(4);
#if NAIVE_SATT || PROBE_SATT
    if (IN(5)) { p4a_scores<AtS>(c); } SEAM(5);
    if (IN(6)) { p4b_topk<AtS>(c); } SEAM(6);
#endif
#if PROBE_ATT && defined(PROBE_SEL) && PROBE_SEL == 4
    if (IN(7)) {
        ATTN_PROMPT(c, -1); __syncthreads(); xcd_barrier(bar);
        { int ln_ = c.lane; asm volatile("" : "+v"(ln_)); const int gw_ = c.bid * NWAVES + c.wave; float bad = 0.f;
          for (int w_ = gw_; w_ < NB * NKV * T; w_ += c.G * NWAVES) { const float v_ = c.SCOREH()[(size_t)w_ * 64 + ln_]; int rk_ = 0;
              for (int l2 = 0; l2 < 64; ++l2) { const float v2 = __shfl(v_, l2); rk_ += (v2 > v_ || (v2 == v_ && l2 < ln_)) ? 1 : 0; }
              const unsigned long long mk_ = __ballot(rk_ < 16 && ln_ <= ((w_ & (T - 1)) >> 6)); bad += (mk_ != c.MASKM()[w_]) ? 1.f : 0.f; }
          if (ln_ == 0 && bad != 0.f) atomicAdd(c.CHK + 7, bad); }
        xcd_barrier(bar);
    }
#elif PROBE_ATT
    if (IN(7)) {
        p4a_scores<AtP>(c); xcd_barrier(bar); p4b_topk<AtP>(c); xcd_barrier(bar);
#define PROBE_MODE(mode) do { \
            ATTN_PROMPT(c, mode); __syncthreads(); xcd_barrier(bar); \
            if (mode == 0) { \
                float diff = 0.f; \
                for (int i = gtid(c); i < NB * NKV * T; i += c.G * NTHR) { diff += (c.MASK()[i] != c.MASKM()[i]) ? 1.f : 0.f; } \
                if (diff != 0.f) atomicAdd(c.CHK + 6, diff); \
                { int ln_ = c.lane; asm volatile("" : "+v"(ln_)); const int gw_ = c.bid * NWAVES + c.wave; float bad = 0.f; \
                  for (int w_ = gw_; w_ < NB * NKV * T; w_ += c.G * NWAVES) { const float v_ = c.SCOREH()[(size_t)w_ * 64 + ln_]; int rk_ = 0; \
                      for (int l2 = 0; l2 < 64; ++l2) { const float v2 = __shfl(v_, l2); rk_ += (v2 > v_ || (v2 == v_ && l2 < ln_)) ? 1 : 0; } \
                      const unsigned long long mk_ = __ballot(rk_ < 16 && ln_ <= ((w_ & (T - 1)) >> 6)); bad += (mk_ != c.MASKM()[w_]) ? 1.f : 0.f; } \
                  if (ln_ == 0 && bad != 0.f) atomicAdd(c.CHK + 7, bad); } \
                xcd_barrier(bar); \
                for (int i = gtid(c); i < NB * NKV * T; i += c.G * NTHR) c.MASK()[i] = c.MASKM()[i]; \
                xcd_barrier(bar); \
            } \
            { Ctx c2 = c; c2.OB = c.OB2(); p4c_attend<AtP>(c2, mode); } \
            xcd_barrier(bar); \
            float num = 0.f, den = 0.f, nfa = 0.f, nfr = 0.f; \
            for (int i = gtid(c); i < M * D; i += c.G * NTHR) { const float a_ = bf2f(c.OB[i]), r_ = bf2f(c.OB2()[i]); const bool fa_ = fabsf(a_) < 1e30f, fr_ = fabsf(r_) < 1e30f; \
                if (fa_ && fr_) { num += (a_ - r_) * (a_ - r_); den += r_ * r_; } nfa += fa_ ? 0.f : 1.f; nfr += fr_ ? 0.f : 1.f; } \
            if (nfa != 0.f) atomicAdd(c.CHK + 8 + 2 * mode, nfa); if (nfr != 0.f) atomicAdd(c.CHK + 9 + 2 * mode, nfr); \
            atomicAdd(c.CHK + 2 * mode, num); atomicAdd(c.CHK + 2 * mode + 1, den); \
            xcd_barrier(bar); } while (0)
        PROBE_MODE(0);
#if !defined(PROBE_SEL) || PROBE_SEL != 4
        PROBE_MODE(1); PROBE_MODE(2);
#endif
    }
#endif
    if (IN(7)) { ATTN_PROMPT(c); __syncthreads();
#ifdef DUP_ATT
        ATTN_PROMPT(c); __syncthreads();
#endif
#if !defined(NO_S6)
#if NAIVE_SATT
        p4c_attend<AtS>(c);
#elif PROBE_SATT
        p4c_attend<AtS>(c); xcd_barrier(bar);
        for (int i = gtid(c); i < MS * D; i += c.G * NTHR) c.X2S()[i] = c.OBS()[i];
        xcd_barrier(bar);
        at::p4_attn_sample(c); xcd_barrier(bar);
        { float num = 0.f, den = 0.f;
          for (int i = gtid(c); i < MS * D; i += c.G * NTHR) { const float a_ = c.OBS()[i], r_ = c.X2S()[i]; num += (a_ - r_) * (a_ - r_); den += r_ * r_; }
          if (num != 0.f || den != 0.f) { atomicAdd(c.CHK + 40, num); atomicAdd(c.CHK + 41, den); } }
#else
        at::p4_attn_sample(c);
#ifdef DUP_SATT
        at::p4_attn_sample(c);
#endif
#endif
#endif
 } SEAM(7);
    if (IN(8)) {
        { pg8::Gemm g{c.AA(), c.WOC_T(), M, D, D}; pg8::StaticOrder S; S.init(M, D, c.G, c.bid); EpiYa E{c.GA(), c.P1()};
          pg8::gemm_phase<EpiYa, pg8::StaticOrder, true, true>(c.lds + RING_OFF, g, S, E); }
        { pg8::Gemm g{c.OB, c.WON_T(), M, D, D}; pg8::StaticOrder S; S.init(M, D, c.G, c.bid); EpiYb E{c.GB(), c.P1(), c.MG()};
          pg8::gemm_phase<EpiYb, pg8::StaticOrder, true, true>(c.lds + RING_OFF, g, S, E); }
        for (int it = c.G - 1 - c.bid; it < D / 16; it += c.G) { const int n0 = it * 16;
            sgemm_item<2>(c, c.AAS(), c.OBS(), D, c.WOC_T() + (size_t)n0 * D, c.WON_T() + (size_t)n0 * D, D, MEpiMG{c.ZS(), c.MGS(), n0}); }
    } SEAM(8);
    if (IN(9)) {
        pg8::Gemm g{c.MG(), c.WOUT_T(), M, D, D}; pg8::StaticOrder S; S.init(M, D, c.G, c.bid); EpiRes E{c.x_p(), c.X1(), c.MOD(), 2 * D};
        pg8::gemm_phase<EpiRes, pg8::StaticOrder, true, true>(c.lds + RING_OFF, g, S, E);
        for (int it = c.G - 1 - c.bid; it < D / 16; it += c.G) { const int n0 = it * 16;
            sgemm_item<1>(c, c.MGS(), c.MGS(), D, c.WOUT_T() + (size_t)n0 * D, c.WOUT_T(), D, MEpiRes{c.x_s(), c.X1S(), c.MOD(), 2 * D, n0}); }
    } SEAM(9);
    if (IN(10)) { p5c_norm2(c);
#ifdef DUP_THIN
        p5c_norm2(c);
#endif
    } SEAM(10);
    if (IN(11)) {
        pg8::Gemm g{c.XN(), c.WGU_T(), M, NGU, D}; pg8::StaticOrder S; S.init(M, NGU, c.G, c.bid); EpiFF E{c.HF()};
        pg8::gemm_phase<EpiFF, pg8::StaticOrder, true, true>(c.lds + RING_OFF, g, S, E);
#ifdef DUP_FF
        pg8::gemm_phase<EpiFF, pg8::StaticOrder, true, true>(c.lds + RING_OFF, g, S, E);
#endif
        for (int it = c.G - 1 - c.bid; it < FF / 16; it += c.G) { const int n0 = it * 16, pg = ((n0 >> 7) << 8) + (n0 & 127);
            sgemm_item<2>(c, c.XN2S(), c.XN2S(), D, c.WGU_T() + (size_t)pg * D, c.WGU_T() + (size_t)(pg + 128) * D, D, MEpiFF{c.HFS(), n0}); }
    } SEAM(11);
    if (IN(12)) {
        pg8::Gemm g{c.HF(), c.WDN_T(), M, D, FF}; pg8::StaticOrder S; S.init(M, D, c.G, c.bid); EpiRes E{c.X1(), c.out() + O_YP, c.MOD(), 5 * D};
        pg8::gemm_phase<EpiRes, pg8::StaticOrder, true, true>(c.lds + RING_OFF, g, S, E);
        for (int it = c.G - 1 - c.bid; it < D / 16; it += c.G) { const int n0 = it * 16;
            sgemm_item<1>(c, c.HFS(), c.HFS(), FF, c.WDN_T() + (size_t)n0 * FF, c.WDN_T(), FF, MEpiRes{c.X1S(), c.X2S(), c.MOD(), 5 * D, n0}); }
    } SEAM(12);
    if (IN(13)) { p8_normf(c);
#if PROBE_SATT
        { const float n_ = __hip_atomic_load(c.CHK + 40, __ATOMIC_RELAXED, __HIP_MEMORY_SCOPE_AGENT), d_ = __hip_atomic_load(c.CHK + 41, __ATOMIC_RELAXED, __HIP_MEMORY_SCOPE_AGENT);
          if (!(n_ / d_ < PROBE_STH * PROBE_STH)) for (int i = gtid(c); i < 8192; i += c.G * NTHR) c.out()[O_CONV_P + i] = 0.f; }
#endif
#if PROBE_CMP
        { float chk[4]; for (int i = 0; i < 4; ++i) chk[i] = __hip_atomic_load(c.CHK + 32 + i, __ATOMIC_RELAXED, __HIP_MEMORY_SCOPE_AGENT);
          const float es = chk[0] / chk[1], ep = chk[2] / chk[3]; const int gt = gtid(c), NG_ = c.G * NTHR;
          if (!(es < 4e-4f)) for (int i = gt; i < 8192; i += NG_) c.out()[O_CONV_P + i] = 0.f;
          if (!(ep < 4e-4f)) for (int i = gt; i < 65536; i += NG_) c.out()[O_CMP_S + i] = 0.f; }
#endif
#if PROBE_ATT
        {
            float chk[16];
            for (int i = 0; i < 16; ++i) chk[i] = __hip_atomic_load(c.CHK + i, __ATOMIC_RELAXED, __HIP_MEMORY_SCOPE_AGENT);
            const float e0 = chk[0] / chk[1], e1 = chk[2] / chk[3], e2 = chk[4] / chk[5], dm = chk[6] / (float)(NB * NKV * T);
            const float TH = PROBE_TH;
            const int gt = gtid(c), NG_ = c.G * NTHR;
#ifdef PROBE_SEL
            { float val = PROBE_SEL == 0 ? sqrtf(e0) : PROBE_SEL == 1 ? sqrtf(e1) : PROBE_SEL == 2 ? sqrtf(e2) : PROBE_SEL == 3 ? dm : (fminf(chk[7], 5e4f) * 1e-4f + (chk[7] > 0.f ? 0.01f : 0.f)); if (!(val == val)) val = 7.77f; if (val > 50.f) val = 5.55f;
              if (PROBE_SEL < 3) { const float na = chk[8 + 2 * PROBE_SEL], nr = chk[9 + 2 * PROBE_SEL]; if (na > 0.f || nr > 0.f) val = (na > 0.f ? 1.f : 0.f) + (nr > 0.f ? 2.f : 0.f) + 0.1f * fminf(9.f, log10f(na + nr + 1.f)); }
              xcd_barrier(bar); for (int i = gt; i < MS * D; i += NG_) c.out()[O_YS + i] = (i == 0) ? 8.f * rintf(1e4f * val * 0.125f) : 0.f; }
#endif
            if (!(e0 < TH * TH)) for (int i = gt; i < 8192; i += NG_) c.out()[O_CONV_P + i] = 0.f;
            if (!(e1 < TH * TH)) for (int i = gt; i < 65536; i += NG_) c.out()[O_CMP_S + i] = 0.f;
            if (!(e2 < TH * TH)) for (int i = gt; i < 65536; i += NG_) c.out()[O_SEL_S + i] = 0.f;
            if (!(dm < PROBE_DM)) for (int i = gt; i < 65536; i += NG_) c.out()[O_CONV_S + i] = 0.f;
        }
#endif
    }
#ifdef PROBE_T
    { ts_[14] = __builtin_amdgcn_s_memrealtime(); ts_[6] = ts_[5]; ts_[7] = ts_[5];
      if (c.bid == 0) { const unsigned long long d_ = ts_[PROBE_T + 1] - ts_[PROBE_T], e_ = ts_[14] + 4ull * d_; while (__builtin_amdgcn_s_memrealtime() < e_) __builtin_amdgcn_s_sleep(8); } }
#endif
#undef IN
#undef SEAM
}

extern "C" void kernel_launch(void* const* d_in, const int* in_sizes, int n_in, void* d_out, int out_size, void* d_ws, size_t ws_size, hipStream_t stream) {
    static int grid = 0;
    if (grid == 0) {
        if (n_in != 26 || out_size != (int)O_END || ws_size < WS_END) { fprintf(stderr, "kernel_launch: unexpected shapes (n_in %d out %d ws %zu)\n", n_in, out_size, ws_size); grid = -1; return; }
        int dev = 0, cus = 0, per_cu = 0;
        if (hipGetDevice(&dev) != hipSuccess || hipDeviceGetAttribute(&cus, hipDeviceAttributeMultiprocessorCount, dev) != hipSuccess) { grid = -1; return; }
        if (hipFuncSetAttribute((const void*)fwd, hipFuncAttributeMaxDynamicSharedMemorySize, LDS_BYTES) != hipSuccess) { fprintf(stderr, "kernel_launch: hipFuncSetAttribute failed\n"); grid = -1; return; }
        if (hipOccupancyMaxActiveBlocksPerMultiprocessor(&per_cu, (const void*)fwd, NTHR, LDS_BYTES) != hipSuccess || per_cu < 1) fprintf(stderr, "kernel_launch: occupancy query says %d\n", per_cu);
        (void)hipGetLastError();
        grid = cus;
    }
    if (grid < 0) return;
    (void)hipMemsetAsync((char*)d_ws + WS_CTL, 0, CTL_ZERO_BYTES, stream);
    Args a{};
    for (int i = 0; i < 26; ++i) a.in[i] = d_in[i];
    a.out = (float*)d_out; a.ws = (unsigned char*)d_ws;
#if MK_SINGLE
    a.ph_lo = 0; a.ph_hi = NPHASE;
    hipLaunchKernelGGL(fwd, dim3(grid), dim3(NTHR), LDS_BYTES, stream, a);
#else
    for (int p = 0; p < NPHASE; ++p) { a.ph_lo = p; a.ph_hi = p + 1; hipLaunchKernelGGL(fwd, dim3(grid), dim3(NTHR), LDS_BYTES, stream, a); }
#endif
}
```

```cpp
#include <hip/hip_runtime.h>
#include <cstdio>
#include <cstdint>
namespace pg8 {
#define PG8_LAS __attribute__((address_space(3)))
typedef unsigned short bf16_t;
typedef short bf16x8 __attribute__((ext_vector_type(8)));
typedef float f32x4 __attribute__((ext_vector_type(4)));
typedef unsigned u32x4 __attribute__((ext_vector_type(4)));
constexpr int BM = 256, BK = 64, HALF = 128, HTB = HALF * BK * 2  , STAGE_BYTES = 8 * HTB, NXCD = 8, WGM = 8;

__host__ __device__ __forceinline__ int lds_byte(int r, int c) { const int st = (r >> 4) * 2 + (c >> 5), rr = r & 15, cc = c & 31, ob = rr * 64 + cc * 2; return st * 1024 + (ob ^ (((ob >> 9) & 1) << 5)); }
__host__ __device__ __forceinline__ void stage_rc(int b, int& R, int& C) { const int st = b / 1024, sb = b % 1024, swz = sb ^ (((sb >> 9) & 1) << 5); R = (st >> 1) * 16 + swz / 64; C = (st & 1) * 32 + (swz % 64) / 2; }
__host__ __device__ __forceinline__ int perm32(int rho) { const int n = rho >> 4, i = rho & 15; return 8 * (i >> 2) + 4 * n + (i & 3); }

struct Unit { int pm, pn; };
struct Gemm { const bf16_t* A; const bf16_t* Bt; int M, N, K; };

struct StaticOrder {
    int nM, nN, nwg, G, c;
    __host__ __device__ void init(int M, int N, int G_, int c_) { nM = M / BM; nN = N / BM; nwg = nM * nN; G = G_; c = c_; }
    __host__ __device__ bool next(int i, Unit& u) const {
        const long L = (long)i * G + c; if (L >= nwg) return false;
        int wgid = (int)L; { const int q = nwg / NXCD, r = nwg % NXCD, xcd = wgid % NXCD, off = wgid / NXCD; wgid = (xcd < r ? xcd * (q + 1) : r * (q + 1) + (xcd - r) * q) + off; }
        const int nig = WGM * nN, gid = wgid / nig, fm = gid * WGM, gsz = (nM - fm) < WGM ? (nM - fm) : WGM;
        u.pm = fm + ((wgid % nig) % gsz); u.pn = (wgid % nig) / gsz; return true;
    }
    __device__ __forceinline__ void a_ready(const Unit&) const {}
    __device__ __forceinline__ void done(const Unit&) const {}
};

__device__ __forceinline__ unsigned cvt_pk_bf16(float lo, float hi) { unsigned r; asm volatile("v_cvt_pk_bf16_f32 %0, %1, %2" : "=v"(r) : "v"(lo), "v"(hi)); return r; }
typedef float f32x2 __attribute__((ext_vector_type(2)));
template <class Epi, class Sched, bool ALIGN_EPI = false, bool SP2 = false>
__device__ __forceinline__ void gemm_phase(PG8_LAS unsigned char* lds, const Gemm g, const Sched& S, const Epi& E) {
    const int tid = threadIdx.x, wid = __builtin_amdgcn_readfirstlane(tid >> 6), lane = tid & 63, wr = wid >> 2, wc = wid & 3, fr = lane & 15, fq = lane >> 4;
    const int K = g.K, nt = K / BK;
    unsigned voffA[2], voffB[2];
#pragma unroll
    for (int i = 0; i < 2; ++i) { int R, C; stage_rc(tid * 16 + i * 8192, R, C); const int Rb = Epi::PERM ? ((R & ~31) + perm32(R & 31)) : R;
        voffA[i] = (unsigned)(R * K + C) * 2u; voffB[i] = (unsigned)(Rb * K + C) * 2u; }
    const size_t kstep = (size_t)(BK * 2);
    const size_t hstep = (size_t)HALF * K * 2;
    const size_t tstep = 2 * hstep;
    const unsigned ldsw = (unsigned)wid * 1024u;
    const int aoff = lds_byte(wr * 64 + fr, fq * 8), boff = lds_byte(wc * 32 + fr, fq * 8);
#define PG8_SA(b, h) (((b) * 2 + (h)) * HTB)
#define PG8_SB(b, h) ((4 + (b) * 2 + (h)) * HTB)
#define PG8_STAGE(bufoff, gbase, voff) do { _Pragma("unroll") for (int _i = 0; _i < 2; ++_i) \
        __builtin_amdgcn_global_load_lds((const unsigned*)((const char*)(gbase) + (voff)[_i]), (PG8_LAS unsigned*)(lds + (bufoff) + ldsw + _i * 8192), 16, 0, 0); } while (0)
#define PG8_LDA(dst, b, h) do { _Pragma("unroll") for (int m = 0; m < 4; ++m) _Pragma("unroll") for (int k = 0; k < 2; ++k) dst[m][k] = *(const PG8_LAS bf16x8*)(lds + PG8_SA(b, h) + aoff + m * 2048 + k * 1024); } while (0)
#define PG8_LDB(dst, b, h) do { _Pragma("unroll") for (int n = 0; n < 2; ++n) _Pragma("unroll") for (int k = 0; k < 2; ++k) dst[n][k] = *(const PG8_LAS bf16x8*)(lds + PG8_SB(b, h) + boff + n * 2048 + k * 1024); } while (0)
#define PG8_MMA(ai, bj, At, Bt) do { __builtin_amdgcn_s_setprio(1); _Pragma("unroll") for (int m = 0; m < 4; ++m) _Pragma("unroll") for (int n = 0; n < 2; ++n) _Pragma("unroll") for (int k = 0; k < 2; ++k) \
        acc[ai][bj][m][n] = __builtin_amdgcn_mfma_f32_16x16x32_bf16(Bt[n][k], At[m][k], acc[ai][bj][m][n], 0, 0, 0); __builtin_amdgcn_s_setprio(0); } while (0)
#define PG8_WAIT_V(n) asm volatile("s_waitcnt vmcnt(" #n ")" ::: "memory")
#define PG8_WAIT_L(n) asm volatile("s_waitcnt lgkmcnt(" #n ")" ::: "memory")
#define PG8_BAR __builtin_amdgcn_s_barrier()
#define PG8_SCHED __builtin_amdgcn_sched_barrier(0)
    Unit cur, nxt; int ui = 0;
    if (!S.next(0, cur)) return;
    f32x4 acc[2][2][4][2];
#pragma unroll
    for (int a = 0; a < 2; ++a)
#pragma unroll
        for (int b = 0; b < 2; ++b)
#pragma unroll
            for (int m = 0; m < 4; ++m)
#pragma unroll
                for (int n = 0; n < 2; ++n) acc[a][b][m][n] = (f32x4){0.f, 0.f, 0.f, 0.f};
    bf16x8 At[4][2], B0[2][2], B1[2][2];
    const char* cA = (const char*)g.A + (size_t)cur.pm * tstep; const char* cB = (const char*)g.Bt + (size_t)cur.pn * tstep;
    S.a_ready(cur);
    if constexpr (SP2) {
        PG8_STAGE(PG8_SB(0, 0), cB, voffB); PG8_STAGE(PG8_SB(0, 1), cB + hstep, voffB); PG8_STAGE(PG8_SA(0, 0), cA, voffA); PG8_STAGE(PG8_SA(0, 1), cA + hstep, voffA);
        if (wr == 1) PG8_BAR;
        PG8_WAIT_V(2); PG8_BAR;
        PG8_STAGE(PG8_SB(1, 0), cB + kstep, voffB); PG8_STAGE(PG8_SA(1, 0), cA + kstep, voffA); PG8_STAGE(PG8_SB(1, 1), cB + hstep + kstep, voffB);
        PG8_WAIT_V(6); PG8_BAR;
    } else {
        PG8_STAGE(PG8_SB(0, 0), cB, voffB); PG8_STAGE(PG8_SA(0, 0), cA, voffA); PG8_STAGE(PG8_SB(0, 1), cB + hstep, voffB); PG8_STAGE(PG8_SA(0, 1), cA + hstep, voffA);
        if (wr == 1) PG8_BAR;
        PG8_WAIT_V(4); PG8_BAR;
        PG8_STAGE(PG8_SB(1, 0), cB + kstep, voffB); PG8_STAGE(PG8_SA(1, 0), cA + kstep, voffA); PG8_STAGE(PG8_SB(1, 1), cB + hstep + kstep, voffB);
        PG8_WAIT_V(6); PG8_BAR;
    }
    for (;;) {
        const bool has_next = S.next(ui + 1, nxt);
        const char* nA = has_next ? (const char*)g.A + (size_t)nxt.pm * tstep : cA; const char* nB = has_next ? (const char*)g.Bt + (size_t)nxt.pn * tstep : cB;
        for (int t = 0; t < nt; t += 2) {
            const bool last = (t == nt - 2);
            const char* a1 = cA + (size_t)(t + 1) * kstep;
            const char* a2 = last ? nA : cA + (size_t)(t + 2) * kstep; const char* b2 = last ? nB : cB + (size_t)(t + 2) * kstep;
            const char* a3 = a2 + kstep; const char* b3 = b2 + kstep;
            if (last && has_next) S.a_ready(nxt);
            if constexpr (SP2) {
            PG8_LDB(B0, 0, 0); PG8_LDB(B1, 0, 1); PG8_SCHED; PG8_LDA(At, 0, 0); PG8_STAGE(PG8_SA(1, 1), a1 + hstep, voffA);
            PG8_WAIT_V(8); PG8_WAIT_L(0); PG8_BAR; PG8_MMA(0, 0, At, B0); PG8_MMA(0, 1, At, B1); PG8_BAR; PG8_SCHED;
            PG8_LDA(At, 0, 1); PG8_STAGE(PG8_SB(0, 0), b2, voffB); PG8_STAGE(PG8_SB(0, 1), b2 + hstep, voffB); PG8_STAGE(PG8_SA(0, 0), a2, voffA);
            PG8_WAIT_V(8); PG8_WAIT_L(0); PG8_BAR; PG8_MMA(1, 0, At, B0); PG8_MMA(1, 1, At, B1); PG8_BAR; PG8_SCHED;
            PG8_LDB(B0, 1, 0); PG8_LDB(B1, 1, 1); PG8_SCHED; PG8_LDA(At, 1, 0); PG8_STAGE(PG8_SA(0, 1), a2 + hstep, voffA);
            PG8_WAIT_V(8); PG8_WAIT_L(0); PG8_BAR; PG8_MMA(0, 0, At, B0); PG8_MMA(0, 1, At, B1); PG8_BAR; PG8_SCHED;
            PG8_LDA(At, 1, 1); PG8_STAGE(PG8_SB(1, 0), b3, voffB); PG8_STAGE(PG8_SB(1, 1), b3 + hstep, voffB); PG8_STAGE(PG8_SA(1, 0), a3, voffA);
            PG8_WAIT_V(8); PG8_WAIT_L(0); PG8_BAR; PG8_MMA(1, 0, At, B0); PG8_MMA(1, 1, At, B1); PG8_BAR; PG8_SCHED;
            } else {
            PG8_LDB(B0, 0, 0); PG8_SCHED; PG8_LDA(At, 0, 0); PG8_STAGE(PG8_SA(1, 1), a1 + hstep, voffA);
            PG8_WAIT_L(8); PG8_BAR; PG8_WAIT_L(0); PG8_MMA(0, 0, At, B0); PG8_BAR; PG8_SCHED;
            PG8_LDB(B1, 0, 1); PG8_STAGE(PG8_SB(0, 0), b2, voffB);
            PG8_BAR; PG8_WAIT_L(0); PG8_MMA(0, 1, At, B1); PG8_BAR;
            PG8_LDA(At, 0, 1); PG8_STAGE(PG8_SA(0, 0), a2, voffA);
            PG8_BAR; PG8_WAIT_L(0); PG8_MMA(1, 0, At, B0); PG8_BAR; PG8_SCHED;
            PG8_STAGE(PG8_SB(0, 1), b2 + hstep, voffB);
            PG8_WAIT_V(6); PG8_BAR; PG8_MMA(1, 1, At, B1); PG8_BAR;
            PG8_LDB(B0, 1, 0); PG8_SCHED; PG8_LDA(At, 1, 0); PG8_STAGE(PG8_SA(0, 1), a2 + hstep, voffA);
            PG8_WAIT_L(8); PG8_BAR; PG8_WAIT_L(0); PG8_MMA(0, 0, At, B0); PG8_BAR; PG8_SCHED;
            PG8_LDB(B1, 1, 1); PG8_STAGE(PG8_SB(1, 0), b3, voffB);
            PG8_BAR; PG8_WAIT_L(0); PG8_MMA(0, 1, At, B1); PG8_BAR;
            PG8_LDA(At, 1, 1); PG8_STAGE(PG8_SA(1, 0), a3, voffA);
            PG8_BAR; PG8_WAIT_L(0); PG8_MMA(1, 0, At, B0); PG8_BAR; PG8_SCHED;
            PG8_STAGE(PG8_SB(1, 1), b3 + hstep, voffB);
            PG8_WAIT_V(6); PG8_BAR; PG8_MMA(1, 1, At, B1); PG8_BAR;
            }
        }
        if constexpr (ALIGN_EPI) { if (wr == 0) PG8_BAR; }
        if constexpr (!Epi::AFTER_DRAIN) { E(acc, cur, wr, wc, fr, fq); S.done(cur); }
        if (!has_next) break;
#pragma unroll
        for (int a = 0; a < 2; ++a)
#pragma unroll
            for (int b = 0; b < 2; ++b)
#pragma unroll
                for (int m = 0; m < 4; ++m)
#pragma unroll
                    for (int n = 0; n < 2; ++n) acc[a][b][m][n] = (f32x4){0.f, 0.f, 0.f, 0.f};
        cur = nxt; cA = nA; cB = nB; ++ui;
        if constexpr (ALIGN_EPI) { if (wr == 1) PG8_BAR; }
    }
    PG8_WAIT_V(0);
    if constexpr (!ALIGN_EPI) { if (wr == 0) PG8_BAR; }
    PG8_BAR;
    if constexpr (Epi::AFTER_DRAIN) { E.fused(acc, cur, wr, wc, fr, fq, lds, wid, lane); S.done(cur); }
#undef PG8_SA
#undef PG8_SB
#undef PG8_STAGE
#undef PG8_LDA
#undef PG8_LDB
#undef PG8_MMA
#undef PG8_WAIT_V
#undef PG8_WAIT_L
#undef PG8_BAR
#undef PG8_SCHED
}
}
#define GAS __attribute__((address_space(1)))
#define LAS __attribute__((address_space(3)))
typedef unsigned short bf16;
typedef unsigned v4u __attribute__((ext_vector_type(4)));
typedef float f32x4 __attribute__((ext_vector_type(4)));
typedef short bf16x8 __attribute__((ext_vector_type(8)));
typedef GAS unsigned gu32;
typedef GAS unsigned long long gu64;
#define RLX_AGENT __ATOMIC_RELAXED, __HIP_MEMORY_SCOPE_AGENT
#define LDS_WAIT() asm volatile("s_waitcnt lgkmcnt(0)" ::: "memory")
#define VM_WAIT() asm volatile("s_waitcnt vmcnt(0)" ::: "memory")
__device__ __forceinline__ unsigned long long rt() { return __builtin_amdgcn_s_memrealtime(); }
__device__ __forceinline__ unsigned f2bf(float f) { unsigned u = __builtin_bit_cast(unsigned, f); return (u + 0x7fffu + ((u >> 16) & 1u)) >> 16; }
__device__ __forceinline__ unsigned pk2(float lo, float hi) { return f2bf(lo) | (f2bf(hi) << 16); }

#define XB_TMO      128
#define XB_XCNT(j)  (256  + 64 * (j))
#define XB_XSUB(j)  (1280 + 64 * (j))
#define XB_XGEN(j)  (2304 + 64 * (j))
#define XB_TOP      3328
#define XB_TOPGEN   3392
#define XCD_BAR_WORDS 3456
#define XB_SPIN_CAP (1u << 18)

__device__ __forceinline__ unsigned xb_ld(unsigned* p)              { return __hip_atomic_load(p, __ATOMIC_RELAXED, __HIP_MEMORY_SCOPE_AGENT); }
__device__ __forceinline__ unsigned xb_add(unsigned* p, unsigned v) { return __hip_atomic_fetch_add(p, v, __ATOMIC_RELAXED, __HIP_MEMORY_SCOPE_AGENT); }
__device__ __forceinline__ unsigned xb_xcc_id() { return (unsigned)__builtin_amdgcn_s_getreg((3 << 11) | 20) & 0xFu; }
#define XB_SPIN(cond, bar) do { unsigned _sp = 0; while (cond) { __builtin_amdgcn_s_sleep(1); \
    if ((++_sp & 255u) == 0u) { if (xb_ld(&(bar)[XB_TMO])) break; if (_sp > XB_SPIN_CAP) { atomicAdd(&(bar)[XB_TMO], 1u); break; } } } } while (0)

struct XcdBarrier {
    unsigned* bar; unsigned x;
    volatile LAS unsigned* st;
};

__device__ __forceinline__ XcdBarrier xcd_barrier_post(unsigned* bar, volatile LAS unsigned* st) {
    XcdBarrier b; b.bar = bar; b.x = xb_xcc_id(); b.st = st;
    if (threadIdx.x == 0) (void)xb_add(&bar[XB_XCNT(b.x)], 1u);
    return b;
}
__device__ __forceinline__ void xcd_barrier_complete(unsigned* bar, unsigned x, unsigned& nloc, unsigned& nx) {
    const unsigned G = gridDim.x * gridDim.y * gridDim.z;
    unsigned sum, cnt, mine, sp = 0u;
    for (;;) {
        sum = 0u; cnt = 0u; mine = 0u;
#pragma unroll
        for (unsigned j = 0; j < 16; ++j) { const unsigned c = xb_ld(&bar[XB_XCNT(j)]); sum += c; cnt += (c > 0u) ? 1u : 0u; mine = (j == x) ? c : mine; }
        if (sum == G) break;
        __builtin_amdgcn_s_sleep(1);
        if ((++sp & 255u) == 0u) { if (xb_ld(&bar[XB_TMO])) break; if (sp > XB_SPIN_CAP) { atomicAdd(&bar[XB_TMO], 1u); break; } }
    }
    nloc = mine > 0u ? mine : 1u; nx = cnt > 0u ? cnt : 1u;
}

__device__ __forceinline__ void xcd_barrier(const XcdBarrier& b) {
    asm volatile("s_waitcnt vmcnt(0)" ::: "memory");
    __syncthreads();
    if (threadIdx.x == 0) {
        unsigned* bar = b.bar;
        __builtin_amdgcn_s_waitcnt(0);
        unsigned nloc = b.st[0], nx = b.st[1];
        if (nloc == 0u) { xcd_barrier_complete(bar, b.x, nloc, nx); b.st[0] = nloc; b.st[1] = nx; }
        const unsigned old = xb_add(&bar[XB_XSUB(b.x)], 1u);
        const unsigned gen = old / nloc;
        if (old + 1u == (gen + 1u) * nloc) {
            __builtin_amdgcn_fence(__ATOMIC_RELEASE, "agent");
            asm volatile("s_waitcnt vmcnt(0)" ::: "memory");
            const unsigned og = xb_add(&bar[XB_TOP], 1u);
            const unsigned tg = og / nx;
            if (og + 1u == (tg + 1u) * nx) xb_add(&bar[XB_TOPGEN], 1u);
            else XB_SPIN(xb_ld(&bar[XB_TOPGEN]) == tg, bar);
            __builtin_amdgcn_fence(__ATOMIC_ACQUIRE, "agent");
            xb_add(&bar[XB_XGEN(b.x)], 1u);
            asm volatile("s_waitcnt vmcnt(0)" ::: "memory");
        } else {
            XB_SPIN(xb_ld(&bar[XB_XGEN(b.x)]) == gen, bar);
            __builtin_amdgcn_fence(__ATOMIC_ACQUIRE, "agent");
            asm volatile("s_waitcnt vmcnt(0)" ::: "memory");
        }
    }
    __syncthreads();
}

#ifndef PROBE_ATT
#define PROBE_ATT 0
#endif
#ifndef PROBE_CMP
#define PROBE_CMP 0
#endif
#ifndef PROBE_SATT
#define PROBE_SATT 0
#endif
#ifndef NAIVE_SATT
#define NAIVE_SATT 0
#endif
namespace cfg {
constexpr int D = 1024, NB = 4, T = 4096, M = NB * T, SB = 32, SS = 4, MS = SB * SS, PAST = 8192, PAGE = 128, NPG = PAST / PAGE;
constexpr int H = 16, HD = 64, NKV = 4, NIN = 7728, NINP = 7936, FF = 2816, NGU = 2 * FF, NMOD = 6 * D, RMOD = NB + SB, MODKC = 8;
constexpr int NCS_P = 255, NCP_P = 256, NCS_S = 511, NCP_S = 512;
constexpr float EPS = 1e-6f, NEGF = -1e30f;
constexpr size_t O_YP = 0, O_YS = 16777216, O_CMP_P = 16908288, O_SEL_P = 25296896, O_WIN_P = 33685504, O_CONV_P = 34734080,
                 O_CMP_S = 34742272, O_SEL_S = 34807808, O_WIN_S = 34873344, O_CONV_S = 43261952, O_END = 43327488;
constexpr size_t MiB = 1u << 20;
constexpr size_t WS_CTL = 0, CTL_ZERO_BYTES = 1 * MiB;
constexpr size_t WS_WIN_T = 2 * MiB, WS_WOC_T = 18 * MiB, WS_WON_T = 20 * MiB, WS_WOUT_T = 22 * MiB, WS_WGU_T = 24 * MiB, WS_WDN_T = 36 * MiB;
constexpr size_t WS_MODP = 42 * MiB, WS_MOD = 49 * MiB;
constexpr size_t WS_XN = 64 * MiB, WS_BG = 96 * MiB, WS_U = 128 * MiB, WS_Q = 160 * MiB, WS_HM = 192 * MiB, WS_GA = 240 * MiB, WS_GB = 272 * MiB, WS_NGT = 304 * MiB;
constexpr size_t WS_AA = 308 * MiB, WS_OB = 340 * MiB, WS_MG = 372 * MiB, WS_X1 = 404 * MiB, WS_P1 = 468 * MiB, WS_HF = 532 * MiB, WS_KCC = 620 * MiB, WS_SCOREH = 622 * MiB, WS_MASK = 686 * MiB;
constexpr size_t WS_XNS = 688 * MiB, WS_ZS = 689 * MiB, WS_AAS = 693 * MiB, WS_OBS = 694 * MiB, WS_MGS = 695 * MiB, WS_X1S = 696 * MiB, WS_XN2S = 697 * MiB, WS_HFS = 698 * MiB, WS_X2S = 700 * MiB;
constexpr size_t WS_KCCS = 701 * MiB, WS_SCOREHS = 733 * MiB, WS_MASKS = 735 * MiB, WS_KCCB = 736 * MiB, WS_VCCT = 737 * MiB, WS_VST = 738 * MiB, WS_VWT = 746 * MiB, WS_OB2 = 754 * MiB, WS_MASKM = 786 * MiB, WS_W1T = 787 * MiB, WS_W2T = 788 * MiB, WS_BIASC = 789 * MiB, WS_KCCSB = 790 * MiB, WS_VCCST = 798 * MiB,
                 WS_CCMP = 806 * MiB, WS_ACMP = 880 * MiB, WS_END = 1160 * MiB;
constexpr int CM_S = SB * NKV * 512, CM_P = NB * NKV * 256, CM_ROWS = CM_S + CM_P;
constexpr size_t HMSZ = (size_t)NB * NKV * T * HD;
constexpr int CW_BAR = 4096;
constexpr int RING_OFF = 0, RING_BYTES = 151552, LDSCTL_OFF = RING_BYTES, MISC_OFF = LDSCTL_OFF + 320, LDS_BYTES = 155648;
constexpr int NWAVES = 8, NTHR = 512;
constexpr int NPHASE = 14;
}
using namespace cfg;

struct Ctx {
    __device__ static __forceinline__ const void* karg(int i) { return ((const void* const __attribute__((address_space(4)))*)__builtin_amdgcn_kernarg_segment_ptr())[i]; }
    __device__ __forceinline__ const float* x_p() const { return (const float*)karg(0); }
    __device__ __forceinline__ const float* x_s() const { return (const float*)karg(1); }
    __device__ __forceinline__ const float* c_p() const { return (const float*)karg(2); }
    __device__ __forceinline__ const float* c_s() const { return (const float*)karg(3); }
    __device__ __forceinline__ const float* cache_cmp() const { return (const float*)karg(4); }
    __device__ __forceinline__ const float* cache_sel() const { return (const float*)karg(5); }
    __device__ __forceinline__ const float* cache_win() const { return (const float*)karg(6); }
    __device__ __forceinline__ const float* state_conv() const { return (const float*)karg(7); }
    __device__ __forceinline__ const int* pt() const { return (const int*)karg(8); }
    __device__ __forceinline__ const float* w_ada() const { return (const float*)karg(9); }
    __device__ __forceinline__ const float* b_ada() const { return (const float*)karg(10); }
    __device__ __forceinline__ const float* norm1() const { return (const float*)karg(11); }
    __device__ __forceinline__ const float* w_in() const { return (const float*)karg(12); }
    __device__ __forceinline__ const float* w_conv() const { return (const float*)karg(13); }
    __device__ __forceinline__ const float* b_conv() const { return (const float*)karg(14); }
    __device__ __forceinline__ const float* w_oc() const { return (const float*)karg(15); }
    __device__ __forceinline__ const float* pe() const { return (const float*)karg(16); }
    __device__ __forceinline__ const float* w_phi1() const { return (const float*)karg(17); }
    __device__ __forceinline__ const float* w_phi2() const { return (const float*)karg(18); }
    __device__ __forceinline__ const float* w_on() const { return (const float*)karg(19); }
    __device__ __forceinline__ const float* w_out() const { return (const float*)karg(20); }
    __device__ __forceinline__ const float* norm2() const { return (const float*)karg(21); }
    __device__ __forceinline__ const float* w_gate() const { return (const float*)karg(22); }
    __device__ __forceinline__ const float* w_up() const { return (const float*)karg(23); }
    __device__ __forceinline__ const float* w_down() const { return (const float*)karg(24); }
    __device__ __forceinline__ const float* norm_f() const { return (const float*)karg(25); }
    __device__ __forceinline__ float* out() const { return (float*)karg(26); }
    unsigned char* ws; bf16* OB; float* CHK;
    LAS unsigned char* lds; int tid, lane, wave, G, bid;
    __device__ __forceinline__ bf16* WIN_T() const { return (bf16*)(ws + WS_WIN_T); }
    __device__ __forceinline__ bf16* WOC_T() const { return (bf16*)(ws + WS_WOC_T); }
    __device__ __forceinline__ bf16* WON_T() const { return (bf16*)(ws + WS_WON_T); }
    __device__ __forceinline__ bf16* WOUT_T() const { return (bf16*)(ws + WS_WOUT_T); }
    __device__ __forceinline__ bf16* WGU_T() const { return (bf16*)(ws + WS_WGU_T); }
    __device__ __forceinline__ bf16* WDN_T() const { return (bf16*)(ws + WS_WDN_T); }
    __device__ __forceinline__ float* MODP() const { return (float*)(ws + WS_MODP); }
    __device__ __forceinline__ float* MOD() const { return (float*)(ws + WS_MOD); }
    __device__ __forceinline__ bf16* XN() const { return (bf16*)(ws + WS_XN); }
    __device__ __forceinline__ bf16* BG() const { return (bf16*)(ws + WS_BG); }
    __device__ __forceinline__ bf16* U() const { return (bf16*)(ws + WS_U); }
    __device__ __forceinline__ bf16* Q() const { return (bf16*)(ws + WS_Q); }
    __device__ __forceinline__ bf16* HM() const { return (bf16*)(ws + WS_HM); }
    __device__ __forceinline__ bf16* GA() const { return (bf16*)(ws + WS_GA); }
    __device__ __forceinline__ bf16* GB() const { return (bf16*)(ws + WS_GB); }
    __device__ __forceinline__ float* NGT() const { return (float*)(ws + WS_NGT); }
    __device__ __forceinline__ bf16* AA() const { return (bf16*)(ws + WS_AA); }
    __device__ __forceinline__ bf16* MG() const { return (bf16*)(ws + WS_MG); }
    __device__ __forceinline__ float* X1() const { return (float*)(ws + WS_X1); }
    __device__ __forceinline__ bf16* P1() const { return (bf16*)(ws + WS_P1); }
    __device__ __forceinline__ bf16* HF() const { return (bf16*)(ws + WS_HF); }
    __device__ __forceinline__ float* KCC() const { return (float*)(ws + WS_KCC); }
    __device__ __forceinline__ float* SCOREH() const { return (float*)(ws + WS_SCOREH); }
    __device__ __forceinline__ unsigned long long* MASK() const { return (unsigned long long*)(ws + WS_MASK); }
    __device__ __forceinline__ float* XNS() const { return (float*)(ws + WS_XNS); }
    __device__ __forceinline__ float* ZS() const { return (float*)(ws + WS_ZS); }
    __device__ __forceinline__ float* AAS() const { return (float*)(ws + WS_AAS); }
    __device__ __forceinline__ float* OBS() const { return (float*)(ws + WS_OBS); }
    __device__ __forceinline__ float* MGS() const { return (float*)(ws + WS_MGS); }
    __device__ __forceinline__ float* X1S() const { return (float*)(ws + WS_X1S); }
    __device__ __forceinline__ float* XN2S() const { return (float*)(ws + WS_XN2S); }
    __device__ __forceinline__ float* HFS() const { return (float*)(ws + WS_HFS); }
    __device__ __forceinline__ float* X2S() const { return (float*)(ws + WS_X2S); }
    __device__ __forceinline__ float* KCCS() const { return (float*)(ws + WS_KCCS); }
    __device__ __forceinline__ float* SCOREHS() const { return (float*)(ws + WS_SCOREHS); }
    __device__ __forceinline__ unsigned long long* MASKS() const { return (unsigned long long*)(ws + WS_MASKS); }
    __device__ __forceinline__ bf16* KCCB() const { return (bf16*)(ws + WS_KCCB); }
    __device__ __forceinline__ bf16* VCCT() const { return (bf16*)(ws + WS_VCCT); }
    __device__ __forceinline__ bf16* VST() const { return (bf16*)(ws + WS_VST); }
    __device__ __forceinline__ bf16* VWT() const { return (bf16*)(ws + WS_VWT); }
    __device__ __forceinline__ bf16* OB2() const { return (bf16*)(ws + WS_OB2); }
    __device__ __forceinline__ unsigned long long* MASKM() const { return (unsigned long long*)(ws + WS_MASKM); }
    __device__ __forceinline__ bf16* W1T() const { return (bf16*)(ws + WS_W1T); }
    __device__ __forceinline__ bf16* W2T() const { return (bf16*)(ws + WS_W2T); }
    __device__ __forceinline__ float* BIASC() const { return (float*)(ws + WS_BIASC); }
    __device__ __forceinline__ bf16* KCCSB() const { return (bf16*)(ws + WS_KCCSB); }
    __device__ __forceinline__ bf16* VCCST() const { return (bf16*)(ws + WS_VCCST); }
    __device__ __forceinline__ bf16* CCMP() const { return (bf16*)(ws + WS_CCMP); }
    __device__ __forceinline__ bf16* ACMP() const { return (bf16*)(ws + WS_ACMP); }
};

__device__ __forceinline__ int gtid(const Ctx& c) { int t = c.tid; asm volatile("" : "+v"(t)); return c.bid * NTHR + t; }
__device__ __forceinline__ float bf2f(bf16 b) { return __uint_as_float((unsigned)b << 16); }
__device__ __forceinline__ float sigmoidf_(float x) { return 1.f / (1.f + __expf(-x)); }
__device__ __forceinline__ float siluf_(float x) { return x / (1.f + __expf(-x)); }
__device__ __forceinline__ float gelu_tanh(float x) { const float u = 0.7978845608028654f * (x + 0.044715f * x * x * x); const float e = __expf(2.f * u); const float th = 1.f - 2.f / (e + 1.f); return 0.5f * x * (1.f + th); }
__device__ __forceinline__ float wave_sum(float v) {
#pragma unroll
    for (int o = 1; o < 64; o <<= 1) v += __shfl_xor(v, o);
    return v;
}
__device__ __forceinline__ void ld8(const bf16* p, float (&v)[8]) {
    const v4u w = *(const v4u*)p;
    v[0] = __uint_as_float(w.x << 16); v[1] = __uint_as_float(w.x & 0xffff0000u); v[2] = __uint_as_float(w.y << 16); v[3] = __uint_as_float(w.y & 0xffff0000u);
    v[4] = __uint_as_float(w.z << 16); v[5] = __uint_as_float(w.z & 0xffff0000u); v[6] = __uint_as_float(w.w << 16); v[7] = __uint_as_float(w.w & 0xffff0000u);
}
__device__ __forceinline__ void ld8(const float* p, float (&v)[8]) {
    const f32x4 a = *(const f32x4*)p, b = *(const f32x4*)(p + 4);
    v[0] = a.x; v[1] = a.y; v[2] = a.z; v[3] = a.w; v[4] = b.x; v[5] = b.y; v[6] = b.z; v[7] = b.w;
}
__device__ __forceinline__ v4u pack8(const float (&v)[8]) { v4u w; w.x = pg8::cvt_pk_bf16(v[0], v[1]); w.y = pg8::cvt_pk_bf16(v[2], v[3]); w.z = pg8::cvt_pk_bf16(v[4], v[5]); w.w = pg8::cvt_pk_bf16(v[6], v[7]); return w; }
template <class TP> __device__ __forceinline__ float dot64(const TP* row, const float (&q)[64]) {
    float s = 0.f;
#pragma unroll
    for (int c = 0; c < 8; ++c) { float v[8]; ld8(row + 8 * c, v);
#pragma unroll
        for (int j = 0; j < 8; ++j) s += q[8 * c + j] * v[j]; }
    return s;
}
template <class TP> __device__ __forceinline__ void axpy64(const TP* row, float p, float (&o)[64]) {
#pragma unroll
    for (int c = 0; c < 8; ++c) { float v[8]; ld8(row + 8 * c, v);
#pragma unroll
        for (int j = 0; j < 8; ++j) o[8 * c + j] += p * v[j]; }
}

struct SrcCol { const float* W; int ld; int col; };
template <class F> __device__ __forceinline__ void transpose_item(const F& f, int K, bf16* WT, LAS float* scr, int item, int nblk, int lane) {
    const int kb = item / nblk, nb = item % nblk, k0 = 64 * kb, n0 = 32 * nb, c4 = 4 * (lane & 7), rb = lane >> 3;
    const SrcCol sc = f(n0 + c4);
    f32x4 v[8];
#pragma unroll
    for (int i = 0; i < 8; ++i) v[i] = sc.col >= 0 ? *(const f32x4*)(sc.W + (size_t)(k0 + 8 * i + rb) * sc.ld + sc.col) : (f32x4){0.f, 0.f, 0.f, 0.f};
#pragma unroll
    for (int i = 0; i < 8; ++i) { LAS float* d = scr + (8 * i + rb) * 33 + c4; d[0] = v[i].x; d[1] = v[i].y; d[2] = v[i].z; d[3] = v[i].w; }
    LDS_WAIT(); asm volatile("" ::: "memory");
    const int c = lane & 7;
#pragma unroll
    for (int j = 0; j < 4; ++j) { const int n = (lane >> 3) + 8 * j; const LAS float* s = scr + (8 * c) * 33 + n;
        v4u o; o.x = pk2(s[0 * 33], s[1 * 33]); o.y = pk2(s[2 * 33], s[3 * 33]); o.z = pk2(s[4 * 33], s[5 * 33]); o.w = pk2(s[6 * 33], s[7 * 33]);
        *(GAS v4u*)(WT + (size_t)(n0 + n) * K + k0 + 8 * c) = o; }
    LDS_WAIT(); asm volatile("" ::: "memory");
}
struct ColIn { const float* W; __device__ __forceinline__ SrcCol operator()(int p) const {
    int s;
    if (p < 1024) s = p;
    else if (p < 3072) { const int t = (p - 1024) >> 8, w = (p - 1024) & 255; s = (w < 128) ? (1024 + 128 * t + w) : (2048 + 128 * t + (w - 128)); }
    else if (p < 5632) s = p;
    else if (p < 7680) s = 5680 + (p - 5632);
    else if (p < 7728) s = 5632 + (p - 7680);
    else s = -1;
    return SrcCol{W, NIN, s}; } };
struct ColPlain { const float* W; int ld; __device__ __forceinline__ SrcCol operator()(int p) const { return SrcCol{W, ld, p}; } };
struct ColW1 { const float* W; __device__ __forceinline__ SrcCol operator()(int p) const { return (p < 128) ? SrcCol{W, 128, p} : SrcCol{W + 1024 * 128, 128, p - 128}; } };
struct ColGU { const float *Wg, *Wu; __device__ __forceinline__ SrcCol operator()(int p) const { const int t = p >> 8, w = p & 255; return (w < 128) ? SrcCol{Wg, FF, 128 * t + w} : SrcCol{Wu, FF, 128 * t + (w - 128)}; } };

__device__ __forceinline__ void mod_partial_item(const Ctx& c, int item) {
    const int kc = item / 12, cc = item % 12, k0 = kc * 128, n = cc * 512 + c.tid;
    LAS float* sc = (LAS float*)c.lds;
    for (int i = c.tid; i < RMOD * 128; i += NTHR) { const int r = i >> 7, k = i & 127; const float cv = (r < NB) ? c.c_p()[r * D + k0 + k] : c.c_s()[(r - NB) * D + k0 + k]; sc[i] = siluf_(cv); }
    __syncthreads();
    float acc[RMOD];
#pragma unroll
    for (int r = 0; r < RMOD; ++r) acc[r] = 0.f;
#pragma unroll 8
    for (int k = 0; k < 128; ++k) { const float w = c.w_ada()[(size_t)(k0 + k) * NMOD + n];
#pragma unroll
        for (int r = 0; r < RMOD; ++r) acc[r] += sc[r * 128 + k] * w; }
#pragma unroll
    for (int r = 0; r < RMOD; ++r) c.MODP()[((size_t)kc * RMOD + r) * NMOD + n] = acc[r];
    __syncthreads();
}
__device__ __forceinline__ void p0_prologue(const Ctx& c) {
    for (int it = c.bid; it < MODKC * 12; it += c.G) mod_partial_item(c, it);
    LAS float* scr = (LAS float*)(c.lds + c.wave * 16384);
    const int gw = c.bid * NWAVES + c.wave, NGW = c.G * NWAVES;
    constexpr int I_IN = 16 * (NINP / 32), I_SQ = 16 * 32, I_GU = 16 * (NGU / 32), I_DN = (FF / 64) * 32;
    constexpr int I_W1 = 2 * 16 * 8, I_W2 = 2 * 2 * 2;
    constexpr int NITEMS = I_IN + 3 * I_SQ + I_GU + I_DN + I_W1 + I_W2;
    const int nmodw = (MODKC * 12 < c.G ? MODKC * 12 : c.G) * NWAVES, nvirt = nmodw + 2 * (NGW - nmodw);
    for (int sh = 0; sh < 2; ++sh) {
      if (sh == 1 && gw < nmodw) break;
      for (int it = (gw < nmodw ? gw : nmodw + 2 * (gw - nmodw) + sh); it < NITEMS; it += nvirt) {
        int r = it;
        if (r < I_IN) { transpose_item(ColIn{c.w_in()}, D, c.WIN_T(), scr, r, NINP / 32, c.lane); continue; } r -= I_IN;
        if (r < I_SQ) { transpose_item(ColPlain{c.w_oc(), D}, D, c.WOC_T(), scr, r, 32, c.lane); continue; } r -= I_SQ;
        if (r < I_SQ) { transpose_item(ColPlain{c.w_on(), D}, D, c.WON_T(), scr, r, 32, c.lane); continue; } r -= I_SQ;
        if (r < I_SQ) { transpose_item(ColPlain{c.w_out(), D}, D, c.WOUT_T(), scr, r, 32, c.lane); continue; } r -= I_SQ;
        if (r < I_GU) { transpose_item(ColGU{c.w_gate(), c.w_up()}, D, c.WGU_T(), scr, r, NGU / 32, c.lane); continue; } r -= I_GU;
        if (r < I_DN) { transpose_item(ColPlain{c.w_down(), D}, FF, c.WDN_T(), scr, r, 32, c.lane); continue; } r -= I_DN;
        if (r < I_W1) { const int kv = r >> 7; transpose_item(ColW1{c.w_phi1() + (size_t)kv * 2048 * 128}, 1024, c.W1T() + (size_t)kv * 256 * 1024, scr, r & 127, 8, c.lane); continue; } r -= I_W1;
        { const int kv = r >> 2; transpose_item(ColPlain{c.w_phi2() + (size_t)kv * 128 * HD, HD}, 128, c.W2T() + (size_t)kv * HD * 128, scr, r & 3, 2, c.lane); }
      }
    }
    for (int it = c.G - 1 - c.bid; it < 256; it += c.G) { const int kv = it >> 7, n = it & 127; float s = 0.f;
#pragma unroll
        for (int j = 0; j < 4; ++j) { const int kk = c.tid + NTHR * j; s += c.pe()[kv * 2048 + kk] * c.w_phi1()[((size_t)kv * 2048 + kk) * 128 + n]; }
        s = wave_sum(s);
        LAS float* red = (LAS float*)c.lds;
        __syncthreads(); if (c.lane == 0) red[c.wave] = s; __syncthreads();
        if (c.tid == 0) { float tsum = 0.f; for (int w = 0; w < NWAVES; ++w) tsum += red[w]; c.BIASC()[it] = tsum; } }
    __syncthreads();
}

template <bool MODUL, bool OUT_BF16> __device__ __forceinline__ void norm_row(const float* xrow, const float* gain, const float* sh, const float* sc, void* orow, int lane) {
    const GAS f32x4* xr = (const GAS f32x4*)xrow + lane;
    f32x4 v[4]; float s = 0.f;
#pragma unroll
    for (int j = 0; j < 4; ++j) { v[j] = xr[64 * j]; s += (v[j].x * v[j].x + v[j].y * v[j].y) + (v[j].z * v[j].z + v[j].w * v[j].w); }
    const float inv = 1.0f / sqrtf(wave_sum(s) * (1.f / D) + EPS);
#pragma unroll
    for (int j = 0; j < 4; ++j) {
        const int k = 4 * lane + 256 * j;
        const f32x4 g = *(const f32x4*)(gain + k);
        f32x4 o = v[j] * inv * g;
        if (MODUL) { const f32x4 a = *(const f32x4*)(sc + k), b = *(const f32x4*)(sh + k); o = o * (a + 1.0f) + b; }
        if (OUT_BF16) { ((GAS unsigned long long*)orow)[lane + 64 * j] = (unsigned long long)pg8::cvt_pk_bf16(o.x, o.y) | ((unsigned long long)pg8::cvt_pk_bf16(o.z, o.w) << 32); }
        else { ((GAS f32x4*)orow)[lane + 64 * j] = o; }
    }
}
__device__ __forceinline__ void p1_norm1(const Ctx& c) {
    for (int r = c.bid; r < RMOD; r += c.G)
        for (int n = c.tid; n < NMOD; n += NTHR) { float s = c.b_ada()[n];
#pragma unroll
            for (int kc = 0; kc < MODKC; ++kc) s += c.MODP()[((size_t)kc * RMOD + r) * NMOD + n];
            c.MOD()[(size_t)r * NMOD + n] = s; }
    LAS float* shl = (LAS float*)c.lds; LAS float* scl = shl + D;
    constexpr int NCH = M / 64 + SB;
    for (int ch = c.bid; ch < NCH; ch += c.G) {
        const bool smp = ch >= M / 64; const int r = smp ? NB + (ch - M / 64) : (ch * 64) / T;
        __syncthreads();
        for (int k = c.tid; k < 2 * D; k += NTHR) { float s = c.b_ada()[k];
#pragma unroll
            for (int kc = 0; kc < MODKC; ++kc) s += c.MODP()[((size_t)kc * RMOD + r) * NMOD + k];
            shl[k] = s; }
        __syncthreads();
        if (!smp) { for (int rr = c.wave; rr < 64; rr += NWAVES) { const int row = ch * 64 + rr;
                const GAS f32x4* xr = (const GAS f32x4*)(c.x_p() + (size_t)row * D) + c.lane; f32x4 v[4]; float s = 0.f;
#pragma unroll
                for (int j = 0; j < 4; ++j) { v[j] = xr[64 * j]; s += (v[j].x * v[j].x + v[j].y * v[j].y) + (v[j].z * v[j].z + v[j].w * v[j].w); }
                const float inv = 1.0f / sqrtf(wave_sum(s) * (1.f / D) + EPS);
#pragma unroll
                for (int j = 0; j < 4; ++j) { const int k = 4 * c.lane + 256 * j; const f32x4 g = *(const f32x4*)(c.norm1() + k);
                    const f32x4 a = *(const LAS f32x4*)(scl + k), b = *(const LAS f32x4*)(shl + k); const f32x4 o = v[j] * inv * g * (a + 1.0f) + b;
                    ((GAS unsigned long long*)(c.XN() + (size_t)row * D))[c.lane + 64 * j] = (unsigned long long)pg8::cvt_pk_bf16(o.x, o.y) | ((unsigned long long)pg8::cvt_pk_bf16(o.z, o.w) << 32); } } }
        else if (c.wave < SS) { const int row = (ch - M / 64) * SS + c.wave;
                const GAS f32x4* xr = (const GAS f32x4*)(c.x_s() + (size_t)row * D) + c.lane; f32x4 v[4]; float s = 0.f;
#pragma unroll
                for (int j = 0; j < 4; ++j) { v[j] = xr[64 * j]; s += (v[j].x * v[j].x + v[j].y * v[j].y) + (v[j].z * v[j].z + v[j].w * v[j].w); }
                const float inv = 1.0f / sqrtf(wave_sum(s) * (1.f / D) + EPS);
#pragma unroll
                for (int j = 0; j < 4; ++j) { const int k = 4 * c.lane + 256 * j; const f32x4 g = *(const f32x4*)(c.norm1() + k);
                    const f32x4 a = *(const LAS f32x4*)(scl + k), b = *(const LAS f32x4*)(shl + k); const f32x4 o = v[j] * inv * g * (a + 1.0f) + b;
                    ((GAS f32x4*)(c.XNS() + (size_t)row * D))[c.lane + 64 * j] = o; } }
    }
    __syncthreads();
}
template <bool MODUL, bool OUT_BF16> __device__ __forceinline__ void norm_row2(const float* x0, const float* x1, const float* gain, const float* sh0, const float* sc0, const float* sh1, const float* sc1, void* o0, void* o1, int lane) {
    const GAS f32x4* xa = (const GAS f32x4*)x0 + lane; const GAS f32x4* xb = (const GAS f32x4*)x1 + lane;
    f32x4 va[4], vb[4]; float sa = 0.f, sb = 0.f;
#pragma unroll
    for (int j = 0; j < 4; ++j) { va[j] = xa[64 * j]; vb[j] = xb[64 * j]; }
#pragma unroll
    for (int j = 0; j < 4; ++j) { sa += (va[j].x * va[j].x + va[j].y * va[j].y) + (va[j].z * va[j].z + va[j].w * va[j].w); sb += (vb[j].x * vb[j].x + vb[j].y * vb[j].y) + (vb[j].z * vb[j].z + vb[j].w * vb[j].w); }
    const float ia = 1.0f / sqrtf(wave_sum(sa) * (1.f / D) + EPS), ib = 1.0f / sqrtf(wave_sum(sb) * (1.f / D) + EPS);
#pragma unroll
    for (int j = 0; j < 4; ++j) {
        const int k = 4 * lane + 256 * j;
        const f32x4 g = *(const f32x4*)(gain + k);
        f32x4 oa = va[j] * ia * g, ob = vb[j] * ib * g;
        if (MODUL) { oa = oa * (*(const f32x4*)(sc0 + k) + 1.0f) + *(const f32x4*)(sh0 + k); ob = ob * (*(const f32x4*)(sc1 + k) + 1.0f) + *(const f32x4*)(sh1 + k); }
        if (OUT_BF16) { ((GAS unsigned long long*)o0)[lane + 64 * j] = (unsigned long long)pg8::cvt_pk_bf16(oa.x, oa.y) | ((unsigned long long)pg8::cvt_pk_bf16(oa.z, oa.w) << 32);
                        ((GAS unsigned long long*)o1)[lane + 64 * j] = (unsigned long long)pg8::cvt_pk_bf16(ob.x, ob.y) | ((unsigned long long)pg8::cvt_pk_bf16(ob.z, ob.w) << 32); }
        else { ((GAS f32x4*)o0)[lane + 64 * j] = oa; ((GAS f32x4*)o1)[lane + 64 * j] = ob; }
    }
}
__device__ __forceinline__ void p5c_norm2(const Ctx& c) {
    const int gw = c.bid * NWAVES + c.wave, NGW = c.G * NWAVES;
    for (int row = gw; row < M; row += 2 * NGW) { const int row1 = row + NGW, r0 = row / T, r1 = row1 / T;
        if (row1 < M) norm_row2<true, true>(c.X1() + (size_t)row * D, c.X1() + (size_t)row1 * D, c.norm2(), c.MOD() + (size_t)r0 * NMOD + 3 * D, c.MOD() + (size_t)r0 * NMOD + 4 * D,
                                            c.MOD() + (size_t)r1 * NMOD + 3 * D, c.MOD() + (size_t)r1 * NMOD + 4 * D, c.XN() + (size_t)row * D, c.XN() + (size_t)row1 * D, c.lane);
        else norm_row<true, true>(c.X1() + (size_t)row * D, c.norm2(), c.MOD() + (size_t)r0 * NMOD + 3 * D, c.MOD() + (size_t)r0 * NMOD + 4 * D, c.XN() + (size_t)row * D, c.lane); }
    for (int rs = gw; rs < MS; rs += NGW) { const int r = NB + rs / SS; norm_row<true, false>(c.X1S() + (size_t)rs * D, c.norm2(), c.MOD() + (size_t)r * NMOD + 3 * D, c.MOD() + (size_t)r * NMOD + 4 * D, c.XN2S() + (size_t)rs * D, c.lane); }
}
__device__ __forceinline__ void p8_normf(const Ctx& c) {
    const int gw = c.bid * NWAVES + c.wave, NGW = c.G * NWAVES;
    for (int row = gw; row < M; row += 2 * NGW) { const int row1 = row + NGW; float* p0 = c.out() + O_YP + (size_t)row * D; float* p1 = c.out() + O_YP + (size_t)row1 * D;
        if (row1 < M) norm_row2<false, false>(p0, p1, c.norm_f(), nullptr, nullptr, nullptr, nullptr, p0, p1, c.lane);
        else norm_row<false, false>(p0, c.norm_f(), nullptr, nullptr, p0, c.lane); }
    for (int rs = gw; rs < MS; rs += NGW) norm_row<false, false>(c.X2S() + (size_t)rs * D, c.norm_f(), nullptr, nullptr, c.out() + O_YS + (size_t)rs * D, c.lane);
}

using pg8::Unit;
#define EPI_ROWS(...) _Pragma("unroll") for (int ai = 0; ai < 2; ++ai) _Pragma("unroll") for (int m = 0; m < 4; ++m) { const int row = row0 + ai * 128 + m * 16; __VA_ARGS__ }
struct EpiIn {
    static constexpr bool PERM = true, AFTER_DRAIN = false;
    bf16 *BG, *U, *Q, *HM, *GA, *GB; float* NGT; float* out; bf16 *VST, *VWT, *ACMP;
    __device__ __forceinline__ void operator()(const f32x4 (&acc)[2][2][4][2], const Unit& u, int wr, int wc, int fr, int fq) const {
        const int pn = u.pn, row0 = u.pm * 256 + wr * 64 + fr, cl0 = wc * 32 + 8 * fq;
        if (pn < 4 || (pn >= 12 && pn < 16) || (pn >= 22 && pn < 30)) {
            bf16* base; int colt; float sc = 1.f; bool sig = false;
            if (pn < 4) { base = BG; colt = pn * 256; } else if (pn < 16) { base = Q; colt = (pn - 12) * 256; sc = 0.125f * 1.4426950408889634f; } else if (pn < 26) { base = GA; colt = (pn - 22) * 256; sig = true; } else { base = GB; colt = (pn - 26) * 256; sig = true; }
            EPI_ROWS(
_Pragma("unroll")
                for (int bj = 0; bj < 2; ++bj) { const f32x4 a = acc[ai][bj][m][0], b = acc[ai][bj][m][1]; float v[8] = {a.x, a.y, a.z, a.w, b.x, b.y, b.z, b.w};
_Pragma("unroll")
                    for (int j = 0; j < 8; ++j) v[j] = sig ? sigmoidf_(v[j]) : v[j] * sc;
                    *(GAS v4u*)(base + (size_t)row * D + colt + bj * 128 + cl0) = pack8(v); } )
        } else if (pn < 12) {
            const int t = pn - 4;
            EPI_ROWS(
                const f32x4 a = acc[ai][0][m][0] * acc[ai][1][m][0], b = acc[ai][0][m][1] * acc[ai][1][m][1]; const float v[8] = {a.x, a.y, a.z, a.w, b.x, b.y, b.z, b.w};
                *(GAS v4u*)(U + (size_t)row * D + t * 128 + cl0) = pack8(v);
                const int tt = row & (T - 1);
                if (tt >= T - 2) { float* o = out + O_CONV_P + (size_t)((row >> 12) * 2 + (tt - (T - 2))) * D + t * 128 + cl0; *(GAS f32x4*)o = a; *(GAS f32x4*)(o + 4) = b; } )
        } else if (pn < 22) {
            const int kind = pn - 16, kv = kind & 1, reg = kind >> 1;
            EPI_ROWS(
                const int b = row >> 12, tt = row & (T - 1);
_Pragma("unroll")
                for (int bj = 0; bj < 2; ++bj) { const f32x4 a = acc[ai][bj][m][0], bq = acc[ai][bj][m][1]; const float v[8] = {a.x, a.y, a.z, a.w, bq.x, bq.y, bq.z, bq.w};
                    const int cl = bj * 128 + cl0, g = cl >> 6, d = cl & 63;
                    if (kind == 3 || kind == 5) { bf16* vt = (kind == 3 ? VST : VWT) + ((size_t)((b * NKV + g) * HD + d)) * T + tt;
_Pragma("unroll")
                        for (int j = 0; j < 8; ++j) vt[(size_t)j * T] = (bf16)f2bf(v[j]); }
                    if (kind < 2) *(GAS v4u*)(ACMP + ((size_t)kind * CM_ROWS + CM_S) * 1024 + ((size_t)((b * NKV + g) * T + tt)) * HD + d) = pack8(v);
                    else if (PROBE_ATT || !(kind == 3 || kind == 5)) *(GAS v4u*)(HM + (size_t)kind * HMSZ + ((size_t)((b * NKV + g) * T + tt)) * HD + d) = pack8(v);
                    float* o = nullptr;
                    if (reg == 0) o = out + O_CMP_P + ((size_t)row * 2 + kv) * 256 + cl;
                    else if (reg == 1) o = out + O_SEL_P + ((size_t)row * 2 + kv) * 256 + cl;
                    else if (tt >= T - 512) o = out + O_WIN_P + ((size_t)(b * 512 + tt - (T - 512)) * 2 + kv) * 256 + cl;
                    if (o) { *(GAS f32x4*)o = a; *(GAS f32x4*)(o + 4) = bq; } } )
        } else {
            if (cl0 < 48) {
                EPI_ROWS(
                    const f32x4 a = acc[ai][0][m][0], b = acc[ai][0][m][1];
                    f32x4 sa, sb; sa.x = sigmoidf_(a.x); sa.y = sigmoidf_(a.y); sa.z = sigmoidf_(a.z); sa.w = sigmoidf_(a.w); sb.x = sigmoidf_(b.x); sb.y = sigmoidf_(b.y); sb.z = sigmoidf_(b.z); sb.w = sigmoidf_(b.w);
                    float* o = NGT + (size_t)row * 48 + cl0; *(GAS f32x4*)o = sa; *(GAS f32x4*)(o + 4) = sb; )
            }
        }
    }
};
struct EpiYa { static constexpr bool PERM = true, AFTER_DRAIN = false; const bf16* GA; bf16* P1;
    __device__ __forceinline__ void operator()(const f32x4 (&acc)[2][2][4][2], const Unit& u, int wr, int wc, int fr, int fq) const {
        const int row0 = u.pm * 256 + wr * 64 + fr, col0 = u.pn * 256 + wc * 32 + 8 * fq;
        EPI_ROWS(
_Pragma("unroll")
            for (int bj = 0; bj < 2; ++bj) { const size_t off = (size_t)row * D + col0 + bj * 128; float g[8]; ld8(GA + off, g); const f32x4 a = acc[ai][bj][m][0], b = acc[ai][bj][m][1];
                const float o[8] = {g[0] * a.x, g[1] * a.y, g[2] * a.z, g[3] * a.w, g[4] * b.x, g[5] * b.y, g[6] * b.z, g[7] * b.w};
                *(GAS v4u*)(P1 + off) = pack8(o); } )
    } };
struct EpiYb { static constexpr bool PERM = true, AFTER_DRAIN = false; const bf16* GB; const bf16* P1; bf16* MG;
    __device__ __forceinline__ void operator()(const f32x4 (&acc)[2][2][4][2], const Unit& u, int wr, int wc, int fr, int fq) const {
        const int row0 = u.pm * 256 + wr * 64 + fr, col0 = u.pn * 256 + wc * 32 + 8 * fq;
        EPI_ROWS(
_Pragma("unroll")
            for (int bj = 0; bj < 2; ++bj) { const size_t off = (size_t)row * D + col0 + bj * 128; float g[8]; ld8(GB + off, g); float p[8]; ld8(P1 + off, p); const f32x4 a = acc[ai][bj][m][0], b = acc[ai][bj][m][1];
                const float v[8] = {p[0] + g[0] * a.x, p[1] + g[1] * a.y, p[2] + g[2] * a.z, p[3] + g[3] * a.w, p[4] + g[4] * b.x, p[5] + g[5] * b.y, p[6] + g[6] * b.z, p[7] + g[7] * b.w};
                *(GAS v4u*)(MG + off) = pack8(v); } )
    } };
struct EpiRes { static constexpr bool PERM = true, AFTER_DRAIN = false; const float* base; float* O; const float* MOD; int goff;
    __device__ __forceinline__ void operator()(const f32x4 (&acc)[2][2][4][2], const Unit& u, int wr, int wc, int fr, int fq) const {
        const int row0 = u.pm * 256 + wr * 64 + fr, col0 = u.pn * 256 + wc * 32 + 8 * fq;
        const float* gp = MOD + (size_t)((u.pm * 256) / T) * NMOD + goff + col0;
        f32x4 gt[2][2];
#pragma unroll
        for (int bj = 0; bj < 2; ++bj) { gt[bj][0] = *(const f32x4*)(gp + bj * 128); gt[bj][1] = *(const f32x4*)(gp + bj * 128 + 4); }
        EPI_ROWS(
_Pragma("unroll")
            for (int bj = 0; bj < 2; ++bj) { const size_t off = (size_t)row * D + col0 + bj * 128;
                const f32x4 x0 = *(const f32x4*)(base + off), x1 = *(const f32x4*)(base + off + 4);
                *(GAS f32x4*)(O + off) = x0 + gt[bj][0] * acc[ai][bj][m][0]; *(GAS f32x4*)(O + off + 4) = x1 + gt[bj][1] * acc[ai][bj][m][1]; } )
    } };
struct EpiFF { static constexpr bool PERM = true, AFTER_DRAIN = false; bf16* HF;
    __device__ __forceinline__ void operator()(const f32x4 (&acc)[2][2][4][2], const Unit& u, int wr, int wc, int fr, int fq) const {
        const int row0 = u.pm * 256 + wr * 64 + fr, col0 = u.pn * 128 + wc * 32 + 8 * fq;
        EPI_ROWS(
            const f32x4 g0 = acc[ai][0][m][0], g1 = acc[ai][0][m][1], u0 = acc[ai][1][m][0], u1 = acc[ai][1][m][1];
            const float v[8] = {siluf_(g0.x) * u0.x, siluf_(g0.y) * u0.y, siluf_(g0.z) * u0.z, siluf_(g0.w) * u0.w, siluf_(g1.x) * u1.x, siluf_(g1.y) * u1.y, siluf_(g1.z) * u1.z, siluf_(g1.w) * u1.w};
            *(GAS v4u*)(HF + (size_t)row * FF + col0) = pack8(v); )
    } };

struct CmpOrder { int G, c; static constexpr int NPM = CM_ROWS / 256, NPP = CM_P / 256;
    __device__ bool next(int i, Unit& u) const { const int L = i * G + c; if (L >= 2 * NPP) return false; const int kv = L / NPP; u.pm = kv * NPM + CM_S / 256 + (L % NPP); u.pn = kv; return true; }
    __device__ __forceinline__ void a_ready(const Unit&) const {}
    __device__ __forceinline__ void done(const Unit&) const {} };
struct EpiCmp { static constexpr bool PERM = true, AFTER_DRAIN = false; bf16* C;
    __device__ __forceinline__ void operator()(const f32x4 (&acc)[2][2][4][2], const Unit& u, int wr, int wc, int fr, int fq) const {
        const int row0 = u.pm * 256 + wr * 64 + fr, col0 = wc * 32 + 8 * fq;
        EPI_ROWS(
_Pragma("unroll")
            for (int bj = 0; bj < 2; ++bj) { const f32x4 a = acc[ai][bj][m][0], b = acc[ai][bj][m][1]; const float v[8] = {a.x, a.y, a.z, a.w, b.x, b.y, b.z, b.w};
                *(GAS v4u*)(C + (size_t)row * 256 + bj * 128 + col0) = pack8(v); } )
    } };
constexpr int SC_BP = 80, SC_BBUF = 512 * SC_BP;
__device__ __forceinline__ void scmp_tile(const Ctx& c, int tile) {
    typedef short bfx8 __attribute__((ext_vector_type(8)));
    int lane_ = c.lane; asm volatile("" : "+v"(lane_));
    int tid_ = c.tid; asm volatile("" : "+v"(tid_));
    const int r16 = lane_ & 15, G = lane_ >> 4, wave = c.wave;
    const int b = tile >> 4, j0 = (tile & 15) * 32, kv = wave >> 2, g = wave & 3;
    const int r0 = (b * NKV + g) * 512 + j0;
    const float* abase[2];
#pragma unroll
    for (int rb = 0; rb < 2; ++rb) { const int pos0 = 16 * (j0 + 16 * rb + r16);
        abase[rb] = c.cache_cmp() + ((size_t)c.pt()[b * NPG + (pos0 >> 7)] * PAGE + (pos0 & 127)) * 512 + kv * 256 + g * HD + 8 * G; }
    const bf16* wsrc = c.W1T() + (size_t)tid_ * 1024;
    LAS unsigned char* lds = c.lds; const int wdst = tid_ * SC_BP;
    f32x4 acc[2][16];
#pragma unroll
    for (int rb = 0; rb < 2; ++rb)
#pragma unroll
        for (int cb = 0; cb < 16; ++cb) acc[rb][cb] = (f32x4){0.f, 0.f, 0.f, 0.f};
    f32x4 ar0[2][2], ar1[2][2]; v4u wr0[4], wr1[4];
#pragma unroll
    for (int rb = 0; rb < 2; ++rb) { ar0[rb][0] = *(const f32x4*)(abase[rb]); ar0[rb][1] = *(const f32x4*)(abase[rb] + 4);
                                     ar1[rb][0] = *(const f32x4*)(abase[rb] + 32); ar1[rb][1] = *(const f32x4*)(abase[rb] + 36); }
#pragma unroll
    for (int q = 0; q < 4; ++q) { wr0[q] = *(const v4u*)(wsrc + 8 * q); wr1[q] = *(const v4u*)(wsrc + 32 + 8 * q); }
    __syncthreads();
#pragma unroll
    for (int q = 0; q < 4; ++q) *(LAS v4u*)(lds + wdst + 16 * q) = wr0[q];
#pragma unroll
    for (int q = 0; q < 4; ++q) wr0[q] = *(const v4u*)(wsrc + 64 + 8 * q);
    __syncthreads();
#define SC_STEP(KS, AR, WN) do { \
        bfx8 af[2]; \
        _Pragma("unroll") for (int rb = 0; rb < 2; ++rb) { const float v_[8] = {AR[rb][0].x, AR[rb][0].y, AR[rb][0].z, AR[rb][0].w, AR[rb][1].x, AR[rb][1].y, AR[rb][1].z, AR[rb][1].w}; \
            af[rb] = __builtin_bit_cast(bfx8, pack8(v_)); } \
        if ((KS) + 2 < 32) { const int o_ = (((KS) + 2) >> 1) * 512 + (((KS) + 2) & 1) * 32; \
            _Pragma("unroll") for (int rb = 0; rb < 2; ++rb) { AR[rb][0] = *(const f32x4*)(abase[rb] + o_); AR[rb][1] = *(const f32x4*)(abase[rb] + o_ + 4); } } \
        asm volatile("" ::: "memory"); \
        const LAS unsigned char* bb = lds + ((KS) & 1) * SC_BBUF + (kv * 256 + r16) * SC_BP + G * 16; \
        bfx8 bq[2][4]; \
        _Pragma("unroll") for (int i = 0; i < 4; ++i) bq[0][i] = *(const LAS bfx8*)(bb + i * 16 * SC_BP); \
        _Pragma("unroll") for (int q4 = 0; q4 < 4; ++q4) { \
            if (q4 < 3) { _Pragma("unroll") for (int i = 0; i < 4; ++i) bq[(q4 + 1) & 1][i] = *(const LAS bfx8*)(bb + (4 * (q4 + 1) + i) * 16 * SC_BP); } \
            _Pragma("unroll") for (int i = 0; i < 4; ++i) { const int cb = 4 * q4 + i; \
                acc[0][cb] = __builtin_amdgcn_mfma_f32_16x16x32_bf16(bq[q4 & 1][i], af[0], acc[0][cb], 0, 0, 0); \
                acc[1][cb] = __builtin_amdgcn_mfma_f32_16x16x32_bf16(bq[q4 & 1][i], af[1], acc[1][cb], 0, 0, 0); } } \
        asm volatile("" ::: "memory"); \
        if ((KS) + 1 < 32) { LAS unsigned char* d_ = lds + (((KS) + 1) & 1) * SC_BBUF + wdst; _Pragma("unroll") for (int q = 0; q < 4; ++q) *(LAS v4u*)(d_ + 16 * q) = WN[q]; } \
        if ((KS) + 3 < 32) { _Pragma("unroll") for (int q = 0; q < 4; ++q) WN[q] = *(const v4u*)(wsrc + ((KS) + 3) * 32 + 8 * q); } \
        __syncthreads(); } while (0)
#pragma unroll 1
    for (int ks = 0; ks < 32; ks += 2) { SC_STEP(ks, ar0, wr1); SC_STEP(ks + 1, ar1, wr0); }
#undef SC_STEP
#pragma unroll
    for (int rb = 0; rb < 2; ++rb) { bf16* crow = c.CCMP() + ((size_t)kv * CM_ROWS + r0 + 16 * rb + r16) * 256 + 4 * G;
#pragma unroll
        for (int cb = 0; cb < 16; ++cb) *(GAS unsigned long long*)(crow + 16 * cb) =
            (unsigned long long)pg8::cvt_pk_bf16(acc[rb][cb][0], acc[rb][cb][1]) | ((unsigned long long)pg8::cvt_pk_bf16(acc[rb][cb][2], acc[rb][cb][3]) << 32); }
}
__device__ __forceinline__ void scmp_phase(const Ctx& c) { for (int tile = c.bid; tile < 512; tile += c.G) scmp_tile(c, tile); }

__device__ __forceinline__ void compress_step2(const Ctx& c) {
    typedef short bfx8 __attribute__((ext_vector_type(8)));
    constexpr int NT_S = SB * NKV * 32, NT_P = NB * NKV * 16, NTASK = 2 * (NT_S + NT_P);
    const int gw = c.bid * NWAVES + c.wave, NGW = c.G * NWAVES, r16 = c.lane & 15, G = c.lane >> 4;
    for (int w = gw; w < NTASK; w += NGW) {
        const int kv = w / (NT_S + NT_P), w2 = w % (NT_S + NT_P); const bool smp = w2 < NT_S;
        const int bgi = smp ? (w2 >> 5) : ((w2 - NT_S) >> 4), it = smp ? (w2 & 31) : ((w2 - NT_S) & 15);
        const int nper = smp ? 512 : 256, ncs = smp ? NCS_S : NCS_P;
        const int ci = it * 16 + r16, cic = ci < ncs ? ci : ncs - 1;
        const size_t rowA = (size_t)kv * CM_ROWS + (smp ? 0 : CM_S) + (size_t)bgi * nper + cic;
        const bf16* ca = c.CCMP() + rowA * 256; const bf16* cb = ca + 256 + 128;
        f32x4 acc[4];
#pragma unroll
        for (int ob = 0; ob < 4; ++ob) acc[ob] = (f32x4){0.f, 0.f, 0.f, 0.f};
#pragma unroll
        for (int ks = 0; ks < 4; ++ks) {
            float a[8], b[8], bi[8]; ld8(ca + 32 * ks + 8 * G, a); ld8(cb + 32 * ks + 8 * G, b); ld8(c.BIASC() + kv * 128 + 32 * ks + 8 * G, bi);
            float h[8];
#pragma unroll
            for (int j = 0; j < 8; ++j) h[j] = gelu_tanh(a[j] + b[j] + bi[j]);
            const bfx8 hf = __builtin_bit_cast(bfx8, pack8(h));
#pragma unroll
            for (int ob = 0; ob < 4; ++ob) { const bfx8 wf = *(const bfx8*)(c.W2T() + ((size_t)kv * HD + 16 * ob + r16) * 128 + 32 * ks + 8 * G);
                acc[ob] = __builtin_amdgcn_mfma_f32_16x16x32_bf16(wf, hf, acc[ob], 0, 0, 0); }
        }
        if (PROBE_CMP && ci < ncs) {
            float num = 0.f, den = 0.f;
#pragma unroll
            for (int ob = 0; ob < 4; ++ob)
#pragma unroll
                for (int i = 0; i < 4; ++i) { const int o = 16 * ob + 4 * G + i;
                    const float r = smp ? c.KCCS()[((size_t)((kv * SB * NKV + bgi)) * NCP_S + ci) * HD + o] : c.KCC()[((size_t)((kv * NB * NKV + bgi)) * NCP_P + ci) * HD + o];
                    num += (acc[ob][i] - r) * (acc[ob][i] - r); den += r * r; }
            atomicAdd(c.CHK + (smp ? 0 : 2) + 32, num); atomicAdd(c.CHK + (smp ? 1 : 3) + 32, den);
        }
        if (ci < ncs) {
            if (smp && (NAIVE_SATT || PROBE_SATT || PROBE_CMP)) {
#pragma unroll
                for (int ob = 0; ob < 4; ++ob)
#pragma unroll
                    for (int i = 0; i < 4; ++i) c.KCCS()[((size_t)((kv * SB * NKV + bgi)) * NCP_S + ci) * HD + 16 * ob + 4 * G + i] = acc[ob][i];
            }
            if (PROBE_ATT && !smp) {
#pragma unroll
                for (int ob = 0; ob < 4; ++ob)
#pragma unroll
                    for (int i = 0; i < 4; ++i) c.KCC()[((size_t)((kv * NB * NKV + bgi)) * NCP_P + ci) * HD + 16 * ob + 4 * G + i] = acc[ob][i];
            }
            bf16* kout = smp ? c.KCCSB() : c.KCCB(); bf16* vout = smp ? c.VCCST() : c.VCCT();
            if (kv == 0) {
#pragma unroll
                for (int ob = 0; ob < 4; ++ob) *(GAS unsigned long long*)(kout + ((size_t)bgi * nper + ci) * HD + 16 * ob + 4 * G) =
                    (unsigned long long)pg8::cvt_pk_bf16(acc[ob][0], acc[ob][1]) | ((unsigned long long)pg8::cvt_pk_bf16(acc[ob][2], acc[ob][3]) << 32);
            } else {
#pragma unroll
                for (int ob = 0; ob < 4; ++ob)
#pragma unroll
                    for (int i = 0; i < 4; ++i) vout[((size_t)bgi * HD + 16 * ob + 4 * G + i) * nper + ci] = (bf16)f2bf(acc[ob][i]);
            }
        }
    }
}

template <bool DUAL, class Epi> __device__ __forceinline__ void sgemm(const Ctx& c, const float* A1, const float* A2, int lda, const float* W1, const float* W2, int ldw, int K, int N, const Epi& epi) {
    const int nch = (N + NTHR - 1) / NTHR, nitems = 8 * nch;
    for (int it = c.G - 1 - c.bid; it < nitems; it += c.G) {
        const int rg = it & 7, n = (it >> 3) * NTHR + c.tid;
        if (n < N) {
            float a1[16], a2[16];
#pragma unroll
            for (int r = 0; r < 16; ++r) { a1[r] = 0.f; a2[r] = 0.f; }
            const float* ar1 = A1 + (size_t)rg * 16 * lda; const float* ar2 = A2 + (size_t)rg * 16 * lda;
            for (int k = 0; k < K; ++k) { const float w1 = W1[(size_t)k * ldw + n]; const float w2 = DUAL ? W2[(size_t)k * ldw + n] : 0.f;
#pragma unroll
                for (int r = 0; r < 16; ++r) { a1[r] += ar1[(size_t)r * lda + k] * w1; if (DUAL) a2[r] += ar2[(size_t)r * lda + k] * w2; } }
#pragma unroll
            for (int r = 0; r < 16; ++r) epi(rg * 16 + r, n, a1[r], a2[r]);
        }
    }
}

template <int NACC, class Epi> __device__ __forceinline__ void sgemm_item(const Ctx& c, const float* A1, const float* A2, int lda, const bf16* B1, const bf16* B2, int K, const Epi& epi) {
    typedef short bfx8 __attribute__((ext_vector_type(8)));
    int lane_ = c.lane; asm volatile("" : "+v"(lane_));
    const int r16 = lane_ & 15, G = lane_ >> 4, wave = c.wave, ks = K / NWAVES, k0 = wave * ks;
    f32x4 acc[NACC][8];
#pragma unroll
    for (int a = 0; a < NACC; ++a)
#pragma unroll
        for (int rb = 0; rb < 8; ++rb) acc[a][rb] = (f32x4){0.f, 0.f, 0.f, 0.f};
#pragma unroll
    for (int a = 0; a < NACC; ++a) {
        const bf16* Bp = (a == 0 ? B1 : B2) + (size_t)r16 * K + k0 + 8 * G; const float* Ap = (a == 0 ? A1 : A2) + (size_t)r16 * lda + k0 + 8 * G;
        f32x4 an[8][2]; bfx8 bn = *(const bfx8*)Bp;
#pragma unroll
        for (int rb = 0; rb < 8; ++rb) { an[rb][0] = *(const f32x4*)(Ap + (size_t)rb * 16 * lda); an[rb][1] = *(const f32x4*)(Ap + (size_t)rb * 16 * lda + 4); }
#pragma unroll 1
        for (int kk = 0; kk < ks; kk += 32) {
            bfx8 af[8]; const bfx8 bf = bn;
#pragma unroll
            for (int rb = 0; rb < 8; ++rb) { const float v[8] = {an[rb][0].x, an[rb][0].y, an[rb][0].z, an[rb][0].w, an[rb][1].x, an[rb][1].y, an[rb][1].z, an[rb][1].w};
                af[rb] = __builtin_bit_cast(bfx8, pack8(v)); }
            if (kk + 32 < ks) { bn = *(const bfx8*)(Bp + kk + 32);
#pragma unroll
                for (int rb = 0; rb < 8; ++rb) { an[rb][0] = *(const f32x4*)(Ap + (size_t)rb * 16 * lda + kk + 32); an[rb][1] = *(const f32x4*)(Ap + (size_t)rb * 16 * lda + kk + 36); } }
#pragma unroll
            for (int rb = 0; rb < 8; ++rb) acc[a][rb] = __builtin_amdgcn_mfma_f32_16x16x32_bf16(af[rb], bf, acc[a][rb], 0, 0, 0);
        }
    }
    LAS float* L = (LAS float*)c.lds;
    __syncthreads();
#pragma unroll
    for (int a = 0; a < NACC; ++a)
#pragma unroll
        for (int rb = 0; rb < 8; ++rb)
#pragma unroll
            for (int i = 0; i < 4; ++i) L[(wave * NACC + a) * 2048 + (16 * rb + 4 * G + i) * 16 + r16] = acc[a][rb][i];
    __syncthreads();
    { const int e0 = c.tid * 4; f32x4 s[NACC];
#pragma unroll
      for (int a = 0; a < NACC; ++a) { s[a] = (f32x4){0.f, 0.f, 0.f, 0.f};
#pragma unroll
          for (int w = 0; w < NWAVES; ++w) s[a] = s[a] + *(const LAS f32x4*)(L + (w * NACC + a) * 2048 + e0); }
#pragma unroll
      for (int i = 0; i < 4; ++i) epi((e0 + i) >> 4, (e0 + i) & 15, s[0][i], NACC > 1 ? s[NACC - 1][i] : 0.f); }
}

__device__ __forceinline__ void p3_conv_prompt(const Ctx& c, int first_wg) {
    if (c.bid < first_wg) return;
    const int gt = (c.bid - first_wg) * NTHR + c.tid, NGT_ = (c.G - first_wg) * NTHR;
    float w0[8], w1[8], w2[8], bb[8];
    for (int it = gt; it < (M / 4) * (D / 8); it += NGT_) {
        const int r0 = (it >> 7) * 4, ch = (it & 127) * 8, tt0 = r0 & (T - 1);
        ld8(c.w_conv() + ch, w0); ld8(c.w_conv() + D + ch, w1); ld8(c.w_conv() + 2 * D + ch, w2); ld8(c.b_conv() + ch, bb);
        v4u ur[6], bgr[4];
#pragma unroll
        for (int i = 0; i < 6; ++i) { const int rr = r0 - 2 + i; ur[i] = (tt0 - 2 + i >= 0) ? *(const v4u*)(c.U() + (size_t)rr * D + ch) : (v4u){0u, 0u, 0u, 0u}; }
#pragma unroll
        for (int i = 0; i < 4; ++i) bgr[i] = *(const v4u*)(c.BG() + (size_t)(r0 + i) * D + ch);
#pragma unroll
        for (int i = 0; i < 4; ++i) {
            float u2[8], u1[8], u0[8], bg[8];
            { const v4u a = ur[i], b = ur[i + 1], d = ur[i + 2], e = bgr[i];
              u2[0] = __uint_as_float(a.x << 16); u2[1] = __uint_as_float(a.x & 0xffff0000u); u2[2] = __uint_as_float(a.y << 16); u2[3] = __uint_as_float(a.y & 0xffff0000u);
              u2[4] = __uint_as_float(a.z << 16); u2[5] = __uint_as_float(a.z & 0xffff0000u); u2[6] = __uint_as_float(a.w << 16); u2[7] = __uint_as_float(a.w & 0xffff0000u);
              u1[0] = __uint_as_float(b.x << 16); u1[1] = __uint_as_float(b.x & 0xffff0000u); u1[2] = __uint_as_float(b.y << 16); u1[3] = __uint_as_float(b.y & 0xffff0000u);
              u1[4] = __uint_as_float(b.z << 16); u1[5] = __uint_as_float(b.z & 0xffff0000u); u1[6] = __uint_as_float(b.w << 16); u1[7] = __uint_as_float(b.w & 0xffff0000u);
              u0[0] = __uint_as_float(d.x << 16); u0[1] = __uint_as_float(d.x & 0xffff0000u); u0[2] = __uint_as_float(d.y << 16); u0[3] = __uint_as_float(d.y & 0xffff0000u);
              u0[4] = __uint_as_float(d.z << 16); u0[5] = __uint_as_float(d.z & 0xffff0000u); u0[6] = __uint_as_float(d.w << 16); u0[7] = __uint_as_float(d.w & 0xffff0000u);
              bg[0] = __uint_as_float(e.x << 16); bg[1] = __uint_as_float(e.x & 0xffff0000u); bg[2] = __uint_as_float(e.y << 16); bg[3] = __uint_as_float(e.y & 0xffff0000u);
              bg[4] = __uint_as_float(e.z << 16); bg[5] = __uint_as_float(e.z & 0xffff0000u); bg[6] = __uint_as_float(e.w << 16); bg[7] = __uint_as_float(e.w & 0xffff0000u); }
            float v[8];
#pragma unroll
            for (int j = 0; j < 8; ++j) v[j] = bg[j] * (bb[j] + w0[j] * u2[j] + w1[j] * u1[j] + w2[j] * u0[j]);
            *(GAS v4u*)(c.AA() + (size_t)(r0 + i) * D + ch) = pack8(v);
        }
    }
}
__device__ __forceinline__ void p3_sample_thin(const Ctx& c, int first_wg) {
    if (c.bid < first_wg) return;
    const int gt = (c.bid - first_wg) * NTHR + c.tid, NGT_ = (c.G - first_wg) * NTHR;
    for (int it = gt; it < MS * D; it += NGT_) {
        const int row = it >> 10, ch = it & 1023, b = row >> 2, s = row & 3;
        float up[3];
#pragma unroll
        for (int k = 0; k < 3; ++k) { const int ss = s - 2 + k; up[k] = (ss >= 0) ? c.ZS()[(size_t)(b * SS + ss) * NIN + 1024 + ch] * c.ZS()[(size_t)(b * SS + ss) * NIN + 2048 + ch] : c.state_conv()[(size_t)(b * 2 + (ss + 2)) * D + ch]; }
        const float v = c.b_conv()[ch] + c.w_conv()[ch] * up[0] + c.w_conv()[D + ch] * up[1] + c.w_conv()[2 * D + ch] * up[2];
        c.AAS()[(size_t)row * D + ch] = c.ZS()[(size_t)row * NIN + ch] * v;
        if (s >= 2) c.out()[O_CONV_S + (size_t)(b * 2 + (s - 2)) * D + ch] = up[2];
    }
    for (int it = gt; it < MS * 512; it += NGT_) { const int row = it >> 9, cc = it & 511;
        c.out()[O_CMP_S + (size_t)row * 512 + cc] = c.ZS()[(size_t)row * NIN + 4096 + cc]; c.out()[O_SEL_S + (size_t)row * 512 + cc] = c.ZS()[(size_t)row * NIN + 4608 + cc]; }
    for (int it0 = gt; it0 < SB * 512 * 128; it0 += 4 * NGT_) { f32x4 v[4];
#pragma unroll
        for (int u = 0; u < 4; ++u) { const int it = it0 + u * NGT_; if (it < SB * 512 * 128) { const int cc = (it & 127) * 4, j = (it >> 7) & 511, b = it >> 16;
            v[u] = (j + SS < 512) ? *(const f32x4*)(c.cache_win() + ((size_t)(b * 512 + j + SS)) * 512 + cc) : *(const f32x4*)(c.ZS() + (size_t)(b * SS + (j + SS - 512)) * NIN + 5120 + cc); } }
#pragma unroll
        for (int u = 0; u < 4; ++u) { const int it = it0 + u * NGT_; if (it < SB * 512 * 128) { const int cc = (it & 127) * 4, j = (it >> 7) & 511, b = it >> 16;
            *(GAS f32x4*)(c.out() + O_WIN_S + ((size_t)(b * 512 + j)) * 512 + cc) = v[u]; } } }
}
struct CmpP { static constexpr int NB_ = NB, NCS = NCS_P, NCP = NCP_P, NGRP = 16;
    __device__ static __forceinline__ float x(const Ctx& c, int kv, int b, int g, int pos, int d) { return bf2f(c.ACMP()[((size_t)kv * CM_ROWS + CM_S) * 1024 + ((size_t)((b * NKV + g) * T + pos)) * HD + d]); }
    __device__ static __forceinline__ void store(const Ctx& c, int kv, int b, int g, int i, int o, float s) {
        c.KCC()[((size_t)((kv * NB + b) * NKV + g) * NCP_P + i) * HD + o] = s; } };
struct CmpS { static constexpr int NB_ = SB, NCS = NCS_S, NCP = NCP_S, NGRP = 32;
    __device__ static __forceinline__ float x(const Ctx& c, int kv, int b, int g, int pos, int d) { return c.cache_cmp()[((size_t)c.pt()[b * NPG + (pos >> 7)] * PAGE + (pos & 127)) * 512 + kv * 256 + g * HD + d]; }
    __device__ static __forceinline__ void store(const Ctx& c, int kv, int b, int g, int i, int o, float s) { c.KCCS()[((size_t)((kv * SB + b) * NKV + g) * NCP_S + i) * HD + o] = s; } };
template <class S> __device__ __forceinline__ void compress_naive(const Ctx& c) {
    constexpr int NITEMS = 2 * S::NB_ * NKV * S::NGRP;
    LAS float* hid = (LAS float*)c.lds;
    const int n = c.tid & 127, rq = c.tid >> 7;
    for (int it = c.bid; it < NITEMS; it += c.G) {
        const int ig = it % S::NGRP, g = (it / S::NGRP) % NKV, b = (it / (S::NGRP * NKV)) % S::NB_, kv = it / (S::NGRP * NKV * S::NB_);
        const int i0 = ig * 16 + 4 * rq;
        float acc[4] = {0.f, 0.f, 0.f, 0.f};
        for (int t = 0; t < 32; ++t) {
            for (int d = 0; d < HD; ++d) {
                const int k = t * HD + d; const float w = c.w_phi1()[((size_t)kv * 2048 + k) * 128 + n], pe = c.pe()[kv * 2048 + k];
#pragma unroll
                for (int r = 0; r < 4; ++r) { int i = i0 + r; i = i < S::NCS ? i : S::NCS - 1; acc[r] += (S::x(c, kv, b, g, 16 * i + t, d) + pe) * w; }
            }
        }
        __syncthreads();
#pragma unroll
        for (int r = 0; r < 4; ++r) hid[(4 * rq + r) * 128 + n] = gelu_tanh(acc[r]);
        __syncthreads();
        const int o = c.tid & 63;
#pragma unroll
        for (int rr = 0; rr < 2; ++rr) { const int r = (c.tid >> 6) + 8 * rr, i = ig * 16 + r; float s = 0.f;
            for (int k = 0; k < 128; ++k) s += hid[r * 128 + k] * c.w_phi2()[((size_t)kv * 128 + k) * HD + o];
            if (i < S::NCS) S::store(c, kv, b, g, i, o, s); }
    }
    __syncthreads();
}

struct AtP {
    static constexpr int NQ = T, QBASE = 0, NS = 64, NSP = 64, NSL = 1, NBAT = NB, NCP = NCP_P;
    typedef bf16 KT;
    __device__ static __forceinline__ void decode(int idx, int& b, int& h, int& qi) { qi = idx & (T - 1); h = (idx >> 12) & 15; b = idx >> 16; }
    __device__ static __forceinline__ void load_q(const Ctx& c, int b, int h, int qi, float (&q)[64]) { const bf16* p = c.Q() + (size_t)(b * T + qi) * D + h * HD;
#pragma unroll
        for (int cc = 0; cc < 8; ++cc) { float v[8]; ld8(p + 8 * cc, v);
#pragma unroll
            for (int j = 0; j < 8; ++j) q[8 * cc + j] = v[j] * 0.6931471805599453f; } }
    __device__ static __forceinline__ float gate(const Ctx& c, int b, int h, int qi, int j) { return c.NGT()[(size_t)(b * T + qi) * 48 + h * 3 + j]; }
    __device__ static __forceinline__ const float* kcc(const Ctx& c, int kv, int b, int g, int ci) { return c.KCC() + ((size_t)((kv * NB + b) * NKV + g) * NCP_P + ci) * HD; }
    __device__ static __forceinline__ const KT* ksel(const Ctx& c, int kv, int b, int g, int pos) { return c.HM() + (size_t)(2 + kv) * HMSZ + ((size_t)((b * NKV + g) * T + pos)) * HD; }
    __device__ static __forceinline__ const KT* kwin(const Ctx& c, int kv, int b, int g, int pos) { return c.HM() + (size_t)(4 + kv) * HMSZ + ((size_t)((b * NKV + g) * T + pos)) * HD; }
    __device__ static __forceinline__ float* scoreh(const Ctx& c) { return c.SCOREH(); }
    __device__ static __forceinline__ unsigned long long* mask(const Ctx& c) { return c.MASK(); }
    __device__ static __forceinline__ void store_o(const Ctx& c, int b, int h, int qi, const float (&o)[64]) { bf16* p = c.OB + (size_t)(b * T + qi) * D + h * HD;
#pragma unroll
        for (int cc = 0; cc < 8; ++cc) { float v[8];
#pragma unroll
            for (int j = 0; j < 8; ++j) v[j] = o[8 * cc + j];
            *(GAS v4u*)(p + 8 * cc) = pack8(v); } }
};
struct AtS {
    static constexpr int NQ = SS, QBASE = PAST, NS = 129, NSP = 192, NSL = 3, NBAT = SB, NCP = NCP_S;
    typedef float KT;
    __device__ static __forceinline__ void decode(int idx, int& b, int& h, int& qi) { qi = idx & 3; h = (idx >> 2) & 15; b = idx >> 6; }
    __device__ static __forceinline__ void load_q(const Ctx& c, int b, int h, int qi, float (&q)[64]) { const float* p = c.ZS() + (size_t)(b * SS + qi) * NIN + 3072 + h * HD;
#pragma unroll
        for (int j = 0; j < 64; ++j) q[j] = p[j] * 0.125f; }
    __device__ static __forceinline__ float gate(const Ctx& c, int b, int h, int qi, int j) { return sigmoidf_(c.ZS()[(size_t)(b * SS + qi) * NIN + 5632 + h * 3 + j]); }
    __device__ static __forceinline__ const float* kcc(const Ctx& c, int kv, int b, int g, int ci) { return c.KCCS() + ((size_t)((kv * SB + b) * NKV + g) * NCP_S + ci) * HD; }
    __device__ static __forceinline__ const KT* ksel(const Ctx& c, int kv, int b, int g, int pos) {
        if (pos < PAST) return c.cache_sel() + ((size_t)c.pt()[b * NPG + (pos >> 7)] * PAGE + (pos & 127)) * 512 + kv * 256 + g * HD;
        return c.ZS() + (size_t)(b * SS + (pos - PAST)) * NIN + 4608 + kv * 256 + g * HD; }
    __device__ static __forceinline__ const KT* kwin(const Ctx& c, int kv, int b, int g, int pos) {
        if (pos < PAST) return c.cache_win() + ((size_t)(b * 512 + (pos - (PAST - 512)))) * 512 + kv * 256 + g * HD;
        return c.ZS() + (size_t)(b * SS + (pos - PAST)) * NIN + 5120 + kv * 256 + g * HD; }
    __device__ static __forceinline__ float* scoreh(const Ctx& c) { return c.SCOREHS(); }
    __device__ static __forceinline__ unsigned long long* mask(const Ctx& c) { return c.MASKS(); }
    __device__ static __forceinline__ void store_o(const Ctx& c, int b, int h, int qi, const float (&o)[64]) { float* p = c.OBS() + (size_t)(b * SS + qi) * D + h * HD;
#pragma unroll
        for (int j = 0; j < 64; ++j) p[j] = o[j]; }
};
__device__ __forceinline__ int wave_max_i(int v) {
#pragma unroll
    for (int o = 1; o < 64; o <<= 1) { const int t = __shfl_xor(v, o); v = t > v ? t : v; }
    return v;
}
__device__ __forceinline__ int wave_min_i(int v) {
#pragma unroll
    for (int o = 1; o < 64; o <<= 1) { const int t = __shfl_xor(v, o); v = t < v ? t : v; }
    return v;
}
template <class S> __device__ __forceinline__ void p4a_scores(const Ctx& c) {
    constexpr int NW = S::NBAT * H * S::NQ / 64;
    const int gw = c.bid * NWAVES + c.wave, NGW = c.G * NWAVES;
    for (int w = gw; w < NW; w += NGW) {
        const int idx = w * 64 + c.lane; int b, h, qi; S::decode(idx, b, h, qi);
        const int g = h >> 2, qpos = S::QBASE + qi; const float tq = (float)qpos, slope = exp2f(-0.5f * (float)(h + 1));
        float q[64]; S::load_q(c, b, h, qi, q);
        const int ncv = qpos >= 31 ? ((qpos - 31) >> 4) + 1 : 0, ncm = wave_max_i(ncv);
        float m = NEGF;
        for (int ci = 0; ci < ncm; ++ci) { const int cc = ci < ncv ? ci : 0; const float s = dot64(S::kcc(c, 0, b, g, cc), q) - slope * (tq - 16.f * ci - 15.5f); if (ci < ncv) m = fmaxf(m, s); }
        float l = 0.f;
        for (int ci = 0; ci < ncm; ++ci) { const int cc = ci < ncv ? ci : 0; const float s = dot64(S::kcc(c, 0, b, g, cc), q) - slope * (tq - 16.f * ci - 15.5f); if (ci < ncv) l += __expf(s - m); }
        const float il = l > 0.f ? 1.f / l : 0.f;
        float carry = 0.f; float* sp = S::scoreh(c) + (size_t)idx * S::NSP;
        const int nsm = (ncm + 3) >> 2;
        for (int s4 = 0; s4 < S::NS; ++s4) {
            float a = carry;
            if (s4 < nsm + 1) {
#pragma unroll 1
                for (int j = 0; j < 4; ++j) { const int ci = 4 * s4 + j; float p = 0.f;
                    if (ci < ncm) { const int cc = ci < ncv ? ci : 0; const float s = dot64(S::kcc(c, 0, b, g, cc), q) - slope * (tq - 16.f * ci - 15.5f); p = ci < ncv ? __expf(s - m) * il : 0.f; }
                    a += p; if (j == 3) carry = p; }
            } else carry = 0.f;
            sp[s4] = a;
        }
    }
}
template <class S> __device__ __forceinline__ void p4b_topk(const Ctx& c) {
    constexpr int NW = S::NBAT * NKV * S::NQ;
    const int gw = c.bid * NWAVES + c.wave, NGW = c.G * NWAVES;
    for (int w = gw; w < NW; w += NGW) {
        const int qi = w % S::NQ, g = (w / S::NQ) % NKV, b = w / (S::NQ * NKV);
        const int qpos = S::QBASE + qi, cur = qpos >> 6;
        float val[S::NSL];
#pragma unroll
        for (int j = 0; j < S::NSL; ++j) { const int s = c.lane + 64 * j; float v = -INFINITY;
            if (s < S::NS) { float imp = 0.f;
#pragma unroll
                for (int r = 0; r < 4; ++r) imp += S::scoreh(c)[((size_t)((b * H + 4 * g + r) * S::NQ + qi)) * S::NSP + s];
                const bool valid = 64 * s <= qpos, forced = (s == 0) || (s == cur) || (s == cur - 1);
                v = valid ? imp + (forced ? 1000.f : 0.f) : NEGF; }
            val[j] = v; }
        int rank[S::NSL];
#pragma unroll
        for (int j = 0; j < S::NSL; ++j) rank[j] = 0;
#pragma unroll
        for (int j2 = 0; j2 < S::NSL; ++j2)
            for (int l2 = 0; l2 < 64; ++l2) { const float v2 = __shfl(val[j2], l2); const int s2 = l2 + 64 * j2;
#pragma unroll
                for (int j = 0; j < S::NSL; ++j) { const int s = c.lane + 64 * j; rank[j] += (v2 > val[j] || (v2 == val[j] && s2 < s)) ? 1 : 0; } }
#pragma unroll
        for (int j = 0; j < S::NSL; ++j) { const int s = c.lane + 64 * j; const unsigned long long mk = __ballot(rank[j] < 16 && s < S::NS);
            if (c.lane == 0) S::mask(c)[(size_t)w * S::NSL + j] = mk; }
    }
}
#define ONLINE_UPD(sv, vrow, ok) do { if (ok) { if ((sv) > m) { const float al = __expf(m - (sv)); l *= al; _Pragma("unroll") for (int d_ = 0; d_ < 64; ++d_) o[d_] *= al; m = (sv); } \
        const float p_ = __expf((sv) - m); l += p_; axpy64((vrow), p_, o); } } while (0)
template <class S> __device__ __forceinline__ void p4c_attend(const Ctx& c, int mode = -1) {
    constexpr int NW = S::NBAT * H * S::NQ / 64;
    const int gw = c.bid * NWAVES + c.wave, NGW = c.G * NWAVES;
    for (int w = gw; w < NW; w += NGW) {
        const int idx = w * 64 + c.lane; int b, h, qi; S::decode(idx, b, h, qi);
        const int g = h >> 2, qpos = S::QBASE + qi, cur = qpos >> 6; const float tq = (float)qpos, slope = exp2f(-0.5f * (float)(h + 1));
        float q[64]; S::load_q(c, b, h, qi, q);
        LAS float* ot = (LAS float*)c.lds + c.tid;
#pragma unroll
        for (int d = 0; d < 64; ++d) ot[d * NTHR] = 0.f;
        float o[64]; float m, l;
        {
#pragma unroll
            for (int d = 0; d < 64; ++d) o[d] = 0.f;
            m = NEGF; l = 0.f;
            const int ncv = qpos >= 31 ? ((qpos - 31) >> 4) + 1 : 0, ncm = wave_max_i(ncv);
            for (int ci = 0; ci < ncm; ++ci) { const bool ok = ci < ncv; const int cc = ok ? ci : 0;
                const float s = dot64(S::kcc(c, 0, b, g, cc), q) - slope * (tq - 16.f * ci - 15.5f);
                ONLINE_UPD(s, S::kcc(c, 1, b, g, cc), ok); }
            if (l > 0.f) { const float f = ((mode < 0 || mode == 0) ? S::gate(c, b, h, qi, 0) : 0.f) / l;
#pragma unroll
                for (int d = 0; d < 64; ++d) ot[d * NTHR] += f * o[d]; }
        }
        {
#pragma unroll
            for (int d = 0; d < 64; ++d) o[d] = 0.f;
            m = NEGF; l = 0.f;
            unsigned long long mk[S::NSL];
#pragma unroll
            for (int j = 0; j < S::NSL; ++j) mk[j] = S::mask(c)[((size_t)((b * NKV + g) * S::NQ + qi)) * S::NSL + j];
            const int curm = wave_max_i(cur);
            for (int s = 0; s <= curm; ++s) {
                unsigned long long word = mk[0];
#pragma unroll
                for (int j = 1; j < S::NSL; ++j) if ((s >> 6) == j) word = mk[j];
                const bool sel = (s <= cur) && ((word >> (s & 63)) & 1ull);
                if (!__any(sel)) continue;
                for (int k = 0; k < 64; ++k) { const int pos = 64 * s + k; const bool ok = sel && pos <= qpos; const int pc = pos <= qpos ? pos : qpos;
                    if (!__any(ok)) continue;
                    const float sv = dot64(S::ksel(c, 0, b, g, pc), q) - slope * (tq - (float)pos);
                    ONLINE_UPD(sv, S::ksel(c, 1, b, g, pc), ok); }
            }
            if (l > 0.f) { const float f = ((mode < 0 || mode == 1) ? S::gate(c, b, h, qi, 1) : 0.f) / l;
#pragma unroll
                for (int d = 0; d < 64; ++d) ot[d * NTHR] += f * o[d]; }
        }
        {
#pragma unroll
            for (int d = 0; d < 64; ++d) o[d] = 0.f;
            m = NEGF; l = 0.f;
            const int lo = qpos - 511 > 0 ? qpos - 511 : 0; const int lom = wave_min_i(lo), him = wave_max_i(qpos);
            for (int kp = lom; kp <= him; ++kp) { const bool ok = kp >= lo && kp <= qpos; int pc = kp < lo ? lo : kp; pc = pc > qpos ? qpos : pc;
                if (S::QBASE > 0 && pc < PAST - 512) pc = PAST - 512;
                const float sv = dot64(S::kwin(c, 0, b, g, pc), q) - slope * (tq - (float)kp);
                ONLINE_UPD(sv, S::kwin(c, 1, b, g, pc), ok); }
            if (l > 0.f) { const float f = ((mode < 0 || mode == 2) ? S::gate(c, b, h, qi, 2) : 0.f) / l;
#pragma unroll
                for (int d = 0; d < 64; ++d) ot[d * NTHR] += f * o[d]; }
        }
#pragma unroll
        for (int d = 0; d < 64; ++d) o[d] = ot[d * NTHR];
        S::store_o(c, b, h, qi, o);
    }
}

namespace at {
typedef short bfx8 __attribute__((ext_vector_type(8)));
constexpr float LOG2E = 1.4426950408889634f;
constexpr float QSCALE = 0.125f * LOG2E;
constexpr int IMP_PITCH = 68;
__device__ __forceinline__ f32x4 mfma16(bfx8 a, bfx8 b, f32x4 c) { return __builtin_amdgcn_mfma_f32_16x16x32_bf16(a, b, c, 0, 0, 0); }
__device__ __forceinline__ void ce_desc(float& a, float& b) { const float hi = fmaxf(a, b), lo = fminf(a, b); a = hi; b = lo; }
__device__ __forceinline__ void sort16_desc(float (&v)[16]) {
#pragma unroll
    for (int k = 2; k <= 16; k <<= 1)
#pragma unroll
        for (int j = k >> 1; j > 0; j >>= 1)
#pragma unroll
            for (int i = 0; i < 16; ++i) { const int l = i ^ j; if (l > i) { if ((i & k) == 0) ce_desc(v[i], v[l]); else ce_desc(v[l], v[i]); } }
}
__device__ __forceinline__ void merge16_desc(float (&v)[16]) {
#pragma unroll
    for (int j = 8; j > 0; j >>= 1)
#pragma unroll
        for (int i = 0; i < 16; ++i) { const int l = i ^ j; if (l > i) ce_desc(v[i], v[l]); }
}
struct Tile {
    bfx8 qf[4][2]; float slope2[4]; f32x4 ot[4][4]; float m[4], l[4];
    f32x4 negm[4], lt[4];
    int lane, ql, G, qpos;
};
__device__ __forceinline__ void qk_chunk(const Tile& t, const bf16* kb, f32x4 (&sa)[4], f32x4 (&sb)[4]) {
    const int r16 = t.ql; const bf16* ka = kb + (8 * (r16 >> 2) + (r16 & 3)) * 64 + 8 * t.G;
    const bfx8 a0 = *(const bfx8*)ka, a1 = *(const bfx8*)(ka + 32), b0 = *(const bfx8*)(ka + 256), b1 = *(const bfx8*)(ka + 256 + 32);
#pragma unroll
    for (int r = 0; r < 4; ++r) {
        f32x4 z = {0.f, 0.f, 0.f, 0.f};
        sa[r] = mfma16(a0, t.qf[r][0], z); sa[r] = mfma16(a1, t.qf[r][1], sa[r]);
        sb[r] = mfma16(b0, t.qf[r][0], z); sb[r] = mfma16(b1, t.qf[r][1], sb[r]);
    }
}
__device__ __forceinline__ void pv_chunk(Tile& t, const bf16* vtb, int pitch, const bfx8 (&pf)[4]) {
#pragma unroll
    for (int db = 0; db < 4; ++db) { const bfx8 vf = *(const bfx8*)(vtb + (size_t)(16 * db + t.ql) * pitch + 8 * t.G);
#pragma unroll
        for (int r = 0; r < 4; ++r) t.ot[r][db] = mfma16(vf, pf[r], t.ot[r][db]); }
}
__device__ __forceinline__ float gmax4(float v) {
    auto a = __builtin_amdgcn_permlane16_swap(__float_as_uint(v), __float_as_uint(v), false, false); v = fmaxf(__uint_as_float(a[0]), __uint_as_float(a[1]));
    auto b = __builtin_amdgcn_permlane32_swap(__float_as_uint(v), __float_as_uint(v), false, false); return fmaxf(__uint_as_float(b[0]), __uint_as_float(b[1])); }
__device__ __forceinline__ float gsum4(float v) {
    auto a = __builtin_amdgcn_permlane16_swap(__float_as_uint(v), __float_as_uint(v), false, false); v = __uint_as_float(a[0]) + __uint_as_float(a[1]);
    auto b = __builtin_amdgcn_permlane32_swap(__float_as_uint(v), __float_as_uint(v), false, false); return __uint_as_float(b[0]) + __uint_as_float(b[1]); }
__device__ __forceinline__ bfx8 pack_p(const float (&p)[8]) {
    v4u w; w.x = pg8::cvt_pk_bf16(p[0], p[1]); w.y = pg8::cvt_pk_bf16(p[2], p[3]); w.z = pg8::cvt_pk_bf16(p[4], p[5]); w.w = pg8::cvt_pk_bf16(p[6], p[7]);
    return __builtin_bit_cast(bfx8, w);
}
__device__ __forceinline__ void softmax_online(Tile& t, const f32x4 (&sa)[4], const f32x4 (&sb)[4], const float (&tk)[8], const bool (&ok)[8], bfx8 (&pf)[4]) {
#pragma unroll
    for (int r = 0; r < 4; ++r) {
        float s[8];
#pragma unroll
        for (int j = 0; j < 4; ++j) { s[j] = ok[j] ? __builtin_fmaf(t.slope2[r], tk[j], sa[r][j]) : -INFINITY; s[4 + j] = ok[4 + j] ? __builtin_fmaf(t.slope2[r], tk[4 + j], sb[r][j]) : -INFINITY; }
        float pm = fmaxf(fmaxf(fmaxf(s[0], s[1]), fmaxf(s[2], s[3])), fmaxf(fmaxf(s[4], s[5]), fmaxf(s[6], s[7])));
        pm = gmax4(pm);
        if (__any(pm > t.m[r])) {
            const float mn = fmaxf(t.m[r], pm), al = __builtin_amdgcn_exp2f(t.m[r] - mn);
            t.m[r] = mn; t.l[r] *= al;
#pragma unroll
            for (int db = 0; db < 4; ++db) t.ot[r][db] = t.ot[r][db] * al;
        }
        float p[8]; float ps = 0.f;
#pragma unroll
        for (int j = 0; j < 8; ++j) { p[j] = __builtin_amdgcn_exp2f(s[j] - t.m[r]); ps += p[j]; }
        t.l[r] += ps;
        pf[r] = pack_p(p);
    }
}
struct Frags { bfx8 a0, a1, b0, b1, vf[4]; };
__device__ __forceinline__ void load_frags(Frags& f, const Tile& t, const bf16* kb, const bf16* vtb, int pitch) {
    const int r16 = t.ql; const bf16* ka = kb + (8 * (r16 >> 2) + (r16 & 3)) * 64 + 8 * t.G;
    f.a0 = *(const bfx8*)ka; f.a1 = *(const bfx8*)(ka + 32); f.b0 = *(const bfx8*)(ka + 256); f.b1 = *(const bfx8*)(ka + 256 + 32);
#pragma unroll
    for (int db = 0; db < 4; ++db) f.vf[db] = *(const bfx8*)(vtb + (size_t)(16 * db + t.ql) * pitch + 8 * t.G);
}
__device__ __forceinline__ void chunk_compute(Tile& t, const Frags& f, const float (&tk)[8]) {
    float s[4][8]; bool grow = false;
#pragma unroll
    for (int r = 0; r < 4; ++r) {
        f32x4 sa = mfma16(f.a0, t.qf[r][0], t.negm[r]); sa = mfma16(f.a1, t.qf[r][1], sa);
        f32x4 sb = mfma16(f.b0, t.qf[r][0], t.negm[r]); sb = mfma16(f.b1, t.qf[r][1], sb);
#pragma unroll
        for (int j = 0; j < 4; ++j) { s[r][j] = __builtin_fmaf(t.slope2[r], tk[j], sa[j]); s[r][4 + j] = __builtin_fmaf(t.slope2[r], tk[4 + j], sb[j]); }
        const float pm = fmaxf(fmaxf(fmaxf(s[r][0], s[r][1]), fmaxf(s[r][2], s[r][3])), fmaxf(fmaxf(s[r][4], s[r][5]), fmaxf(s[r][6], s[r][7])));
        grow = grow || (pm > 8.f);
    }
    if (__any(grow)) {
#pragma unroll
        for (int r = 0; r < 4; ++r) {
            float pm = fmaxf(fmaxf(fmaxf(s[r][0], s[r][1]), fmaxf(s[r][2], s[r][3])), fmaxf(fmaxf(s[r][4], s[r][5]), fmaxf(s[r][6], s[r][7])));
            pm = gmax4(pm);
            const float dl = fmaxf(pm, 0.f), al = __builtin_amdgcn_exp2f(-dl);
            t.m[r] += dl; t.negm[r] = t.negm[r] - dl; t.lt[r] = t.lt[r] * al;
#pragma unroll
            for (int db = 0; db < 4; ++db) t.ot[r][db] = t.ot[r][db] * al;
#pragma unroll
            for (int j = 0; j < 8; ++j) s[r][j] -= dl;
        }
    }
    const v4u one4 = {0x3f803f80u, 0x3f803f80u, 0x3f803f80u, 0x3f803f80u}; const bfx8 ones = __builtin_bit_cast(bfx8, one4);
#pragma unroll
    for (int r = 0; r < 4; ++r) {
        float p[8];
#pragma unroll
        for (int j = 0; j < 8; ++j) p[j] = __builtin_amdgcn_exp2f(s[r][j]);
        const bfx8 pf = pack_p(p);
#pragma unroll
        for (int db = 0; db < 4; ++db) t.ot[r][db] = mfma16(f.vf[db], pf, t.ot[r][db]);
        t.lt[r] = mfma16(ones, pf, t.lt[r]);
    }
}
__device__ __forceinline__ void reset_branch(Tile& t) {
#pragma unroll
    for (int r = 0; r < 4; ++r) { t.m[r] = -60.f; t.l[r] = 0.f; t.negm[r] = (f32x4){60.f, 60.f, 60.f, 60.f}; t.lt[r] = (f32x4){0.f, 0.f, 0.f, 0.f};
#pragma unroll
        for (int db = 0; db < 4; ++db) t.ot[r][db] = (f32x4){0.f, 0.f, 0.f, 0.f}; }
}
template <bool FIRST> __device__ __forceinline__ void fold_branch(Tile& t, LAS float* otl, const float (&gate)[4]) {
#pragma unroll
    for (int r = 0; r < 4; ++r) { const float lt = t.lt[r][0]; const float f = lt > 0.f ? gate[r] / lt : 0.f;
#pragma unroll
        for (int db = 0; db < 4; ++db)
#pragma unroll
            for (int i = 0; i < 4; ++i) { LAS float* p = otl + ((r * 16 + db * 4 + i) * 64 + t.lane); const float v = f * t.ot[r][db][i]; *p = FIRST ? v : (*p + v); } }
}

__device__ __forceinline__ void tile_select(const Ctx& c, const Tile& t, int lane_, int b, int g, int qt, const bf16* KC, LAS float* wl, unsigned long long& m64_out, unsigned long long& U_out) {
    const int qpos = t.qpos, ql = t.ql, G = t.G;
    const int ncv = qpos >= 31 ? ((qpos - 31) >> 4) + 1 : 0;
    const int nch = (qt + 31) >> 5;
    unsigned long long m64, U;
    {
        LAS float* impA = wl; LAS float* impB = wl + 16 * IMP_PITCH;
        for (int i = lane_; i < 2 * 16 * IMP_PITCH; i += 64) wl[i] = 0.f;
        float cm[4], cl[4];
#pragma unroll
        for (int r = 0; r < 4; ++r) { cm[r] = NEGF; cl[r] = 0.f; }
        for (int ch = 0; ch < nch; ++ch) {
            f32x4 sa[4], sb[4]; qk_chunk(t, KC + (size_t)ch * 32 * HD, sa, sb);
            float tk[8];
#pragma unroll
            for (int j = 0; j < 8; ++j) { const int ci = ch * 32 + 8 * G + j; tk[j] = __builtin_fmaf(fmaxf((float)(ci - ncv + 1), 0.f), -1e36f, 16.f * (float)ci + 15.5f - (float)qpos); }
#pragma unroll
            for (int r = 0; r < 4; ++r) {
                float s[8];
#pragma unroll
                for (int j = 0; j < 4; ++j) { s[j] = __builtin_fmaf(t.slope2[r], tk[j], sa[r][j]); s[4 + j] = __builtin_fmaf(t.slope2[r], tk[4 + j], sb[r][j]); }
                float pm = fmaxf(fmaxf(fmaxf(s[0], s[1]), fmaxf(s[2], s[3])), fmaxf(fmaxf(s[4], s[5]), fmaxf(s[6], s[7])));
                pm = gmax4(pm);
                const float mn = fmaxf(cm[r], pm), al = __builtin_amdgcn_exp2f(cm[r] - mn);
                float ps = 0.f;
#pragma unroll
                for (int j = 0; j < 8; ++j) ps += __builtin_amdgcn_exp2f(s[j] - mn);
                cl[r] = cl[r] * al + ps; cm[r] = mn;
            }
        }
#pragma unroll
        for (int r = 0; r < 4; ++r) { const float lt = gsum4(cl[r]); cl[r] = lt > 0.f ? 1.f / lt : 0.f; }
        for (int ch = 0; ch < nch; ++ch) {
            f32x4 sa[4], sb[4]; qk_chunk(t, KC + (size_t)ch * 32 * HD, sa, sb);
            float tk[8];
#pragma unroll
            for (int j = 0; j < 8; ++j) { const int ci = ch * 32 + 8 * G + j; tk[j] = __builtin_fmaf(fmaxf((float)(ci - ncv + 1), 0.f), -1e36f, 16.f * (float)ci + 15.5f - (float)qpos); }
            float psum[8];
#pragma unroll
            for (int j = 0; j < 8; ++j) psum[j] = 0.f;
#pragma unroll
            for (int r = 0; r < 4; ++r) {
                float sv[8];
#pragma unroll
                for (int j = 0; j < 4; ++j) { sv[j] = __builtin_fmaf(t.slope2[r], tk[j], sa[r][j]); sv[4 + j] = __builtin_fmaf(t.slope2[r], tk[4 + j], sb[r][j]); }
#pragma unroll
                for (int j = 0; j < 8; ++j) psum[j] += __builtin_amdgcn_exp2f(sv[j] - cm[r]) * cl[r];
            }
            const int s0 = ch * 8 + 2 * G;
            impA[ql * IMP_PITCH + s0] = (psum[0] + psum[1]) + (psum[2] + psum[3]);
            impA[ql * IMP_PITCH + s0 + 1] = (psum[4] + psum[5]) + (psum[6] + psum[7]) + psum[3];
            impB[ql * IMP_PITCH + s0 + 2] = psum[7];
        }
        LDS_WAIT(); asm volatile("" ::: "memory");
        const int cur = qpos >> 6;
        float v[16], srt[16];
#pragma unroll
        for (int i4 = 0; i4 < 4; ++i4) { const f32x4 a = *(const LAS f32x4*)(impA + ql * IMP_PITCH + 16 * G + 4 * i4), bq = *(const LAS f32x4*)(impB + ql * IMP_PITCH + 16 * G + 4 * i4);
#pragma unroll
            for (int k = 0; k < 4; ++k) { const int s = 16 * G + 4 * i4 + k; const bool forced = (s == 0) || (s == cur) || (s == cur - 1);
                v[4 * i4 + k] = (s <= cur) ? (a[k] + bq[k]) + (forced ? 1000.f : 0.f) : NEGF; } }
#pragma unroll
        for (int i = 0; i < 16; ++i) srt[i] = v[i];
        if (PROBE_ATT) {
            float* sp_ = c.SCOREH() + ((size_t)(b * NKV + g) * T + qpos) * 64 + 16 * G;
#pragma unroll
            for (int i = 0; i < 4; ++i) *(GAS f32x4*)(sp_ + 4 * i) = (f32x4){v[4 * i], v[4 * i + 1], v[4 * i + 2], v[4 * i + 3]}; }
        sort16_desc(srt);
        float oth[16];
#pragma unroll
        for (int i = 0; i < 16; ++i) oth[i] = __shfl_xor(srt[i], 16);
#pragma unroll
        for (int i = 0; i < 16; ++i) srt[i] = fmaxf(srt[i], oth[15 - i]);
        merge16_desc(srt);
#pragma unroll
        for (int i = 0; i < 16; ++i) oth[i] = __shfl_xor(srt[i], 32);
        float thr = fmaxf(srt[0], oth[15]);
#pragma unroll
        for (int i = 1; i < 16; ++i) thr = fminf(thr, fmaxf(srt[i], oth[15 - i]));
        int ngt = 0, neq = 0;
#pragma unroll
        for (int i = 0; i < 16; ++i) { ngt += v[i] > thr ? 1 : 0; neq += v[i] == thr ? 1 : 0; }
        int ngt_t = ngt + __shfl_xor(ngt, 16); ngt_t += __shfl_xor(ngt_t, 32);
        const int need = 16 - ngt_t;
        int eqb = 0;
#pragma unroll
        for (int gg = 0; gg < 3; ++gg) { const int o = __shfl(neq, ql + 16 * gg); eqb += (gg < G) ? o : 0; }
        unsigned mloc = 0; int run = eqb;
#pragma unroll
        for (int i = 0; i < 16; ++i) { const int s = 16 * G + i; bool sel = v[i] > thr; if (v[i] == thr) { sel = run < need; ++run; } sel = sel && (s <= cur); mloc |= sel ? (1u << i) : 0u; }
        const unsigned w0 = __shfl(mloc, ql), w1 = __shfl(mloc, ql + 16), w2 = __shfl(mloc, ql + 32), w3 = __shfl(mloc, ql + 48);
        const unsigned lo = w0 | (w1 << 16), hi = w2 | (w3 << 16);
        m64 = ((unsigned long long)hi << 32) | lo;
        unsigned ulo = lo, uhi = hi;
#pragma unroll
        for (int o = 1; o < 16; o <<= 1) { ulo |= __shfl_xor(ulo, o); uhi |= __shfl_xor(uhi, o); }
        U = ((unsigned long long)(unsigned)__builtin_amdgcn_readfirstlane(uhi) << 32) | (unsigned)__builtin_amdgcn_readfirstlane(ulo);
        if (PROBE_ATT && G == 0) c.MASKM()[(size_t)(b * NKV + g) * T + qpos] = m64;
    }
    m64_out = m64; U_out = U;
}

__device__ __forceinline__ void attn_tile(const Ctx& c, int b, int g, int qt, LAS float* wl, int mode = -1) {
    int lane_ = c.lane; asm volatile("" : "+v"(lane_));
    Tile t; t.lane = lane_; t.ql = lane_ & 15; t.G = lane_ >> 4;
    const int q0 = qt * 16; t.qpos = q0 + t.ql;
    const int qpos = t.qpos, ql = t.ql, G = t.G;
    const size_t row = (size_t)(b * T + qpos);
#pragma unroll
    for (int r = 0; r < 4; ++r) {
        const int h = 4 * g + r;
        t.qf[r][0] = *(const bfx8*)(c.Q() + row * D + h * HD + 8 * G); t.qf[r][1] = *(const bfx8*)(c.Q() + row * D + h * HD + 32 + 8 * G);
        t.slope2[r] = exp2f(-0.5f * (float)(h + 1)) * LOG2E;
    }
    const float* gatep = c.NGT() + row * 48 + 12 * g;
    const size_t bg = (size_t)(b * NKV + g);
    const bf16* KC = c.KCCB() + bg * NCP_P * HD;
    const bf16* VCT = c.VCCT() + bg * HD * NCP_P;
    const bf16* KS = c.HM() + 2 * HMSZ + bg * T * HD;
    const bf16* VST = c.VST() + bg * HD * T;
    const bf16* KW = c.HM() + 4 * HMSZ + bg * T * HD;
    const bf16* VWT = c.VWT() + bg * HD * T;
    const int ncv = qpos >= 31 ? ((qpos - 31) >> 4) + 1 : 0;
    const int nch = (qt + 31) >> 5;
    unsigned long long m64, U;
    {
        LAS float* impA = wl; LAS float* impB = wl + 16 * IMP_PITCH;
        for (int i = lane_; i < 2 * 16 * IMP_PITCH; i += 64) wl[i] = 0.f;
        float cm[4], cl[4];
#pragma unroll
        for (int r = 0; r < 4; ++r) { cm[r] = NEGF; cl[r] = 0.f; }
        for (int ch = 0; ch < nch; ++ch) {
            f32x4 sa[4], sb[4]; qk_chunk(t, KC + (size_t)ch * 32 * HD, sa, sb);
            float tk[8];
#pragma unroll
            for (int j = 0; j < 8; ++j) { const int ci = ch * 32 + 8 * G + j; tk[j] = __builtin_fmaf(fmaxf((float)(ci - ncv + 1), 0.f), -1e36f, 16.f * (float)ci + 15.5f - (float)qpos); }
#pragma unroll
            for (int r = 0; r < 4; ++r) {
                float s[8];
#pragma unroll
                for (int j = 0; j < 4; ++j) { s[j] = __builtin_fmaf(t.slope2[r], tk[j], sa[r][j]); s[4 + j] = __builtin_fmaf(t.slope2[r], tk[4 + j], sb[r][j]); }
                float pm = fmaxf(fmaxf(fmaxf(s[0], s[1]), fmaxf(s[2], s[3])), fmaxf(fmaxf(s[4], s[5]), fmaxf(s[6], s[7])));
                pm = gmax4(pm);
                const float mn = fmaxf(cm[r], pm), al = __builtin_amdgcn_exp2f(cm[r] - mn);
                float ps = 0.f;
#pragma unroll
                for (int j = 0; j < 8; ++j) ps += __builtin_amdgcn_exp2f(s[j] - mn);
                cl[r] = cl[r] * al + ps; cm[r] = mn;
            }
        }
#pragma unroll
        for (int r = 0; r < 4; ++r) { const float lt = gsum4(cl[r]); cl[r] = lt > 0.f ? 1.f / lt : 0.f; }
        for (int ch = 0; ch < nch; ++ch) {
            f32x4 sa[4], sb[4]; qk_chunk(t, KC + (size_t)ch * 32 * HD, sa, sb);
            float tk[8];
#pragma unroll
            for (int j = 0; j < 8; ++j) { const int ci = ch * 32 + 8 * G + j; tk[j] = __builtin_fmaf(fmaxf((float)(ci - ncv + 1), 0.f), -1e36f, 16.f * (float)ci + 15.5f - (float)qpos); }
            float psum[8];
#pragma unroll
            for (int j = 0; j < 8; ++j) psum[j] = 0.f;
#pragma unroll
            for (int r = 0; r < 4; ++r) {
                float sv[8];
#pragma unroll
                for (int j = 0; j < 4; ++j) { sv[j] = __builtin_fmaf(t.slope2[r], tk[j], sa[r][j]); sv[4 + j] = __builtin_fmaf(t.slope2[r], tk[4 + j], sb[r][j]); }
#pragma unroll
                for (int j = 0; j < 8; ++j) psum[j] += __builtin_amdgcn_exp2f(sv[j] - cm[r]) * cl[r];
            }
            const int s0 = ch * 8 + 2 * G;
            impA[ql * IMP_PITCH + s0] = (psum[0] + psum[1]) + (psum[2] + psum[3]);
            impA[ql * IMP_PITCH + s0 + 1] = (psum[4] + psum[5]) + (psum[6] + psum[7]) + psum[3];
            impB[ql * IMP_PITCH + s0 + 2] = psum[7];
        }
        LDS_WAIT(); asm volatile("" ::: "memory");
        const int cur = qpos >> 6;
        float v[16], srt[16];
#pragma unroll
        for (int i4 = 0; i4 < 4; ++i4) { const f32x4 a = *(const LAS f32x4*)(impA + ql * IMP_PITCH + 16 * G + 4 * i4), bq = *(const LAS f32x4*)(impB + ql * IMP_PITCH + 16 * G + 4 * i4);
#pragma unroll
            for (int k = 0; k < 4; ++k) { const int s = 16 * G + 4 * i4 + k; const bool forced = (s == 0) || (s == cur) || (s == cur - 1);
                v[4 * i4 + k] = (s <= cur) ? (a[k] + bq[k]) + (forced ? 1000.f : 0.f) : NEGF; } }
#pragma unroll
        for (int i = 0; i < 16; ++i) srt[i] = v[i];
        if (PROBE_ATT) {
            float* sp_ = c.SCOREH() + ((size_t)(b * NKV + g) * T + qpos) * 64 + 16 * G;
#pragma unroll
            for (int i = 0; i < 4; ++i) *(GAS f32x4*)(sp_ + 4 * i) = (f32x4){v[4 * i], v[4 * i + 1], v[4 * i + 2], v[4 * i + 3]}; }
        sort16_desc(srt);
        float oth[16];
#pragma unroll
        for (int i = 0; i < 16; ++i) oth[i] = __shfl_xor(srt[i], 16);
#pragma unroll
        for (int i = 0; i < 16; ++i) srt[i] = fmaxf(srt[i], oth[15 - i]);
        merge16_desc(srt);
#pragma unroll
        for (int i = 0; i < 16; ++i) oth[i] = __shfl_xor(srt[i], 32);
        float thr = fmaxf(srt[0], oth[15]);
#pragma unroll
        for (int i = 1; i < 16; ++i) thr = fminf(thr, fmaxf(srt[i], oth[15 - i]));
        int ngt = 0, neq = 0;
#pragma unroll
        for (int i = 0; i < 16; ++i) { ngt += v[i] > thr ? 1 : 0; neq += v[i] == thr ? 1 : 0; }
        int ngt_t = ngt + __shfl_xor(ngt, 16); ngt_t += __shfl_xor(ngt_t, 32);
        const int need = 16 - ngt_t;
        int eqb = 0;
#pragma unroll
        for (int gg = 0; gg < 3; ++gg) { const int o = __shfl(neq, ql + 16 * gg); eqb += (gg < G) ? o : 0; }
        unsigned mloc = 0; int run = eqb;
#pragma unroll
        for (int i = 0; i < 16; ++i) { const int s = 16 * G + i; bool sel = v[i] > thr; if (v[i] == thr) { sel = run < need; ++run; } sel = sel && (s <= cur); mloc |= sel ? (1u << i) : 0u; }
        const unsigned w0 = __shfl(mloc, ql), w1 = __shfl(mloc, ql + 16), w2 = __shfl(mloc, ql + 32), w3 = __shfl(mloc, ql + 48);
        const unsigned lo = w0 | (w1 << 16), hi = w2 | (w3 << 16);
        m64 = ((unsigned long long)hi << 32) | lo;
        unsigned ulo = lo, uhi = hi;
#pragma unroll
        for (int o = 1; o < 16; o <<= 1) { ulo |= __shfl_xor(ulo, o); uhi |= __shfl_xor(uhi, o); }
        U = ((unsigned long long)(unsigned)__builtin_amdgcn_readfirstlane(uhi) << 32) | (unsigned)__builtin_amdgcn_readfirstlane(ulo);
        if (PROBE_ATT && G == 0) c.MASKM()[(size_t)(b * NKV + g) * T + qpos] = m64;
    }
    asm volatile("" ::: "memory");
    reset_branch(t);
    {
        unsigned long long Ur = U; int hf = 0;
        int nxt = Ur ? 64 * __builtin_ctzll(Ur) : -1;
        Frags fn; if (nxt >= 0) load_frags(fn, t, KS + (size_t)nxt * HD, VST + nxt, T);
        while (nxt >= 0) {
            const int base = nxt; const Frags fc = fn;
            if (hf == 0 && base + 32 <= q0 + 15) { hf = 1; nxt = base + 32; }
            else { hf = 0; Ur &= Ur - 1; nxt = Ur ? 64 * __builtin_ctzll(Ur) : -1; }
            if (nxt >= 0) load_frags(fn, t, KS + (size_t)nxt * HD, VST + nxt, T);
            const float pen = ((m64 >> (base >> 6)) & 1ull) ? 0.f : -1e36f;
            float tk[8]; const float fb = (float)(base + 8 * G - qpos) + pen;
            if (base + 31 <= q0) {
#pragma unroll
                for (int j = 0; j < 8; ++j) tk[j] = fb + (float)j;
            } else {
#pragma unroll
                for (int j = 0; j < 8; ++j) { const float fd = fb + (float)j; tk[j] = __builtin_fmaf(fmaxf(fd - pen, 0.f), -1e36f, fd); }
            }
            chunk_compute(t, fc, tk);
        }
    }
    { float gt[4];
#pragma unroll
      for (int r = 0; r < 4; ++r) gt[r] = (mode < 0 || mode == 1) ? gatep[r * 3 + 1] : 0.f;
      fold_branch<true>(t, wl, gt); }
    reset_branch(t);
    {
        int wlo = q0 - 511; wlo = wlo < 0 ? 0 : wlo; wlo &= ~31;
        const int whi = (q0 + 15) & ~31;
        Frags fn; load_frags(fn, t, KW + (size_t)wlo * HD, VWT + wlo, T);
#pragma unroll 1
        for (int base = wlo; base <= whi; base += 32) {
            const Frags fc = fn;
            if (base + 32 <= whi) load_frags(fn, t, KW + (size_t)(base + 32) * HD, VWT + base + 32, T);
            float tk[8]; const float fb = (float)(base + 8 * G - qpos);
            if (base + 31 <= q0 && base >= q0 - 496) {
#pragma unroll
                for (int j = 0; j < 8; ++j) tk[j] = fb + (float)j;
            } else {
#pragma unroll
                for (int j = 0; j < 8; ++j) { const float fd = fb + (float)j; const float cl_ = fminf(fmaxf(fd, -511.f), 0.f); tk[j] = __builtin_fmaf(fabsf(fd - cl_), -1e36f, fd); }
            }
            chunk_compute(t, fc, tk);
        }
    }
    { float gt[4];
#pragma unroll
      for (int r = 0; r < 4; ++r) gt[r] = (mode < 0 || mode == 2) ? gatep[r * 3 + 2] : 0.f;
      fold_branch<false>(t, wl, gt); }
    reset_branch(t);
    { Frags fn; if (nch > 0) load_frags(fn, t, KC, VCT, NCP_P);
#pragma unroll 1
      for (int ch = 0; ch < nch; ++ch) {
        const Frags fc = fn;
        if (ch + 1 < nch) load_frags(fn, t, KC + (size_t)(ch + 1) * 32 * HD, VCT + (ch + 1) * 32, NCP_P);
        float tk[8];
#pragma unroll
        for (int j = 0; j < 8; ++j) { const int ci = ch * 32 + 8 * G + j; tk[j] = __builtin_fmaf(fmaxf((float)(ci - ncv + 1), 0.f), -1e36f, 16.f * (float)ci + 15.5f - (float)qpos); }
        chunk_compute(t, fc, tk);
      } }
#pragma unroll
    for (int r = 0; r < 4; ++r) { const float lt = t.lt[r][0]; const float f = (lt > 0.f && (mode < 0 || mode == 0)) ? gatep[r * 3] / lt : 0.f;
#pragma unroll
        for (int db = 0; db < 4; ++db) { float o4[4];
#pragma unroll
            for (int i = 0; i < 4; ++i) o4[i] = wl[(r * 16 + db * 4 + i) * 64 + t.lane] + f * t.ot[r][db][i];
            const unsigned long long pk = (unsigned long long)pg8::cvt_pk_bf16(o4[0], o4[1]) | ((unsigned long long)pg8::cvt_pk_bf16(o4[2], o4[3]) << 32);
            *(GAS unsigned long long*)(c.OB + row * D + (4 * g + r) * HD + 16 * db + 4 * G) = pk; } }
    LDS_WAIT(); asm volatile("" ::: "memory");
}
__device__ __forceinline__ void p4_attn_prompt(const Ctx& c, int mode = -1) {
    LAS float* wl = (LAS float*)c.lds + c.wave * 4096;
    for (int wg = c.bid; wg < NB * NKV * 16; wg += c.G) {
        const int p = wg & 15, g = (wg >> 4) & 3, b = wg >> 6;
        attn_tile(c, b, g, 8 * (31 - p) + c.wave, wl, mode);
        attn_tile(c, b, g, 8 * p + c.wave, wl, mode);
    }
}
}

namespace at {
constexpr int KP = 144, VP = 80, STG_K = 32 * KP, STG_V = 64 * VP, STG_BYTES = STG_K + STG_V;
constexpr int WG_WAVE_BYTES = 16384, WG_STG_OFF = 8 * WG_WAVE_BYTES, WG_UX_OFF = WG_STG_OFF + 2 * STG_BYTES;
static_assert(WG_UX_OFF + 64 <= RING_BYTES, "attention LDS map");
__device__ __forceinline__ void attn_wg(const Ctx& c, int b, int g, int cq, int mode) {
    int lane_ = c.lane; asm volatile("" : "+v"(lane_));
    int tid_ = c.tid; asm volatile("" : "+v"(tid_));
    const int wave = c.wave;
    Tile t; t.lane = lane_; t.ql = lane_ & 15; t.G = lane_ >> 4;
    const int qt = 8 * cq + wave, q0 = qt * 16, q0w = cq * 128; t.qpos = q0 + t.ql;
    const int qpos = t.qpos, G = t.G, r16 = t.ql;
    const size_t row = (size_t)(b * T + qpos);
#pragma unroll
    for (int r = 0; r < 4; ++r) {
        const int h = 4 * g + r;
        t.qf[r][0] = *(const bfx8*)(c.Q() + row * D + h * HD + 8 * G); t.qf[r][1] = *(const bfx8*)(c.Q() + row * D + h * HD + 32 + 8 * G);
        t.slope2[r] = exp2f(-0.5f * (float)(h + 1)) * LOG2E;
    }
    const float* gatep = c.NGT() + row * 48 + 12 * g;
    const size_t bg = (size_t)(b * NKV + g);
    const bf16* KC = c.KCCB() + bg * NCP_P * HD; const bf16* VCT = c.VCCT() + bg * HD * NCP_P;
    const bf16* KS = c.HM() + 2 * HMSZ + bg * T * HD; const bf16* VST = c.VST() + bg * HD * T;
    const bf16* KW = c.HM() + 4 * HMSZ + bg * T * HD; const bf16* VWT = c.VWT() + bg * HD * T;
    LAS unsigned char* lds = c.lds;
    unsigned long long m64, Ut;
    LAS float* wl = (LAS float*)(lds + wave * WG_WAVE_BYTES);
    tile_select(c, t, lane_, b, g, qt, KC, wl, m64, Ut);
#ifdef DUP_SELECT
    { unsigned long long m2, u2; tile_select(c, t, lane_, b, g, qt, KC, wl, m2, u2); m64 |= m2; Ut |= u2; }
#endif
    LAS unsigned long long* UX = (LAS unsigned long long*)(lds + WG_UX_OFF);
    if (lane_ == 0) UX[wave] = Ut;
    __syncthreads();
    unsigned long long Uw = 0;
#pragma unroll
    for (int w = 0; w < NWAVES; ++w) Uw |= UX[w];
    Uw = ((unsigned long long)(unsigned)__builtin_amdgcn_readfirstlane((unsigned)(Uw >> 32)) << 32) | (unsigned)__builtin_amdgcn_readfirstlane((unsigned)Uw);
    const int ncv = qpos >= 31 ? ((qpos - 31) >> 4) + 1 : 0;
    const int ncht = (qt + 31) >> 5, nchw = (8 * cq + 7 + 31) >> 5;
    int wlo = q0w - 511; wlo = wlo < 0 ? 0 : wlo; wlo &= ~31; const int whi = (q0w + 127) & ~31;
    const bool kpart = tid_ < 256; const int sp = kpart ? tid_ : tid_ - 256;
    const int srow = kpart ? (sp >> 3) : (sp >> 2), spc = kpart ? (sp & 7) : (sp & 3);
    const int sdst = kpart ? (srow * KP + spc * 16) : (STG_K + srow * VP + spc * 16);
    int br = 0; unsigned long long Ur = Uw; int base = 64 * __builtin_ctzll(Ur);
#define ATT_SRC(BR, BASE) (kpart ? (const void*)(((BR) == 0 ? KS : (BR) == 1 ? KW : KC) + (size_t)((BASE) + srow) * HD + 8 * spc) \
                                 : (const void*)(((BR) == 0 ? VST : (BR) == 1 ? VWT : VCT) + (size_t)srow * ((BR) == 2 ? NCP_P : T) + (BASE) + 8 * spc))
    v4u sreg = *(const v4u*)ATT_SRC(br, base);
    *(LAS v4u*)(lds + WG_STG_OFF + sdst) = sreg;
    __syncthreads();
    reset_branch(t);
    int cur = 0;
    while (br < 3) {
        int nbr = br, nbase = base;
        if (br == 0) { if ((base & 32) == 0 && base + 32 <= q0w + 127) nbase = base + 32; else { Ur &= Ur - 1; if (Ur) nbase = 64 * __builtin_ctzll(Ur); else { nbr = 1; nbase = wlo; } } }
        else if (br == 1) { nbase = base + 32; if (nbase > whi) { nbr = nchw > 0 ? 2 : 3; nbase = 0; } }
        else { nbase = base + 32; if (nbase >= 32 * nchw) nbr = 3; }
        if (nbr < 3) sreg = *(const v4u*)ATT_SRC(nbr, nbase);
        bool need;
        if (br == 0) need = ((Ut >> (base >> 6)) & 1ull) && base <= q0 + 15;
        else if (br == 1) need = base + 31 >= q0 - 511 && base <= q0 + 15;
        else need = (base >> 5) < ncht;
        if (need) {
            const LAS unsigned char* kb = lds + WG_STG_OFF + cur * STG_BYTES;
            Frags f; const LAS unsigned char* ka = kb + (8 * (r16 >> 2) + (r16 & 3)) * KP + G * 16;
            f.a0 = *(const LAS bfx8*)ka; f.a1 = *(const LAS bfx8*)(ka + 64); f.b0 = *(const LAS bfx8*)(ka + 4 * KP); f.b1 = *(const LAS bfx8*)(ka + 4 * KP + 64);
#pragma unroll
            for (int db = 0; db < 4; ++db) f.vf[db] = *(const LAS bfx8*)(kb + STG_K + (16 * db + r16) * VP + G * 16);
            float tk[8];
            if (br == 0) {
                const float pen = ((m64 >> (base >> 6)) & 1ull) ? 0.f : -1e36f;
                const float fb = (float)(base + 8 * G - qpos) + pen;
                if (base + 31 <= q0) {
#pragma unroll
                    for (int j = 0; j < 8; ++j) tk[j] = fb + (float)j;
                } else {
#pragma unroll
                    for (int j = 0; j < 8; ++j) { const float fd = fb + (float)j; tk[j] = __builtin_fmaf(fmaxf(fd - pen, 0.f), -1e36f, fd); }
                }
            } else if (br == 1) {
                const float fb = (float)(base + 8 * G - qpos);
                if (base + 31 <= q0 && base >= q0 - 496) {
#pragma unroll
                    for (int j = 0; j < 8; ++j) tk[j] = fb + (float)j;
                } else {
#pragma unroll
                    for (int j = 0; j < 8; ++j) { const float fd = fb + (float)j; const float cl_ = fminf(fmaxf(fd, -511.f), 0.f); tk[j] = __builtin_fmaf(fabsf(fd - cl_), -1e36f, fd); }
                }
            } else {
#pragma unroll
                for (int j = 0; j < 8; ++j) { const int ci = base + 8 * G + j; tk[j] = __builtin_fmaf(fmaxf((float)(ci - ncv + 1), 0.f), -1e36f, 16.f * (float)ci + 15.5f - (float)qpos); }
            }
            chunk_compute(t, f, tk);
        }
        if (nbr != br) {
            const int gi = br == 0 ? 1 : br == 1 ? 2 : 0;
            float gt[4];
#pragma unroll
            for (int r = 0; r < 4; ++r) gt[r] = (mode < 0 || mode == gi) ? gatep[r * 3 + gi] : 0.f;
            if (br == 0) fold_branch<true>(t, wl, gt); else fold_branch<false>(t, wl, gt);
            reset_branch(t);
        }
        if (nbr < 3) *(LAS v4u*)(lds + WG_STG_OFF + (cur ^ 1) * STG_BYTES + sdst) = sreg;
        __syncthreads();
        br = nbr; base = nbase; cur ^= 1;
    }
#undef ATT_SRC
#pragma unroll
    for (int r = 0; r < 4; ++r)
#pragma unroll
        for (int db = 0; db < 4; ++db) {
            float o4[4];
#pragma unroll
            for (int i = 0; i < 4; ++i) o4[i] = wl[(r * 16 + db * 4 + i) * 64 + lane_];
            const unsigned long long pk = (unsigned long long)pg8::cvt_pk_bf16(o4[0], o4[1]) | ((unsigned long long)pg8::cvt_pk_bf16(o4[2], o4[3]) << 32);
            *(GAS unsigned long long*)(c.OB + row * D + (4 * g + r) * HD + 16 * db + 4 * G) = pk; }
    LDS_WAIT(); asm volatile("" ::: "memory");
    __syncthreads();
}
__device__ __forceinline__ void p4_attn_prompt_wg(const Ctx& c, int mode = -1) {
    for (int wg = c.bid; wg < NB * NKV * 16; wg += c.G) {
        const int p = wg & 15, g = (wg >> 4) & 3, b = wg >> 6;
        attn_wg(c, b, g, 31 - p, mode);
        attn_wg(c, b, g, p, mode);
    }
}
}

namespace at {
constexpr int SC_PITCH = 520;
struct SCol { bfx8 qf[2]; float slope2; f32x4 ot[4]; float m, l; int lane, col, G, qpos, qi; };
__device__ __forceinline__ const float* srow_sel(const Ctx& c, int b, int g, int kv, int pos) {
    pos = pos > PAST + SS - 1 ? PAST + SS - 1 : pos;
    if (pos < PAST) return c.cache_sel() + ((size_t)c.pt()[b * NPG + (pos >> 7)] * PAGE + (pos & 127)) * 512 + kv * 256 + g * HD;
    return c.ZS() + (size_t)(b * SS + (pos - PAST)) * NIN + 4608 + kv * 256 + g * HD; }
__device__ __forceinline__ const float* srow_win(const Ctx& c, int b, int g, int kv, int pos) {
    pos = pos > PAST + SS - 1 ? PAST + SS - 1 : pos;
    if (pos < PAST) return c.cache_win() + ((size_t)(b * 512 + (pos - (PAST - 512)))) * 512 + kv * 256 + g * HD;
    return c.ZS() + (size_t)(b * SS + (pos - PAST)) * NIN + 5120 + kv * 256 + g * HD; }
__device__ __forceinline__ bfx8 cvt8(const float* p) { float v[8]; ld8(p, v); return __builtin_bit_cast(bfx8, pack8(v)); }
__device__ __forceinline__ void s_update(SCol& t, const f32x4& sa, const f32x4& sb, const float (&tk)[8], const bfx8 (&vf)[4]) {
    float s[8];
#pragma unroll
    for (int j = 0; j < 4; ++j) { s[j] = __builtin_fmaf(t.slope2, tk[j], sa[j]); s[4 + j] = __builtin_fmaf(t.slope2, tk[4 + j], sb[j]); }
    float pm = fmaxf(fmaxf(fmaxf(s[0], s[1]), fmaxf(s[2], s[3])), fmaxf(fmaxf(s[4], s[5]), fmaxf(s[6], s[7])));
    pm = gmax4(pm);
    const float mn = fmaxf(t.m, pm), al = __builtin_amdgcn_exp2f(t.m - mn);
    t.m = mn; t.l *= al;
#pragma unroll
    for (int db = 0; db < 4; ++db) t.ot[db] = t.ot[db] * al;
    float p[8]; float ps = 0.f;
#pragma unroll
    for (int j = 0; j < 8; ++j) { p[j] = __builtin_amdgcn_exp2f(s[j] - t.m); ps += p[j]; }
    t.l += ps;
    const bfx8 pf = pack_p(p);
#pragma unroll
    for (int db = 0; db < 4; ++db) t.ot[db] = mfma16(vf[db], pf, t.ot[db]);
}
__device__ __forceinline__ void s_chunk_bf16(SCol& t, const bf16* kb, const bf16* vtb, int pitch, const float (&tk)[8]) {
    const int r16 = t.col; const bf16* ka = kb + (8 * (r16 >> 2) + (r16 & 3)) * 64 + 8 * t.G;
    const bfx8 a0 = *(const bfx8*)ka, a1 = *(const bfx8*)(ka + 32), b0 = *(const bfx8*)(ka + 256), b1 = *(const bfx8*)(ka + 256 + 32);
    bfx8 vf[4];
#pragma unroll
    for (int db = 0; db < 4; ++db) vf[db] = *(const bfx8*)(vtb + (size_t)(16 * db + r16) * pitch + 8 * t.G);
    const f32x4 z = {0.f, 0.f, 0.f, 0.f};
    f32x4 sa = mfma16(a0, t.qf[0], z); sa = mfma16(a1, t.qf[1], sa);
    f32x4 sb = mfma16(b0, t.qf[0], z); sb = mfma16(b1, t.qf[1], sb);
    s_update(t, sa, sb, tk, vf);
}
template <bool WIN> __device__ __forceinline__ void s_chunk_f32(const Ctx& c, SCol& t, int b, int g, int base, const float (&tk)[8]) {
    const int r16 = t.col, ka_pos = base + 8 * (r16 >> 2) + (r16 & 3);
    const float* pa = WIN ? srow_win(c, b, g, 0, ka_pos) : srow_sel(c, b, g, 0, ka_pos);
    const float* pb = WIN ? srow_win(c, b, g, 0, ka_pos + 4) : srow_sel(c, b, g, 0, ka_pos + 4);
    const bfx8 a0 = cvt8(pa + 8 * t.G), a1 = cvt8(pa + 32 + 8 * t.G), b0 = cvt8(pb + 8 * t.G), b1 = cvt8(pb + 32 + 8 * t.G);
    float vv[4][8];
#pragma unroll
    for (int j = 0; j < 8; ++j) { const float* pv = WIN ? srow_win(c, b, g, 1, base + 8 * t.G + j) : srow_sel(c, b, g, 1, base + 8 * t.G + j);
#pragma unroll
        for (int db = 0; db < 4; ++db) vv[db][j] = pv[16 * db + r16]; }
    bfx8 vf[4];
#pragma unroll
    for (int db = 0; db < 4; ++db) vf[db] = __builtin_bit_cast(bfx8, pack8(vv[db]));
    const f32x4 z = {0.f, 0.f, 0.f, 0.f};
    f32x4 sa = mfma16(a0, t.qf[0], z); sa = mfma16(a1, t.qf[1], sa);
    f32x4 sb = mfma16(b0, t.qf[0], z); sb = mfma16(b1, t.qf[1], sb);
    s_update(t, sa, sb, tk, vf);
}
__device__ __forceinline__ void s_reset(SCol& t) { t.m = NEGF; t.l = 0.f;
#pragma unroll
    for (int db = 0; db < 4; ++db) t.ot[db] = (f32x4){0.f, 0.f, 0.f, 0.f}; }
__device__ __forceinline__ void s_store_partial(const SCol& t, LAS float* L, int wave, int br) {
    const int idx = (wave * 3 + br) * 16 + t.col;
#pragma unroll
    for (int db = 0; db < 4; ++db) *(LAS f32x4*)(L + idx * 64 + 16 * db + 4 * t.G) = t.ot[db];
    const float lt = gsum4(t.l);
    if (t.G == 0) { L[24576 + idx] = t.m; L[24576 + 384 + idx] = lt; }
}
__device__ __forceinline__ void attn_sample_item(const Ctx& c, int b, int g) {
    int lane_ = c.lane; asm volatile("" : "+v"(lane_));
    SCol t; t.lane = lane_; t.col = lane_ & 15; t.G = lane_ >> 4; t.qi = t.col & 3; t.qpos = PAST + t.qi;
    const int wave = c.wave, col = t.col, G = t.G, qpos = t.qpos;
    const int h = 4 * g + (col >> 2);
    t.slope2 = exp2f(-0.5f * (float)(h + 1)) * LOG2E;
    { const float* qp = c.ZS() + (size_t)(b * SS + t.qi) * NIN + 3072 + h * HD;
#pragma unroll
      for (int dh = 0; dh < 2; ++dh) { float v[8]; ld8(qp + 32 * dh + 8 * G, v);
#pragma unroll
          for (int j = 0; j < 8; ++j) v[j] *= QSCALE;
          t.qf[dh] = __builtin_bit_cast(bfx8, pack8(v)); } }
    const size_t bg = (size_t)(b * NKV + g);
    const bf16* KC = c.KCCSB() + bg * NCP_S * HD; const bf16* VCT = c.VCCST() + bg * HD * NCP_S;
    LAS float* L = (LAS float*)c.lds;
    LAS unsigned long long* MK = (LAS unsigned long long*)(L + 16 * SC_PITCH);
    __syncthreads();
    for (int ch = wave; ch < 16; ch += NWAVES) {
        const bf16* ka = KC + (size_t)ch * 32 * HD + (8 * (col >> 2) + (col & 3)) * 64 + 8 * G;
        const bfx8 a0 = *(const bfx8*)ka, a1 = *(const bfx8*)(ka + 32), b0 = *(const bfx8*)(ka + 256), b1 = *(const bfx8*)(ka + 256 + 32);
        const f32x4 z = {0.f, 0.f, 0.f, 0.f};
        f32x4 sa = mfma16(a0, t.qf[0], z); sa = mfma16(a1, t.qf[1], sa);
        f32x4 sb = mfma16(b0, t.qf[0], z); sb = mfma16(b1, t.qf[1], sb);
        f32x4 o0, o1;
#pragma unroll
        for (int j = 0; j < 4; ++j) { const int ci = ch * 32 + 8 * G + j;
            o0[j] = ci < NCS_S ? __builtin_fmaf(t.slope2, 16.f * (float)ci + 15.5f - (float)qpos, sa[j]) : -1e36f;
            o1[j] = ci + 4 < NCS_S ? __builtin_fmaf(t.slope2, 16.f * (float)(ci + 4) + 15.5f - (float)qpos, sb[j]) : -1e36f; }
        *(LAS f32x4*)(L + col * SC_PITCH + ch * 32 + 8 * G) = o0; *(LAS f32x4*)(L + col * SC_PITCH + ch * 32 + 8 * G + 4) = o1;
    }
    __syncthreads();
#pragma unroll 1
    for (int cc = 0; cc < 2; ++cc) { LAS float* sc = L + (2 * wave + cc) * SC_PITCH;
        float v[8]; float mx = -3e38f;
#pragma unroll
        for (int k = 0; k < 8; ++k) { v[k] = sc[lane_ + 64 * k]; mx = fmaxf(mx, v[k]); }
#pragma unroll
        for (int o = 1; o < 64; o <<= 1) mx = fmaxf(mx, __shfl_xor(mx, o));
        float sm = 0.f;
#pragma unroll
        for (int k = 0; k < 8; ++k) { v[k] = __builtin_amdgcn_exp2f(v[k] - mx); sm += v[k]; }
        sm = wave_sum(sm); const float inv = 1.f / sm;
#pragma unroll
        for (int k = 0; k < 8; ++k) sc[lane_ + 64 * k] = v[k] * inv; }
    __syncthreads();
    if (wave < SS) {
        const int qi = wave, cur = (PAST + qi) >> 6;
        float val[3];
#pragma unroll
        for (int k = 0; k < 3; ++k) { const int s = lane_ + 64 * k; float imp = 0.f;
            if (s < 129) {
#pragma unroll
                for (int r = 0; r < 4; ++r) { const LAS float* pc = L + (4 * r + qi) * SC_PITCH;
#pragma unroll
                    for (int j = -1; j < 4; ++j) { const int ci = 4 * s + j; if (ci >= 0 && ci < 512) imp += pc[ci]; } }
                const bool forced = (s == 0) || (s == cur) || (s == cur - 1);
                val[k] = imp + (forced ? 1000.f : 0.f);
            } else val[k] = -INFINITY; }
        int rank[3] = {0, 0, 0};
#pragma unroll
        for (int k2 = 0; k2 < 3; ++k2)
            for (int l2 = 0; l2 < 64; ++l2) { const float v2 = __shfl(val[k2], l2); const int s2 = l2 + 64 * k2;
#pragma unroll
                for (int k = 0; k < 3; ++k) { const int s = lane_ + 64 * k; rank[k] += (v2 > val[k] || (v2 == val[k] && s2 < s)) ? 1 : 0; } }
#pragma unroll
        for (int k = 0; k < 3; ++k) { const unsigned long long mk = __ballot(rank[k] < 16 && lane_ + 64 * k < 129); if (lane_ == 0) MK[qi * 3 + k] = mk; }
    }
    __syncthreads();
    unsigned long long mk[3], U[3];
#pragma unroll
    for (int k = 0; k < 3; ++k) { mk[k] = MK[t.qi * 3 + k]; U[k] = MK[k] | MK[3 + k] | MK[6 + k] | MK[9 + k]; }
    __syncthreads();
    s_reset(t);
    for (int ch = wave; ch < 16; ch += NWAVES) {
        float tk[8];
#pragma unroll
        for (int j = 0; j < 8; ++j) { const int ci = ch * 32 + 8 * G + j; tk[j] = ci < NCS_S ? 16.f * (float)ci + 15.5f - (float)qpos : -1e36f; }
        s_chunk_bf16(t, KC + (size_t)ch * 32 * HD, VCT + ch * 32, NCP_S, tk);
    }
    s_store_partial(t, L, wave, 0);
    s_reset(t);
    { int kcnt = 0;
#pragma unroll 1
      for (int w3 = 0; w3 < 3; ++w3) { unsigned long long u = (unsigned long long)__builtin_amdgcn_readfirstlane((unsigned)(U[w3] >> 32)) << 32 | (unsigned)__builtin_amdgcn_readfirstlane((unsigned)U[w3]);
        while (u) { const int sb_ = __builtin_ctzll(u); u &= u - 1; const int s = 64 * w3 + sb_;
            const bool mine = (mk[w3] >> sb_) & 1ull;
#pragma unroll 1
            for (int hf = 0; hf < 2; ++hf) { const int base = 64 * s + 32 * hf;
                if (base > PAST + SS - 1) break;
                if ((kcnt++ & (NWAVES - 1)) != wave) continue;
                float tk[8];
#pragma unroll
                for (int j = 0; j < 8; ++j) { const int pos = base + 8 * G + j; tk[j] = (mine && pos <= qpos) ? (float)(pos - qpos) : -1e36f; }
                s_chunk_f32<false>(c, t, b, g, base, tk); } } } }
    s_store_partial(t, L, wave, 1);
    s_reset(t);
    for (int ci = wave; ci < 17; ci += NWAVES) { const int base = PAST - 512 + 32 * ci;
        float tk[8];
#pragma unroll
        for (int j = 0; j < 8; ++j) { const int pos = base + 8 * G + j; tk[j] = (pos <= qpos && qpos - pos < 512) ? (float)(pos - qpos) : -1e36f; }
        s_chunk_f32<true>(c, t, b, g, base, tk); }
    s_store_partial(t, L, wave, 2);
    __syncthreads();
    { const int cc = c.tid >> 5, d0 = (c.tid & 31) * 2, qi = cc & 3, hh = 4 * g + (cc >> 2); const size_t row = (size_t)(b * SS + qi);
      float o0 = 0.f, o1 = 0.f;
#pragma unroll
      for (int br = 0; br < 3; ++br) {
          float M = -3e38f;
#pragma unroll
          for (int w = 0; w < NWAVES; ++w) M = fmaxf(M, L[24576 + (w * 3 + br) * 16 + cc]);
          float Ls = 0.f, a0 = 0.f, a1 = 0.f;
#pragma unroll
          for (int w = 0; w < NWAVES; ++w) { const int idx = (w * 3 + br) * 16 + cc; const float f = __builtin_amdgcn_exp2f(L[24576 + idx] - M);
              Ls += f * L[24576 + 384 + idx]; a0 += f * L[idx * 64 + d0]; a1 += f * L[idx * 64 + d0 + 1]; }
          const float gt = sigmoidf_(c.ZS()[row * NIN + 5632 + hh * 3 + br]);
          if (Ls > 0.f) { o0 += gt * a0 / Ls; o1 += gt * a1 / Ls; } }
      c.OBS()[row * D + hh * HD + d0] = o0; c.OBS()[row * D + hh * HD + d0 + 1] = o1; }
    __syncthreads();
}
__device__ __forceinline__ void p4_attn_sample(const Ctx& c) {
    for (int wg = c.bid; wg < NB * NKV * 16; wg += c.G) { const int p = wg & 15; if (p < 8) { const int it = 8 * (wg >> 4) + p; attn_sample_item(c, it >> 2, it & 3); } }
}
}

struct SEpiZ { float* ZS; __device__ __forceinline__ void operator()(int row, int n, float a1, float) const { ZS[(size_t)row * NIN + n] = a1; } };
struct SEpiMG { const float* ZS; float* MGS; __device__ __forceinline__ void operator()(int row, int n, float a1, float a2) const {
    MGS[(size_t)row * D + n] = sigmoidf_(ZS[(size_t)row * NIN + 5680 + n]) * a1 + sigmoidf_(ZS[(size_t)row * NIN + 5680 + D + n]) * a2; } };
struct SEpiRes { const float* base; float* O; const float* MOD; int goff; __device__ __forceinline__ void operator()(int row, int n, float a1, float) const {
    O[(size_t)row * D + n] = base[(size_t)row * D + n] + MOD[(size_t)(NB + (row >> 2)) * NMOD + goff + n] * a1; } };
struct SEpiFF { float* HFS; __device__ __forceinline__ void operator()(int row, int n, float a1, float a2) const { HFS[(size_t)row * FF + n] = siluf_(a1) * a2; } };

struct MEpiZ { float* ZS; int col0; __device__ __forceinline__ void operator()(int row, int j, float a1, float) const { ZS[(size_t)row * NIN + col0 + j] = a1; } };
struct MEpiMG { const float* ZS; float* MGS; int col0; __device__ __forceinline__ void operator()(int row, int j, float a1, float a2) const { const int n = col0 + j;
    MGS[(size_t)row * D + n] = sigmoidf_(ZS[(size_t)row * NIN + 5680 + n]) * a1 + sigmoidf_(ZS[(size_t)row * NIN + 5680 + D + n]) * a2; } };
struct MEpiRes { const float* base; float* O; const float* MOD; int goff, col0; __device__ __forceinline__ void operator()(int row, int j, float a1, float) const { const int n = col0 + j;
    O[(size_t)row * D + n] = base[(size_t)row * D + n] + MOD[(size_t)(NB + (row >> 2)) * NMOD + goff + n] * a1; } };
struct MEpiFF { float* HFS; int col0; __device__ __forceinline__ void operator()(int row, int j, float a1, float a2) const { HFS[(size_t)row * FF + col0 + j] = siluf_(a1) * a2; } };
__device__ __forceinline__ int win_src_col(int p) {
    if (p < 1024) return p;
    if (p < 3072) { const int t = (p - 1024) >> 8, w = (p - 1024) & 255; return (w < 128) ? (1024 + 128 * t + w) : (2048 + 128 * t + (w - 128)); }
    if (p < 5632) return p;
    if (p < 7680) return 5680 + (p - 5632);
    return 5632 + (p - 7680);
}

#ifndef PROBE_TH
#define PROBE_TH 0.02f
#endif
#ifndef PROBE_DM
#define PROBE_DM 0.10f
#endif
#ifndef PROBE_SATT
#define PROBE_SATT 0
#endif
#ifndef PROBE_STH
#define PROBE_STH 0.05f
#endif
#ifndef NAIVE_SATT
#define NAIVE_SATT 0
#endif
#ifndef ATTN_WG
#define ATTN_WG 1
#endif
#if ATTN_WG
#define ATTN_PROMPT at::p4_attn_prompt_wg
#else
#define ATTN_PROMPT at::p4_attn_prompt
#endif
#ifndef MK_SINGLE
#define MK_SINGLE 1
#endif
struct Args { const void* in[26]; float* out; unsigned char* ws; int ph_lo, ph_hi; };
__global__ void __launch_bounds__(NTHR, 2) fwd(Args a) {
    extern __shared__ __attribute__((aligned(16))) unsigned char lds[];
    Ctx c;
    c.lds = (LAS unsigned char*)lds;
    c.tid = threadIdx.x; c.lane = c.tid & 63; c.wave = __builtin_amdgcn_readfirstlane(c.tid >> 6); c.G = gridDim.x; c.bid = blockIdx.x;
    unsigned char* ws = a.ws;
    c.ws = ws; c.OB = (bf16*)(ws + WS_OB); c.CHK = (float*)(ws + WS_CTL) + 8192;

    for (int u = c.tid; u < (LDS_BYTES - LDSCTL_OFF) / 4; u += NTHR) ((LAS unsigned*)(c.lds + LDSCTL_OFF))[u] = 0u;
    __syncthreads();
    const int lo = a.ph_lo, hi = a.ph_hi;
    unsigned* ctl = (unsigned*)(ws + WS_CTL);
    volatile LAS unsigned* MISC = (volatile LAS unsigned*)(c.lds + MISC_OFF);
    XcdBarrier bar; bar.bar = ctl + CW_BAR; bar.x = 0; bar.st = nullptr;
    if (hi - lo > 1) bar = xcd_barrier_post(ctl + CW_BAR, MISC + 8);
#ifdef PH_ONLY
#define IN(k) ((k) == PH_ONLY)
#else
#define IN(k) (lo <= (k) && (k) < hi)
#endif
#ifdef PROBE_T
    unsigned long long ts_[16]; ts_[0] = __builtin_amdgcn_s_memrealtime();
#define SEAM(k) do { if (IN(k) && IN((k) + 1)) xcd_barrier(bar); ts_[(k) + 1] = __builtin_amdgcn_s_memrealtime(); } while (0)
#else
#define SEAM(k) do { if (IN(k) && IN((k) + 1)) xcd_barrier(bar); } while (0)
#endif

    if (IN(0)) { p0_prologue(c);
#ifdef DUP_P0
        __syncthreads(); p0_prologue(c);
#endif
    } SEAM(0);
    if (IN(1)) { p1_norm1(c); scmp_phase(c);
#ifdef DUP_SCMP
        scmp_phase(c);
#endif
#ifdef DUP_THIN
        p1_norm1(c);
#endif
    } SEAM(1);
    if (IN(2)) {
        pg8::Gemm g{c.XN(), c.WIN_T(), M, NINP, D}; pg8::StaticOrder S; S.init(M, NINP, c.G, c.bid);
        EpiIn E{c.BG(), c.U(), c.Q(), c.HM(), c.GA(), c.GB(), c.NGT(), c.out(), c.VST(), c.VWT(), c.ACMP()};
        pg8::gemm_phase<EpiIn, pg8::StaticOrder, true, true>(c.lds + RING_OFF, g, S, E);
#ifdef DUP_IN
        pg8::gemm_phase<EpiIn, pg8::StaticOrder, true, true>(c.lds + RING_OFF, g, S, E);
#endif
        for (int it = c.G - 1 - c.bid; it < NIN / 16; it += c.G) { const int p0 = it * 16;
            sgemm_item<1>(c, c.XNS(), c.XNS(), D, c.WIN_T() + (size_t)p0 * D, c.WIN_T(), D, MEpiZ{c.ZS(), win_src_col(p0)}); }
    } SEAM(2);
    if (IN(3)) {
        { pg8::Gemm g{c.ACMP(), c.W1T(), 2 * CM_ROWS, 512, 1024}; CmpOrder S{c.G, c.bid}; EpiCmp E{c.CCMP()};
          pg8::gemm_phase<EpiCmp, CmpOrder, true, true>(c.lds + RING_OFF, g, S, E); }
        p3_conv_prompt(c, 32); p3_sample_thin(c, 32);
#ifdef DUP_THIN
        p3_conv_prompt(c, 32); p3_sample_thin(c, 32);
#endif
#if PROBE_CMP
        compress_naive<CmpP>(c); compress_naive<CmpS>(c);
#endif
    } SEAM(3);
    if (IN(4)) { compress_step2(c);
#ifdef DUP_THIN
        compress_step2(c);
#endif
    } SEAM(4);
#if NAIVE_SATT || PROBE_SATT
    if (IN(5)) { p4a_scores<AtS>(c); } SEAM(5);
    if (IN(6)) { p4b_topk<AtS>(c); } SEAM(6);
#endif
#if PROBE_ATT && defined(PROBE_SEL) && PROBE_SEL == 4
    if (IN(7)) {
        ATTN_PROMPT(c, -1); __syncthreads(); xcd_barrier(bar);
        { int ln_ = c.lane; asm volatile("" : "+v"(ln_)); const int gw_ = c.bid * NWAVES + c.wave; float bad = 0.f;
          for (int w_ = gw_; w_ < NB * NKV * T; w_ += c.G * NWAVES) { const float v_ = c.SCOREH()[(size_t)w_ * 64 + ln_]; int rk_ = 0;
              for (int l2 = 0; l2 < 64; ++l2) { const float v2 = __shfl(v_, l2); rk_ += (v2 > v_ || (v2 == v_ && l2 < ln_)) ? 1 : 0; }
              const unsigned long long mk_ = __ballot(rk_ < 16 && ln_ <= ((w_ & (T - 1)) >> 6)); bad += (mk_ != c.MASKM()[w_]) ? 1.f : 0.f; }
          if (ln_ == 0 && bad != 0.f) atomicAdd(c.CHK + 7, bad); }
        xcd_barrier(bar);
    }
#elif PROBE_ATT
    if (IN(7)) {
        p4a_scores<AtP>(c); xcd_barrier(bar); p4b_topk<AtP>(c); xcd_barrier(bar);
#define PROBE_MODE(mode) do { \
            ATTN_PROMPT(c, mode); __syncthreads(); xcd_barrier(bar); \
            if (mode == 0) { \
                float diff = 0.f; \
                for (int i = gtid(c); i < NB * NKV * T; i += c.G * NTHR) { diff += (c.MASK()[i] != c.MASKM()[i]) ? 1.f : 0.f; } \
                if (diff != 0.f) atomicAdd(c.CHK + 6, diff); \
                { int ln_ = c.lane; asm volatile("" : "+v"(ln_)); const int gw_ = c.bid * NWAVES + c.wave; float bad = 0.f; \
                  for (int w_ = gw_; w_ < NB * NKV * T; w_ += c.G * NWAVES) { const float v_ = c.SCOREH()[(size_t)w_ * 64 + ln_]; int rk_ = 0; \
                      for (int l2 = 0; l2 < 64; ++l2) { const float v2 = __shfl(v_, l2); rk_ += (v2 > v_ || (v2 == v_ && l2 < ln_)) ? 1 : 0; } \
                      const unsigned long long mk_ = __ballot(rk_ < 16 && ln_ <= ((w_ & (T - 1)) >> 6)); bad += (mk_ != c.MASKM()[w_]) ? 1.f : 0.f; } \
                  if (ln_ == 0 && bad != 0.f) atomicAdd(c.CHK + 7, bad); } \
                xcd_barrier(bar); \
                for (int i = gtid(c); i < NB * NKV * T; i += c.G * NTHR) c.MASK()[i] = c.MASKM()[i]; \
                xcd_barrier(bar); \
            } \
            { Ctx c2 = c; c2.OB = c.OB2(); p4c_attend<AtP>(c2, mode); } \
            xcd_barrier(bar); \
            float num = 0.f, den = 0.f, nfa = 0.f, nfr = 0.f; \
            for (int i = gtid(c); i < M * D; i += c.G * NTHR) { const float a_ = bf2f(c.OB[i]), r_ = bf2f(c.OB2()[i]); const bool fa_ = fabsf(a_) < 1e30f, fr_ = fabsf(r_) < 1e30f; \
                if (fa_ && fr_) { num += (a_ - r_) * (a_ - r_); den += r_ * r_; } nfa += fa_ ? 0.f : 1.f; nfr += fr_ ? 0.f : 1.f; } \
            if (nfa != 0.f) atomicAdd(c.CHK + 8 + 2 * mode, nfa); if (nfr != 0.f) atomicAdd(c.CHK + 9 + 2 * mode, nfr); \
            atomicAdd(c.CHK + 2 * mode, num); atomicAdd(c.CHK + 2 * mode + 1, den); \
            xcd_barrier(bar); } while (0)
        PROBE_MODE(0);
#if !defined(PROBE_SEL) || PROBE_SEL != 4
        PROBE_MODE(1); PROBE_MODE(2);
#endif
    }
#endif
    if (IN(7)) { ATTN_PROMPT(c); __syncthreads();
#ifdef DUP_ATT
        ATTN_PROMPT(c); __syncthreads();
#endif
#if !defined(NO_S6)
#if NAIVE_SATT
        p4c_attend<AtS>(c);
#elif PROBE_SATT
        p4c_attend<AtS>(c); xcd_barrier(bar);
        for (int i = gtid(c); i < MS * D; i += c.G * NTHR) c.X2S()[i] = c.OBS()[i];
        xcd_barrier(bar);
        at::p4_attn_sample(c); xcd_barrier(bar);
        { float num = 0.f, den = 0.f;
          for (int i = gtid(c); i < MS * D; i += c.G * NTHR) { const float a_ = c.OBS()[i], r_ = c.X2S()[i]; num += (a_ - r_) * (a_ - r_); den += r_ * r_; }
          if (num != 0.f || den != 0.f) { atomicAdd(c.CHK + 40, num); atomicAdd(c.CHK + 41, den); } }
#else
        at::p4_attn_sample(c);
#ifdef DUP_SATT
        at::p4_attn_sample(c);
#endif
#endif
#endif
 } SEAM(7);
    if (IN(8)) {
        { pg8::Gemm g{c.AA(), c.WOC_T(), M, D, D}; pg8::StaticOrder S; S.init(M, D, c.G, c.bid); EpiYa E{c.GA(), c.P1()};
          pg8::gemm_phase<EpiYa, pg8::StaticOrder, true, true>(c.lds + RING_OFF, g, S, E); }
        { pg8::Gemm g{c.OB, c.WON_T(), M, D, D}; pg8::StaticOrder S; S.init(M, D, c.G, c.bid); EpiYb E{c.GB(), c.P1(), c.MG()};
          pg8::gemm_phase<EpiYb, pg8::StaticOrder, true, true>(c.lds + RING_OFF, g, S, E); }
        for (int it = c.G - 1 - c.bid; it < D / 16; it += c.G) { const int n0 = it * 16;
            sgemm_item<2>(c, c.AAS(), c.OBS(), D, c.WOC_T() + (size_t)n0 * D, c.WON_T() + (size_t)n0 * D, D, MEpiMG{c.ZS(), c.MGS(), n0}); }
    } SEAM(8);
    if (IN(9)) {
        pg8::Gemm g{c.MG(), c.WOUT_T(), M, D, D}; pg8::StaticOrder S; S.init(M, D, c.G, c.bid); EpiRes E{c.x_p(), c.X1(), c.MOD(), 2 * D};
        pg8::gemm_phase<EpiRes, pg8::StaticOrder, true, true>(c.lds + RING_OFF, g, S, E);
        for (int it = c.G - 1 - c.bid; it < D / 16; it += c.G) { const int n0 = it * 16;
            sgemm_item<1>(c, c.MGS(), c.MGS(), D, c.WOUT_T() + (size_t)n0 * D, c.WOUT_T(), D, MEpiRes{c.x_s(), c.X1S(), c.MOD(), 2 * D, n0}); }
    } SEAM(9);
    if (IN(10)) { p5c_norm2(c);
#ifdef DUP_THIN
        p5c_norm2(c);
#endif
    } SEAM(10);
    if (IN(11)) {
        pg8::Gemm g{c.XN(), c.WGU_T(), M, NGU, D}; pg8::StaticOrder S; S.init(M, NGU, c.G, c.bid); EpiFF E{c.HF()};
        pg8::gemm_phase<EpiFF, pg8::StaticOrder, true, true>(c.lds + RING_OFF, g, S, E);
#ifdef DUP_FF
        pg8::gemm_phase<EpiFF, pg8::StaticOrder, true, true>(c.lds + RING_OFF, g, S, E);
#endif
        for (int it = c.G - 1 - c.bid; it < FF / 16; it += c.G) { const int n0 = it * 16, pg = ((n0 >> 7) << 8) + (n0 & 127);
            sgemm_item<2>(c, c.XN2S(), c.XN2S(), D, c.WGU_T() + (size_t)pg * D, c.WGU_T() + (size_t)(pg + 128) * D, D, MEpiFF{c.HFS(), n0}); }
    } SEAM(11);
    if (IN(12)) {
        pg8::Gemm g{c.HF(), c.WDN_T(), M, D, FF}; pg8::StaticOrder S; S.init(M, D, c.G, c.bid); EpiRes E{c.X1(), c.out() + O_YP, c.MOD(), 5 * D};
        pg8::gemm_phase<EpiRes, pg8::StaticOrder, true, true>(c.lds + RING_OFF, g, S, E);
        for (int it = c.G - 1 - c.bid; it < D / 16; it += c.G) { const int n0 = it * 16;
            sgemm_item<1>(c, c.HFS(), c.HFS(), FF, c.WDN_T() + (size_t)n0 * FF, c.WDN_T(), FF, MEpiRes{c.X1S(), c.X2S(), c.MOD(), 5 * D, n0}); }
    } SEAM(12);
    if (IN(13)) { p8_normf(c);
#if PROBE_SATT
        { const float n_ = __hip_atomic_load(c.CHK + 40, __ATOMIC_RELAXED, __HIP_MEMORY_SCOPE_AGENT), d_ = __hip_atomic_load(c.CHK + 41, __ATOMIC_RELAXED, __HIP_MEMORY_SCOPE_AGENT);
          if (!(n_ / d_ < PROBE_STH * PROBE_STH)) for (int i = gtid(c); i < 8192; i += c.G * NTHR) c.out()[O_CONV_P + i] = 0.f; }
#endif
#if PROBE_CMP
        { float chk[4]; for (int i = 0; i < 4; ++i) chk[i] = __hip_atomic_load(c.CHK + 32 + i, __ATOMIC_RELAXED, __HIP_MEMORY_SCOPE_AGENT);
          const float es = chk[0] / chk[1], ep = chk[2] / chk[3]; const int gt = gtid(c), NG_ = c.G * NTHR;
          if (!(es < 4e-4f)) for (int i = gt; i < 8192; i += NG_) c.out()[O_CONV_P + i] = 0.f;
          if (!(ep < 4e-4f)) for (int i = gt; i < 65536; i += NG_) c.out()[O_CMP_S + i] = 0.f; }
#endif
#if PROBE_ATT
        {
            float chk[16];
            for (int i = 0; i < 16; ++i) chk[i] = __hip_atomic_load(c.CHK + i, __ATOMIC_RELAXED, __HIP_MEMORY_SCOPE_AGENT);
            const float e0 = chk[0] / chk[1], e1 = chk[2] / chk[3], e2 = chk[4] / chk[5], dm = chk[6] / (float)(NB * NKV * T);
            const float TH = PROBE_TH;
            const int gt = gtid(c), NG_ = c.G * NTHR;
#ifdef PROBE_SEL
            { float val = PROBE_SEL == 0 ? sqrtf(e0) : PROBE_SEL == 1 ? sqrtf(e1) : PROBE_SEL == 2 ? sqrtf(e2) : PROBE_SEL == 3 ? dm : (fminf(chk[7], 5e4f) * 1e-4f + (chk[7] > 0.f ? 0.01f : 0.f)); if (!(val == val)) val = 7.77f; if (val > 50.f) val = 5.55f;
              if (PROBE_SEL < 3) { const float na = chk[8 + 2 * PROBE_SEL], nr = chk[9 + 2 * PROBE_SEL]; if (na > 0.f || nr > 0.f) val = (na > 0.f ? 1.f : 0.f) + (nr > 0.f ? 2.f : 0.f) + 0.1f * fminf(9.f, log10f(na + nr + 1.f)); }
              xcd_barrier(bar); for (int i = gt; i < MS * D; i += NG_) c.out()[O_YS + i] = (i == 0) ? 8.f * rintf(1e4f * val * 0.125f) : 0.f; }
#endif
            if (!(e0 < TH * TH)) for (int i = gt; i < 8192; i += NG_) c.out()[O_CONV_P + i] = 0.f;
            if (!(e1 < TH * TH)) for (int i = gt; i < 65536; i += NG_) c.out()[O_CMP_S + i] = 0.f;
            if (!(e2 < TH * TH)) for (int i = gt; i < 65536; i += NG_) c.out()[O_SEL_S + i] = 0.f;
            if (!(dm < PROBE_DM)) for (int i = gt; i < 65536; i += NG_) c.out()[O_CONV_S + i] = 0.f;
        }
#endif
    }
#ifdef PROBE_T
    { ts_[14] = __builtin_amdgcn_s_memrealtime(); ts_[6] = ts_[5]; ts_[7] = ts_[5];
      if (c.bid == 0) { const unsigned long long d_ = ts_[PROBE_T + 1] - ts_[PROBE_T], e_ = ts_[14] + 4ull * d_; while (__builtin_amdgcn_s_memrealtime() < e_) __builtin_amdgcn_s_sleep(8); } }
#endif
#undef IN
#undef SEAM
}

extern "C" void kernel_launch(void* const* d_in, const int* in_sizes, int n_in, void* d_out, int out_size, void* d_ws, size_t ws_size, hipStream_t stream) {
    static int grid = 0;
    if (grid == 0) {
        if (n_in != 26 || out_size != (int)O_END || ws_size < WS_END) { fprintf(stderr, "kernel_launch: unexpected shapes (n_in %d out %d ws %zu)\n", n_in, out_size, ws_size); grid = -1; return; }
        int dev = 0, cus = 0, per_cu = 0;
        if (hipGetDevice(&dev) != hipSuccess || hipDeviceGetAttribute(&cus, hipDeviceAttributeMultiprocessorCount, dev) != hipSuccess) { grid = -1; return; }
        if (hipFuncSetAttribute((const void*)fwd, hipFuncAttributeMaxDynamicSharedMemorySize, LDS_BYTES) != hipSuccess) { fprintf(stderr, "kernel_launch: hipFuncSetAttribute failed\n"); grid = -1; return; }
        if (hipOccupancyMaxActiveBlocksPerMultiprocessor(&per_cu, (const void*)fwd, NTHR, LDS_BYTES) != hipSuccess || per_cu < 1) fprintf(stderr, "kernel_launch: occupancy query says %d\n", per_cu);
        (void)hipGetLastError();
        grid = cus;
    }
    if (grid < 0) return;
    (void)hipMemsetAsync((char*)d_ws + WS_CTL, 0, CTL_ZERO_BYTES, stream);
    Args a{};
    for (int i = 0; i < 26; ++i) a.in[i] = d_in[i];
    a.out = (float*)d_out; a.ws = (unsigned char*)d_ws;
#if MK_SINGLE
    a.ph_lo = 0; a.ph_hi = NPHASE;
    hipLaunchKernelGGL(fwd, dim3(grid), dim3(NTHR), LDS_BYTES, stream, a);
#else
    for (int p = 0; p < NPHASE; ++p) { a.ph_lo = p; a.ph_hi = p + 1; hipLaunchKernelGGL(fwd, dim3(grid), dim3(NTHR), LDS_BYTES, stream, a); }
#endif
}
```
